# Optimizing an MI355X kernel written in HIP

```python
import math
import jax, jax.numpy as jnp
from jax import lax
import numpy as np

D_MODEL = 1024
BATCH = 4
SEQ = 4096
DEPTH = 2

GRID_W = 64
CTX_LEN = 256
EPS = 1e-6
NEG_INF = -1e30
N_BRANCH = 3
BRANCH_WIDTH = D_MODEL // 2
HEAD_DIM = 64
N_HEADS = BRANCH_WIDTH // HEAD_DIM
N_KV_HEADS = 2
WINDOW = 128
BLOCK = 128
ROPE_THETA = 10000.0
ATTN_WIDTH = N_HEADS * HEAD_DIM
KV_WIDTH = N_KV_HEADS * HEAD_DIM
CONV_K = 3
POOL_SIZES = (2, 4, 8, 16)
N_POOL_GROUPS = 4
POOL_GROUP = BRANCH_WIDTH // N_POOL_GROUPS
Q_END = ATTN_WIDTH
K_END = Q_END + KV_WIDTH
V_END = K_END + KV_WIDTH
CX_END = V_END + BRANCH_WIDTH
CB_END = CX_END + BRANCH_WIDTH
CC_END = CB_END + BRANCH_WIDTH
POOL_END = CC_END + BRANCH_WIDTH
IN_WIDTH = POOL_END + N_BRANCH * D_MODEL
D_FF = 2816
N_EXPERTS = 8
TOP_K = 2
D_FF_EXPERT = 3584
N_DENSE = (DEPTH + 1) // 2
N_MOE = DEPTH // 2

kernel_name = 'hybrid_gated_dit_block'


def rmsnorm(x, g):
    xf = x.astype(jnp.float32)
    y = xf * lax.rsqrt(jnp.mean(xf * xf, axis=-1, keepdims=True) + EPS)
    return (y * g.astype(jnp.float32)).astype(x.dtype)


def modulate(h, shift, scale):
    return h * (1 + scale) + shift


def rope_2d(t, row, col):
    n_freq = HEAD_DIM // 4
    inv = ROPE_THETA ** (-jnp.arange(n_freq, dtype=jnp.float32) / n_freq)
    def rot(u, pos):
        ang = pos.astype(jnp.float32)[:, None] * inv[None, :]
        cos = jnp.cos(ang)[None, :, None, :].astype(u.dtype)
        sin = jnp.sin(ang)[None, :, None, :].astype(u.dtype)
        u1, u2 = u[..., :n_freq], u[..., n_freq:]
        return jnp.concatenate([u1 * cos - u2 * sin, u1 * sin + u2 * cos], axis=-1)
    half = HEAD_DIM // 2
    return jnp.concatenate([rot(t[..., :half], row), rot(t[..., half:], col)], axis=-1)


def split_heads(z):
    b, l, _ = z.shape
    q = z[..., :Q_END].reshape(b, l, N_HEADS, HEAD_DIM)
    k = z[..., Q_END:K_END].reshape(b, l, N_KV_HEADS, HEAD_DIM)
    v = z[..., K_END:V_END].reshape(b, l, N_KV_HEADS, HEAD_DIM)
    return q, k, v


def windowed_attention(q, k, v, kc, vc, sink):
    b, l, h, dh = q.shape
    nb = l // BLOCK
    grp = h // N_KV_HEADS
    scale = dh ** -0.5
    qb = q.reshape(b, nb, BLOCK, N_KV_HEADS, grp, dh)
    def band(t):
        tp = jnp.pad(t, ((0, 0), (BLOCK, BLOCK), (0, 0), (0, 0))).reshape(b, nb + 2, BLOCK, N_KV_HEADS, dh)
        return jnp.concatenate([tp[:, :-2], tp[:, 1:-1], tp[:, 2:]], axis=2)
    kw, vw = band(k), band(v)
    s_loc = jnp.einsum('bnqkgd,bnjkd->bnkgqj', qb, kw, preferred_element_type=jnp.float32) * scale
    blk = jnp.arange(nb)[:, None, None] * BLOCK
    qpos = blk + jnp.arange(BLOCK)[None, :, None]
    kpos = blk - BLOCK + jnp.arange(3 * BLOCK)[None, None, :]
    valid = (kpos >= 0) & (kpos < l) & (jnp.abs(qpos - kpos) <= WINDOW)
    s_loc = jnp.where(valid[None, :, None, None], s_loc, NEG_INF)
    s_ctx = jnp.einsum('bnqkgd,bckd->bnkgqc', qb, kc, preferred_element_type=jnp.float32) * scale
    s_sink = jnp.broadcast_to(sink.astype(jnp.float32).reshape(N_KV_HEADS, grp)[None, None, :, :, None, None],
                              s_ctx.shape[:-1] + (1,))
    p = jax.nn.softmax(jnp.concatenate([s_loc, s_ctx, s_sink], axis=-1), axis=-1).astype(v.dtype)
    lc = kc.shape[1]
    o = (jnp.einsum('bnkgqj,bnjkd->bnqkgd', p[..., :3 * BLOCK], vw)
         + jnp.einsum('bnkgqc,bckd->bnqkgd', p[..., 3 * BLOCK:3 * BLOCK + lc], vc))
    return o.reshape(b, l, h * dh)


def context_attention(qc, kc, vc, sink):
    b, lc, h, dh = qc.shape
    grp = h // N_KV_HEADS
    qg = qc.reshape(b, lc, N_KV_HEADS, grp, dh)
    s = jnp.einsum('bqkgd,bckd->bkgqc', qg, kc, preferred_element_type=jnp.float32) * (dh ** -0.5)
    s_sink = jnp.broadcast_to(sink.astype(jnp.float32).reshape(N_KV_HEADS, grp)[None, :, :, None, None],
                              s.shape[:-1] + (1,))
    p = jax.nn.softmax(jnp.concatenate([s, s_sink], axis=-1), axis=-1).astype(vc.dtype)
    o = jnp.einsum('bkgqc,bckd->bqkgd', p[..., :lc], vc)
    return o.reshape(b, lc, h * dh)


def short_conv(u, w):
    up = jnp.pad(u, ((0, 0), (1, 1), (0, 0)))
    return up[:, :-2] * w[0] + up[:, 1:-1] * w[1] + up[:, 2:] * w[2]


def pool_mixer(u, pool_w, pool_scale):
    b, l, ch = u.shape
    uf = u.astype(jnp.float32)
    csum = jnp.concatenate([jnp.zeros((b, 1, ch), jnp.float32), jnp.cumsum(uf, axis=1)], axis=1)
    t = jnp.arange(l)
    means = []
    for gi, w in enumerate(POOL_SIZES):
        lo = jnp.clip(t - w // 2, 0, l)
        hi = jnp.clip(t + w // 2, 0, l)
        cs = csum[..., gi * POOL_GROUP:(gi + 1) * POOL_GROUP]
        means.append((cs[:, hi] - cs[:, lo]) / (hi - lo).astype(jnp.float32)[None, :, None])
    d = (jnp.concatenate(means, axis=-1) - uf).astype(u.dtype).reshape(b, l, N_POOL_GROUPS, POOL_GROUP)
    y = jnp.einsum('blgc,gcd->blgd', d, pool_w).reshape(b, l, ch)
    return y * pool_scale


def local_mixers(z, conv_w, pool_w, pool_scale):
    cx, cb, cc = z[..., V_END:CX_END], z[..., CX_END:CB_END], z[..., CB_END:CC_END]
    conv_out = cb * short_conv(cc * cx, conv_w)
    pool_out = pool_mixer(z[..., CC_END:POOL_END], pool_w, pool_scale)
    return conv_out, pool_out


def merge_branches(attn_out, conv_out, pool_out, gate_logits, w_branch, w_out):
    g = jax.nn.sigmoid(gate_logits.astype(jnp.float32)).astype(attn_out.dtype)
    y = (g[..., :D_MODEL] * (attn_out @ w_branch[0])
         + g[..., D_MODEL:2 * D_MODEL] * (conv_out @ w_branch[1])
         + g[..., 2 * D_MODEL:] * (pool_out @ w_branch[2]))
    return y @ w_out


def swiglu(h, w_gu, w_down, d_ff):
    gu = h @ w_gu
    return (jax.nn.silu(gu[..., :d_ff]) * gu[..., d_ff:]) @ w_down


def moe_ffn(h, router_w, w_gu, w_down):
    b, l, d = h.shape
    t = h.reshape(b * l, d)
    logits = (t @ router_w).astype(jnp.float32)
    top_v, top_i = lax.top_k(logits, TOP_K)
    wts = jax.nn.softmax(top_v, axis=-1)
    combine = jnp.sum(jax.nn.one_hot(top_i, N_EXPERTS, dtype=jnp.float32) * wts[..., None], axis=1)
    combine = combine.astype(h.dtype)
    out = jnp.zeros_like(t)
    for e in range(N_EXPERTS):
        out = out + combine[:, e:e + 1] * swiglu(t, w_gu[e], w_down[e], D_FF_EXPERT)
    return out.reshape(b, l, d)


def setup_inputs(seed: int = 0) -> dict:
    key = jax.random.key(seed)
    ks = jax.random.split(key, 21)
    f32 = jnp.float32
    def nrm(k, shape, scale):
        return jax.random.normal(k, shape, f32) * scale
    D = D_MODEL
    return {
        'x': nrm(ks[0], (BATCH, SEQ, D), 1.0),
        'c': nrm(ks[1], (BATCH, D), 1.0),
        'ctx': nrm(ks[2], (BATCH, CTX_LEN, D), 1.0),
        'c_ctx': nrm(ks[3], (D,), 1.0),
        'norm1_g': 1.0 + nrm(ks[4], (DEPTH, D), 0.1),
        'norm2_g': 1.0 + nrm(ks[5], (DEPTH, D), 0.1),
        'final_g': 1.0 + nrm(ks[6], (D,), 0.1),
        'w_mod': nrm(ks[7], (DEPTH, D, 6 * D), 0.5 * D ** -0.5),
        'b_mod': nrm(ks[8], (DEPTH, 6 * D), 0.02),
        'w_in': nrm(ks[9], (DEPTH, D, IN_WIDTH), D ** -0.5),
        'conv_w': nrm(ks[10], (DEPTH, CONV_K, BRANCH_WIDTH), CONV_K ** -0.5),
        'sink': nrm(ks[11], (DEPTH, N_HEADS), 1.0),
        'pool_w': nrm(ks[12], (DEPTH, N_POOL_GROUPS, POOL_GROUP, POOL_GROUP), POOL_GROUP ** -0.5),
        'pool_scale': 1.0 + nrm(ks[13], (DEPTH, BRANCH_WIDTH), 0.1),
        'w_branch': nrm(ks[14], (DEPTH, N_BRANCH, BRANCH_WIDTH, D), BRANCH_WIDTH ** -0.5),
        'w_out': nrm(ks[15], (DEPTH, D, D), D ** -0.5),
        'ffn_w_gu': nrm(ks[16], (N_DENSE, D, 2 * D_FF), D ** -0.5),
        'ffn_w_down': nrm(ks[17], (N_DENSE, D_FF, D), D_FF ** -0.5),
        'router_w': nrm(ks[18], (N_MOE, D, N_EXPERTS), D ** -0.5),
        'moe_w_gu': nrm(ks[19], (N_MOE, N_EXPERTS, D, 2 * D_FF_EXPERT), D ** -0.5),
        'moe_w_down': nrm(ks[20], (N_MOE, N_EXPERTS, D_FF_EXPERT, D), D_FF_EXPERT ** -0.5),
    }


def reference(x, c, ctx, c_ctx, norm1_g, norm2_g, final_g, w_mod, b_mod, w_in, conv_w, sink,
              pool_w, pool_scale, w_branch, w_out, ffn_w_gu, ffn_w_down, router_w, moe_w_gu, moe_w_down):
    L = x.shape[1]
    ROWS = L // GRID_W
    row = jnp.repeat(jnp.arange(ROWS), GRID_W)
    col = jnp.tile(jnp.arange(GRID_W), ROWS)
    s_lat = jax.nn.silu(c)[:, None, :]
    s_ctx = jax.nn.silu(c_ctx)[None, None, :]
    xc = ctx
    for l in range(DEPTH):
        last = l == DEPTH - 1
        sh1, sc1, g1, sh2, sc2, g2 = jnp.split(s_lat @ w_mod[l] + b_mod[l], 6, axis=-1)
        csh1, csc1, cg1, csh2, csc2, cg2 = jnp.split(s_ctx @ w_mod[l] + b_mod[l], 6, axis=-1)
        if l % 2 == 0:
            ffn = functools_partial_dense(ffn_w_gu[l // 2], ffn_w_down[l // 2])
        else:
            ffn = functools_partial_moe(router_w[l // 2], moe_w_gu[l // 2], moe_w_down[l // 2])
        hc = modulate(rmsnorm(xc, norm1_g[l]), csh1, csc1)
        if last:
            zkv = hc @ w_in[l][:, Q_END:V_END]
            kc = zkv[..., :KV_WIDTH].reshape(xc.shape[0], xc.shape[1], N_KV_HEADS, HEAD_DIM)
            vc = zkv[..., KV_WIDTH:].reshape(xc.shape[0], xc.shape[1], N_KV_HEADS, HEAD_DIM)
        else:
            zc = hc @ w_in[l]
            qc, kc, vc = split_heads(zc)
            attn_c = context_attention(qc, kc, vc, sink[l])
            conv_c, pool_c = local_mixers(zc, conv_w[l], pool_w[l], pool_scale[l])
            xc_mid = xc + cg1 * merge_branches(attn_c, conv_c, pool_c, zc[..., POOL_END:], w_branch[l], w_out[l])
        h = modulate(rmsnorm(x, norm1_g[l]), sh1, sc1)
        z = h @ w_in[l]
        q, k, v = split_heads(z)
        q, k = rope_2d(q, row, col), rope_2d(k, row, col)
        attn = windowed_attention(q, k, v, kc, vc, sink[l])
        conv_o, pool_o = local_mixers(z, conv_w[l], pool_w[l], pool_scale[l])
        x = x + g1 * merge_branches(attn, conv_o, pool_o, z[..., POOL_END:], w_branch[l], w_out[l])
        x = x + g2 * ffn(modulate(rmsnorm(x, norm2_g[l]), sh2, sc2))
        if not last:
            xc = xc_mid + cg2 * ffn(modulate(rmsnorm(xc_mid, norm2_g[l]), csh2, csc2))
    return rmsnorm(x, final_g)


def functools_partial_dense(w_gu, w_down):
    def f(h):
        return swiglu(h, w_gu, w_down, D_FF)
    return f


def functools_partial_moe(r_w, w_gu, w_down):
    def f(h):
        return moe_ffn(h, r_w, w_gu, w_down)
    return f
```

```cpp
#include <hip/hip_runtime.h>
#include <cstdio>
#include <cstdint>

#ifndef MK_FUSED
#define MK_FUSED 0
#endif

#define LAS __attribute__((address_space(3)))
#define GAS __attribute__((address_space(1)))
typedef unsigned short bf16;
typedef short bf16x8 __attribute__((ext_vector_type(8)));
typedef float f32x4 __attribute__((ext_vector_type(4)));
typedef float f32x2 __attribute__((ext_vector_type(2)));
typedef unsigned u32x4 __attribute__((ext_vector_type(4)));
typedef unsigned u32x2 __attribute__((ext_vector_type(2)));
typedef GAS unsigned gu32;

constexpr int D = 1024, NB = 4, SEQ = 4096, ML = NB * SEQ, CTXL = 256, MC = NB * CTXL, MT = ML + MC;
constexpr int INW = 5888, DFF = 2816, DFE = 3584, NE = 8;
constexpr int ZQ = 0, ZK = 512, ZV = 640, ZCX = 768, ZCB = 1280, ZCC = 1792, ZPU = 2304, ZG = 2816;
constexpr int MIXW = 1536;
constexpr int MS = 2 * ML + NE * 256;
constexpr int MODW = 6 * D;
constexpr float EPS = 1e-6f;
constexpr int NWAVES = 8, NTHR = 512;

__device__ __forceinline__ unsigned f2bf(float f) { unsigned u = __builtin_bit_cast(unsigned, f); return (u + 0x7fffu + ((u >> 16) & 1u)) >> 16; }
__device__ __forceinline__ unsigned pk2(float lo, float hi) { return f2bf(lo) | (f2bf(hi) << 16); }
__device__ __forceinline__ float bf2f(unsigned b) { return __builtin_bit_cast(float, b << 16); }
__device__ __forceinline__ float bflo(unsigned w) { return __builtin_bit_cast(float, w << 16); }
__device__ __forceinline__ float bfhi(unsigned w) { return __builtin_bit_cast(float, w & 0xffff0000u); }

namespace pg8 {
constexpr int BM = 256, BK = 64, HALF = 128, HTB = HALF * BK * 2, STAGE_BYTES = 8 * HTB, NXCD = 8, WGM = 8;
__host__ __device__ __forceinline__ int lds_byte(int r, int c) { const int st = (r >> 4) * 2 + (c >> 5), rr = r & 15, cc = c & 31, ob = rr * 64 + cc * 2; return st * 1024 + (ob ^ (((ob >> 9) & 1) << 5)); }
__host__ __device__ __forceinline__ void stage_rc(int b, int& R, int& C) { const int st = b / 1024, sb = b % 1024, swz = sb ^ (((sb >> 9) & 1) << 5); R = (st >> 1) * 16 + swz / 64; C = (st & 1) * 32 + (swz % 64) / 2; }
__host__ __device__ __forceinline__ int perm32(int rho) { const int n = rho >> 4, i = rho & 15; return 8 * (i >> 2) + 4 * n + (i & 3); }

struct Unit { int pm, pn, tag; const char* a; const char* b; };

__device__ __forceinline__ void tile_of(int L, int nM, int nN, int& pm, int& pn) {
    const int nwg = nM * nN; int wgid = L;
    { const int q = nwg / NXCD, r = nwg % NXCD, xcd = wgid % NXCD, off = wgid / NXCD; wgid = (xcd < r ? xcd * (q + 1) : r * (q + 1) + (xcd - r) * q) + off; }
    const int nig = WGM * nN, gid = wgid / nig, fm = gid * WGM, gsz = (nM - fm) < WGM ? (nM - fm) : WGM;
    pm = fm + ((wgid % nig) % gsz); pn = (wgid % nig) / gsz;
}

__device__ __forceinline__ unsigned cvt_pk_bf16(float lo, float hi) { unsigned r; asm volatile("v_cvt_pk_bf16_f32 %0, %1, %2" : "=v"(r) : "v"(lo), "v"(hi)); return r; }

template <class Epi, class Sched, bool ALIGN_EPI = false, bool SP2 = false>
__device__ __forceinline__ void gemm_phase(LAS unsigned char* lds, const int lda, const int ldb, const int K, const Sched& S, const Epi& E) {
    int tid_ = threadIdx.x; asm volatile("" : "+v"(tid_));
    const int tid = tid_, wid = __builtin_amdgcn_readfirstlane(tid >> 6), lane = tid & 63, wr = wid >> 2, wc = wid & 3, fr = lane & 15, fq = lane >> 4;
    const int nt = K / BK;
    unsigned voffA[2], voffB[2];
#pragma unroll
    for (int i = 0; i < 2; ++i) { int R, C; stage_rc(tid * 16 + i * 8192, R, C); const int Rb = Epi::PERM ? ((R & ~31) + perm32(R & 31)) : R;
        voffA[i] = (unsigned)(R * lda + C) * 2u; voffB[i] = (unsigned)(Rb * ldb + C) * 2u; }
    const size_t kstep = (size_t)(BK * 2);
    const size_t hstepA = (size_t)HALF * lda * 2, hstepB = (size_t)HALF * ldb * 2;
    const unsigned ldsw = (unsigned)wid * 1024u;
    const int aoff = lds_byte(wr * 64 + fr, fq * 8), boff = lds_byte(wc * 32 + fr, fq * 8);
#define PG8_SA(b, h) (((b) * 2 + (h)) * HTB)
#define PG8_SB(b, h) ((4 + (b) * 2 + (h)) * HTB)
#define PG8_STAGE(bufoff, gbase, voff) do { _Pragma("unroll") for (int _i = 0; _i < 2; ++_i) \
        __builtin_amdgcn_global_load_lds((const unsigned*)((const char*)(gbase) + (voff)[_i]), (LAS unsigned*)(lds + (bufoff) + ldsw + _i * 8192), 16, 0, 0); } while (0)
#define PG8_LDA(dst, b, h) do { _Pragma("unroll") for (int m = 0; m < 4; ++m) _Pragma("unroll") for (int k = 0; k < 2; ++k) dst[m][k] = *(const LAS bf16x8*)(lds + PG8_SA(b, h) + aoff + m * 2048 + k * 1024); } while (0)
#define PG8_LDB(dst, b, h) do { _Pragma("unroll") for (int n = 0; n < 2; ++n) _Pragma("unroll") for (int k = 0; k < 2; ++k) dst[n][k] = *(const LAS bf16x8*)(lds + PG8_SB(b, h) + boff + n * 2048 + k * 1024); } while (0)
#define PG8_MMA(ai, bj, At, Bt) do { __builtin_amdgcn_s_setprio(1); _Pragma("unroll") for (int m = 0; m < 4; ++m) _Pragma("unroll") for (int n = 0; n < 2; ++n) _Pragma("unroll") for (int k = 0; k < 2; ++k) \
        acc[ai][bj][m][n] = __builtin_amdgcn_mfma_f32_16x16x32_bf16(Bt[n][k], At[m][k], acc[ai][bj][m][n], 0, 0, 0); __builtin_amdgcn_s_setprio(0); } while (0)
#define PG8_WAIT_V(n) asm volatile("s_waitcnt vmcnt(" #n ")" ::: "memory")
#define PG8_WAIT_L(n) asm volatile("s_waitcnt lgkmcnt(" #n ")" ::: "memory")
#define PG8_BAR __builtin_amdgcn_s_barrier()
#define PG8_SCHED __builtin_amdgcn_sched_barrier(0)
    Unit cur, nxt; int ui = 0;
    if (!S.next(0, cur)) return;
    f32x4 acc[2][2][4][2];
#pragma unroll
    for (int a = 0; a < 2; ++a)
#pragma unroll
        for (int b = 0; b < 2; ++b)
#pragma unroll
            for (int m = 0; m < 4; ++m)
#pragma unroll
                for (int n = 0; n < 2; ++n) acc[a][b][m][n] = (f32x4){0.f, 0.f, 0.f, 0.f};
    bf16x8 At[4][2], B0[2][2], B1[2][2];
    const char* cA = cur.a; const char* cB = cur.b;
    if constexpr (SP2) {
        PG8_STAGE(PG8_SB(0, 0), cB, voffB); PG8_STAGE(PG8_SB(0, 1), cB + hstepB, voffB); PG8_STAGE(PG8_SA(0, 0), cA, voffA); PG8_STAGE(PG8_SA(0, 1), cA + hstepA, voffA);
        if (wr == 1) PG8_BAR;
        PG8_WAIT_V(2); PG8_BAR;
        PG8_STAGE(PG8_SB(1, 0), cB + kstep, voffB); PG8_STAGE(PG8_SA(1, 0), cA + kstep, voffA); PG8_STAGE(PG8_SB(1, 1), cB + hstepB + kstep, voffB);
        PG8_WAIT_V(6); PG8_BAR;
    } else {
        PG8_STAGE(PG8_SB(0, 0), cB, voffB); PG8_STAGE(PG8_SA(0, 0), cA, voffA); PG8_STAGE(PG8_SB(0, 1), cB + hstepB, voffB); PG8_STAGE(PG8_SA(0, 1), cA + hstepA, voffA);
        if (wr == 1) PG8_BAR;
        PG8_WAIT_V(4); PG8_BAR;
        PG8_STAGE(PG8_SB(1, 0), cB + kstep, voffB); PG8_STAGE(PG8_SA(1, 0), cA + kstep, voffA); PG8_STAGE(PG8_SB(1, 1), cB + hstepB + kstep, voffB);
        PG8_WAIT_V(6); PG8_BAR;
    }
    for (;;) {
        const bool has_next = S.next(ui + 1, nxt);
        const char* nA = has_next ? nxt.a : cA; const char* nB = has_next ? nxt.b : cB;
        for (int t = 0; t < nt; t += 2) {
            const bool last = (t == nt - 2);
            const char* a1 = cA + (size_t)(t + 1) * kstep;
            const char* a2 = last ? nA : cA + (size_t)(t + 2) * kstep; const char* b2 = last ? nB : cB + (size_t)(t + 2) * kstep;
            const char* a3 = a2 + kstep; const char* b3 = b2 + kstep;
            if constexpr (SP2) {
            PG8_LDB(B0, 0, 0); PG8_LDB(B1, 0, 1); PG8_SCHED; PG8_LDA(At, 0, 0); PG8_STAGE(PG8_SA(1, 1), a1 + hstepA, voffA);
            PG8_WAIT_V(8); PG8_WAIT_L(0); PG8_BAR; PG8_MMA(0, 0, At, B0); PG8_MMA(0, 1, At, B1); PG8_BAR; PG8_SCHED;
            PG8_LDA(At, 0, 1); PG8_STAGE(PG8_SB(0, 0), b2, voffB); PG8_STAGE(PG8_SB(0, 1), b2 + hstepB, voffB); PG8_STAGE(PG8_SA(0, 0), a2, voffA);
            PG8_WAIT_V(8); PG8_WAIT_L(0); PG8_BAR; PG8_MMA(1, 0, At, B0); PG8_MMA(1, 1, At, B1); PG8_BAR; PG8_SCHED;
            PG8_LDB(B0, 1, 0); PG8_LDB(B1, 1, 1); PG8_SCHED; PG8_LDA(At, 1, 0); PG8_STAGE(PG8_SA(0, 1), a2 + hstepA, voffA);
            PG8_WAIT_V(8); PG8_WAIT_L(0); PG8_BAR; PG8_MMA(0, 0, At, B0); PG8_MMA(0, 1, At, B1); PG8_BAR; PG8_SCHED;
            PG8_LDA(At, 1, 1); PG8_STAGE(PG8_SB(1, 0), b3, voffB); PG8_STAGE(PG8_SB(1, 1), b3 + hstepB, voffB); PG8_STAGE(PG8_SA(1, 0), a3, voffA);
            PG8_WAIT_V(8); PG8_WAIT_L(0); PG8_BAR; PG8_MMA(1, 0, At, B0); PG8_MMA(1, 1, At, B1); PG8_BAR; PG8_SCHED;
            } else {
            PG8_LDB(B0, 0, 0); PG8_SCHED; PG8_LDA(At, 0, 0); PG8_STAGE(PG8_SA(1, 1), a1 + hstepA, voffA);
            PG8_WAIT_L(8); PG8_BAR; PG8_WAIT_L(0); PG8_MMA(0, 0, At, B0); PG8_BAR; PG8_SCHED;
            PG8_LDB(B1, 0, 1); PG8_STAGE(PG8_SB(0, 0), b2, voffB);
            PG8_BAR; PG8_WAIT_L(0); PG8_MMA(0, 1, At, B1); PG8_BAR;
            PG8_LDA(At, 0, 1); PG8_STAGE(PG8_SA(0, 0), a2, voffA);
            PG8_BAR; PG8_WAIT_L(0); PG8_MMA(1, 0, At, B0); PG8_BAR; PG8_SCHED;
            PG8_STAGE(PG8_SB(0, 1), b2 + hstepB, voffB);
            PG8_WAIT_V(6); PG8_BAR; PG8_MMA(1, 1, At, B1); PG8_BAR;
            PG8_LDB(B0, 1, 0); PG8_SCHED; PG8_LDA(At, 1, 0); PG8_STAGE(PG8_SA(0, 1), a2 + hstepA, voffA);
            PG8_WAIT_L(8); PG8_BAR; PG8_WAIT_L(0); PG8_MMA(0, 0, At, B0); PG8_BAR; PG8_SCHED;
            PG8_LDB(B1, 1, 1); PG8_STAGE(PG8_SB(1, 0), b3, voffB);
            PG8_BAR; PG8_WAIT_L(0); PG8_MMA(0, 1, At, B1); PG8_BAR;
            PG8_LDA(At, 1, 1); PG8_STAGE(PG8_SA(1, 0), a3, voffA);
            PG8_BAR; PG8_WAIT_L(0); PG8_MMA(1, 0, At, B0); PG8_BAR; PG8_SCHED;
            PG8_STAGE(PG8_SB(1, 1), b3 + hstepB, voffB);
            PG8_WAIT_V(6); PG8_BAR; PG8_MMA(1, 1, At, B1); PG8_BAR;
            }
        }
        if constexpr (ALIGN_EPI) { if (wr == 0) PG8_BAR; }
        E(acc, cur, wr, wc, fr, fq);
        if (!has_next) break;
#pragma unroll
        for (int a = 0; a < 2; ++a)
#pragma unroll
            for (int b = 0; b < 2; ++b)
#pragma unroll
                for (int m = 0; m < 4; ++m)
#pragma unroll
                    for (int n = 0; n < 2; ++n) acc[a][b][m][n] = (f32x4){0.f, 0.f, 0.f, 0.f};
        cur = nxt; cA = nA; cB = nB; ++ui;
        if constexpr (ALIGN_EPI) { if (wr == 1) PG8_BAR; }
    }
    PG8_WAIT_V(0);
    if constexpr (!ALIGN_EPI) { if (wr == 0) PG8_BAR; }
    PG8_BAR;
#undef PG8_SA
#undef PG8_SB
#undef PG8_STAGE
#undef PG8_LDA
#undef PG8_LDB
#undef PG8_MMA
#undef PG8_WAIT_V
#undef PG8_WAIT_L
#undef PG8_BAR
#undef PG8_SCHED
}
}

constexpr size_t MiB = 1u << 20;
constexpr size_t al256(size_t x) { return (x + 255) & ~(size_t)255; }
constexpr size_t WS_CTL = 0, CTL_ZERO_BYTES = 1 * MiB;
constexpr size_t WS_MODV = 1 * MiB;
constexpr size_t WS_ROPE = WS_MODV + al256((size_t)2 * 5 * MODW * 4);
constexpr size_t WS_CNTWG = WS_ROPE + al256(64 * 16 * 2 * 4);
constexpr size_t WS_TOKE = WS_CNTWG + al256(256 * 8 * 4);
constexpr size_t WS_TOKP = WS_TOKE + al256((size_t)ML * 2 * 4);
constexpr size_t WS_TOKW = WS_TOKP + al256((size_t)ML * 2 * 4);
constexpr size_t WS_TOKS = WS_TOKW + al256((size_t)ML * 2 * 4);
constexpr size_t WS_TILE = WS_TOKS + al256((size_t)ML * 2 * 4);
constexpr size_t WS_WIN = 4 * MiB;
constexpr size_t WS_WBR = WS_WIN + (size_t)2 * INW * D * 2;
constexpr size_t WS_WOUT = WS_WBR + (size_t)2 * 3 * D * 512 * 2;
constexpr size_t WS_WGU0 = WS_WOUT + (size_t)2 * D * D * 2;
constexpr size_t WS_WDN0 = WS_WGU0 + (size_t)2 * DFF * D * 2;
constexpr size_t WS_WMGU = WS_WDN0 + (size_t)D * DFF * 2;
constexpr size_t WS_WMDN = WS_WMGU + (size_t)NE * 2 * DFE * D * 2;
constexpr size_t WS_H = WS_WMDN + (size_t)NE * D * DFE * 2;
constexpr size_t WS_Z = WS_H + (size_t)MT * D * 2;
constexpr size_t WS_MIX = WS_Z + (size_t)MT * INW * 2;
constexpr size_t WS_ACT = WS_Z;
constexpr size_t WS_YACC = WS_MIX + (size_t)MT * MIXW * 2;
constexpr size_t WS_H2S = WS_YACC;
constexpr size_t WS_Y = WS_YACC + (size_t)MT * D * 4;
constexpr size_t WS_X1 = WS_Y + (size_t)MT * D * 2;
constexpr size_t WS_X2 = WS_X1 + (size_t)MT * D * 4;
constexpr size_t WS_YS = WS_X2;
constexpr size_t WS_END = WS_X2 + (size_t)MT * D * 4;
static_assert((size_t)MS * DFE * 2 <= (size_t)MT * INW * 2 + (size_t)MT * MIXW * 2, "ACT overlay");
static_assert((size_t)MS * D * 2 <= (size_t)MT * D * 4, "H2S / YS overlays");
static_assert(WS_TILE + 1024 <= WS_WIN, "small tables");
constexpr int CW_BAR = 4096;

constexpr int RING_BYTES = 131072;
constexpr int LDSCTL_OFF = RING_BYTES, MISC_OFF = LDSCTL_OFF + 320;
constexpr int LDS_BYTES = 147456;

#define XB_TMO      128
#define XB_XCNT(j)  (256  + 64 * (j))
#define XB_XSUB(j)  (1280 + 64 * (j))
#define XB_XGEN(j)  (2304 + 64 * (j))
#define XB_TOP      3328
#define XB_TOPGEN   3392
#define XCD_BAR_WORDS 3456
#define XB_SPIN_CAP (1u << 18)
__device__ __forceinline__ unsigned xb_ld(unsigned* p)              { return __hip_atomic_load(p, __ATOMIC_RELAXED, __HIP_MEMORY_SCOPE_AGENT); }
__device__ __forceinline__ unsigned xb_add(unsigned* p, unsigned v) { return __hip_atomic_fetch_add(p, v, __ATOMIC_RELAXED, __HIP_MEMORY_SCOPE_AGENT); }
__device__ __forceinline__ unsigned xb_xcc_id() { return (unsigned)__builtin_amdgcn_s_getreg((3 << 11) | 20) & 0xFu; }
#define XB_SPIN(cond, bar) do { unsigned _sp = 0; while (cond) { __builtin_amdgcn_s_sleep(1); \
    if ((++_sp & 255u) == 0u) { if (xb_ld(&(bar)[XB_TMO])) break; if (_sp > XB_SPIN_CAP) { atomicAdd(&(bar)[XB_TMO], 1u); break; } } } } while (0)
struct XcdBarrier { unsigned* bar; unsigned x; volatile LAS unsigned* st; };
__device__ __forceinline__ XcdBarrier xcd_barrier_post(unsigned* bar, volatile LAS unsigned* st) {
    XcdBarrier b; b.bar = bar; b.x = xb_xcc_id(); b.st = st;
    if (threadIdx.x == 0) (void)xb_add(&bar[XB_XCNT(b.x)], 1u);
    return b;
}
__device__ __forceinline__ void xcd_barrier_complete(unsigned* bar, unsigned x, unsigned& nloc, unsigned& nx) {
    const unsigned G = gridDim.x * gridDim.y * gridDim.z;
    unsigned sum, cnt, mine, sp = 0u;
    for (;;) {
        sum = 0u; cnt = 0u; mine = 0u;
#pragma unroll
        for (unsigned j = 0; j < 16; ++j) { const unsigned c = xb_ld(&bar[XB_XCNT(j)]); sum += c; cnt += (c > 0u) ? 1u : 0u; mine = (j == x) ? c : mine; }
        if (sum == G) break;
        __builtin_amdgcn_s_sleep(1);
        if ((++sp & 255u) == 0u) { if (xb_ld(&bar[XB_TMO])) break; if (sp > XB_SPIN_CAP) { atomicAdd(&bar[XB_TMO], 1u); break; } }
    }
    nloc = mine > 0u ? mine : 1u; nx = cnt > 0u ? cnt : 1u;
}
__device__ __attribute__((noinline)) void xcd_barrier_leader(unsigned* bar, unsigned bx_, volatile LAS unsigned* st) {
    {
        XcdBarrier b; b.bar = bar; b.x = bx_; b.st = st;
        __builtin_amdgcn_s_waitcnt(0);
        unsigned nloc = b.st[0], nx = b.st[1];
        if (nloc == 0u) { xcd_barrier_complete(bar, b.x, nloc, nx); b.st[0] = nloc; b.st[1] = nx; }
        const unsigned old = xb_add(&bar[XB_XSUB(b.x)], 1u);
        const unsigned gen = old / nloc;
        if (old + 1u == (gen + 1u) * nloc) {
            __builtin_amdgcn_fence(__ATOMIC_RELEASE, "agent");
            asm volatile("s_waitcnt vmcnt(0)" ::: "memory");
            const unsigned og = xb_add(&bar[XB_TOP], 1u);
            const unsigned tg = og / nx;
            if (og + 1u == (tg + 1u) * nx) xb_add(&bar[XB_TOPGEN], 1u);
            else XB_SPIN(xb_ld(&bar[XB_TOPGEN]) == tg, bar);
            __builtin_amdgcn_fence(__ATOMIC_ACQUIRE, "agent");
            xb_add(&bar[XB_XGEN(b.x)], 1u);
            asm volatile("s_waitcnt vmcnt(0)" ::: "memory");
        } else {
            XB_SPIN(xb_ld(&bar[XB_XGEN(b.x)]) == gen, bar);
            __builtin_amdgcn_fence(__ATOMIC_ACQUIRE, "agent");
            asm volatile("s_waitcnt vmcnt(0)" ::: "memory");
        }
    }
}
__device__ __forceinline__ void xcd_barrier(const XcdBarrier& b) {
    asm volatile("s_waitcnt vmcnt(0)" ::: "memory");
    __syncthreads();
    if (threadIdx.x == 0) xcd_barrier_leader(b.bar, b.x, b.st);
    __syncthreads();
}

struct Args {
    const float *x, *c, *ctx, *c_ctx, *norm1_g, *norm2_g, *final_g, *w_mod, *b_mod, *w_in, *conv_w, *sink, *pool_w, *pool_scale, *w_branch, *w_out,
                *ffn_w_gu, *ffn_w_down, *router_w, *moe_w_gu, *moe_w_down;
    float* out; unsigned char* ws; int ph_lo, ph_hi;
};
template <int OFF> __device__ __forceinline__ const void* karg_p() { const void* r; asm volatile("s_load_dwordx2 %0, %1, %2\n\ts_waitcnt lgkmcnt(0)" : "=s"(r) : "s"(__builtin_amdgcn_kernarg_segment_ptr()), "i"(OFF)); return r; }
template <int OFF> __device__ __forceinline__ int karg_i() { int r; asm volatile("s_load_dword %0, %1, %2\n\ts_waitcnt lgkmcnt(0)" : "=s"(r) : "s"(__builtin_amdgcn_kernarg_segment_ptr()), "i"(OFF)); return r; }
#define KP(field) ((const float*)karg_p<(int)__builtin_offsetof(Args, field)>())
struct Frame {
    LAS unsigned char* lds;
    int tid, lane, wave, G, bx;
    unsigned char* ws;
};
__device__ __forceinline__ float wave_sum(float v) {
#pragma unroll
    for (int o = 1; o < 64; o <<= 1) v += __shfl_xor(v, o);
    return v;
}
__device__ __forceinline__ float wave_max(float v) {
#pragma unroll
    for (int o = 1; o < 64; o <<= 1) v = fmaxf(v, __shfl_xor(v, o));
    return v;
}
#define LDS_WAIT() asm volatile("s_waitcnt lgkmcnt(0)" ::: "memory")

__device__ __forceinline__ void p0_transpose_item(const float* W, int ldw, int K, bf16* WT, int k0, int n0, int drow0, LAS float* scr, int lane) {
#pragma unroll 8
    for (int i = 0; i < 32; ++i) { const int kk = 2 * i + (lane >> 5); scr[kk * 33 + (lane & 31)] = W[(size_t)(k0 + kk) * ldw + n0 + (lane & 31)]; }
    LDS_WAIT(); asm volatile("" ::: "memory");
    const int c = lane & 7;
#pragma unroll
    for (int j = 0; j < 4; ++j) { const int n = (lane >> 3) + 8 * j; const LAS float* s = scr + (8 * c) * 33 + n;
        u32x4 o; o.x = pk2(s[0 * 33], s[1 * 33]); o.y = pk2(s[2 * 33], s[3 * 33]); o.z = pk2(s[4 * 33], s[5 * 33]); o.w = pk2(s[6 * 33], s[7 * 33]);
        *(u32x4*)(WT + (size_t)(drow0 + n) * K + k0 + 8 * c) = o; }
    LDS_WAIT(); asm volatile("" ::: "memory");
}
__device__ __forceinline__ void p0_job_item(const float* W, int K, int N, bf16* WT, int IL, int item, LAS float* scr, int lane) {
    const int nblk = N / 32, kb = item / nblk, nb = item % nblk, n0 = 32 * nb;
    int drow0 = n0;
    if (IL > 0) { const int half = n0 >= IL ? 1 : 0, f = n0 - half * IL; drow0 = 256 * (f / 128) + 128 * half + (f % 128); }
    p0_transpose_item(W, N, K, WT, 64 * kb, n0, drow0, scr, lane);
}
__device__ __forceinline__ void p0_prologue(Frame& F) {
    LAS float* scr = (LAS float*)(F.lds + F.wave * 16384);
    const int gw = F.bx * NWAVES + F.wave, NGW = F.G * NWAVES;
    constexpr int I_IN = (D / 64) * (INW / 32), I_BR = (512 / 64) * (D / 32), I_OUT = (D / 64) * (D / 32), I_GU0 = (D / 64) * (2 * DFF / 32), I_DN0 = (DFF / 64) * (D / 32),
                  I_MGU = (D / 64) * (2 * DFE / 32), I_MDN = (DFE / 64) * (D / 32);
    constexpr int NITEMS = 2 * I_IN + 4 * I_BR + 2 * I_OUT + I_GU0 + I_DN0 + NE * I_MGU + NE * I_MDN;
    bf16* const wsb = (bf16*)F.ws;
    for (int it = gw; it < NITEMS; it += NGW) {
        int r = it;
        if (r < NE * I_MGU) { const int e = r / I_MGU; p0_job_item(KP(moe_w_gu) + (size_t)e * D * 2 * DFE, D, 2 * DFE, (bf16*)(F.ws + WS_WMGU) + (size_t)e * 2 * DFE * D, DFE, r % I_MGU, scr, F.lane); continue; } r -= NE * I_MGU;
        if (r < NE * I_MDN) { const int e = r / I_MDN; p0_job_item(KP(moe_w_down) + (size_t)e * DFE * D, DFE, D, (bf16*)(F.ws + WS_WMDN) + (size_t)e * D * DFE, 0, r % I_MDN, scr, F.lane); continue; } r -= NE * I_MDN;
        if (r < 2 * I_IN) { const int l = r / I_IN; p0_job_item(KP(w_in) + (size_t)l * D * INW, D, INW, (bf16*)(F.ws + WS_WIN) + (size_t)l * INW * D, 0, r % I_IN, scr, F.lane); continue; } r -= 2 * I_IN;
        if (r < 4 * I_BR) { const int j = r / I_BR, l = j >> 1, b = j & 1; p0_job_item(KP(w_branch) + (size_t)(l * 3 + b) * 512 * D, 512, D, (bf16*)(F.ws + WS_WBR) + (size_t)(l * 3 + b) * D * 512, 0, r % I_BR, scr, F.lane); continue; } r -= 4 * I_BR;
        if (r < 2 * I_OUT) { const int l = r / I_OUT; p0_job_item(KP(w_out) + (size_t)l * D * D, D, D, (bf16*)(F.ws + WS_WOUT) + (size_t)l * D * D, 0, r % I_OUT, scr, F.lane); continue; } r -= 2 * I_OUT;
        if (r < I_GU0) { p0_job_item(KP(ffn_w_gu), D, 2 * DFF, (bf16*)(F.ws + WS_WGU0), DFF, r, scr, F.lane); continue; } r -= I_GU0;
        p0_job_item(KP(ffn_w_down), DFF, D, (bf16*)(F.ws + WS_WDN0), 0, r, scr, F.lane);
    }
    (void)wsb;
    __syncthreads();
    constexpr int I_MOD = 2 * (MODW / 64), I_FOLD = 2 * 4 * (D / 64);
    for (int it = F.bx; it < I_MOD + I_FOLD + 1; it += F.G) {
        if (it < I_MOD) {
            const int l = it / (MODW / 64), cb = it % (MODW / 64);
            LAS float* sv = (LAS float*)F.lds;
            LAS float* red = (LAS float*)(F.lds + 32768);
            for (int i = F.tid; i < 5 * D; i += NTHR) { const int r = i / D, k = i % D; const float v = r < 4 ? KP(c)[r * D + k] : KP(c_ctx)[k]; sv[i] = v / (1.f + __expf(-v)); }
            __syncthreads();
            const int col = cb * 64 + F.lane; const float* wp = KP(w_mod) + (size_t)l * D * MODW + col;
            float a0 = 0.f, a1 = 0.f, a2 = 0.f, a3 = 0.f, a4 = 0.f;
#pragma unroll 8
            for (int kk = 0; kk < 128; ++kk) { const int k = F.wave * 128 + kk; const float w = wp[(size_t)k * MODW];
                a0 += sv[k] * w; a1 += sv[D + k] * w; a2 += sv[2 * D + k] * w; a3 += sv[3 * D + k] * w; a4 += sv[4 * D + k] * w; }
            red[(F.wave * 5 + 0) * 64 + F.lane] = a0; red[(F.wave * 5 + 1) * 64 + F.lane] = a1; red[(F.wave * 5 + 2) * 64 + F.lane] = a2;
            red[(F.wave * 5 + 3) * 64 + F.lane] = a3; red[(F.wave * 5 + 4) * 64 + F.lane] = a4;
            __syncthreads();
            if (F.tid < 320) { const int r = F.tid / 64, ln = F.tid % 64; float s = 0.f;
#pragma unroll
                for (int w = 0; w < 8; ++w) s += red[(w * 5 + r) * 64 + ln];
                const int cc = cb * 64 + ln;
                ((float*)(F.ws + WS_MODV))[(size_t)(l * 5 + r) * MODW + cc] = s + KP(b_mod)[l * MODW + cc]; }
            __syncthreads();
        } else if (it < I_MOD + I_FOLD) {
            const int r = it - I_MOD, l = r / 64, g = (r % 64) / 16, nb = r % 16;
            LAS float* pw = (LAS float*)F.lds;
            const float* pws = KP(pool_w) + (size_t)(l * 4 + g) * 128 * 128;
            for (int i = F.tid; i < 128 * 128; i += NTHR) pw[i] = pws[i];
            __syncthreads();
            const int n = nb * 64 + F.lane; const float* w2 = KP(w_branch) + (size_t)(l * 3 + 2) * 512 * D + (size_t)(128 * g) * D + n;
            const float* ps = KP(pool_scale) + l * 512 + 128 * g;
            float acc[16];
#pragma unroll
            for (int q = 0; q < 16; ++q) acc[q] = 0.f;
            for (int j = 0; j < 128; ++j) { const float wv = w2[(size_t)j * D] * ps[j];
#pragma unroll
                for (int q = 0; q < 16; ++q) acc[q] += pw[(F.wave * 16 + q) * 128 + j] * wv; }
            bf16* dst = (bf16*)(F.ws + WS_WBR) + (size_t)(l * 3 + 2) * D * 512 + (size_t)n * 512 + 128 * g + F.wave * 16;
            u32x4 o0, o1; o0.x = pk2(acc[0], acc[1]); o0.y = pk2(acc[2], acc[3]); o0.z = pk2(acc[4], acc[5]); o0.w = pk2(acc[6], acc[7]);
            o1.x = pk2(acc[8], acc[9]); o1.y = pk2(acc[10], acc[11]); o1.z = pk2(acc[12], acc[13]); o1.w = pk2(acc[14], acc[15]);
            *(u32x4*)dst = o0; *(u32x4*)(dst + 8) = o1;
            __syncthreads();
        } else {
            for (int i = F.tid; i < 64 * 16; i += NTHR) { const int pos = i / 16, fi = i % 16;
                const float inv = powf(10000.0f, -(float)fi / 16.0f); const float ang = (float)pos * inv;
                ((float*)(F.ws + WS_ROPE))[2 * i] = cosf(ang); ((float*)(F.ws + WS_ROPE))[2 * i + 1] = sinf(ang); }
        }
    }
}

template <bool ROUTER>
__device__ __forceinline__ void norm_mod_phase(Frame& F, const float* xl, const float* xc, const float* gvec, const float* modl, int shi, int sci, int nrows, const float* router_w) {
    bf16* H = (bf16*)(F.ws + WS_H);
    LAS int* lcnt = (LAS int*)F.lds;
    if (ROUTER) { if (F.tid < 8) lcnt[F.tid] = 0; __syncthreads(); }
    const int nloop = ROUTER ? 8 : (nrows + F.G * NWAVES - 1) / (F.G * NWAVES);
    for (int i = 0; i < nloop; ++i) {
        const int r = ROUTER ? (F.bx * 64 + F.wave + 8 * i) : ((i * F.G + F.bx) * NWAVES + F.wave);
        if (r >= nrows) continue;
        const int bidx = r < ML ? r / SEQ : 4;
        const float* xr = r < ML ? xl + (size_t)r * D : xc + (size_t)(r - ML) * D;
        const float* mv = modl + (size_t)bidx * MODW;
        f32x4 v[4]; float ss = 0.f;
#pragma unroll
        for (int j = 0; j < 4; ++j) { v[j] = *(const f32x4*)(xr + 4 * F.lane + 256 * j); ss += (v[j].x * v[j].x + v[j].y * v[j].y) + (v[j].z * v[j].z + v[j].w * v[j].w); }
        const float rstd = 1.0f / sqrtf(wave_sum(ss) * (1.f / D) + EPS);
#pragma unroll
        for (int j = 0; j < 4; ++j) { const int c = 4 * F.lane + 256 * j;
            const f32x4 g = *(const f32x4*)(gvec + c), sh = *(const f32x4*)(mv + shi * D + c), sc = *(const f32x4*)(mv + sci * D + c);
            v[j] = (v[j] * rstd * g) * (sc + 1.0f) + sh;
            u32x2 o; o.x = pk2(v[j].x, v[j].y); o.y = pk2(v[j].z, v[j].w);
            *(u32x2*)(H + (size_t)r * D + c) = o; }
        if (ROUTER) {
            float lg[8];
#pragma unroll
            for (int e = 0; e < 8; ++e) lg[e] = 0.f;
#pragma unroll
            for (int j = 0; j < 4; ++j)
#pragma unroll
                for (int q = 0; q < 4; ++q) { const int c = 4 * F.lane + 256 * j + q; const f32x4 w0 = *(const f32x4*)(router_w + (size_t)c * 8), w1 = *(const f32x4*)(router_w + (size_t)c * 8 + 4); const float hv = v[j][q];
                    lg[0] += hv * w0.x; lg[1] += hv * w0.y; lg[2] += hv * w0.z; lg[3] += hv * w0.w; lg[4] += hv * w1.x; lg[5] += hv * w1.y; lg[6] += hv * w1.z; lg[7] += hv * w1.w; }
#pragma unroll
            for (int e = 0; e < 8; ++e) lg[e] = wave_sum(lg[e]);
            int e1 = 0; float v1 = lg[0];
#pragma unroll
            for (int e = 1; e < 8; ++e) if (lg[e] > v1) { v1 = lg[e]; e1 = e; }
            int e2 = -1; float v2 = -3.0e38f;
#pragma unroll
            for (int e = 0; e < 8; ++e) if (e != e1 && lg[e] > v2) { v2 = lg[e]; e2 = e; }
            const float ex = __expf(v2 - v1), w1 = 1.f / (1.f + ex), w2 = ex * w1;
            if (F.lane == 0) {
                const int p1 = atomicAdd((int*)&lcnt[e1], 1), p2 = atomicAdd((int*)&lcnt[e2], 1);
                int* te = (int*)(F.ws + WS_TOKE) + 2 * r; te[0] = e1; te[1] = e2;
                int* tp = (int*)(F.ws + WS_TOKP) + 2 * r; tp[0] = p1; tp[1] = p2;
                float* tw = (float*)(F.ws + WS_TOKW) + 2 * r; tw[0] = w1; tw[1] = w2;
            }
        }
    }
    if (ROUTER) { __syncthreads(); if (F.tid < 8) ((int*)(F.ws + WS_CNTWG))[F.bx * 8 + F.tid] = lcnt[F.tid]; __syncthreads(); }
}

__device__ __forceinline__ void moe_scatter_phase(Frame& F) {
    LAS int* tab = (LAS int*)F.lds;
    const int* cw = (const int*)(F.ws + WS_CNTWG);
    if (F.tid < 32) tab[F.tid] = 0;
    __syncthreads();
    for (int idx = F.tid; idx < F.G * 8; idx += NTHR) {
        const int c = __hip_atomic_load(cw + idx, __ATOMIC_RELAXED, __HIP_MEMORY_SCOPE_AGENT); const int w = idx >> 3, e = idx & 7;
        atomicAdd((int*)&tab[16 + e], c); if (w < F.bx) atomicAdd((int*)&tab[8 + e], c);
    }
    __syncthreads();
    if (F.tid == 0) { int off = 0; for (int e = 0; e < 8; ++e) { tab[e] = off; off += ((tab[16 + e] + 255) / 256) * 256; } tab[24] = off / 256;
        if (F.bx == 0) { int* tl = (int*)(F.ws + WS_TILE); int t = 0; for (int e = 0; e < 8; ++e) { const int n = (tab[16 + e] + 255) / 256; for (int q = 0; q < n; ++q) tl[t++] = e; } tl[200] = t; } }
    __syncthreads();
    const bf16* H = (const bf16*)(F.ws + WS_H); bf16* HS = (bf16*)(F.ws + WS_H2S);
    for (int i = 0; i < 8; ++i) {
        const int r = F.bx * 64 + F.wave + 8 * i; if (r >= ML) continue;
        const int* te = (const int*)(F.ws + WS_TOKE) + 2 * r; const int* tp = (const int*)(F.ws + WS_TOKP) + 2 * r;
        const int e1 = te[0], e2 = te[1];
        const int s1 = tab[e1] + tab[8 + e1] + tp[0], s2 = tab[e2] + tab[8 + e2] + tp[1];
        if (F.lane == 0) { int* ts = (int*)(F.ws + WS_TOKS) + 2 * r; ts[0] = s1; ts[1] = s2; }
        const u32x4* src = (const u32x4*)(H + (size_t)r * D);
        const u32x4 a = src[F.lane], b = src[64 + F.lane];
        u32x4* d1 = (u32x4*)(HS + (size_t)s1 * D); u32x4* d2 = (u32x4*)(HS + (size_t)s2 * D);
        d1[F.lane] = a; d1[64 + F.lane] = b; d2[F.lane] = a; d2[64 + F.lane] = b;
    }
}

__device__ __forceinline__ void final_phase(Frame& F, const float* final_g, float* out, const float* modl) {
    const float* X1 = (const float*)(F.ws + WS_X1); const bf16* YS = (const bf16*)(F.ws + WS_YS);
    const int NGW = F.G * NWAVES;
    for (int r = F.bx * NWAVES + F.wave; r < ML; r += NGW) {
        const int bidx = r / SEQ; const float* g2 = modl + (size_t)bidx * MODW + 5 * D;
        const int* ts = (const int*)(F.ws + WS_TOKS) + 2 * r; const float* tw = (const float*)(F.ws + WS_TOKW) + 2 * r;
        const int s1 = ts[0], s2 = ts[1]; const float w1 = tw[0], w2 = tw[1];
        f32x4 v[4]; float ss = 0.f;
#pragma unroll
        for (int j = 0; j < 4; ++j) { const int c = 4 * F.lane + 256 * j;
            const f32x4 xv = *(const f32x4*)(X1 + (size_t)r * D + c), g = *(const f32x4*)(g2 + c);
            const u32x2 y1 = *(const u32x2*)(YS + (size_t)s1 * D + c), y2 = *(const u32x2*)(YS + (size_t)s2 * D + c);
            f32x4 f; f.x = w1 * bflo(y1.x) + w2 * bflo(y2.x); f.y = w1 * bfhi(y1.x) + w2 * bfhi(y2.x); f.z = w1 * bflo(y1.y) + w2 * bflo(y2.y); f.w = w1 * bfhi(y1.y) + w2 * bfhi(y2.y);
            v[j] = xv + g * f; ss += (v[j].x * v[j].x + v[j].y * v[j].y) + (v[j].z * v[j].z + v[j].w * v[j].w); }
        const float rstd = 1.0f / sqrtf(wave_sum(ss) * (1.f / D) + EPS);
#pragma unroll
        for (int j = 0; j < 4; ++j) { const int c = 4 * F.lane + 256 * j; const f32x4 g = *(const f32x4*)(final_g + c);
            *(f32x4*)(out + (size_t)r * D + c) = v[j] * rstd * g; }
    }
}

__device__ __forceinline__ void unpack8(const u32x4 w, float (&f)[8]) { f[0] = bflo(w.x); f[1] = bfhi(w.x); f[2] = bflo(w.y); f[3] = bfhi(w.y); f[4] = bflo(w.z); f[5] = bfhi(w.z); f[6] = bflo(w.w); f[7] = bfhi(w.w); }
__device__ __forceinline__ void local_mix_phase(Frame& F, const float* cw, int nrows) {
    const bf16* Z = (const bf16*)(F.ws + WS_Z); bf16* MIX = (bf16*)(F.ws + WS_MIX);
    const int total = nrows * 64, stride = F.G * NTHR;
    for (int idx = F.bx * NTHR + F.tid; idx < total; idx += stride) {
        const int r = idx >> 6, cg = idx & 63, c0 = cg * 8;
        int t, L, base;
        if (r < ML) { t = r % SEQ; L = SEQ; base = r - t; } else { const int rc = r - ML; t = rc % CTXL; L = CTXL; base = r - t; }
        float o[8];
#pragma unroll
        for (int q = 0; q < 8; ++q) o[q] = 0.f;
#pragma unroll
        for (int j = 0; j < 3; ++j) { const int tt = t - 1 + j; if (tt < 0 || tt >= L) continue;
            const bf16* zr = Z + (size_t)(base + tt) * INW; float cx[8], cc[8];
            unpack8(*(const u32x4*)(zr + ZCX + c0), cx); unpack8(*(const u32x4*)(zr + ZCC + c0), cc);
            const f32x4 w0 = *(const f32x4*)(cw + j * 512 + c0), w1 = *(const f32x4*)(cw + j * 512 + c0 + 4);
            o[0] += w0.x * (cc[0] * cx[0]); o[1] += w0.y * (cc[1] * cx[1]); o[2] += w0.z * (cc[2] * cx[2]); o[3] += w0.w * (cc[3] * cx[3]);
            o[4] += w1.x * (cc[4] * cx[4]); o[5] += w1.y * (cc[5] * cx[5]); o[6] += w1.z * (cc[6] * cx[6]); o[7] += w1.w * (cc[7] * cx[7]); }
        { float cb[8]; unpack8(*(const u32x4*)(Z + (size_t)r * INW + ZCB + c0), cb);
          u32x4 w; w.x = pk2(cb[0] * o[0], cb[1] * o[1]); w.y = pk2(cb[2] * o[2], cb[3] * o[3]); w.z = pk2(cb[4] * o[4], cb[5] * o[5]); w.w = pk2(cb[6] * o[6], cb[7] * o[7]);
          *(u32x4*)(MIX + (size_t)r * MIXW + 512 + c0) = w; }
        { const int hw = 1 << (c0 >> 7); const int lo = t - hw < 0 ? 0 : t - hw, hi = t + hw > L ? L : t + hw;
          float s[8];
#pragma unroll
          for (int q = 0; q < 8; ++q) s[q] = 0.f;
          for (int tt = lo; tt < hi; ++tt) { float u[8]; unpack8(*(const u32x4*)(Z + (size_t)(base + tt) * INW + ZPU + c0), u);
#pragma unroll
              for (int q = 0; q < 8; ++q) s[q] += u[q]; }
          float u0[8]; unpack8(*(const u32x4*)(Z + (size_t)r * INW + ZPU + c0), u0);
          const float inv = 1.0f / (float)(hi - lo);
          u32x4 w; w.x = pk2(s[0] * inv - u0[0], s[1] * inv - u0[1]); w.y = pk2(s[2] * inv - u0[2], s[3] * inv - u0[3]);
          w.z = pk2(s[4] * inv - u0[4], s[5] * inv - u0[5]); w.w = pk2(s[6] * inv - u0[6], s[7] * inv - u0[7]);
          *(u32x4*)(MIX + (size_t)r * MIXW + 1024 + c0) = w; }
    }
}

__device__ __forceinline__ void attn_naive_phase(Frame& F, const float* sinkl, int nrows) {
    const bf16* Z = (const bf16*)(F.ws + WS_Z); bf16* MIX = (bf16*)(F.ws + WS_MIX);
    LAS float* qs = (LAS float*)(F.lds + F.wave * 10240);
    LAS float* sc = qs + 256;
    const int nunits = nrows * 2, NGW = F.G * NWAVES;
    for (int uidx = F.bx * NWAVES + F.wave; uidx < nunits; uidx += NGW) {
        const int r = uidx >> 1, kh = uidx & 1;
        int b, nloc, krow0;
        if (r < ML) { b = r / SEQ; const int t = r % SEQ; const int lo = t - 128 < 0 ? 0 : t - 128, hi = t + 128 > SEQ - 1 ? SEQ - 1 : t + 128; nloc = hi - lo + 1; krow0 = b * SEQ + lo; }
        else { b = (r - ML) / CTXL; nloc = 0; krow0 = 0; }
        const int crow0 = ML + b * CTXL, nk = nloc + CTXL;
        { const u32x2 qw = *(const u32x2*)(Z + (size_t)r * INW + ZQ + kh * 256 + 4 * F.lane); const int g = F.lane >> 4, d = (4 * F.lane) & 63;
          qs[(d + 0) * 4 + g] = bflo(qw.x); qs[(d + 1) * 4 + g] = bfhi(qw.x); qs[(d + 2) * 4 + g] = bflo(qw.y); qs[(d + 3) * 4 + g] = bfhi(qw.y); }
        LDS_WAIT(); asm volatile("" ::: "memory");
        for (int c0 = 0; c0 < nk; c0 += 64) {
            const int kk = c0 + F.lane;
            if (kk < nk) {
                const int krow = kk < nloc ? krow0 + kk : crow0 + (kk - nloc);
                const u32x4* kp = (const u32x4*)(Z + (size_t)krow * INW + ZK + kh * 64);
                f32x4 s = (f32x4){0.f, 0.f, 0.f, 0.f};
#pragma unroll
                for (int d8 = 0; d8 < 8; ++d8) { float kf[8]; unpack8(kp[d8], kf);
#pragma unroll
                    for (int q = 0; q < 8; ++q) { const f32x4 qv = *(const LAS f32x4*)(qs + (d8 * 8 + q) * 4); s += qv * kf[q]; } }
                *(LAS f32x4*)(sc + kk * 4) = s;
            }
        }
        LDS_WAIT(); asm volatile("" ::: "memory");
        f32x4 mx; { const float* sk = sinkl + kh * 4; mx = (f32x4){sk[0], sk[1], sk[2], sk[3]}; }
        const f32x4 snk = mx;
        for (int kk = F.lane; kk < nk; kk += 64) { const f32x4 s = *(const LAS f32x4*)(sc + kk * 4); mx.x = fmaxf(mx.x, s.x); mx.y = fmaxf(mx.y, s.y); mx.z = fmaxf(mx.z, s.z); mx.w = fmaxf(mx.w, s.w); }
        mx.x = wave_max(mx.x); mx.y = wave_max(mx.y); mx.z = wave_max(mx.z); mx.w = wave_max(mx.w);
        f32x4 sm = (f32x4){0.f, 0.f, 0.f, 0.f};
        for (int kk = F.lane; kk < nk; kk += 64) { f32x4 s = *(const LAS f32x4*)(sc + kk * 4);
            s.x = __expf(s.x - mx.x); s.y = __expf(s.y - mx.y); s.z = __expf(s.z - mx.z); s.w = __expf(s.w - mx.w); sm += s; *(LAS f32x4*)(sc + kk * 4) = s; }
        sm.x = wave_sum(sm.x) + __expf(snk.x - mx.x); sm.y = wave_sum(sm.y) + __expf(snk.y - mx.y); sm.z = wave_sum(sm.z) + __expf(snk.z - mx.z); sm.w = wave_sum(sm.w) + __expf(snk.w - mx.w);
        LDS_WAIT(); asm volatile("" ::: "memory");
        f32x4 o = (f32x4){0.f, 0.f, 0.f, 0.f};
        const bf16* vb = Z + ZV + kh * 64 + F.lane;
#pragma unroll 4
        for (int kk = 0; kk < nk; ++kk) { const int krow = kk < nloc ? krow0 + kk : crow0 + (kk - nloc);
            const float v = bf2f((unsigned)vb[(size_t)krow * INW]); const f32x4 p = *(const LAS f32x4*)(sc + kk * 4); o += p * v; }
        bf16* op = MIX + (size_t)r * MIXW + kh * 256 + F.lane;
        op[0] = (bf16)f2bf(o.x / sm.x); op[64] = (bf16)f2bf(o.y / sm.y); op[128] = (bf16)f2bf(o.z / sm.z); op[192] = (bf16)f2bf(o.w / sm.w);
        LDS_WAIT(); asm volatile("" ::: "memory");
    }
}

using pg8::Unit;
struct SchedStd {
    const char* A; const char* B; size_t astep, bstep; int nM, nN, G, c, nx, xpm0, xpn;
    __device__ __forceinline__ bool next(int i, Unit& u) const {
        const int L = i * G + c, nwg = nM * nN; if (L >= nwg + nx) return false;
        if (L < nwg) pg8::tile_of(L, nM, nN, u.pm, u.pn); else { u.pm = xpm0 + (L - nwg); u.pn = xpn; }
        u.tag = 0; u.a = A + (size_t)u.pm * astep; u.b = B + (size_t)u.pn * bstep; return true;
    }
};
struct SchedBr {
    const char* A; const char* B; int nM, G, c;
    __device__ __forceinline__ bool next(int i, Unit& u) const {
        const int t = i / 3, br = i - 3 * t; const int L = t * G + c; if (L >= nM * 4) return false;
        pg8::tile_of(L, nM, 4, u.pm, u.pn); u.tag = br;
        u.a = A + ((size_t)u.pm * 256 * MIXW + br * 512) * 2; u.b = B + ((size_t)br * D * 512 + (size_t)u.pn * 256 * 512) * 2; return true;
    }
};
struct SchedMoe {
    const char* A; const char* B; size_t astep, bstep_e, bstep_n; int NJ, G, c; const int* tile;
    __device__ __forceinline__ bool next(int i, Unit& u) const {
        const int nt = __builtin_amdgcn_readfirstlane(__hip_atomic_load(tile + 200, __ATOMIC_RELAXED, __HIP_MEMORY_SCOPE_AGENT));
        const int L = i * G + c; if (L >= nt * NJ) return false;
        u.pm = L % nt; u.pn = L / nt; u.tag = __builtin_amdgcn_readfirstlane(__hip_atomic_load(tile + u.pm, __ATOMIC_RELAXED, __HIP_MEMORY_SCOPE_AGENT));
        u.a = A + (size_t)u.pm * astep; u.b = B + (size_t)u.tag * bstep_e + (size_t)u.pn * bstep_n; return true;
    }
};

struct EpiIn {
    static constexpr bool PERM = true;
    bf16* Z; const float* rope;
    __device__ __forceinline__ void operator()(const f32x4 (&acc)[2][2][4][2], const Unit& u, int wr, int wc, int fr, int fq) const {
        const int row0 = u.pm * 256 + wr * 64 + fr, col0 = u.pn * 256 + wc * 32 + 8 * fq;
        const bool latent = u.pm < 64, gate = u.pn >= 11;
        const float sgn = fq < 2 ? -1.f : 1.f;
#pragma unroll
        for (int ai = 0; ai < 2; ++ai)
#pragma unroll
            for (int m = 0; m < 4; ++m) { const int row = row0 + ai * 128 + m * 16; bf16* rowp = Z + (size_t)row * INW + col0;
                const int pos = (wc & 1) ? (16 * m + fr) : (4 * (u.pm & 15) + 2 * ai + wr);
#pragma unroll
                for (int bj = 0; bj < 2; ++bj) { f32x4 v0 = acc[ai][bj][m][0], v1 = acc[ai][bj][m][1];
                    const bool isq = u.pn < 2, isk = (u.pn == 2 && bj == 0);
                    if (isq || isk) {
                        if (latent) {
                            const f32x4* cs = (const f32x4*)(rope + (size_t)(pos * 16 + 8 * (fq & 1)) * 2);
                            const f32x4 t0 = cs[0], t1 = cs[1], t2 = cs[2], t3 = cs[3];
                            f32x4 p0, p1;
                            p0.x = __shfl_xor(v0.x, 32); p0.y = __shfl_xor(v0.y, 32); p0.z = __shfl_xor(v0.z, 32); p0.w = __shfl_xor(v0.w, 32);
                            p1.x = __shfl_xor(v1.x, 32); p1.y = __shfl_xor(v1.y, 32); p1.z = __shfl_xor(v1.z, 32); p1.w = __shfl_xor(v1.w, 32);
                            v0.x = v0.x * t0.x + p0.x * (sgn * t0.y); v0.y = v0.y * t0.z + p0.y * (sgn * t0.w); v0.z = v0.z * t1.x + p0.z * (sgn * t1.y); v0.w = v0.w * t1.z + p0.w * (sgn * t1.w);
                            v1.x = v1.x * t2.x + p1.x * (sgn * t2.y); v1.y = v1.y * t2.z + p1.y * (sgn * t2.w); v1.z = v1.z * t3.x + p1.z * (sgn * t3.y); v1.w = v1.w * t3.z + p1.w * (sgn * t3.w);
                        }
                        if (isq) { v0 = v0 * 0.125f; v1 = v1 * 0.125f; }
                    }
                    if (gate) {
#pragma unroll
                        for (int q = 0; q < 4; ++q) { v0[q] = 1.f / (1.f + __expf(-v0[q])); v1[q] = 1.f / (1.f + __expf(-v1[q])); } }
                    u32x4 w; w.x = pg8::cvt_pk_bf16(v0[0], v0[1]); w.y = pg8::cvt_pk_bf16(v0[2], v0[3]); w.z = pg8::cvt_pk_bf16(v1[0], v1[1]); w.w = pg8::cvt_pk_bf16(v1[2], v1[3]);
                    *(u32x4*)(rowp + bj * 128) = w; } }
    }
};
struct EpiBr {
    static constexpr bool PERM = false;
    const bf16* Z; float* YACC; bf16* Y;
    __device__ __forceinline__ void operator()(const f32x4 (&acc)[2][2][4][2], const Unit& u, int wr, int wc, int fr, int fq) const {
        const int row0 = u.pm * 256 + wr * 64 + fr, col0 = u.pn * 256 + wc * 32 + 4 * fq; const int br = u.tag;
#pragma unroll
        for (int ai = 0; ai < 2; ++ai)
#pragma unroll
            for (int m = 0; m < 4; ++m) { const int row = row0 + ai * 128 + m * 16;
#pragma unroll
                for (int bj = 0; bj < 2; ++bj)
#pragma unroll
                    for (int n = 0; n < 2; ++n) { const int c = col0 + bj * 128 + n * 16;
                        const u32x2 gw = *(const u32x2*)(Z + (size_t)row * INW + ZG + br * D + c);
                        f32x4 v = acc[ai][bj][m][n]; v.x *= bflo(gw.x); v.y *= bfhi(gw.x); v.z *= bflo(gw.y); v.w *= bfhi(gw.y);
                        float* yp = YACC + (size_t)row * D + c;
                        if (br == 0) *(f32x4*)yp = v;
                        else if (br == 1) *(f32x4*)yp = *(const f32x4*)yp + v;
                        else { v += *(const f32x4*)yp; u32x2 w; w.x = pg8::cvt_pk_bf16(v.x, v.y); w.y = pg8::cvt_pk_bf16(v.z, v.w); *(u32x2*)(Y + (size_t)row * D + c) = w; } } }
    }
};
struct EpiRes {
    static constexpr bool PERM = false;
    const float* rl; const float* rc; float* out; const float* gv;
    __device__ __forceinline__ void operator()(const f32x4 (&acc)[2][2][4][2], const Unit& u, int wr, int wc, int fr, int fq) const {
        const int row0 = u.pm * 256 + wr * 64 + fr, col0 = u.pn * 256 + wc * 32 + 4 * fq;
        const int bidx = u.pm < 64 ? (u.pm >> 4) : 4; const float* g = gv + (size_t)bidx * MODW;
        const float* rbase = u.pm < 64 ? rl : rc - (size_t)ML * D;
        f32x4 gg[2][2];
#pragma unroll
        for (int bj = 0; bj < 2; ++bj)
#pragma unroll
            for (int n = 0; n < 2; ++n) gg[bj][n] = *(const f32x4*)(g + col0 + bj * 128 + n * 16);
#pragma unroll
        for (int ai = 0; ai < 2; ++ai)
#pragma unroll
            for (int m = 0; m < 4; ++m) { const size_t off = (size_t)(row0 + ai * 128 + m * 16) * D + col0;
#pragma unroll
                for (int bj = 0; bj < 2; ++bj)
#pragma unroll
                    for (int n = 0; n < 2; ++n) *(f32x4*)(out + off + bj * 128 + n * 16) = *(const f32x4*)(rbase + off + bj * 128 + n * 16) + gg[bj][n] * acc[ai][bj][m][n]; }
    }
};
struct EpiSwiglu {
    static constexpr bool PERM = true;
    bf16* ACT; int ldc;
    __device__ __forceinline__ void operator()(const f32x4 (&acc)[2][2][4][2], const Unit& u, int wr, int wc, int fr, int fq) const {
        const int row0 = u.pm * 256 + wr * 64 + fr, col0 = u.pn * 128 + wc * 32 + 8 * fq;
#pragma unroll
        for (int ai = 0; ai < 2; ++ai)
#pragma unroll
            for (int m = 0; m < 4; ++m) { f32x4 r[2];
#pragma unroll
                for (int n = 0; n < 2; ++n) { const f32x4 g = acc[ai][0][m][n], up = acc[ai][1][m][n];
#pragma unroll
                    for (int q = 0; q < 4; ++q) r[n][q] = g[q] / (1.f + __expf(-g[q])) * up[q]; }
                u32x4 w; w.x = pg8::cvt_pk_bf16(r[0][0], r[0][1]); w.y = pg8::cvt_pk_bf16(r[0][2], r[0][3]); w.z = pg8::cvt_pk_bf16(r[1][0], r[1][1]); w.w = pg8::cvt_pk_bf16(r[1][2], r[1][3]);
                *(u32x4*)(ACT + (size_t)(row0 + ai * 128 + m * 16) * ldc + col0) = w; }
    }
};
struct EpiPlain {
    static constexpr bool PERM = true;
    bf16* O; int ldc;
    __device__ __forceinline__ void operator()(const f32x4 (&acc)[2][2][4][2], const Unit& u, int wr, int wc, int fr, int fq) const {
        const int row0 = u.pm * 256 + wr * 64 + fr, col0 = u.pn * 256 + wc * 32 + 8 * fq;
#pragma unroll
        for (int ai = 0; ai < 2; ++ai)
#pragma unroll
            for (int m = 0; m < 4; ++m)
#pragma unroll
                for (int bj = 0; bj < 2; ++bj) { const f32x4 v0 = acc[ai][bj][m][0], v1 = acc[ai][bj][m][1];
                    u32x4 w; w.x = pg8::cvt_pk_bf16(v0[0], v0[1]); w.y = pg8::cvt_pk_bf16(v0[2], v0[3]); w.z = pg8::cvt_pk_bf16(v1[0], v1[1]); w.w = pg8::cvt_pk_bf16(v1[2], v1[3]);
                    *(u32x4*)(O + (size_t)(row0 + ai * 128 + m * 16) * ldc + col0 + bj * 128) = w; }
    }
};

#define IN(k) (lo <= (k) && (k) < hi)
#define SEAM(k) do { if (IN(k) && IN((k) + 1)) xcd_barrier(bar); } while (0)
#define SITE() do { F.ws = (unsigned char*)karg_p<(int)__builtin_offsetof(Args, ws)>(); int t_ = threadIdx.x; asm volatile("" : "+v"(t_)); F.tid = t_; F.lane = t_ & 63; } while (0)
template <int l> __device__ __forceinline__ void layer_common(Frame& F, const int lo, const int hi, const XcdBarrier& bar, LAS unsigned char* ring) {
    constexpr int pb = 1 + 8 * l;
        if (IN(pb + 0)) { SITE(); const float* modl = (const float*)(F.ws + WS_MODV) + (size_t)l * 5 * MODW; const float* X2 = (const float*)(F.ws + WS_X2);
            const float* xl = l == 0 ? KP(x) : X2; const float* xc = l == 0 ? KP(ctx) : X2 + (size_t)ML * D;
            norm_mod_phase<false>(F, xl, xc, KP(norm1_g) + l * D, modl, 0, 1, MT, nullptr); } SEAM(pb + 0);
        if (IN(pb + 1)) { SITE();
            SchedStd S{(const char*)(F.ws + WS_H), (const char*)(F.ws + WS_WIN) + (size_t)l * INW * D * 2, (size_t)256 * D * 2, (size_t)256 * D * 2, l == 0 ? 68 : 64, 23, F.G, F.bx, l == 0 ? 0 : 4, 64, 2};
            EpiIn E{(bf16*)(F.ws + WS_Z), (const float*)(F.ws + WS_ROPE)};
            pg8::gemm_phase<EpiIn, SchedStd, true, true>(ring, D, D, D, S, E);
        } SEAM(pb + 1);
        if (IN(pb + 2)) { SITE(); const int nrows = l == 0 ? MT : ML; attn_naive_phase(F, KP(sink) + l * 8, nrows); local_mix_phase(F, KP(conv_w) + (size_t)l * 3 * 512, nrows); } SEAM(pb + 2);
        if (IN(pb + 3)) { SITE();
            SchedBr S{(const char*)(F.ws + WS_MIX), (const char*)(F.ws + WS_WBR) + (size_t)l * 3 * D * 512 * 2, l == 0 ? 68 : 64, F.G, F.bx};
            EpiBr E{(const bf16*)(F.ws + WS_Z), (float*)(F.ws + WS_YACC), (bf16*)(F.ws + WS_Y)};
            pg8::gemm_phase<EpiBr, SchedBr, true, true>(ring, MIXW, 512, 512, S, E);
        } SEAM(pb + 3);
        if (IN(pb + 4)) { SITE(); const float* modl = (const float*)(F.ws + WS_MODV) + (size_t)l * 5 * MODW; const float* X2 = (const float*)(F.ws + WS_X2);
            const float* xl = l == 0 ? KP(x) : X2; const float* xc = l == 0 ? KP(ctx) : X2 + (size_t)ML * D;
            SchedStd S{(const char*)(F.ws + WS_Y), (const char*)(F.ws + WS_WOUT) + (size_t)l * D * D * 2, (size_t)256 * D * 2, (size_t)256 * D * 2, l == 0 ? 68 : 64, 4, F.G, F.bx, 0, 0, 0};
            EpiRes E{xl, xc, (float*)(F.ws + WS_X1), modl + 2 * D};
            pg8::gemm_phase<EpiRes, SchedStd, true, true>(ring, D, D, D, S, E);
        } SEAM(pb + 4);
}
constexpr int N_PHASES = 19;
__global__ void __launch_bounds__(NTHR, 2) mk_fwd(Args args_byval) {
    extern __shared__ __attribute__((aligned(16))) unsigned char lds_raw[];
    Frame F;
    F.lds = (LAS unsigned char*)lds_raw;
    F.tid = threadIdx.x; F.lane = F.tid & 63; F.wave = __builtin_amdgcn_readfirstlane(F.tid >> 6);
    F.G = gridDim.x; F.bx = blockIdx.x;
    SITE();
    volatile LAS unsigned* MISC = (volatile LAS unsigned*)(F.lds + MISC_OFF);
    for (int u = F.tid; u < (LDS_BYTES - LDSCTL_OFF) / 4; u += NTHR) ((LAS unsigned*)(F.lds + LDSCTL_OFF))[u] = 0u;
    __syncthreads();
    const int lo = karg_i<(int)__builtin_offsetof(Args, ph_lo)>(), hi = karg_i<(int)__builtin_offsetof(Args, ph_hi)>();
    const bool fused = (hi - lo) > 1;
    XcdBarrier bar; bar.bar = (unsigned*)(F.ws + WS_CTL) + CW_BAR; bar.x = 0; bar.st = nullptr;
    if (fused) bar = xcd_barrier_post((unsigned*)(F.ws + WS_CTL) + CW_BAR, MISC + 8);
    LAS unsigned char* ring = F.lds;

    if (IN(0)) { SITE(); p0_prologue(F); } SEAM(0);

    layer_common<0>(F, lo, hi, bar, ring);
    {
            if (IN(6)) { SITE(); const float* X1 = (const float*)(F.ws + WS_X1); norm_mod_phase<false>(F, X1, X1 + (size_t)ML * D, KP(norm2_g), (const float*)(F.ws + WS_MODV), 3, 4, MT, nullptr); } SEAM(6);
            if (IN(7)) { SITE();
                SchedStd S{(const char*)(F.ws + WS_H), (const char*)(F.ws + WS_WGU0), (size_t)256 * D * 2, (size_t)256 * D * 2, 68, 22, F.G, F.bx, 0, 0, 0};
                EpiSwiglu E{(bf16*)(F.ws + WS_ACT), DFF};
                pg8::gemm_phase<EpiSwiglu, SchedStd, true, true>(ring, D, D, D, S, E);
            } SEAM(7);
            if (IN(8)) { SITE(); const float* X1 = (const float*)(F.ws + WS_X1);
                SchedStd S{(const char*)(F.ws + WS_ACT), (const char*)(F.ws + WS_WDN0), (size_t)256 * DFF * 2, (size_t)256 * DFF * 2, 68, 4, F.G, F.bx, 0, 0, 0};
                EpiRes E{X1, X1 + (size_t)ML * D, (float*)(F.ws + WS_X2), (const float*)(F.ws + WS_MODV) + 5 * D};
                pg8::gemm_phase<EpiRes, SchedStd, true, true>(ring, DFF, DFF, DFF, S, E);
            } SEAM(8);
    }
    layer_common<1>(F, lo, hi, bar, ring);
    {
            if (IN(14)) { SITE(); const float* X1 = (const float*)(F.ws + WS_X1); norm_mod_phase<true>(F, X1, X1, KP(norm2_g) + D, (const float*)(F.ws + WS_MODV) + (size_t)5 * MODW, 3, 4, ML, KP(router_w)); } SEAM(14);
            if (IN(15)) { SITE(); moe_scatter_phase(F); } SEAM(15);
            if (IN(16)) { SITE();
                SchedMoe S{(const char*)(F.ws + WS_H2S), (const char*)(F.ws + WS_WMGU), (size_t)256 * D * 2, (size_t)2 * DFE * D * 2, (size_t)256 * D * 2, 28, F.G, F.bx, (const int*)(F.ws + WS_TILE)};
                EpiSwiglu E{(bf16*)(F.ws + WS_ACT), DFE};
                pg8::gemm_phase<EpiSwiglu, SchedMoe, true, true>(ring, D, D, D, S, E);
            } SEAM(16);
            if (IN(17)) { SITE();
                SchedMoe S{(const char*)(F.ws + WS_ACT), (const char*)(F.ws + WS_WMDN), (size_t)256 * DFE * 2, (size_t)D * DFE * 2, (size_t)256 * DFE * 2, 4, F.G, F.bx, (const int*)(F.ws + WS_TILE)};
                EpiPlain E{(bf16*)(F.ws + WS_YS), D};
                pg8::gemm_phase<EpiPlain, SchedMoe, true, true>(ring, DFE, DFE, DFE, S, E);
            } SEAM(17);
            if (IN(18)) { SITE(); final_phase(F, KP(final_g), (float*)karg_p<(int)__builtin_offsetof(Args, out)>(), (const float*)(F.ws + WS_MODV) + (size_t)5 * MODW); }
        }

#undef IN
#undef SEAM
}

extern "C" void kernel_launch(void* const* d_in, const int* in_sizes, int n_in, void* d_out, int out_size, void* d_ws, size_t ws_size, hipStream_t stream) {
    static int grid = 0;
    if (grid == 0) {
        if (n_in != 21 || out_size != ML * D || ws_size < WS_END) { fprintf(stderr, "kernel_launch: unexpected sizes (n_in %d, out %d, ws %zu < %zu)\n", n_in, out_size, ws_size, (size_t)WS_END); grid = -1; return; }
        int dev = 0, cus = 0, per_cu = 0;
        if (hipGetDevice(&dev) != hipSuccess || hipDeviceGetAttribute(&cus, hipDeviceAttributeMultiprocessorCount, dev) != hipSuccess) { grid = -1; return; }
        if (hipFuncSetAttribute((const void*)mk_fwd, hipFuncAttributeMaxDynamicSharedMemorySize, LDS_BYTES) != hipSuccess) { fprintf(stderr, "kernel_launch: hipFuncSetAttribute failed\n"); grid = -1; return; }
        if (hipOccupancyMaxActiveBlocksPerMultiprocessor(&per_cu, (const void*)mk_fwd, NTHR, LDS_BYTES) != hipSuccess || per_cu < 1) { fprintf(stderr, "kernel_launch: occupancy query says %d\n", per_cu); per_cu = 1; }
        (void)hipGetLastError();
        grid = cus;
    }
    if (grid < 0) return;
    (void)hipMemsetAsync((char*)d_ws + WS_CTL, 0, CTL_ZERO_BYTES, stream);
    Args a{};
    const float** pp = (const float**)&a;
    for (int i = 0; i < 21; ++i) pp[i] = (const float*)d_in[i];
    a.out = (float*)d_out; a.ws = (unsigned char*)d_ws;
#if MK_FUSED
    a.ph_lo = 0; a.ph_hi = N_PHASES;
    hipLaunchKernelGGL(mk_fwd, dim3(grid), dim3(NTHR), LDS_BYTES, stream, a);
#else
    for (int p = 0; p < N_PHASES; ++p) { a.ph_lo = p; a.ph_hi = p + 1; hipLaunchKernelGGL(mk_fwd, dim3(grid), dim3(NTHR), LDS_BYTES, stream, a); }
#endif
}
```

```cpp
#include <hip/hip_runtime.h>
#include <cstdio>
#include <cstdint>

#ifndef MK_FUSED
#define MK_FUSED 1
#endif

#define LAS __attribute__((address_space(3)))
#define GAS __attribute__((address_space(1)))
typedef unsigned short bf16;
typedef short bf16x8 __attribute__((ext_vector_type(8)));
typedef float f32x4 __attribute__((ext_vector_type(4)));
typedef float f32x2 __attribute__((ext_vector_type(2)));
typedef unsigned u32x4 __attribute__((ext_vector_type(4)));
typedef unsigned u32x2 __attribute__((ext_vector_type(2)));
typedef GAS unsigned gu32;

constexpr int D = 1024, NB = 4, SEQ = 4096, ML = NB * SEQ, CTXL = 256, MC = NB * CTXL, MT = ML + MC;
constexpr int INW = 5888, DFF = 2816, DFE = 3584, NE = 8;
constexpr int ZQ = 0, ZK = 512, ZV = 640, ZCX = 768, ZCB = 1280, ZCC = 1792, ZPU = 2304, ZG = 2816;
constexpr int MIXW = 1536;
constexpr int MS = 2 * ML + NE * 256;
constexpr int MODW = 6 * D;
constexpr float EPS = 1e-6f;
constexpr int NWAVES = 8, NTHR = 512;

__device__ __forceinline__ unsigned f2bf(float f) { unsigned u = __builtin_bit_cast(unsigned, f); return (u + 0x7fffu + ((u >> 16) & 1u)) >> 16; }
__device__ __forceinline__ unsigned pk2(float lo, float hi) { return f2bf(lo) | (f2bf(hi) << 16); }
__device__ __forceinline__ float bf2f(unsigned b) { return __builtin_bit_cast(float, b << 16); }
__device__ __forceinline__ float bflo(unsigned w) { return __builtin_bit_cast(float, w << 16); }
__device__ __forceinline__ float bfhi(unsigned w) { return __builtin_bit_cast(float, w & 0xffff0000u); }

namespace pg8 {
constexpr int BM = 256, BK = 64, HALF = 128, HTB = HALF * BK * 2, STAGE_BYTES = 8 * HTB, NXCD = 8, WGM = 8;
__host__ __device__ __forceinline__ int lds_byte(int r, int c) { const int st = (r >> 4) * 2 + (c >> 5), rr = r & 15, cc = c & 31, ob = rr * 64 + cc * 2; return st * 1024 + (ob ^ (((ob >> 9) & 1) << 5)); }
__host__ __device__ __forceinline__ void stage_rc(int b, int& R, int& C) { const int st = b / 1024, sb = b % 1024, swz = sb ^ (((sb >> 9) & 1) << 5); R = (st >> 1) * 16 + swz / 64; C = (st & 1) * 32 + (swz % 64) / 2; }
__host__ __device__ __forceinline__ int perm32(int rho) { const int n = rho >> 4, i = rho & 15; return 8 * (i >> 2) + 4 * n + (i & 3); }

struct Unit { int pm, pn, tag; const char* a; const char* b; };

__device__ __forceinline__ void tile_of(int L, int nM, int nN, int& pm, int& pn) {
    const int nwg = nM * nN; int wgid = L;
    { const int q = nwg / NXCD, r = nwg % NXCD, xcd = wgid % NXCD, off = wgid / NXCD; wgid = (xcd < r ? xcd * (q + 1) : r * (q + 1) + (xcd - r) * q) + off; }
    const int nig = WGM * nN, gid = wgid / nig, fm = gid * WGM, gsz = (nM - fm) < WGM ? (nM - fm) : WGM;
    pm = fm + ((wgid % nig) % gsz); pn = (wgid % nig) / gsz;
}

__device__ __forceinline__ unsigned cvt_pk_bf16(float lo, float hi) { unsigned r; asm volatile("v_cvt_pk_bf16_f32 %0, %1, %2" : "=v"(r) : "v"(lo), "v"(hi)); return r; }

template <class Epi, class Sched, bool ALIGN_EPI = false, bool SP2 = false>
__device__ __forceinline__ void gemm_phase(LAS unsigned char* lds, const int lda, const int ldb, const int K, const Sched& S, const Epi& E) {
    int tid_ = threadIdx.x; asm volatile("" : "+v"(tid_));
    const int tid = tid_, wid = __builtin_amdgcn_readfirstlane(tid >> 6), lane = tid & 63, wr = wid >> 2, wc = wid & 3, fr = lane & 15, fq = lane >> 4;
    const int nt = K / BK;
    unsigned voffA[2], voffB[2];
#pragma unroll
    for (int i = 0; i < 2; ++i) { int R, C; stage_rc(tid * 16 + i * 8192, R, C); const int Rb = Epi::PERM ? ((R & ~31) + perm32(R & 31)) : R;
        voffA[i] = (unsigned)(R * lda + C) * 2u; voffB[i] = (unsigned)(Rb * ldb + C) * 2u; }
    const size_t kstep = (size_t)(BK * 2);
    const size_t hstepA = (size_t)HALF * lda * 2, hstepB = (size_t)HALF * ldb * 2;
    const unsigned ldsw = (unsigned)wid * 1024u;
    const int aoff = lds_byte(wr * 64 + fr, fq * 8), boff = lds_byte(wc * 32 + fr, fq * 8);
#define PG8_SA(b, h) (((b) * 2 + (h)) * HTB)
#define PG8_SB(b, h) ((4 + (b) * 2 + (h)) * HTB)
#define PG8_STAGE(bufoff, gbase, voff) do { _Pragma("unroll") for (int _i = 0; _i < 2; ++_i) \
        __builtin_amdgcn_global_load_lds((const unsigned*)((const char*)(gbase) + (voff)[_i]), (LAS unsigned*)(lds + (bufoff) + ldsw + _i * 8192), 16, 0, 0); } while (0)
#define PG8_LDA(dst, b, h) do { _Pragma("unroll") for (int m = 0; m < 4; ++m) _Pragma("unroll") for (int k = 0; k < 2; ++k) dst[m][k] = *(const LAS bf16x8*)(lds + PG8_SA(b, h) + aoff + m * 2048 + k * 1024); } while (0)
#define PG8_LDB(dst, b, h) do { _Pragma("unroll") for (int n = 0; n < 2; ++n) _Pragma("unroll") for (int k = 0; k < 2; ++k) dst[n][k] = *(const LAS bf16x8*)(lds + PG8_SB(b, h) + boff + n * 2048 + k * 1024); } while (0)
#define PG8_MMA(ai, bj, At, Bt) do { __builtin_amdgcn_s_setprio(1); _Pragma("unroll") for (int m = 0; m < 4; ++m) _Pragma("unroll") for (int n = 0; n < 2; ++n) _Pragma("unroll") for (int k = 0; k < 2; ++k) \
        acc[ai][bj][m][n] = __builtin_amdgcn_mfma_f32_16x16x32_bf16(Bt[n][k], At[m][k], acc[ai][bj][m][n], 0, 0, 0); __builtin_amdgcn_s_setprio(0); } while (0)
#define PG8_WAIT_V(n) asm volatile("s_waitcnt vmcnt(" #n ")" ::: "memory")
#define PG8_WAIT_L(n) asm volatile("s_waitcnt lgkmcnt(" #n ")" ::: "memory")
#define PG8_BAR __builtin_amdgcn_s_barrier()
#define PG8_SCHED __builtin_amdgcn_sched_barrier(0)
    Unit cur, nxt; int ui = 0;
    if (!S.next(0, cur)) return;
    f32x4 acc[2][2][4][2];
#pragma unroll
    for (int a = 0; a < 2; ++a)
#pragma unroll
        for (int b = 0; b < 2; ++b)
#pragma unroll
            for (int m = 0; m < 4; ++m)
#pragma unroll
                for (int n = 0; n < 2; ++n) acc[a][b][m][n] = (f32x4){0.f, 0.f, 0.f, 0.f};
    bf16x8 At[4][2], B0[2][2], B1[2][2];
    const char* cA = cur.a; const char* cB = cur.b;
    if constexpr (SP2) {
        PG8_STAGE(PG8_SB(0, 0), cB, voffB); PG8_STAGE(PG8_SB(0, 1), cB + hstepB, voffB); PG8_STAGE(PG8_SA(0, 0), cA, voffA); PG8_STAGE(PG8_SA(0, 1), cA + hstepA, voffA);
        if (wr == 1) PG8_BAR;
        PG8_WAIT_V(2); PG8_BAR;
        PG8_STAGE(PG8_SB(1, 0), cB + kstep, voffB); PG8_STAGE(PG8_SA(1, 0), cA + kstep, voffA); PG8_STAGE(PG8_SB(1, 1), cB + hstepB + kstep, voffB);
        PG8_WAIT_V(6); PG8_BAR;
    } else {
        PG8_STAGE(PG8_SB(0, 0), cB, voffB); PG8_STAGE(PG8_SA(0, 0), cA, voffA); PG8_STAGE(PG8_SB(0, 1), cB + hstepB, voffB); PG8_STAGE(PG8_SA(0, 1), cA + hstepA, voffA);
        if (wr == 1) PG8_BAR;
        PG8_WAIT_V(4); PG8_BAR;
        PG8_STAGE(PG8_SB(1, 0), cB + kstep, voffB); PG8_STAGE(PG8_SA(1, 0), cA + kstep, voffA); PG8_STAGE(PG8_SB(1, 1), cB + hstepB + kstep, voffB);
        PG8_WAIT_V(6); PG8_BAR;
    }
    for (;;) {
        const bool has_next = S.next(ui + 1, nxt);
        const char* nA = has_next ? nxt.a : cA; const char* nB = has_next ? nxt.b : cB;
        for (int t = 0; t < nt; t += 2) {
            const bool last = (t == nt - 2);
            const char* a1 = cA + (size_t)(t + 1) * kstep;
            const char* a2 = last ? nA : cA + (size_t)(t + 2) * kstep; const char* b2 = last ? nB : cB + (size_t)(t + 2) * kstep;
            const char* a3 = a2 + kstep; const char* b3 = b2 + kstep;
            if constexpr (SP2) {
            PG8_LDB(B0, 0, 0); PG8_LDB(B1, 0, 1); PG8_SCHED; PG8_LDA(At, 0, 0); PG8_STAGE(PG8_SA(1, 1), a1 + hstepA, voffA);
            PG8_WAIT_V(8); PG8_WAIT_L(0); PG8_BAR; PG8_MMA(0, 0, At, B0); PG8_MMA(0, 1, At, B1); PG8_BAR; PG8_SCHED;
            PG8_LDA(At, 0, 1); PG8_STAGE(PG8_SB(0, 0), b2, voffB); PG8_STAGE(PG8_SB(0, 1), b2 + hstepB, voffB); PG8_STAGE(PG8_SA(0, 0), a2, voffA);
            PG8_WAIT_V(8); PG8_WAIT_L(0); PG8_BAR; PG8_MMA(1, 0, At, B0); PG8_MMA(1, 1, At, B1); PG8_BAR; PG8_SCHED;
            PG8_LDB(B0, 1, 0); PG8_LDB(B1, 1, 1); PG8_SCHED; PG8_LDA(At, 1, 0); PG8_STAGE(PG8_SA(0, 1), a2 + hstepA, voffA);
            PG8_WAIT_V(8); PG8_WAIT_L(0); PG8_BAR; PG8_MMA(0, 0, At, B0); PG8_MMA(0, 1, At, B1); PG8_BAR; PG8_SCHED;
            PG8_LDA(At, 1, 1); PG8_STAGE(PG8_SB(1, 0), b3, voffB); PG8_STAGE(PG8_SB(1, 1), b3 + hstepB, voffB); PG8_STAGE(PG8_SA(1, 0), a3, voffA);
            PG8_WAIT_V(8); PG8_WAIT_L(0); PG8_BAR; PG8_MMA(1, 0, At, B0); PG8_MMA(1, 1, At, B1); PG8_BAR; PG8_SCHED;
            } else {
            PG8_LDB(B0, 0, 0); PG8_SCHED; PG8_LDA(At, 0, 0); PG8_STAGE(PG8_SA(1, 1), a1 + hstepA, voffA);
            PG8_WAIT_L(8); PG8_BAR; PG8_WAIT_L(0); PG8_MMA(0, 0, At, B0); PG8_BAR; PG8_SCHED;
            PG8_LDB(B1, 0, 1); PG8_STAGE(PG8_SB(0, 0), b2, voffB);
            PG8_BAR; PG8_WAIT_L(0); PG8_MMA(0, 1, At, B1); PG8_BAR;
            PG8_LDA(At, 0, 1); PG8_STAGE(PG8_SA(0, 0), a2, voffA);
            PG8_BAR; PG8_WAIT_L(0); PG8_MMA(1, 0, At, B0); PG8_BAR; PG8_SCHED;
            PG8_STAGE(PG8_SB(0, 1), b2 + hstepB, voffB);
            PG8_WAIT_V(6); PG8_BAR; PG8_MMA(1, 1, At, B1); PG8_BAR;
            PG8_LDB(B0, 1, 0); PG8_SCHED; PG8_LDA(At, 1, 0); PG8_STAGE(PG8_SA(0, 1), a2 + hstepA, voffA);
            PG8_WAIT_L(8); PG8_BAR; PG8_WAIT_L(0); PG8_MMA(0, 0, At, B0); PG8_BAR; PG8_SCHED;
            PG8_LDB(B1, 1, 1); PG8_STAGE(PG8_SB(1, 0), b3, voffB);
            PG8_BAR; PG8_WAIT_L(0); PG8_MMA(0, 1, At, B1); PG8_BAR;
            PG8_LDA(At, 1, 1); PG8_STAGE(PG8_SA(1, 0), a3, voffA);
            PG8_BAR; PG8_WAIT_L(0); PG8_MMA(1, 0, At, B0); PG8_BAR; PG8_SCHED;
            PG8_STAGE(PG8_SB(1, 1), b3 + hstepB, voffB);
            PG8_WAIT_V(6); PG8_BAR; PG8_MMA(1, 1, At, B1); PG8_BAR;
            }
        }
        if constexpr (ALIGN_EPI) { if (wr == 0) PG8_BAR; }
        E(acc, cur, wr, wc, fr, fq);
        if (!has_next) break;
#pragma unroll
        for (int a = 0; a < 2; ++a)
#pragma unroll
            for (int b = 0; b < 2; ++b)
#pragma unroll
                for (int m = 0; m < 4; ++m)
#pragma unroll
                    for (int n = 0; n < 2; ++n) acc[a][b][m][n] = (f32x4){0.f, 0.f, 0.f, 0.f};
        cur = nxt; cA = nA; cB = nB; ++ui;
        if constexpr (ALIGN_EPI) { if (wr == 1) PG8_BAR; }
    }
    PG8_WAIT_V(0);
    if constexpr (!ALIGN_EPI) { if (wr == 0) PG8_BAR; }
    PG8_BAR;
#undef PG8_SA
#undef PG8_SB
#undef PG8_STAGE
#undef PG8_LDA
#undef PG8_LDB
#undef PG8_MMA
#undef PG8_WAIT_V
#undef PG8_WAIT_L
#undef PG8_BAR
#undef PG8_SCHED
}
}

constexpr size_t MiB = 1u << 20;
constexpr size_t al256(size_t x) { return (x + 255) & ~(size_t)255; }
constexpr size_t WS_CTL = 0, CTL_ZERO_BYTES = 1 * MiB;
constexpr size_t WS_MODV = 1 * MiB;
constexpr size_t WS_ROPE = WS_MODV + al256((size_t)2 * 5 * MODW * 4);
constexpr size_t WS_CNTWG = WS_ROPE + al256(64 * 16 * 2 * 4);
constexpr size_t WS_TOKE = WS_CNTWG + al256(256 * 8 * 4);
constexpr size_t WS_TOKP = WS_TOKE + al256((size_t)ML * 2 * 4);
constexpr size_t WS_TOKW = WS_TOKP + al256((size_t)ML * 2 * 4);
constexpr size_t WS_TOKS = WS_TOKW + al256((size_t)ML * 2 * 4);
constexpr size_t WS_TILE = WS_TOKS + al256((size_t)ML * 2 * 4);
constexpr size_t WS_WIN = 4 * MiB;
constexpr size_t WS_WBR = WS_WIN + (size_t)2 * INW * D * 2;
constexpr size_t WS_WOUT = WS_WBR + (size_t)2 * 3 * D * 512 * 2;
constexpr size_t WS_WGU0 = WS_WOUT + (size_t)2 * D * D * 2;
constexpr size_t WS_WDN0 = WS_WGU0 + (size_t)2 * DFF * D * 2;
constexpr size_t WS_WMGU = WS_WDN0 + (size_t)D * DFF * 2;
constexpr size_t WS_WMDN = WS_WMGU + (size_t)NE * 2 * DFE * D * 2;
constexpr size_t WS_H = WS_WMDN + (size_t)NE * D * DFE * 2;
constexpr size_t WS_Z = WS_H + (size_t)MT * D * 2;
constexpr size_t WS_MIX = WS_Z + (size_t)MT * INW * 2;
constexpr size_t WS_ACT = WS_Z;
constexpr size_t WS_YACC = WS_MIX + (size_t)MT * MIXW * 2;
constexpr size_t WS_H2S = WS_YACC;
constexpr size_t WS_Y = WS_YACC + (size_t)MT * D * 4;
constexpr size_t WS_X1 = WS_Y + (size_t)MT * D * 2;
constexpr size_t WS_X2 = WS_X1 + (size_t)MT * D * 4;
constexpr size_t WS_YS = WS_X2;
constexpr size_t WS_END = WS_X2 + (size_t)MT * D * 4;
static_assert((size_t)MS * DFE * 2 <= (size_t)MT * INW * 2 + (size_t)MT * MIXW * 2, "ACT overlay");
static_assert((size_t)MS * D * 2 <= (size_t)MT * D * 4, "H2S / YS overlays");
static_assert(WS_TILE + 1024 <= WS_WIN, "small tables");
constexpr int CW_BAR = 4096;

constexpr int RING_BYTES = 131072;
constexpr int LDSCTL_OFF = RING_BYTES, MISC_OFF = LDSCTL_OFF + 320;
constexpr int LDS_BYTES = 147456;

#define XB_TMO      128
#define XB_XCNT(j)  (256  + 64 * (j))
#define XB_XSUB(j)  (1280 + 64 * (j))
#define XB_XGEN(j)  (2304 + 64 * (j))
#define XB_TOP      3328
#define XB_TOPGEN   3392
#define XCD_BAR_WORDS 3456
#define XB_SPIN_CAP (1u << 18)
__device__ __forceinline__ unsigned xb_ld(unsigned* p)              { return __hip_atomic_load(p, __ATOMIC_RELAXED, __HIP_MEMORY_SCOPE_AGENT); }
__device__ __forceinline__ unsigned xb_add(unsigned* p, unsigned v) { return __hip_atomic_fetch_add(p, v, __ATOMIC_RELAXED, __HIP_MEMORY_SCOPE_AGENT); }
__device__ __forceinline__ unsigned xb_xcc_id() { return (unsigned)__builtin_amdgcn_s_getreg((3 << 11) | 20) & 0xFu; }
#define XB_SPIN(cond, bar) do { unsigned _sp = 0; while (cond) { __builtin_amdgcn_s_sleep(1); \
    if ((++_sp & 255u) == 0u) { if (xb_ld(&(bar)[XB_TMO])) break; if (_sp > XB_SPIN_CAP) { atomicAdd(&(bar)[XB_TMO], 1u); break; } } } } while (0)
struct XcdBarrier { unsigned* bar; unsigned x; volatile LAS unsigned* st; };
__device__ __forceinline__ XcdBarrier xcd_barrier_post(unsigned* bar, volatile LAS unsigned* st) {
    XcdBarrier b; b.bar = bar; b.x = xb_xcc_id(); b.st = st;
    if (threadIdx.x == 0) (void)xb_add(&bar[XB_XCNT(b.x)], 1u);
    return b;
}
__device__ __forceinline__ void xcd_barrier_complete(unsigned* bar, unsigned x, unsigned& nloc, unsigned& nx) {
    const unsigned G = gridDim.x * gridDim.y * gridDim.z;
    unsigned sum, cnt, mine, sp = 0u;
    for (;;) {
        sum = 0u; cnt = 0u; mine = 0u;
#pragma unroll
        for (unsigned j = 0; j < 16; ++j) { const unsigned c = xb_ld(&bar[XB_XCNT(j)]); sum += c; cnt += (c > 0u) ? 1u : 0u; mine = (j == x) ? c : mine; }
        if (sum == G) break;
        __builtin_amdgcn_s_sleep(1);
        if ((++sp & 255u) == 0u) { if (xb_ld(&bar[XB_TMO])) break; if (sp > XB_SPIN_CAP) { atomicAdd(&bar[XB_TMO], 1u); break; } }
    }
    nloc = mine > 0u ? mine : 1u; nx = cnt > 0u ? cnt : 1u;
}
__device__ __attribute__((noinline)) void xcd_barrier_leader(unsigned* bar, unsigned bx_, volatile LAS unsigned* st) {
    {
        XcdBarrier b; b.bar = bar; b.x = bx_; b.st = st;
        __builtin_amdgcn_s_waitcnt(0);
        unsigned nloc = b.st[0], nx = b.st[1];
        if (nloc == 0u) { xcd_barrier_complete(bar, b.x, nloc, nx); b.st[0] = nloc; b.st[1] = nx; }
        const unsigned old = xb_add(&bar[XB_XSUB(b.x)], 1u);
        const unsigned gen = old / nloc;
        if (old + 1u == (gen + 1u) * nloc) {
            __builtin_amdgcn_fence(__ATOMIC_RELEASE, "agent");
            asm volatile("s_waitcnt vmcnt(0)" ::: "memory");
            const unsigned og = xb_add(&bar[XB_TOP], 1u);
            const unsigned tg = og / nx;
            if (og + 1u == (tg + 1u) * nx) xb_add(&bar[XB_TOPGEN], 1u);
            else XB_SPIN(xb_ld(&bar[XB_TOPGEN]) == tg, bar);
            __builtin_amdgcn_fence(__ATOMIC_ACQUIRE, "agent");
            xb_add(&bar[XB_XGEN(b.x)], 1u);
            asm volatile("s_waitcnt vmcnt(0)" ::: "memory");
        } else {
            XB_SPIN(xb_ld(&bar[XB_XGEN(b.x)]) == gen, bar);
            __builtin_amdgcn_fence(__ATOMIC_ACQUIRE, "agent");
            asm volatile("s_waitcnt vmcnt(0)" ::: "memory");
        }
    }
}
__device__ __forceinline__ void xcd_barrier(const XcdBarrier& b) {
    asm volatile("s_waitcnt vmcnt(0)" ::: "memory");
    __syncthreads();
    if (threadIdx.x == 0) xcd_barrier_leader(b.bar, b.x, b.st);
    __syncthreads();
}

struct Args {
    const float *x, *c, *ctx, *c_ctx, *norm1_g, *norm2_g, *final_g, *w_mod, *b_mod, *w_in, *conv_w, *sink, *pool_w, *pool_scale, *w_branch, *w_out,
                *ffn_w_gu, *ffn_w_down, *router_w, *moe_w_gu, *moe_w_down;
    float* out; unsigned char* ws; int ph_lo, ph_hi;
};
template <int OFF> __device__ __forceinline__ const void* karg_p() { const void* r; asm volatile("s_load_dwordx2 %0, %1, %2\n\ts_waitcnt lgkmcnt(0)" : "=s"(r) : "s"(__builtin_amdgcn_kernarg_segment_ptr()), "i"(OFF)); return r; }
template <int OFF> __device__ __forceinline__ int karg_i() { int r; asm volatile("s_load_dword %0, %1, %2\n\ts_waitcnt lgkmcnt(0)" : "=s"(r) : "s"(__builtin_amdgcn_kernarg_segment_ptr()), "i"(OFF)); return r; }
#define KP(field) ((const float*)karg_p<(int)__builtin_offsetof(Args, field)>())
struct Frame {
    LAS unsigned char* lds;
    int tid, lane, wave, G, bx;
    unsigned char* ws;
};
__device__ __forceinline__ float wave_sum(float v) {
#pragma unroll
    for (int o = 1; o < 64; o <<= 1) v += __shfl_xor(v, o);
    return v;
}
__device__ __forceinline__ float wave_max(float v) {
#pragma unroll
    for (int o = 1; o < 64; o <<= 1) v = fmaxf(v, __shfl_xor(v, o));
    return v;
}
#define LDS_WAIT() asm volatile("s_waitcnt lgkmcnt(0)" ::: "memory")

__device__ __forceinline__ void p0_transpose_item(const float* W, int ldw, int K, bf16* WT, int k0, int n0, int drow0, LAS float* scr, int lane) {
#pragma unroll 8
    for (int i = 0; i < 32; ++i) { const int kk = 2 * i + (lane >> 5); scr[kk * 33 + (lane & 31)] = W[(size_t)(k0 + kk) * ldw + n0 + (lane & 31)]; }
    LDS_WAIT(); asm volatile("" ::: "memory");
    const int c = lane & 7;
#pragma unroll
    for (int j = 0; j < 4; ++j) { const int n = (lane >> 3) + 8 * j; const LAS float* s = scr + (8 * c) * 33 + n;
        u32x4 o; o.x = pk2(s[0 * 33], s[1 * 33]); o.y = pk2(s[2 * 33], s[3 * 33]); o.z = pk2(s[4 * 33], s[5 * 33]); o.w = pk2(s[6 * 33], s[7 * 33]);
        *(u32x4*)(WT + (size_t)(drow0 + n) * K + k0 + 8 * c) = o; }
    LDS_WAIT(); asm volatile("" ::: "memory");
}
__device__ __forceinline__ void p0_job_item(const float* W, int K, int N, bf16* WT, int IL, int item, LAS float* scr, int lane) {
    const int nblk = N / 32, kb = item / nblk, nb = item % nblk, n0 = 32 * nb;
    int drow0 = n0;
    if (IL > 0) { const int half = n0 >= IL ? 1 : 0, f = n0 - half * IL; drow0 = 256 * (f / 128) + 128 * half + (f % 128); }
    p0_transpose_item(W, N, K, WT, 64 * kb, n0, drow0, scr, lane);
}
__device__ __forceinline__ void p0_prologue(Frame& F) {
    LAS float* scr = (LAS float*)(F.lds + F.wave * 16384);
    const int gw = F.bx * NWAVES + F.wave, NGW = F.G * NWAVES;
    constexpr int I_IN = (D / 64) * (INW / 32), I_BR = (512 / 64) * (D / 32), I_OUT = (D / 64) * (D / 32), I_GU0 = (D / 64) * (2 * DFF / 32), I_DN0 = (DFF / 64) * (D / 32),
                  I_MGU = (D / 64) * (2 * DFE / 32), I_MDN = (DFE / 64) * (D / 32);
    constexpr int NITEMS = 2 * I_IN + 4 * I_BR + 2 * I_OUT + I_GU0 + I_DN0 + NE * I_MGU + NE * I_MDN;
    bf16* const wsb = (bf16*)F.ws;
    for (int it = gw; it < NITEMS; it += NGW) {
        int r = it;
        if (r < NE * I_MGU) { const int e = r / I_MGU; p0_job_item(KP(moe_w_gu) + (size_t)e * D * 2 * DFE, D, 2 * DFE, (bf16*)(F.ws + WS_WMGU) + (size_t)e * 2 * DFE * D, DFE, r % I_MGU, scr, F.lane); continue; } r -= NE * I_MGU;
        if (r < NE * I_MDN) { const int e = r / I_MDN; p0_job_item(KP(moe_w_down) + (size_t)e * DFE * D, DFE, D, (bf16*)(F.ws + WS_WMDN) + (size_t)e * D * DFE, 0, r % I_MDN, scr, F.lane); continue; } r -= NE * I_MDN;
        if (r < 2 * I_IN) { const int l = r / I_IN; p0_job_item(KP(w_in) + (size_t)l * D * INW, D, INW, (bf16*)(F.ws + WS_WIN) + (size_t)l * INW * D, 0, r % I_IN, scr, F.lane); continue; } r -= 2 * I_IN;
        if (r < 4 * I_BR) { const int j = r / I_BR, l = j >> 1, b = j & 1; p0_job_item(KP(w_branch) + (size_t)(l * 3 + b) * 512 * D, 512, D, (bf16*)(F.ws + WS_WBR) + (size_t)(l * 3 + b) * D * 512, 0, r % I_BR, scr, F.lane); continue; } r -= 4 * I_BR;
        if (r < 2 * I_OUT) { const int l = r / I_OUT; p0_job_item(KP(w_out) + (size_t)l * D * D, D, D, (bf16*)(F.ws + WS_WOUT) + (size_t)l * D * D, 0, r % I_OUT, scr, F.lane); continue; } r -= 2 * I_OUT;
        if (r < I_GU0) { p0_job_item(KP(ffn_w_gu), D, 2 * DFF, (bf16*)(F.ws + WS_WGU0), DFF, r, scr, F.lane); continue; } r -= I_GU0;
        p0_job_item(KP(ffn_w_down), DFF, D, (bf16*)(F.ws + WS_WDN0), 0, r, scr, F.lane);
    }
    (void)wsb;
    __syncthreads();
    constexpr int I_MOD = 2 * (MODW / 64), I_FOLD = 2 * 4 * (D / 64);
    for (int it = F.bx; it < I_MOD + I_FOLD + 1; it += F.G) {
        if (it < I_MOD) {
            const int l = it / (MODW / 64), cb = it % (MODW / 64);
            LAS float* sv = (LAS float*)F.lds;
            LAS float* red = (LAS float*)(F.lds + 32768);
            for (int i = F.tid; i < 5 * D; i += NTHR) { const int r = i / D, k = i % D; const float v = r < 4 ? KP(c)[r * D + k] : KP(c_ctx)[k]; sv[i] = v / (1.f + __expf(-v)); }
            __syncthreads();
            const int col = cb * 64 + F.lane; const float* wp = KP(w_mod) + (size_t)l * D * MODW + col;
            float a0 = 0.f, a1 = 0.f, a2 = 0.f, a3 = 0.f, a4 = 0.f;
#pragma unroll 8
            for (int kk = 0; kk < 128; ++kk) { const int k = F.wave * 128 + kk; const float w = wp[(size_t)k * MODW];
                a0 += sv[k] * w; a1 += sv[D + k] * w; a2 += sv[2 * D + k] * w; a3 += sv[3 * D + k] * w; a4 += sv[4 * D + k] * w; }
            red[(F.wave * 5 + 0) * 64 + F.lane] = a0; red[(F.wave * 5 + 1) * 64 + F.lane] = a1; red[(F.wave * 5 + 2) * 64 + F.lane] = a2;
            red[(F.wave * 5 + 3) * 64 + F.lane] = a3; red[(F.wave * 5 + 4) * 64 + F.lane] = a4;
            __syncthreads();
            if (F.tid < 320) { const int r = F.tid / 64, ln = F.tid % 64; float s = 0.f;
#pragma unroll
                for (int w = 0; w < 8; ++w) s += red[(w * 5 + r) * 64 + ln];
                const int cc = cb * 64 + ln;
                ((float*)(F.ws + WS_MODV))[(size_t)(l * 5 + r) * MODW + cc] = s + KP(b_mod)[l * MODW + cc]; }
            __syncthreads();
        } else if (it < I_MOD + I_FOLD) {
            const int r = it - I_MOD, l = r / 64, g = (r % 64) / 16, nb = r % 16;
            LAS float* pw = (LAS float*)F.lds;
            const float* pws = KP(pool_w) + (size_t)(l * 4 + g) * 128 * 128;
            for (int i = F.tid; i < 128 * 128; i += NTHR) pw[i] = pws[i];
            __syncthreads();
            const int n = nb * 64 + F.lane; const float* w2 = KP(w_branch) + (size_t)(l * 3 + 2) * 512 * D + (size_t)(128 * g) * D + n;
            const float* ps = KP(pool_scale) + l * 512 + 128 * g;
            float acc[16];
#pragma unroll
            for (int q = 0; q < 16; ++q) acc[q] = 0.f;
            for (int j = 0; j < 128; ++j) { const float wv = w2[(size_t)j * D] * ps[j];
#pragma unroll
                for (int q = 0; q < 16; ++q) acc[q] += pw[(F.wave * 16 + q) * 128 + j] * wv; }
            bf16* dst = (bf16*)(F.ws + WS_WBR) + (size_t)(l * 3 + 2) * D * 512 + (size_t)n * 512 + 128 * g + F.wave * 16;
            u32x4 o0, o1; o0.x = pk2(acc[0], acc[1]); o0.y = pk2(acc[2], acc[3]); o0.z = pk2(acc[4], acc[5]); o0.w = pk2(acc[6], acc[7]);
            o1.x = pk2(acc[8], acc[9]); o1.y = pk2(acc[10], acc[11]); o1.z = pk2(acc[12], acc[13]); o1.w = pk2(acc[14], acc[15]);
            *(u32x4*)dst = o0; *(u32x4*)(dst + 8) = o1;
            __syncthreads();
        } else {
            for (int i = F.tid; i < 64 * 16; i += NTHR) { const int pos = i / 16, fi = i % 16;
                const float inv = powf(10000.0f, -(float)fi / 16.0f); const float ang = (float)pos * inv;
                ((float*)(F.ws + WS_ROPE))[2 * i] = cosf(ang); ((float*)(F.ws + WS_ROPE))[2 * i + 1] = sinf(ang); }
        }
    }
}

template <bool ROUTER>
__device__ __forceinline__ void norm_mod_phase(Frame& F, const float* xl, const float* xc, const float* gvec, const float* modl, int shi, int sci, int nrows, const float* router_w) {
    bf16* H = (bf16*)(F.ws + WS_H);
    LAS int* lcnt = (LAS int*)F.lds;
    if (ROUTER) { if (F.tid < 8) lcnt[F.tid] = 0; __syncthreads(); }
    const int nloop = ROUTER ? 8 : (nrows + F.G * NWAVES - 1) / (F.G * NWAVES);
    for (int i = 0; i < nloop; ++i) {
        const int r = ROUTER ? (F.bx * 64 + F.wave + 8 * i) : ((i * F.G + F.bx) * NWAVES + F.wave);
        if (r >= nrows) continue;
        const int bidx = r < ML ? r / SEQ : 4;
        const float* xr = r < ML ? xl + (size_t)r * D : xc + (size_t)(r - ML) * D;
        const float* mv = modl + (size_t)bidx * MODW;
        f32x4 v[4]; float ss = 0.f;
#pragma unroll
        for (int j = 0; j < 4; ++j) { v[j] = *(const f32x4*)(xr + 4 * F.lane + 256 * j); ss += (v[j].x * v[j].x + v[j].y * v[j].y) + (v[j].z * v[j].z + v[j].w * v[j].w); }
        const float rstd = 1.0f / sqrtf(wave_sum(ss) * (1.f / D) + EPS);
#pragma unroll
        for (int j = 0; j < 4; ++j) { const int c = 4 * F.lane + 256 * j;
            const f32x4 g = *(const f32x4*)(gvec + c), sh = *(const f32x4*)(mv + shi * D + c), sc = *(const f32x4*)(mv + sci * D + c);
            v[j] = (v[j] * rstd * g) * (sc + 1.0f) + sh;
            u32x2 o; o.x = pk2(v[j].x, v[j].y); o.y = pk2(v[j].z, v[j].w);
            *(u32x2*)(H + (size_t)r * D + c) = o; }
        if (ROUTER) {
            float lg[8];
#pragma unroll
            for (int e = 0; e < 8; ++e) lg[e] = 0.f;
#pragma unroll
            for (int j = 0; j < 4; ++j)
#pragma unroll
                for (int q = 0; q < 4; ++q) { const int c = 4 * F.lane + 256 * j + q; const f32x4 w0 = *(const f32x4*)(router_w + (size_t)c * 8), w1 = *(const f32x4*)(router_w + (size_t)c * 8 + 4); const float hv = v[j][q];
                    lg[0] += hv * w0.x; lg[1] += hv * w0.y; lg[2] += hv * w0.z; lg[3] += hv * w0.w; lg[4] += hv * w1.x; lg[5] += hv * w1.y; lg[6] += hv * w1.z; lg[7] += hv * w1.w; }
#pragma unroll
            for (int e = 0; e < 8; ++e) lg[e] = wave_sum(lg[e]);
            int e1 = 0; float v1 = lg[0];
#pragma unroll
            for (int e = 1; e < 8; ++e) if (lg[e] > v1) { v1 = lg[e]; e1 = e; }
            int e2 = -1; float v2 = -3.0e38f;
#pragma unroll
            for (int e = 0; e < 8; ++e) if (e != e1 && lg[e] > v2) { v2 = lg[e]; e2 = e; }
            const float ex = __expf(v2 - v1), w1 = 1.f / (1.f + ex), w2 = ex * w1;
            if (F.lane == 0) {
                const int p1 = atomicAdd((int*)&lcnt[e1], 1), p2 = atomicAdd((int*)&lcnt[e2], 1);
                int* te = (int*)(F.ws + WS_TOKE) + 2 * r; te[0] = e1; te[1] = e2;
                int* tp = (int*)(F.ws + WS_TOKP) + 2 * r; tp[0] = p1; tp[1] = p2;
                float* tw = (float*)(F.ws + WS_TOKW) + 2 * r; tw[0] = w1; tw[1] = w2;
            }
        }
    }
    if (ROUTER) { __syncthreads(); if (F.tid < 8) ((int*)(F.ws + WS_CNTWG))[F.bx * 8 + F.tid] = lcnt[F.tid]; __syncthreads(); }
}

__device__ __forceinline__ void moe_scatter_phase(Frame& F) {
    LAS int* tab = (LAS int*)F.lds;
    const int* cw = (const int*)(F.ws + WS_CNTWG);
    if (F.tid < 32) tab[F.tid] = 0;
    __syncthreads();
    for (int idx = F.tid; idx < F.G * 8; idx += NTHR) {
        const int c = __hip_atomic_load(cw + idx, __ATOMIC_RELAXED, __HIP_MEMORY_SCOPE_AGENT); const int w = idx >> 3, e = idx & 7;
        atomicAdd((int*)&tab[16 + e], c); if (w < F.bx) atomicAdd((int*)&tab[8 + e], c);
    }
    __syncthreads();
    if (F.tid == 0) { int off = 0; for (int e = 0; e < 8; ++e) { tab[e] = off; off += ((tab[16 + e] + 255) / 256) * 256; } tab[24] = off / 256;
        if (F.bx == 0) { int* tl = (int*)(F.ws + WS_TILE); int t = 0; for (int e = 0; e < 8; ++e) { const int n = (tab[16 + e] + 255) / 256; for (int q = 0; q < n; ++q) tl[t++] = e; } tl[200] = t; } }
    __syncthreads();
    const bf16* H = (const bf16*)(F.ws + WS_H); bf16* HS = (bf16*)(F.ws + WS_H2S);
    for (int i = 0; i < 8; ++i) {
        const int r = F.bx * 64 + F.wave + 8 * i; if (r >= ML) continue;
        const int* te = (const int*)(F.ws + WS_TOKE) + 2 * r; const int* tp = (const int*)(F.ws + WS_TOKP) + 2 * r;
        const int e1 = te[0], e2 = te[1];
        const int s1 = tab[e1] + tab[8 + e1] + tp[0], s2 = tab[e2] + tab[8 + e2] + tp[1];
        if (F.lane == 0) { int* ts = (int*)(F.ws + WS_TOKS) + 2 * r; ts[0] = s1; ts[1] = s2; }
        const u32x4* src = (const u32x4*)(H + (size_t)r * D);
        const u32x4 a = src[F.lane], b = src[64 + F.lane];
        u32x4* d1 = (u32x4*)(HS + (size_t)s1 * D); u32x4* d2 = (u32x4*)(HS + (size_t)s2 * D);
        d1[F.lane] = a; d1[64 + F.lane] = b; d2[F.lane] = a; d2[64 + F.lane] = b;
    }
}

__device__ __forceinline__ void final_phase(Frame& F, const float* final_g, float* out, const float* modl) {
    const float* X1 = (const float*)(F.ws + WS_X1); const bf16* YS = (const bf16*)(F.ws + WS_YS);
    const int NGW = F.G * NWAVES;
    for (int r = F.bx * NWAVES + F.wave; r < ML; r += NGW) {
        const int bidx = r / SEQ; const float* g2 = modl + (size_t)bidx * MODW + 5 * D;
        const int* ts = (const int*)(F.ws + WS_TOKS) + 2 * r; const float* tw = (const float*)(F.ws + WS_TOKW) + 2 * r;
        const int s1 = ts[0], s2 = ts[1]; const float w1 = tw[0], w2 = tw[1];
        f32x4 v[4]; float ss = 0.f;
#pragma unroll
        for (int j = 0; j < 4; ++j) { const int c = 4 * F.lane + 256 * j;
            const f32x4 xv = *(const f32x4*)(X1 + (size_t)r * D + c), g = *(const f32x4*)(g2 + c);
            const u32x2 y1 = *(const u32x2*)(YS + (size_t)s1 * D + c), y2 = *(const u32x2*)(YS + (size_t)s2 * D + c);
            f32x4 f; f.x = w1 * bflo(y1.x) + w2 * bflo(y2.x); f.y = w1 * bfhi(y1.x) + w2 * bfhi(y2.x); f.z = w1 * bflo(y1.y) + w2 * bflo(y2.y); f.w = w1 * bfhi(y1.y) + w2 * bfhi(y2.y);
            v[j] = xv + g * f; ss += (v[j].x * v[j].x + v[j].y * v[j].y) + (v[j].z * v[j].z + v[j].w * v[j].w); }
        const float rstd = 1.0f / sqrtf(wave_sum(ss) * (1.f / D) + EPS);
#pragma unroll
        for (int j = 0; j < 4; ++j) { const int c = 4 * F.lane + 256 * j; const f32x4 g = *(const f32x4*)(final_g + c);
            *(f32x4*)(out + (size_t)r * D + c) = v[j] * rstd * g; }
    }
}

__device__ __forceinline__ void unpack8(const u32x4 w, float (&f)[8]) { f[0] = bflo(w.x); f[1] = bfhi(w.x); f[2] = bflo(w.y); f[3] = bfhi(w.y); f[4] = bflo(w.z); f[5] = bfhi(w.z); f[6] = bflo(w.w); f[7] = bfhi(w.w); }
__device__ __forceinline__ void local_mix_phase(Frame& F, const float* cw, int nrows) {
    const bf16* Z = (const bf16*)(F.ws + WS_Z); bf16* MIX = (bf16*)(F.ws + WS_MIX);
    const int total = nrows * 64, stride = F.G * NTHR;
    for (int idx = F.bx * NTHR + F.tid; idx < total; idx += stride) {
        const int r = idx >> 6, cg = idx & 63, c0 = cg * 8;
        int t, L, base;
        if (r < ML) { t = r % SEQ; L = SEQ; base = r - t; } else { const int rc = r - ML; t = rc % CTXL; L = CTXL; base = r - t; }
        float o[8];
#pragma unroll
        for (int q = 0; q < 8; ++q) o[q] = 0.f;
#pragma unroll
        for (int j = 0; j < 3; ++j) { const int tt = t - 1 + j; if (tt < 0 || tt >= L) continue;
            const bf16* zr = Z + (size_t)(base + tt) * INW; float cx[8], cc[8];
            unpack8(*(const u32x4*)(zr + ZCX + c0), cx); unpack8(*(const u32x4*)(zr + ZCC + c0), cc);
            const f32x4 w0 = *(const f32x4*)(cw + j * 512 + c0), w1 = *(const f32x4*)(cw + j * 512 + c0 + 4);
            o[0] += w0.x * (cc[0] * cx[0]); o[1] += w0.y * (cc[1] * cx[1]); o[2] += w0.z * (cc[2] * cx[2]); o[3] += w0.w * (cc[3] * cx[3]);
            o[4] += w1.x * (cc[4] * cx[4]); o[5] += w1.y * (cc[5] * cx[5]); o[6] += w1.z * (cc[6] * cx[6]); o[7] += w1.w * (cc[7] * cx[7]); }
        { float cb[8]; unpack8(*(const u32x4*)(Z + (size_t)r * INW + ZCB + c0), cb);
          u32x4 w; w.x = pk2(cb[0] * o[0], cb[1] * o[1]); w.y = pk2(cb[2] * o[2], cb[3] * o[3]); w.z = pk2(cb[4] * o[4], cb[5] * o[5]); w.w = pk2(cb[6] * o[6], cb[7] * o[7]);
          *(u32x4*)(MIX + (size_t)r * MIXW + 512 + c0) = w; }
        { const int hw = 1 << (c0 >> 7); const int lo = t - hw < 0 ? 0 : t - hw, hi = t + hw > L ? L : t + hw;
          float s[8];
#pragma unroll
          for (int q = 0; q < 8; ++q) s[q] = 0.f;
          for (int tt = lo; tt < hi; ++tt) { float u[8]; unpack8(*(const u32x4*)(Z + (size_t)(base + tt) * INW + ZPU + c0), u);
#pragma unroll
              for (int q = 0; q < 8; ++q) s[q] += u[q]; }
          float u0[8]; unpack8(*(const u32x4*)(Z + (size_t)r * INW + ZPU + c0), u0);
          const float inv = 1.0f / (float)(hi - lo);
          u32x4 w; w.x = pk2(s[0] * inv - u0[0], s[1] * inv - u0[1]); w.y = pk2(s[2] * inv - u0[2], s[3] * inv - u0[3]);
          w.z = pk2(s[4] * inv - u0[4], s[5] * inv - u0[5]); w.w = pk2(s[6] * inv - u0[6], s[7] * inv - u0[7]);
          *(u32x4*)(MIX + (size_t)r * MIXW + 1024 + c0) = w; }
    }
}

__device__ __forceinline__ void attn_naive_phase(Frame& F, const float* sinkl, int nrows) {
    const bf16* Z = (const bf16*)(F.ws + WS_Z); bf16* MIX = (bf16*)(F.ws + WS_MIX);
    LAS float* qs = (LAS float*)(F.lds + F.wave * 10240);
    LAS float* sc = qs + 256;
    const int nunits = nrows * 2, NGW = F.G * NWAVES;
    for (int uidx = F.bx * NWAVES + F.wave; uidx < nunits; uidx += NGW) {
        const int r = uidx >> 1, kh = uidx & 1;
        int b, nloc, krow0;
        if (r < ML) { b = r / SEQ; const int t = r % SEQ; const int lo = t - 128 < 0 ? 0 : t - 128, hi = t + 128 > SEQ - 1 ? SEQ - 1 : t + 128; nloc = hi - lo + 1; krow0 = b * SEQ + lo; }
        else { b = (r - ML) / CTXL; nloc = 0; krow0 = 0; }
        const int crow0 = ML + b * CTXL, nk = nloc + CTXL;
        { const u32x2 qw = *(const u32x2*)(Z + (size_t)r * INW + ZQ + kh * 256 + 4 * F.lane); const int g = F.lane >> 4, d = (4 * F.lane) & 63;
          qs[(d + 0) * 4 + g] = bflo(qw.x); qs[(d + 1) * 4 + g] = bfhi(qw.x); qs[(d + 2) * 4 + g] = bflo(qw.y); qs[(d + 3) * 4 + g] = bfhi(qw.y); }
        LDS_WAIT(); asm volatile("" ::: "memory");
        for (int c0 = 0; c0 < nk; c0 += 64) {
            const int kk = c0 + F.lane;
            if (kk < nk) {
                const int krow = kk < nloc ? krow0 + kk : crow0 + (kk - nloc);
                const u32x4* kp = (const u32x4*)(Z + (size_t)krow * INW + ZK + kh * 64);
                f32x4 s = (f32x4){0.f, 0.f, 0.f, 0.f};
#pragma unroll
                for (int d8 = 0; d8 < 8; ++d8) { float kf[8]; unpack8(kp[d8], kf);
#pragma unroll
                    for (int q = 0; q < 8; ++q) { const f32x4 qv = *(const LAS f32x4*)(qs + (d8 * 8 + q) * 4); s += qv * kf[q]; } }
                *(LAS f32x4*)(sc + kk * 4) = s;
            }
        }
        LDS_WAIT(); asm volatile("" ::: "memory");
        f32x4 mx; { const float* sk = sinkl + kh * 4; mx = (f32x4){sk[0], sk[1], sk[2], sk[3]}; }
        const f32x4 snk = mx;
        for (int kk = F.lane; kk < nk; kk += 64) { const f32x4 s = *(const LAS f32x4*)(sc + kk * 4); mx.x = fmaxf(mx.x, s.x); mx.y = fmaxf(mx.y, s.y); mx.z = fmaxf(mx.z, s.z); mx.w = fmaxf(mx.w, s.w); }
        mx.x = wave_max(mx.x); mx.y = wave_max(mx.y); mx.z = wave_max(mx.z); mx.w = wave_max(mx.w);
        f32x4 sm = (f32x4){0.f, 0.f, 0.f, 0.f};
        for (int kk = F.lane; kk < nk; kk += 64) { f32x4 s = *(const LAS f32x4*)(sc + kk * 4);
            s.x = __expf(s.x - mx.x); s.y = __expf(s.y - mx.y); s.z = __expf(s.z - mx.z); s.w = __expf(s.w - mx.w); sm += s; *(LAS f32x4*)(sc + kk * 4) = s; }
        sm.x = wave_sum(sm.x) + __expf(snk.x - mx.x); sm.y = wave_sum(sm.y) + __expf(snk.y - mx.y); sm.z = wave_sum(sm.z) + __expf(snk.z - mx.z); sm.w = wave_sum(sm.w) + __expf(snk.w - mx.w);
        LDS_WAIT(); asm volatile("" ::: "memory");
        f32x4 o = (f32x4){0.f, 0.f, 0.f, 0.f};
        const bf16* vb = Z + ZV + kh * 64 + F.lane;
#pragma unroll 4
        for (int kk = 0; kk < nk; ++kk) { const int krow = kk < nloc ? krow0 + kk : crow0 + (kk - nloc);
            const float v = bf2f((unsigned)vb[(size_t)krow * INW]); const f32x4 p = *(const LAS f32x4*)(sc + kk * 4); o += p * v; }
        bf16* op = MIX + (size_t)r * MIXW + kh * 256 + F.lane;
        op[0] = (bf16)f2bf(o.x / sm.x); op[64] = (bf16)f2bf(o.y / sm.y); op[128] = (bf16)f2bf(o.z / sm.z); op[192] = (bf16)f2bf(o.w / sm.w);
        LDS_WAIT(); asm volatile("" ::: "memory");
    }
}

using pg8::Unit;
struct SchedStd {
    const char* A; const char* B; size_t astep, bstep; int nM, nN, G, c, nx, xpm0, xpn;
    __device__ __forceinline__ bool next(int i, Unit& u) const {
        const int L = i * G + c, nwg = nM * nN; if (L >= nwg + nx) return false;
        if (L < nwg) pg8::tile_of(L, nM, nN, u.pm, u.pn); else { u.pm = xpm0 + (L - nwg); u.pn = xpn; }
        u.tag = 0; u.a = A + (size_t)u.pm * astep; u.b = B + (size_t)u.pn * bstep; return true;
    }
};
struct SchedBr {
    const char* A; const char* B; int nM, G, c;
    __device__ __forceinline__ bool next(int i, Unit& u) const {
        const int t = i / 3, br = i - 3 * t; const int L = t * G + c; if (L >= nM * 4) return false;
        pg8::tile_of(L, nM, 4, u.pm, u.pn); u.tag = br;
        u.a = A + ((size_t)u.pm * 256 * MIXW + br * 512) * 2; u.b = B + ((size_t)br * D * 512 + (size_t)u.pn * 256 * 512) * 2; return true;
    }
};
struct SchedMoe {
    const char* A; const char* B; size_t astep, bstep_e, bstep_n; int NJ, G, c; const int* tile;
    __device__ __forceinline__ bool next(int i, Unit& u) const {
        const int nt = __builtin_amdgcn_readfirstlane(__hip_atomic_load(tile + 200, __ATOMIC_RELAXED, __HIP_MEMORY_SCOPE_AGENT));
        const int L = i * G + c; if (L >= nt * NJ) return false;
        u.pm = L % nt; u.pn = L / nt; u.tag = __builtin_amdgcn_readfirstlane(__hip_atomic_load(tile + u.pm, __ATOMIC_RELAXED, __HIP_MEMORY_SCOPE_AGENT));
        u.a = A + (size_t)u.pm * astep; u.b = B + (size_t)u.tag * bstep_e + (size_t)u.pn * bstep_n; return true;
    }
};

struct EpiIn {
    static constexpr bool PERM = true;
    bf16* Z; const float* rope;
    __device__ __forceinline__ void operator()(const f32x4 (&acc)[2][2][4][2], const Unit& u, int wr, int wc, int fr, int fq) const {
        const int row0 = u.pm * 256 + wr * 64 + fr, col0 = u.pn * 256 + wc * 32 + 8 * fq;
        const bool latent = u.pm < 64, gate = u.pn >= 11;
        const float sgn = fq < 2 ? -1.f : 1.f;
#pragma unroll
        for (int ai = 0; ai < 2; ++ai)
#pragma unroll
            for (int m = 0; m < 4; ++m) { const int row = row0 + ai * 128 + m * 16; bf16* rowp = Z + (size_t)row * INW + col0;
                const int pos = (wc & 1) ? (16 * m + fr) : (4 * (u.pm & 15) + 2 * ai + wr);
#pragma unroll
                for (int bj = 0; bj < 2; ++bj) { f32x4 v0 = acc[ai][bj][m][0], v1 = acc[ai][bj][m][1];
                    const bool isq = u.pn < 2, isk = (u.pn == 2 && bj == 0);
                    if (isq || isk) {
                        if (latent) {
                            const f32x4* cs = (const f32x4*)(rope + (size_t)(pos * 16 + 8 * (fq & 1)) * 2);
                            const f32x4 t0 = cs[0], t1 = cs[1], t2 = cs[2], t3 = cs[3];
                            f32x4 p0, p1;
                            p0.x = __shfl_xor(v0.x, 32); p0.y = __shfl_xor(v0.y, 32); p0.z = __shfl_xor(v0.z, 32); p0.w = __shfl_xor(v0.w, 32);
                            p1.x = __shfl_xor(v1.x, 32); p1.y = __shfl_xor(v1.y, 32); p1.z = __shfl_xor(v1.z, 32); p1.w = __shfl_xor(v1.w, 32);
                            v0.x = v0.x * t0.x + p0.x * (sgn * t0.y); v0.y = v0.y * t0.z + p0.y * (sgn * t0.w); v0.z = v0.z * t1.x + p0.z * (sgn * t1.y); v0.w = v0.w * t1.z + p0.w * (sgn * t1.w);
                            v1.x = v1.x * t2.x + p1.x * (sgn * t2.y); v1.y = v1.y * t2.z + p1.y * (sgn * t2.w); v1.z = v1.z * t3.x + p1.z * (sgn * t3.y); v1.w = v1.w * t3.z + p1.w * (sgn * t3.w);
                        }
                        if (isq) { v0 = v0 * 0.125f; v1 = v1 * 0.125f; }
                    }
                    if (gate) {
#pragma unroll
                        for (int q = 0; q < 4; ++q) { v0[q] = 1.f / (1.f + __expf(-v0[q])); v1[q] = 1.f / (1.f + __expf(-v1[q])); } }
                    u32x4 w; w.x = pg8::cvt_pk_bf16(v0[0], v0[1]); w.y = pg8::cvt_pk_bf16(v0[2], v0[3]); w.z = pg8::cvt_pk_bf16(v1[0], v1[1]); w.w = pg8::cvt_pk_bf16(v1[2], v1[3]);
                    *(u32x4*)(rowp + bj * 128) = w; } }
    }
};
struct EpiBr {
    static constexpr bool PERM = false;
    const bf16* Z; float* YACC; bf16* Y;
    __device__ __forceinline__ void operator()(const f32x4 (&acc)[2][2][4][2], const Unit& u, int wr, int wc, int fr, int fq) const {
        const int row0 = u.pm * 256 + wr * 64 + fr, col0 = u.pn * 256 + wc * 32 + 4 * fq; const int br = u.tag;
#pragma unroll
        for (int ai = 0; ai < 2; ++ai)
#pragma unroll
            for (int m = 0; m < 4; ++m) { const int row = row0 + ai * 128 + m * 16;
#pragma unroll
                for (int bj = 0; bj < 2; ++bj)
#pragma unroll
                    for (int n = 0; n < 2; ++n) { const int c = col0 + bj * 128 + n * 16;
                        const u32x2 gw = *(const u32x2*)(Z + (size_t)row * INW + ZG + br * D + c);
                        f32x4 v = acc[ai][bj][m][n]; v.x *= bflo(gw.x); v.y *= bfhi(gw.x); v.z *= bflo(gw.y); v.w *= bfhi(gw.y);
                        float* yp = YACC + (size_t)row * D + c;
                        if (br == 0) *(f32x4*)yp = v;
                        else if (br == 1) *(f32x4*)yp = *(const f32x4*)yp + v;
                        else { v += *(const f32x4*)yp; u32x2 w; w.x = pg8::cvt_pk_bf16(v.x, v.y); w.y = pg8::cvt_pk_bf16(v.z, v.w); *(u32x2*)(Y + (size_t)row * D + c) = w; } } }
    }
};
struct EpiRes {
    static constexpr bool PERM = false;
    const float* rl; const float* rc; float* out; const float* gv;
    __device__ __forceinline__ void operator()(const f32x4 (&acc)[2][2][4][2], const Unit& u, int wr, int wc, int fr, int fq) const {
        const int row0 = u.pm * 256 + wr * 64 + fr, col0 = u.pn * 256 + wc * 32 + 4 * fq;
        const int bidx = u.pm < 64 ? (u.pm >> 4) : 4; const float* g = gv + (size_t)bidx * MODW;
        const float* rbase = u.pm < 64 ? rl : rc - (size_t)ML * D;
        f32x4 gg[2][2];
#pragma unroll
        for (int bj = 0; bj < 2; ++bj)
#pragma unroll
            for (int n = 0; n < 2; ++n) gg[bj][n] = *(const f32x4*)(g + col0 + bj * 128 + n * 16);
#pragma unroll
        for (int ai = 0; ai < 2; ++ai)
#pragma unroll
            for (int m = 0; m < 4; ++m) { const size_t off = (size_t)(row0 + ai * 128 + m * 16) * D + col0;
#pragma unroll
                for (int bj = 0; bj < 2; ++bj)
#pragma unroll
                    for (int n = 0; n < 2; ++n) *(f32x4*)(out + off + bj * 128 + n * 16) = *(const f32x4*)(rbase + off + bj * 128 + n * 16) + gg[bj][n] * acc[ai][bj][m][n]; }
    }
};
struct EpiSwiglu {
    static constexpr bool PERM = true;
    bf16* ACT; int ldc;
    __device__ __forceinline__ void operator()(const f32x4 (&acc)[2][2][4][2], const Unit& u, int wr, int wc, int fr, int fq) const {
        const int row0 = u.pm * 256 + wr * 64 + fr, col0 = u.pn * 128 + wc * 32 + 8 * fq;
#pragma unroll
        for (int ai = 0; ai < 2; ++ai)
#pragma unroll
            for (int m = 0; m < 4; ++m) { f32x4 r[2];
#pragma unroll
                for (int n = 0; n < 2; ++n) { const f32x4 g = acc[ai][0][m][n], up = acc[ai][1][m][n];
#pragma unroll
                    for (int q = 0; q < 4; ++q) r[n][q] = g[q] / (1.f + __expf(-g[q])) * up[q]; }
                u32x4 w; w.x = pg8::cvt_pk_bf16(r[0][0], r[0][1]); w.y = pg8::cvt_pk_bf16(r[0][2], r[0][3]); w.z = pg8::cvt_pk_bf16(r[1][0], r[1][1]); w.w = pg8::cvt_pk_bf16(r[1][2], r[1][3]);
                *(u32x4*)(ACT + (size_t)(row0 + ai * 128 + m * 16) * ldc + col0) = w; }
    }
};
struct EpiPlain {
    static constexpr bool PERM = true;
    bf16* O; int ldc;
    __device__ __forceinline__ void operator()(const f32x4 (&acc)[2][2][4][2], const Unit& u, int wr, int wc, int fr, int fq) const {
        const int row0 = u.pm * 256 + wr * 64 + fr, col0 = u.pn * 256 + wc * 32 + 8 * fq;
#pragma unroll
        for (int ai = 0; ai < 2; ++ai)
#pragma unroll
            for (int m = 0; m < 4; ++m)
#pragma unroll
                for (int bj = 0; bj < 2; ++bj) { const f32x4 v0 = acc[ai][bj][m][0], v1 = acc[ai][bj][m][1];
                    u32x4 w; w.x = pg8::cvt_pk_bf16(v0[0], v0[1]); w.y = pg8::cvt_pk_bf16(v0[2], v0[3]); w.z = pg8::cvt_pk_bf16(v1[0], v1[1]); w.w = pg8::cvt_pk_bf16(v1[2], v1[3]);
                    *(u32x4*)(O + (size_t)(row0 + ai * 128 + m * 16) * ldc + col0 + bj * 128) = w; }
    }
};

#define IN(k) (lo <= (k) && (k) < hi)
#define SEAM(k) do { if (IN(k) && IN((k) + 1)) xcd_barrier(bar); } while (0)
#define SITE() do { F.ws = (unsigned char*)karg_p<(int)__builtin_offsetof(Args, ws)>(); int t_ = threadIdx.x; asm volatile("" : "+v"(t_)); F.tid = t_; F.lane = t_ & 63; } while (0)
template <int l> __device__ __forceinline__ void layer_common(Frame& F, const int lo, const int hi, const XcdBarrier& bar, LAS unsigned char* ring) {
    constexpr int pb = 1 + 8 * l;
        if (IN(pb + 0)) { SITE(); const float* modl = (const float*)(F.ws + WS_MODV) + (size_t)l * 5 * MODW; const float* X2 = (const float*)(F.ws + WS_X2);
            const float* xl = l == 0 ? KP(x) : X2; const float* xc = l == 0 ? KP(ctx) : X2 + (size_t)ML * D;
            norm_mod_phase<false>(F, xl, xc, KP(norm1_g) + l * D, modl, 0, 1, MT, nullptr); } SEAM(pb + 0);
        if (IN(pb + 1)) { SITE();
            SchedStd S{(const char*)(F.ws + WS_H), (const char*)(F.ws + WS_WIN) + (size_t)l * INW * D * 2, (size_t)256 * D * 2, (size_t)256 * D * 2, l == 0 ? 68 : 64, 23, F.G, F.bx, l == 0 ? 0 : 4, 64, 2};
            EpiIn E{(bf16*)(F.ws + WS_Z), (const float*)(F.ws + WS_ROPE)};
            pg8::gemm_phase<EpiIn, SchedStd, true, true>(ring, D, D, D, S, E);
        } SEAM(pb + 1);
        if (IN(pb + 2)) { SITE(); const int nrows = l == 0 ? MT : ML; attn_naive_phase(F, KP(sink) + l * 8, nrows); local_mix_phase(F, KP(conv_w) + (size_t)l * 3 * 512, nrows); } SEAM(pb + 2);
        if (IN(pb + 3)) { SITE();
            SchedBr S{(const char*)(F.ws + WS_MIX), (const char*)(F.ws + WS_WBR) + (size_t)l * 3 * D * 512 * 2, l == 0 ? 68 : 64, F.G, F.bx};
            EpiBr E{(const bf16*)(F.ws + WS_Z), (float*)(F.ws + WS_YACC), (bf16*)(F.ws + WS_Y)};
            pg8::gemm_phase<EpiBr, SchedBr, true, true>(ring, MIXW, 512, 512, S, E);
        } SEAM(pb + 3);
        if (IN(pb + 4)) { SITE(); const float* modl = (const float*)(F.ws + WS_MODV) + (size_t)l * 5 * MODW; const float* X2 = (const float*)(F.ws + WS_X2);
            const float* xl = l == 0 ? KP(x) : X2; const float* xc = l == 0 ? KP(ctx) : X2 + (size_t)ML * D;
            SchedStd S{(const char*)(F.ws + WS_Y), (const char*)(F.ws + WS_WOUT) + (size_t)l * D * D * 2, (size_t)256 * D * 2, (size_t)256 * D * 2, l == 0 ? 68 : 64, 4, F.G, F.bx, 0, 0, 0};
            EpiRes E{xl, xc, (float*)(F.ws + WS_X1), modl + 2 * D};
            pg8::gemm_phase<EpiRes, SchedStd, true, true>(ring, D, D, D, S, E);
        } SEAM(pb + 4);
}
constexpr int N_PHASES = 19;
__global__ void __launch_bounds__(NTHR, 2) mk_fwd(Args args_byval) {
    extern __shared__ __attribute__((aligned(16))) unsigned char lds_raw[];
    Frame F;
    F.lds = (LAS unsigned char*)lds_raw;
    F.tid = threadIdx.x; F.lane = F.tid & 63; F.wave = __builtin_amdgcn_readfirstlane(F.tid >> 6);
    F.G = gridDim.x; F.bx = blockIdx.x;
    SITE();
    volatile LAS unsigned* MISC = (volatile LAS unsigned*)(F.lds + MISC_OFF);
    for (int u = F.tid; u < (LDS_BYTES - LDSCTL_OFF) / 4; u += NTHR) ((LAS unsigned*)(F.lds + LDSCTL_OFF))[u] = 0u;
    __syncthreads();
    const int lo = karg_i<(int)__builtin_offsetof(Args, ph_lo)>(), hi = karg_i<(int)__builtin_offsetof(Args, ph_hi)>();
    const bool fused = (hi - lo) > 1;
    XcdBarrier bar; bar.bar = (unsigned*)(F.ws + WS_CTL) + CW_BAR; bar.x = 0; bar.st = nullptr;
    if (fused) bar = xcd_barrier_post((unsigned*)(F.ws + WS_CTL) + CW_BAR, MISC + 8);
    LAS unsigned char* ring = F.lds;

    if (IN(0)) { SITE(); p0_prologue(F); } SEAM(0);

    layer_common<0>(F, lo, hi, bar, ring);
    {
            if (IN(6)) { SITE(); const float* X1 = (const float*)(F.ws + WS_X1); norm_mod_phase<false>(F, X1, X1 + (size_t)ML * D, KP(norm2_g), (const float*)(F.ws + WS_MODV), 3, 4, MT, nullptr); } SEAM(6);
            if (IN(7)) { SITE();
                SchedStd S{(const char*)(F.ws + WS_H), (const char*)(F.ws + WS_WGU0), (size_t)256 * D * 2, (size_t)256 * D * 2, 68, 22, F.G, F.bx, 0, 0, 0};
                EpiSwiglu E{(bf16*)(F.ws + WS_ACT), DFF};
                pg8::gemm_phase<EpiSwiglu, SchedStd, true, true>(ring, D, D, D, S, E);
            } SEAM(7);
            if (IN(8)) { SITE(); const float* X1 = (const float*)(F.ws + WS_X1);
                SchedStd S{(const char*)(F.ws + WS_ACT), (const char*)(F.ws + WS_WDN0), (size_t)256 * DFF * 2, (size_t)256 * DFF * 2, 68, 4, F.G, F.bx, 0, 0, 0};
                EpiRes E{X1, X1 + (size_t)ML * D, (float*)(F.ws + WS_X2), (const float*)(F.ws + WS_MODV) + 5 * D};
                pg8::gemm_phase<EpiRes, SchedStd, true, true>(ring, DFF, DFF, DFF, S, E);
            } SEAM(8);
    }
    layer_common<1>(F, lo, hi, bar, ring);
    {
            if (IN(14)) { SITE(); const float* X1 = (const float*)(F.ws + WS_X1); norm_mod_phase<true>(F, X1, X1, KP(norm2_g) + D, (const float*)(F.ws + WS_MODV) + (size_t)5 * MODW, 3, 4, ML, KP(router_w)); } SEAM(14);
            if (IN(15)) { SITE(); moe_scatter_phase(F); } SEAM(15);
            if (IN(16)) { SITE();
                SchedMoe S{(const char*)(F.ws + WS_H2S), (const char*)(F.ws + WS_WMGU), (size_t)256 * D * 2, (size_t)2 * DFE * D * 2, (size_t)256 * D * 2, 28, F.G, F.bx, (const int*)(F.ws + WS_TILE)};
                EpiSwiglu E{(bf16*)(F.ws + WS_ACT), DFE};
                pg8::gemm_phase<EpiSwiglu, SchedMoe, true, true>(ring, D, D, D, S, E);
            } SEAM(16);
            if (IN(17)) { SITE();
                SchedMoe S{(const char*)(F.ws + WS_ACT), (const char*)(F.ws + WS_WMDN), (size_t)256 * DFE * 2, (size_t)D * DFE * 2, (size_t)256 * DFE * 2, 4, F.G, F.bx, (const int*)(F.ws + WS_TILE)};
                EpiPlain E{(bf16*)(F.ws + WS_YS), D};
                pg8::gemm_phase<EpiPlain, SchedMoe, true, true>(ring, DFE, DFE, DFE, S, E);
            } SEAM(17);
            if (IN(18)) { SITE(); final_phase(F, KP(final_g), (float*)karg_p<(int)__builtin_offsetof(Args, out)>(), (const float*)(F.ws + WS_MODV) + (size_t)5 * MODW); }
        }

#undef IN
#undef SEAM
}

extern "C" void kernel_launch(void* const* d_in, const int* in_sizes, int n_in, void* d_out, int out_size, void* d_ws, size_t ws_size, hipStream_t stream) {
    static int grid = 0;
    if (grid == 0) {
        if (n_in != 21 || out_size != ML * D || ws_size < WS_END) { fprintf(stderr, "kernel_launch: unexpected sizes (n_in %d, out %d, ws %zu < %zu)\n", n_in, out_size, ws_size, (size_t)WS_END); grid = -1; return; }
        int dev = 0, cus = 0, per_cu = 0;
        if (hipGetDevice(&dev) != hipSuccess || hipDeviceGetAttribute(&cus, hipDeviceAttributeMultiprocessorCount, dev) != hipSuccess) { grid = -1; return; }
        if (hipFuncSetAttribute((const void*)mk_fwd, hipFuncAttributeMaxDynamicSharedMemorySize, LDS_BYTES) != hipSuccess) { fprintf(stderr, "kernel_launch: hipFuncSetAttribute failed\n"); grid = -1; return; }
        if (hipOccupancyMaxActiveBlocksPerMultiprocessor(&per_cu, (const void*)mk_fwd, NTHR, LDS_BYTES) != hipSuccess || per_cu < 1) { fprintf(stderr, "kernel_launch: occupancy query says %d\n", per_cu); per_cu = 1; }
        (void)hipGetLastError();
        grid = cus;
    }
    if (grid < 0) return;
    (void)hipMemsetAsync((char*)d_ws + WS_CTL, 0, CTL_ZERO_BYTES, stream);
    Args a{};
    const float** pp = (const float**)&a;
    for (int i = 0; i < 21; ++i) pp[i] = (const float*)d_in[i];
    a.out = (float*)d_out; a.ws = (unsigned char*)d_ws;
#if MK_FUSED
    a.ph_lo = 0; a.ph_hi = N_PHASES;
    hipLaunchKernelGGL(mk_fwd, dim3(grid), dim3(NTHR), LDS_BYTES, stream, a);
#else
    for (int p = 0; p < N_PHASES; ++p) { a.ph_lo = p; a.ph_hi = p + 1; hipLaunchKernelGGL(mk_fwd, dim3(grid), dim3(NTHR), LDS_BYTES, stream, a); }
#endif
}
```

```cpp
#include <hip/hip_runtime.h>
#include <cstdio>
#include <cstdint>

#ifndef ATTN_NAIVE
#define ATTN_NAIVE 0
#endif
#ifndef MK_FUSED
#define MK_FUSED 1
#endif

#define LAS __attribute__((address_space(3)))
#define GAS __attribute__((address_space(1)))
typedef unsigned short bf16;
typedef short bf16x8 __attribute__((ext_vector_type(8)));
typedef float f32x4 __attribute__((ext_vector_type(4)));
typedef float f32x2 __attribute__((ext_vector_type(2)));
typedef unsigned u32x4 __attribute__((ext_vector_type(4)));
typedef unsigned u32x2 __attribute__((ext_vector_type(2)));
typedef GAS unsigned gu32;

constexpr int D = 1024, NB = 4, SEQ = 4096, ML = NB * SEQ, CTXL = 256, MC = NB * CTXL, MT = ML + MC;
constexpr int INW = 5888, DFF = 2816, DFE = 3584, NE = 8;
constexpr int ZQ = 0, ZK = 512, ZV = 640, ZCX = 768, ZCB = 1280, ZCC = 1792, ZPU = 2304, ZG = 2816;
constexpr int MIXW = 1536;
constexpr int MS = 2 * ML + NE * 256;
constexpr int MODW = 6 * D;
constexpr float EPS = 1e-6f;
constexpr float LOG2E = 1.4426950408889634f, QSCALE = 0.125f * LOG2E;
constexpr int NWAVES = 8, NTHR = 512;

__device__ __forceinline__ unsigned f2bf(float f) { unsigned u = __builtin_bit_cast(unsigned, f); return (u + 0x7fffu + ((u >> 16) & 1u)) >> 16; }
__device__ __forceinline__ unsigned pk2(float lo, float hi) { return f2bf(lo) | (f2bf(hi) << 16); }
__device__ __forceinline__ float bf2f(unsigned b) { return __builtin_bit_cast(float, b << 16); }
__device__ __forceinline__ float bflo(unsigned w) { return __builtin_bit_cast(float, w << 16); }
__device__ __forceinline__ float bfhi(unsigned w) { return __builtin_bit_cast(float, w & 0xffff0000u); }

namespace pg8 {
constexpr int BM = 256, BK = 64, HALF = 128, HTB = HALF * BK * 2, STAGE_BYTES = 8 * HTB, NXCD = 8, WGM = 8;
__host__ __device__ __forceinline__ int lds_byte(int r, int c) { const int st = (r >> 4) * 2 + (c >> 5), rr = r & 15, cc = c & 31, ob = rr * 64 + cc * 2; return st * 1024 + (ob ^ (((ob >> 9) & 1) << 5)); }
__host__ __device__ __forceinline__ void stage_rc(int b, int& R, int& C) { const int st = b / 1024, sb = b % 1024, swz = sb ^ (((sb >> 9) & 1) << 5); R = (st >> 1) * 16 + swz / 64; C = (st & 1) * 32 + (swz % 64) / 2; }
__host__ __device__ __forceinline__ int perm32(int rho) { const int n = rho >> 4, i = rho & 15; return 8 * (i >> 2) + 4 * n + (i & 3); }

struct Unit { int pm, pn, tag; const char* a; const char* b; };

__device__ __forceinline__ void tile_of(int L, int nM, int nN, int& pm, int& pn) {
    const int nwg = nM * nN; int wgid = L;
    { const int q = nwg / NXCD, r = nwg % NXCD, xcd = wgid % NXCD, off = wgid / NXCD; wgid = (xcd < r ? xcd * (q + 1) : r * (q + 1) + (xcd - r) * q) + off; }
    const int nig = WGM * nN, gid = wgid / nig, fm = gid * WGM, gsz = (nM - fm) < WGM ? (nM - fm) : WGM;
    pm = fm + ((wgid % nig) % gsz); pn = (wgid % nig) / gsz;
}

__device__ __forceinline__ unsigned cvt_pk_bf16(float lo, float hi) { unsigned r; asm volatile("v_cvt_pk_bf16_f32 %0, %1, %2" : "=v"(r) : "v"(lo), "v"(hi)); return r; }

template <class Epi, class Sched, bool ALIGN_EPI = false, bool SP2 = false>
__device__ __forceinline__ void gemm_phase(LAS unsigned char* lds, const int lda, const int ldb, const int K, const Sched& S, const Epi& E) {
    int tid_ = threadIdx.x; asm volatile("" : "+v"(tid_));
    const int tid = tid_, wid = __builtin_amdgcn_readfirstlane(tid >> 6), lane = tid & 63, wr = wid >> 2, wc = wid & 3, fr = lane & 15, fq = lane >> 4;
    const int nt = K / BK;
    unsigned voffA[2], voffB[2];
#pragma unroll
    for (int i = 0; i < 2; ++i) { int R, C; stage_rc(tid * 16 + i * 8192, R, C); const int Rb = Epi::PERM ? ((R & ~31) + perm32(R & 31)) : R;
        voffA[i] = (unsigned)(R * lda + C) * 2u; voffB[i] = (unsigned)(Rb * ldb + C) * 2u; }
    const size_t kstep = (size_t)(BK * 2);
    const size_t hstepA = (size_t)HALF * lda * 2, hstepB = (size_t)HALF * ldb * 2;
    const unsigned ldsw = (unsigned)wid * 1024u;
    const int aoff = lds_byte(wr * 64 + fr, fq * 8), boff = lds_byte(wc * 32 + fr, fq * 8);
#define PG8_SA(b, h) (((b) * 2 + (h)) * HTB)
#define PG8_SB(b, h) ((4 + (b) * 2 + (h)) * HTB)
#define PG8_STAGE(bufoff, gbase, voff) do { _Pragma("unroll") for (int _i = 0; _i < 2; ++_i) \
        __builtin_amdgcn_global_load_lds((const unsigned*)((const char*)(gbase) + (voff)[_i]), (LAS unsigned*)(lds + (bufoff) + ldsw + _i * 8192), 16, 0, 0); } while (0)
#define PG8_LDA(dst, b, h) do { _Pragma("unroll") for (int m = 0; m < 4; ++m) _Pragma("unroll") for (int k = 0; k < 2; ++k) dst[m][k] = *(const LAS bf16x8*)(lds + PG8_SA(b, h) + aoff + m * 2048 + k * 1024); } while (0)
#define PG8_LDB(dst, b, h) do { _Pragma("unroll") for (int n = 0; n < 2; ++n) _Pragma("unroll") for (int k = 0; k < 2; ++k) dst[n][k] = *(const LAS bf16x8*)(lds + PG8_SB(b, h) + boff + n * 2048 + k * 1024); } while (0)
#define PG8_MMA(ai, bj, At, Bt) do { __builtin_amdgcn_s_setprio(1); _Pragma("unroll") for (int m = 0; m < 4; ++m) _Pragma("unroll") for (int n = 0; n < 2; ++n) _Pragma("unroll") for (int k = 0; k < 2; ++k) \
        acc[ai][bj][m][n] = __builtin_amdgcn_mfma_f32_16x16x32_bf16(Bt[n][k], At[m][k], acc[ai][bj][m][n], 0, 0, 0); __builtin_amdgcn_s_setprio(0); } while (0)
#define PG8_WAIT_V(n) asm volatile("s_waitcnt vmcnt(" #n ")" ::: "memory")
#define PG8_WAIT_L(n) asm volatile("s_waitcnt lgkmcnt(" #n ")" ::: "memory")
#define PG8_BAR __builtin_amdgcn_s_barrier()
#define PG8_SCHED __builtin_amdgcn_sched_barrier(0)
    Unit cur, nxt; int ui = 0;
    if (!S.next(0, cur)) return;
    f32x4 acc[2][2][4][2];
#pragma unroll
    for (int a = 0; a < 2; ++a)
#pragma unroll
        for (int b = 0; b < 2; ++b)
#pragma unroll
            for (int m = 0; m < 4; ++m)
#pragma unroll
                for (int n = 0; n < 2; ++n) acc[a][b][m][n] = (f32x4){0.f, 0.f, 0.f, 0.f};
    bf16x8 At[4][2], B0[2][2], B1[2][2];
    const char* cA = cur.a; const char* cB = cur.b;
    if constexpr (SP2) {
        PG8_STAGE(PG8_SB(0, 0), cB, voffB); PG8_STAGE(PG8_SB(0, 1), cB + hstepB, voffB); PG8_STAGE(PG8_SA(0, 0), cA, voffA); PG8_STAGE(PG8_SA(0, 1), cA + hstepA, voffA);
        if (wr == 1) PG8_BAR;
        PG8_WAIT_V(2); PG8_BAR;
        PG8_STAGE(PG8_SB(1, 0), cB + kstep, voffB); PG8_STAGE(PG8_SA(1, 0), cA + kstep, voffA); PG8_STAGE(PG8_SB(1, 1), cB + hstepB + kstep, voffB);
        PG8_WAIT_V(6); PG8_BAR;
    } else {
        PG8_STAGE(PG8_SB(0, 0), cB, voffB); PG8_STAGE(PG8_SA(0, 0), cA, voffA); PG8_STAGE(PG8_SB(0, 1), cB + hstepB, voffB); PG8_STAGE(PG8_SA(0, 1), cA + hstepA, voffA);
        if (wr == 1) PG8_BAR;
        PG8_WAIT_V(4); PG8_BAR;
        PG8_STAGE(PG8_SB(1, 0), cB + kstep, voffB); PG8_STAGE(PG8_SA(1, 0), cA + kstep, voffA); PG8_STAGE(PG8_SB(1, 1), cB + hstepB + kstep, voffB);
        PG8_WAIT_V(6); PG8_BAR;
    }
    for (;;) {
        const bool has_next = S.next(ui + 1, nxt);
        const char* nA = has_next ? nxt.a : cA; const char* nB = has_next ? nxt.b : cB;
        for (int t = 0; t < nt; t += 2) {
            const bool last = (t == nt - 2);
            const char* a1 = cA + (size_t)(t + 1) * kstep;
            const char* a2 = last ? nA : cA + (size_t)(t + 2) * kstep; const char* b2 = last ? nB : cB + (size_t)(t + 2) * kstep;
            const char* a3 = a2 + kstep; const char* b3 = b2 + kstep;
            if constexpr (SP2) {
            PG8_LDB(B0, 0, 0); PG8_LDB(B1, 0, 1); PG8_SCHED; PG8_LDA(At, 0, 0); PG8_STAGE(PG8_SA(1, 1), a1 + hstepA, voffA);
            PG8_WAIT_V(8); PG8_WAIT_L(0); PG8_BAR; PG8_MMA(0, 0, At, B0); PG8_MMA(0, 1, At, B1); PG8_BAR; PG8_SCHED;
            PG8_LDA(At, 0, 1); PG8_STAGE(PG8_SB(0, 0), b2, voffB); PG8_STAGE(PG8_SB(0, 1), b2 + hstepB, voffB); PG8_STAGE(PG8_SA(0, 0), a2, voffA);
            PG8_WAIT_V(8); PG8_WAIT_L(0); PG8_BAR; PG8_MMA(1, 0, At, B0); PG8_MMA(1, 1, At, B1); PG8_BAR; PG8_SCHED;
            PG8_LDB(B0, 1, 0); PG8_LDB(B1, 1, 1); PG8_SCHED; PG8_LDA(At, 1, 0); PG8_STAGE(PG8_SA(0, 1), a2 + hstepA, voffA);
            PG8_WAIT_V(8); PG8_WAIT_L(0); PG8_BAR; PG8_MMA(0, 0, At, B0); PG8_MMA(0, 1, At, B1); PG8_BAR; PG8_SCHED;
            PG8_LDA(At, 1, 1); PG8_STAGE(PG8_SB(1, 0), b3, voffB); PG8_STAGE(PG8_SB(1, 1), b3 + hstepB, voffB); PG8_STAGE(PG8_SA(1, 0), a3, voffA);
            PG8_WAIT_V(8); PG8_WAIT_L(0); PG8_BAR; PG8_MMA(1, 0, At, B0); PG8_MMA(1, 1, At, B1); PG8_BAR; PG8_SCHED;
            } else {
            PG8_LDB(B0, 0, 0); PG8_SCHED; PG8_LDA(At, 0, 0); PG8_STAGE(PG8_SA(1, 1), a1 + hstepA, voffA);
            PG8_WAIT_L(8); PG8_BAR; PG8_WAIT_L(0); PG8_MMA(0, 0, At, B0); PG8_BAR; PG8_SCHED;
            PG8_LDB(B1, 0, 1); PG8_STAGE(PG8_SB(0, 0), b2, voffB);
            PG8_BAR; PG8_WAIT_L(0); PG8_MMA(0, 1, At, B1); PG8_BAR;
            PG8_LDA(At, 0, 1); PG8_STAGE(PG8_SA(0, 0), a2, voffA);
            PG8_BAR; PG8_WAIT_L(0); PG8_MMA(1, 0, At, B0); PG8_BAR; PG8_SCHED;
            PG8_STAGE(PG8_SB(0, 1), b2 + hstepB, voffB);
            PG8_WAIT_V(6); PG8_BAR; PG8_MMA(1, 1, At, B1); PG8_BAR;
            PG8_LDB(B0, 1, 0); PG8_SCHED; PG8_LDA(At, 1, 0); PG8_STAGE(PG8_SA(0, 1), a2 + hstepA, voffA);
            PG8_WAIT_L(8); PG8_BAR; PG8_WAIT_L(0); PG8_MMA(0, 0, At, B0); PG8_BAR; PG8_SCHED;
            PG8_LDB(B1, 1, 1); PG8_STAGE(PG8_SB(1, 0), b3, voffB);
            PG8_BAR; PG8_WAIT_L(0); PG8_MMA(0, 1, At, B1); PG8_BAR;
            PG8_LDA(At, 1, 1); PG8_STAGE(PG8_SA(1, 0), a3, voffA);
            PG8_BAR; PG8_WAIT_L(0); PG8_MMA(1, 0, At, B0); PG8_BAR; PG8_SCHED;
            PG8_STAGE(PG8_SB(1, 1), b3 + hstepB, voffB);
            PG8_WAIT_V(6); PG8_BAR; PG8_MMA(1, 1, At, B1); PG8_BAR;
            }
        }
        if constexpr (ALIGN_EPI) { if (wr == 0) PG8_BAR; }
        E(acc, cur, wr, wc, fr, fq);
        if (!has_next) break;
#pragma unroll
        for (int a = 0; a < 2; ++a)
#pragma unroll
            for (int b = 0; b < 2; ++b)
#pragma unroll
                for (int m = 0; m < 4; ++m)
#pragma unroll
                    for (int n = 0; n < 2; ++n) acc[a][b][m][n] = (f32x4){0.f, 0.f, 0.f, 0.f};
        cur = nxt; cA = nA; cB = nB; ++ui;
        if constexpr (ALIGN_EPI) { if (wr == 1) PG8_BAR; }
    }
    PG8_WAIT_V(0);
    if constexpr (!ALIGN_EPI) { if (wr == 0) PG8_BAR; }
    PG8_BAR;
#undef PG8_SA
#undef PG8_SB
#undef PG8_STAGE
#undef PG8_LDA
#undef PG8_LDB
#undef PG8_MMA
#undef PG8_WAIT_V
#undef PG8_WAIT_L
#undef PG8_BAR
#undef PG8_SCHED
}
}

constexpr size_t MiB = 1u << 20;
constexpr size_t al256(size_t x) { return (x + 255) & ~(size_t)255; }
constexpr size_t WS_CTL = 0, CTL_ZERO_BYTES = 1 * MiB;
constexpr size_t WS_MODV = 1 * MiB;
constexpr size_t WS_ROPE = WS_MODV + al256((size_t)2 * 5 * MODW * 4);
constexpr size_t WS_CNTWG = WS_ROPE + al256(64 * 16 * 2 * 4);
constexpr size_t WS_TOKE = WS_CNTWG + al256(256 * 8 * 4);
constexpr size_t WS_TOKP = WS_TOKE + al256((size_t)ML * 2 * 4);
constexpr size_t WS_TOKW = WS_TOKP + al256((size_t)ML * 2 * 4);
constexpr size_t WS_TOKS = WS_TOKW + al256((size_t)ML * 2 * 4);
constexpr size_t WS_TILE = WS_TOKS + al256((size_t)ML * 2 * 4);
constexpr size_t WS_WIN = 4 * MiB;
constexpr size_t WS_WBR = WS_WIN + (size_t)2 * INW * D * 2;
constexpr size_t WS_WOUT = WS_WBR + (size_t)2 * 3 * D * 512 * 2;
constexpr size_t WS_WGU0 = WS_WOUT + (size_t)2 * D * D * 2;
constexpr size_t WS_WDN0 = WS_WGU0 + (size_t)2 * DFF * D * 2;
constexpr size_t WS_WMGU = WS_WDN0 + (size_t)D * DFF * 2;
constexpr size_t WS_WMDN = WS_WMGU + (size_t)NE * 2 * DFE * D * 2;
constexpr size_t WS_H = WS_WMDN + (size_t)NE * D * DFE * 2;
constexpr size_t WS_Z = WS_H + (size_t)MT * D * 2;
constexpr size_t WS_MIX = WS_Z + (size_t)MT * INW * 2;
constexpr size_t WS_ACT = WS_Z;
constexpr size_t WS_YACC = WS_MIX + (size_t)MT * MIXW * 2;
constexpr size_t WS_H2S = WS_YACC;
constexpr size_t WS_Y = WS_YACC + (size_t)MT * D * 4;
constexpr size_t WS_X1 = WS_Y + (size_t)MT * D * 2;
constexpr size_t WS_X2 = WS_X1 + (size_t)MT * D * 4;
constexpr size_t WS_YS = WS_X2;
constexpr size_t WS_END = WS_X2 + (size_t)MT * D * 4;
static_assert((size_t)MS * DFE * 2 <= (size_t)MT * INW * 2 + (size_t)MT * MIXW * 2, "ACT overlay");
static_assert((size_t)MS * D * 2 <= (size_t)MT * D * 4, "H2S / YS overlays");
static_assert(WS_TILE + 1024 <= WS_WIN, "small tables");
constexpr int CW_BAR = 4096;

constexpr int RING_BYTES = 131072;
constexpr int LDSCTL_OFF = RING_BYTES, MISC_OFF = LDSCTL_OFF + 320;
constexpr int LDS_BYTES = 147456;

#define XB_TMO      128
#define XB_XCNT(j)  (256  + 64 * (j))
#define XB_XSUB(j)  (1280 + 64 * (j))
#define XB_XGEN(j)  (2304 + 64 * (j))
#define XB_TOP      3328
#define XB_TOPGEN   3392
#define XCD_BAR_WORDS 3456
#define XB_SPIN_CAP (1u << 18)
__device__ __forceinline__ unsigned xb_ld(unsigned* p)              { return __hip_atomic_load(p, __ATOMIC_RELAXED, __HIP_MEMORY_SCOPE_AGENT); }
__device__ __forceinline__ unsigned xb_add(unsigned* p, unsigned v) { return __hip_atomic_fetch_add(p, v, __ATOMIC_RELAXED, __HIP_MEMORY_SCOPE_AGENT); }
__device__ __forceinline__ unsigned xb_xcc_id() { return (unsigned)__builtin_amdgcn_s_getreg((3 << 11) | 20) & 0xFu; }
#define XB_SPIN(cond, bar) do { unsigned _sp = 0; while (cond) { __builtin_amdgcn_s_sleep(1); \
    if ((++_sp & 255u) == 0u) { if (xb_ld(&(bar)[XB_TMO])) break; if (_sp > XB_SPIN_CAP) { atomicAdd(&(bar)[XB_TMO], 1u); break; } } } } while (0)
struct XcdBarrier { unsigned* bar; unsigned x; volatile LAS unsigned* st; };
__device__ __forceinline__ XcdBarrier xcd_barrier_post(unsigned* bar, volatile LAS unsigned* st) {
    XcdBarrier b; b.bar = bar; b.x = xb_xcc_id(); b.st = st;
    if (threadIdx.x == 0) (void)xb_add(&bar[XB_XCNT(b.x)], 1u);
    return b;
}
__device__ __forceinline__ void xcd_barrier_complete(unsigned* bar, unsigned x, unsigned& nloc, unsigned& nx) {
    const unsigned G = gridDim.x * gridDim.y * gridDim.z;
    unsigned sum, cnt, mine, sp = 0u;
    for (;;) {
        sum = 0u; cnt = 0u; mine = 0u;
#pragma unroll
        for (unsigned j = 0; j < 16; ++j) { const unsigned c = xb_ld(&bar[XB_XCNT(j)]); sum += c; cnt += (c > 0u) ? 1u : 0u; mine = (j == x) ? c : mine; }
        if (sum == G) break;
        __builtin_amdgcn_s_sleep(1);
        if ((++sp & 255u) == 0u) { if (xb_ld(&bar[XB_TMO])) break; if (sp > XB_SPIN_CAP) { atomicAdd(&bar[XB_TMO], 1u); break; } }
    }
    nloc = mine > 0u ? mine : 1u; nx = cnt > 0u ? cnt : 1u;
}
__device__ __attribute__((noinline)) void xcd_barrier_leader(unsigned* bar, unsigned bx_, volatile LAS unsigned* st) {
    {
        XcdBarrier b; b.bar = bar; b.x = bx_; b.st = st;
        __builtin_amdgcn_s_waitcnt(0);
        unsigned nloc = b.st[0], nx = b.st[1];
        if (nloc == 0u) { xcd_barrier_complete(bar, b.x, nloc, nx); b.st[0] = nloc; b.st[1] = nx; }
        const unsigned old = xb_add(&bar[XB_XSUB(b.x)], 1u);
        const unsigned gen = old / nloc;
        if (old + 1u == (gen + 1u) * nloc) {
            __builtin_amdgcn_fence(__ATOMIC_RELEASE, "agent");
            asm volatile("s_waitcnt vmcnt(0)" ::: "memory");
            const unsigned og = xb_add(&bar[XB_TOP], 1u);
            const unsigned tg = og / nx;
            if (og + 1u == (tg + 1u) * nx) xb_add(&bar[XB_TOPGEN], 1u);
            else XB_SPIN(xb_ld(&bar[XB_TOPGEN]) == tg, bar);
            __builtin_amdgcn_fence(__ATOMIC_ACQUIRE, "agent");
            xb_add(&bar[XB_XGEN(b.x)], 1u);
            asm volatile("s_waitcnt vmcnt(0)" ::: "memory");
        } else {
            XB_SPIN(xb_ld(&bar[XB_XGEN(b.x)]) == gen, bar);
            __builtin_amdgcn_fence(__ATOMIC_ACQUIRE, "agent");
            asm volatile("s_waitcnt vmcnt(0)" ::: "memory");
        }
    }
}
__device__ __forceinline__ void xcd_barrier(const XcdBarrier& b) {
    asm volatile("s_waitcnt vmcnt(0)" ::: "memory");
    __syncthreads();
    if (threadIdx.x == 0) xcd_barrier_leader(b.bar, b.x, b.st);
    __syncthreads();
}

struct Args {
    const float *x, *c, *ctx, *c_ctx, *norm1_g, *norm2_g, *final_g, *w_mod, *b_mod, *w_in, *conv_w, *sink, *pool_w, *pool_scale, *w_branch, *w_out,
                *ffn_w_gu, *ffn_w_down, *router_w, *moe_w_gu, *moe_w_down;
    float* out; unsigned char* ws; int ph_lo, ph_hi;
};
template <int OFF> __device__ __forceinline__ const void* karg_p() { const void* r; asm volatile("s_load_dwordx2 %0, %1, %2\n\ts_waitcnt lgkmcnt(0)" : "=s"(r) : "s"(__builtin_amdgcn_kernarg_segment_ptr()), "i"(OFF)); return r; }
template <int OFF> __device__ __forceinline__ int karg_i() { int r; asm volatile("s_load_dword %0, %1, %2\n\ts_waitcnt lgkmcnt(0)" : "=s"(r) : "s"(__builtin_amdgcn_kernarg_segment_ptr()), "i"(OFF)); return r; }
#define KP(field) ((const float*)karg_p<(int)__builtin_offsetof(Args, field)>())
struct Frame {
    LAS unsigned char* lds;
    int tid, lane, wave, G, bx;
    unsigned char* ws;
};
__device__ __forceinline__ float wave_sum(float v) {
#pragma unroll
    for (int o = 1; o < 64; o <<= 1) v += __shfl_xor(v, o);
    return v;
}
__device__ __forceinline__ float wave_max(float v) {
#pragma unroll
    for (int o = 1; o < 64; o <<= 1) v = fmaxf(v, __shfl_xor(v, o));
    return v;
}
#define LDS_WAIT() asm volatile("s_waitcnt lgkmcnt(0)" ::: "memory")

__device__ __forceinline__ void p0_transpose_item(const float* W, int ldw, int K, bf16* WT, int k0, int n0, int drow0, LAS float* scr, int lane) {
#pragma unroll 8
    for (int i = 0; i < 32; ++i) { const int kk = 2 * i + (lane >> 5); scr[kk * 33 + (lane & 31)] = W[(size_t)(k0 + kk) * ldw + n0 + (lane & 31)]; }
    LDS_WAIT(); asm volatile("" ::: "memory");
    const int c = lane & 7;
#pragma unroll
    for (int j = 0; j < 4; ++j) { const int n = (lane >> 3) + 8 * j; const LAS float* s = scr + (8 * c) * 33 + n;
        u32x4 o; o.x = pk2(s[0 * 33], s[1 * 33]); o.y = pk2(s[2 * 33], s[3 * 33]); o.z = pk2(s[4 * 33], s[5 * 33]); o.w = pk2(s[6 * 33], s[7 * 33]);
        *(u32x4*)(WT + (size_t)(drow0 + n) * K + k0 + 8 * c) = o; }
    LDS_WAIT(); asm volatile("" ::: "memory");
}
__device__ __forceinline__ void p0_job_item(const float* W, int K, int N, bf16* WT, int IL, int item, LAS float* scr, int lane) {
    const int nblk = N / 32, kb = item / nblk, nb = item % nblk, n0 = 32 * nb;
    int drow0 = n0;
    if (IL > 0) { const int half = n0 >= IL ? 1 : 0, f = n0 - half * IL; drow0 = 256 * (f / 128) + 128 * half + (f % 128); }
    p0_transpose_item(W, N, K, WT, 64 * kb, n0, drow0, scr, lane);
}
__device__ __forceinline__ void p0_prologue(Frame& F) {
    LAS float* scr = (LAS float*)(F.lds + F.wave * 16384);
    const int gw = F.bx * NWAVES + F.wave, NGW = F.G * NWAVES;
    constexpr int I_IN = (D / 64) * (INW / 32), I_BR = (512 / 64) * (D / 32), I_OUT = (D / 64) * (D / 32), I_GU0 = (D / 64) * (2 * DFF / 32), I_DN0 = (DFF / 64) * (D / 32),
                  I_MGU = (D / 64) * (2 * DFE / 32), I_MDN = (DFE / 64) * (D / 32);
    constexpr int NITEMS = 2 * I_IN + 4 * I_BR + 2 * I_OUT + I_GU0 + I_DN0 + NE * I_MGU + NE * I_MDN;
    bf16* const wsb = (bf16*)F.ws;
    for (int it = gw; it < NITEMS; it += NGW) {
        int r = it;
        if (r < NE * I_MGU) { const int e = r / I_MGU; p0_job_item(KP(moe_w_gu) + (size_t)e * D * 2 * DFE, D, 2 * DFE, (bf16*)(F.ws + WS_WMGU) + (size_t)e * 2 * DFE * D, DFE, r % I_MGU, scr, F.lane); continue; } r -= NE * I_MGU;
        if (r < NE * I_MDN) { const int e = r / I_MDN; p0_job_item(KP(moe_w_down) + (size_t)e * DFE * D, DFE, D, (bf16*)(F.ws + WS_WMDN) + (size_t)e * D * DFE, 0, r % I_MDN, scr, F.lane); continue; } r -= NE * I_MDN;
        if (r < 2 * I_IN) { const int l = r / I_IN; p0_job_item(KP(w_in) + (size_t)l * D * INW, D, INW, (bf16*)(F.ws + WS_WIN) + (size_t)l * INW * D, 0, r % I_IN, scr, F.lane); continue; } r -= 2 * I_IN;
        if (r < 4 * I_BR) { const int j = r / I_BR, l = j >> 1, b = j & 1; p0_job_item(KP(w_branch) + (size_t)(l * 3 + b) * 512 * D, 512, D, (bf16*)(F.ws + WS_WBR) + (size_t)(l * 3 + b) * D * 512, 0, r % I_BR, scr, F.lane); continue; } r -= 4 * I_BR;
        if (r < 2 * I_OUT) { const int l = r / I_OUT; p0_job_item(KP(w_out) + (size_t)l * D * D, D, D, (bf16*)(F.ws + WS_WOUT) + (size_t)l * D * D, 0, r % I_OUT, scr, F.lane); continue; } r -= 2 * I_OUT;
        if (r < I_GU0) { p0_job_item(KP(ffn_w_gu), D, 2 * DFF, (bf16*)(F.ws + WS_WGU0), DFF, r, scr, F.lane); continue; } r -= I_GU0;
        p0_job_item(KP(ffn_w_down), DFF, D, (bf16*)(F.ws + WS_WDN0), 0, r, scr, F.lane);
    }
    (void)wsb;
    __syncthreads();
    constexpr int I_MOD = 2 * (MODW / 64), I_FOLD = 2 * 4 * (D / 64);
    for (int it = F.bx; it < I_MOD + I_FOLD + 1; it += F.G) {
        if (it < I_MOD) {
            const int l = it / (MODW / 64), cb = it % (MODW / 64);
            LAS float* sv = (LAS float*)F.lds;
            LAS float* red = (LAS float*)(F.lds + 32768);
            for (int i = F.tid; i < 5 * D; i += NTHR) { const int r = i / D, k = i % D; const float v = r < 4 ? KP(c)[r * D + k] : KP(c_ctx)[k]; sv[i] = v / (1.f + __expf(-v)); }
            __syncthreads();
            const int col = cb * 64 + F.lane; const float* wp = KP(w_mod) + (size_t)l * D * MODW + col;
            float a0 = 0.f, a1 = 0.f, a2 = 0.f, a3 = 0.f, a4 = 0.f;
#pragma unroll 8
            for (int kk = 0; kk < 128; ++kk) { const int k = F.wave * 128 + kk; const float w = wp[(size_t)k * MODW];
                a0 += sv[k] * w; a1 += sv[D + k] * w; a2 += sv[2 * D + k] * w; a3 += sv[3 * D + k] * w; a4 += sv[4 * D + k] * w; }
            red[(F.wave * 5 + 0) * 64 + F.lane] = a0; red[(F.wave * 5 + 1) * 64 + F.lane] = a1; red[(F.wave * 5 + 2) * 64 + F.lane] = a2;
            red[(F.wave * 5 + 3) * 64 + F.lane] = a3; red[(F.wave * 5 + 4) * 64 + F.lane] = a4;
            __syncthreads();
            if (F.tid < 320) { const int r = F.tid / 64, ln = F.tid % 64; float s = 0.f;
#pragma unroll
                for (int w = 0; w < 8; ++w) s += red[(w * 5 + r) * 64 + ln];
                const int cc = cb * 64 + ln;
                ((float*)(F.ws + WS_MODV))[(size_t)(l * 5 + r) * MODW + cc] = s + KP(b_mod)[l * MODW + cc]; }
            __syncthreads();
        } else if (it < I_MOD + I_FOLD) {
            const int r = it - I_MOD, l = r / 64, g = (r % 64) / 16, nb = r % 16;
            LAS float* pw = (LAS float*)F.lds;
            const float* pws = KP(pool_w) + (size_t)(l * 4 + g) * 128 * 128;
            for (int i = F.tid; i < 128 * 128; i += NTHR) pw[i] = pws[i];
            __syncthreads();
            const int n = nb * 64 + F.lane; const float* w2 = KP(w_branch) + (size_t)(l * 3 + 2) * 512 * D + (size_t)(128 * g) * D + n;
            const float* ps = KP(pool_scale) + l * 512 + 128 * g;
            float acc[16];
#pragma unroll
            for (int q = 0; q < 16; ++q) acc[q] = 0.f;
            for (int j = 0; j < 128; ++j) { const float wv = w2[(size_t)j * D] * ps[j];
#pragma unroll
                for (int q = 0; q < 16; ++q) acc[q] += pw[(F.wave * 16 + q) * 128 + j] * wv; }
            bf16* dst = (bf16*)(F.ws + WS_WBR) + (size_t)(l * 3 + 2) * D * 512 + (size_t)n * 512 + 128 * g + F.wave * 16;
            u32x4 o0, o1; o0.x = pk2(acc[0], acc[1]); o0.y = pk2(acc[2], acc[3]); o0.z = pk2(acc[4], acc[5]); o0.w = pk2(acc[6], acc[7]);
            o1.x = pk2(acc[8], acc[9]); o1.y = pk2(acc[10], acc[11]); o1.z = pk2(acc[12], acc[13]); o1.w = pk2(acc[14], acc[15]);
            *(u32x4*)dst = o0; *(u32x4*)(dst + 8) = o1;
            __syncthreads();
        } else {
            for (int i = F.tid; i < 64 * 16; i += NTHR) { const int pos = i / 16, fi = i % 16;
                const float inv = powf(10000.0f, -(float)fi / 16.0f); const float ang = (float)pos * inv;
                ((float*)(F.ws + WS_ROPE))[2 * i] = cosf(ang); ((float*)(F.ws + WS_ROPE))[2 * i + 1] = sinf(ang); }
        }
    }
}

template <bool ROUTER>
__device__ __forceinline__ void norm_mod_phase(Frame& F, const float* xl, const float* xc, const float* gvec, const float* modl, int shi, int sci, int nrows, const float* router_w) {
    bf16* H = (bf16*)(F.ws + WS_H);
    LAS int* lcnt = (LAS int*)F.lds;
    if (ROUTER) { if (F.tid < 8) lcnt[F.tid] = 0; __syncthreads(); }
    const int nloop = ROUTER ? 8 : (nrows + F.G * NWAVES - 1) / (F.G * NWAVES);
    for (int i = 0; i < nloop; ++i) {
        const int r = ROUTER ? (F.bx * 64 + F.wave + 8 * i) : ((i * F.G + F.bx) * NWAVES + F.wave);
        if (r >= nrows) continue;
        const int bidx = r < ML ? r / SEQ : 4;
        const float* xr = r < ML ? xl + (size_t)r * D : xc + (size_t)(r - ML) * D;
        const float* mv = modl + (size_t)bidx * MODW;
        f32x4 v[4]; float ss = 0.f;
#pragma unroll
        for (int j = 0; j < 4; ++j) { v[j] = *(const f32x4*)(xr + 4 * F.lane + 256 * j); ss += (v[j].x * v[j].x + v[j].y * v[j].y) + (v[j].z * v[j].z + v[j].w * v[j].w); }
        const float rstd = 1.0f / sqrtf(wave_sum(ss) * (1.f / D) + EPS);
#pragma unroll
        for (int j = 0; j < 4; ++j) { const int c = 4 * F.lane + 256 * j;
            const f32x4 g = *(const f32x4*)(gvec + c), sh = *(const f32x4*)(mv + shi * D + c), sc = *(const f32x4*)(mv + sci * D + c);
            v[j] = (v[j] * rstd * g) * (sc + 1.0f) + sh;
            u32x2 o; o.x = pk2(v[j].x, v[j].y); o.y = pk2(v[j].z, v[j].w);
            *(u32x2*)(H + (size_t)r * D + c) = o; }
        if (ROUTER) {
            float lg[8];
#pragma unroll
            for (int e = 0; e < 8; ++e) lg[e] = 0.f;
#pragma unroll
            for (int j = 0; j < 4; ++j)
#pragma unroll
                for (int q = 0; q < 4; ++q) { const int c = 4 * F.lane + 256 * j + q; const f32x4 w0 = *(const f32x4*)(router_w + (size_t)c * 8), w1 = *(const f32x4*)(router_w + (size_t)c * 8 + 4); const float hv = v[j][q];
                    lg[0] += hv * w0.x; lg[1] += hv * w0.y; lg[2] += hv * w0.z; lg[3] += hv * w0.w; lg[4] += hv * w1.x; lg[5] += hv * w1.y; lg[6] += hv * w1.z; lg[7] += hv * w1.w; }
#pragma unroll
            for (int e = 0; e < 8; ++e) lg[e] = wave_sum(lg[e]);
            int e1 = 0; float v1 = lg[0];
#pragma unroll
            for (int e = 1; e < 8; ++e) if (lg[e] > v1) { v1 = lg[e]; e1 = e; }
            int e2 = -1; float v2 = -3.0e38f;
#pragma unroll
            for (int e = 0; e < 8; ++e) if (e != e1 && lg[e] > v2) { v2 = lg[e]; e2 = e; }
            const float ex = __expf(v2 - v1), w1 = 1.f / (1.f + ex), w2 = ex * w1;
            if (F.lane == 0) {
                const int p1 = atomicAdd((int*)&lcnt[e1], 1), p2 = atomicAdd((int*)&lcnt[e2], 1);
                int* te = (int*)(F.ws + WS_TOKE) + 2 * r; te[0] = e1; te[1] = e2;
                int* tp = (int*)(F.ws + WS_TOKP) + 2 * r; tp[0] = p1; tp[1] = p2;
                float* tw = (float*)(F.ws + WS_TOKW) + 2 * r; tw[0] = w1; tw[1] = w2;
            }
        }
    }
    if (ROUTER) { __syncthreads(); if (F.tid < 8) ((int*)(F.ws + WS_CNTWG))[F.bx * 8 + F.tid] = lcnt[F.tid]; __syncthreads(); }
}

__device__ __forceinline__ void moe_scatter_phase(Frame& F) {
    LAS int* tab = (LAS int*)F.lds;
    const int* cw = (const int*)(F.ws + WS_CNTWG);
    if (F.tid < 32) tab[F.tid] = 0;
    __syncthreads();
    for (int idx = F.tid; idx < F.G * 8; idx += NTHR) {
        const int c = __hip_atomic_load(cw + idx, __ATOMIC_RELAXED, __HIP_MEMORY_SCOPE_AGENT); const int w = idx >> 3, e = idx & 7;
        atomicAdd((int*)&tab[16 + e], c); if (w < F.bx) atomicAdd((int*)&tab[8 + e], c);
    }
    __syncthreads();
    if (F.tid == 0) { int off = 0; for (int e = 0; e < 8; ++e) { tab[e] = off; off += ((tab[16 + e] + 255) / 256) * 256; } tab[24] = off / 256;
        if (F.bx == 0) { int* tl = (int*)(F.ws + WS_TILE); int t = 0; for (int e = 0; e < 8; ++e) { const int n = (tab[16 + e] + 255) / 256; for (int q = 0; q < n; ++q) tl[t++] = e; } tl[200] = t; } }
    __syncthreads();
    const bf16* H = (const bf16*)(F.ws + WS_H); bf16* HS = (bf16*)(F.ws + WS_H2S);
    for (int i = 0; i < 8; ++i) {
        const int r = F.bx * 64 + F.wave + 8 * i; if (r >= ML) continue;
        const int* te = (const int*)(F.ws + WS_TOKE) + 2 * r; const int* tp = (const int*)(F.ws + WS_TOKP) + 2 * r;
        const int e1 = te[0], e2 = te[1];
        const int s1 = tab[e1] + tab[8 + e1] + tp[0], s2 = tab[e2] + tab[8 + e2] + tp[1];
        if (F.lane == 0) { int* ts = (int*)(F.ws + WS_TOKS) + 2 * r; ts[0] = s1; ts[1] = s2; }
        const u32x4* src = (const u32x4*)(H + (size_t)r * D);
        const u32x4 a = src[F.lane], b = src[64 + F.lane];
        u32x4* d1 = (u32x4*)(HS + (size_t)s1 * D); u32x4* d2 = (u32x4*)(HS + (size_t)s2 * D);
        d1[F.lane] = a; d1[64 + F.lane] = b; d2[F.lane] = a; d2[64 + F.lane] = b;
    }
}

__device__ __forceinline__ void final_phase(Frame& F, const float* final_g, float* out, const float* modl) {
    const float* X1 = (const float*)(F.ws + WS_X1); const bf16* YS = (const bf16*)(F.ws + WS_YS);
    const int NGW = F.G * NWAVES;
    for (int r = F.bx * NWAVES + F.wave; r < ML; r += NGW) {
        const int bidx = r / SEQ; const float* g2 = modl + (size_t)bidx * MODW + 5 * D;
        const int* ts = (const int*)(F.ws + WS_TOKS) + 2 * r; const float* tw = (const float*)(F.ws + WS_TOKW) + 2 * r;
        const int s1 = ts[0], s2 = ts[1]; const float w1 = tw[0], w2 = tw[1];
        f32x4 v[4]; float ss = 0.f;
#pragma unroll
        for (int j = 0; j < 4; ++j) { const int c = 4 * F.lane + 256 * j;
            const f32x4 xv = *(const f32x4*)(X1 + (size_t)r * D + c), g = *(const f32x4*)(g2 + c);
            const u32x2 y1 = *(const u32x2*)(YS + (size_t)s1 * D + c), y2 = *(const u32x2*)(YS + (size_t)s2 * D + c);
            f32x4 f; f.x = w1 * bflo(y1.x) + w2 * bflo(y2.x); f.y = w1 * bfhi(y1.x) + w2 * bfhi(y2.x); f.z = w1 * bflo(y1.y) + w2 * bflo(y2.y); f.w = w1 * bfhi(y1.y) + w2 * bfhi(y2.y);
            v[j] = xv + g * f; ss += (v[j].x * v[j].x + v[j].y * v[j].y) + (v[j].z * v[j].z + v[j].w * v[j].w); }
        const float rstd = 1.0f / sqrtf(wave_sum(ss) * (1.f / D) + EPS);
#pragma unroll
        for (int j = 0; j < 4; ++j) { const int c = 4 * F.lane + 256 * j; const f32x4 g = *(const f32x4*)(final_g + c);
            *(f32x4*)(out + (size_t)r * D + c) = v[j] * rstd * g; }
    }
}

__device__ __forceinline__ void unpack8(const u32x4 w, float (&f)[8]) { f[0] = bflo(w.x); f[1] = bfhi(w.x); f[2] = bflo(w.y); f[3] = bfhi(w.y); f[4] = bflo(w.z); f[5] = bfhi(w.z); f[6] = bflo(w.w); f[7] = bfhi(w.w); }
__device__ __forceinline__ void local_mix_phase(Frame& F, const float* cw, int nrows) {
    const bf16* Z = (const bf16*)(F.ws + WS_Z); bf16* MIX = (bf16*)(F.ws + WS_MIX);
    const int total = nrows * 64, stride = F.G * NTHR;
    for (int idx = F.bx * NTHR + F.tid; idx < total; idx += stride) {
        const int r = idx >> 6, cg = idx & 63, c0 = cg * 8;
        int t, L, base;
        if (r < ML) { t = r % SEQ; L = SEQ; base = r - t; } else { const int rc = r - ML; t = rc % CTXL; L = CTXL; base = r - t; }
        float o[8];
#pragma unroll
        for (int q = 0; q < 8; ++q) o[q] = 0.f;
#pragma unroll
        for (int j = 0; j < 3; ++j) { const int tt = t - 1 + j; if (tt < 0 || tt >= L) continue;
            const bf16* zr = Z + (size_t)(base + tt) * INW; float cx[8], cc[8];
            unpack8(*(const u32x4*)(zr + ZCX + c0), cx); unpack8(*(const u32x4*)(zr + ZCC + c0), cc);
            const f32x4 w0 = *(const f32x4*)(cw + j * 512 + c0), w1 = *(const f32x4*)(cw + j * 512 + c0 + 4);
            o[0] += w0.x * (cc[0] * cx[0]); o[1] += w0.y * (cc[1] * cx[1]); o[2] += w0.z * (cc[2] * cx[2]); o[3] += w0.w * (cc[3] * cx[3]);
            o[4] += w1.x * (cc[4] * cx[4]); o[5] += w1.y * (cc[5] * cx[5]); o[6] += w1.z * (cc[6] * cx[6]); o[7] += w1.w * (cc[7] * cx[7]); }
        { float cb[8]; unpack8(*(const u32x4*)(Z + (size_t)r * INW + ZCB + c0), cb);
          u32x4 w; w.x = pk2(cb[0] * o[0], cb[1] * o[1]); w.y = pk2(cb[2] * o[2], cb[3] * o[3]); w.z = pk2(cb[4] * o[4], cb[5] * o[5]); w.w = pk2(cb[6] * o[6], cb[7] * o[7]);
          *(u32x4*)(MIX + (size_t)r * MIXW + 512 + c0) = w; }
        { const int hw = 1 << (c0 >> 7); const int lo = t - hw < 0 ? 0 : t - hw, hi = t + hw > L ? L : t + hw;
          float s[8];
#pragma unroll
          for (int q = 0; q < 8; ++q) s[q] = 0.f;
          for (int tt = lo; tt < hi; ++tt) { float u[8]; unpack8(*(const u32x4*)(Z + (size_t)(base + tt) * INW + ZPU + c0), u);
#pragma unroll
              for (int q = 0; q < 8; ++q) s[q] += u[q]; }
          float u0[8]; unpack8(*(const u32x4*)(Z + (size_t)r * INW + ZPU + c0), u0);
          const float inv = 1.0f / (float)(hi - lo);
          u32x4 w; w.x = pk2(s[0] * inv - u0[0], s[1] * inv - u0[1]); w.y = pk2(s[2] * inv - u0[2], s[3] * inv - u0[3]);
          w.z = pk2(s[4] * inv - u0[4], s[5] * inv - u0[5]); w.w = pk2(s[6] * inv - u0[6], s[7] * inv - u0[7]);
          *(u32x4*)(MIX + (size_t)r * MIXW + 1024 + c0) = w; }
    }
}

__device__ __forceinline__ void attn_naive_phase(Frame& F, const float* sinkl, int nrows) {
    const bf16* Z = (const bf16*)(F.ws + WS_Z); bf16* MIX = (bf16*)(F.ws + WS_MIX);
    LAS float* qs = (LAS float*)(F.lds + F.wave * 10240);
    LAS float* sc = qs + 256;
    const int nunits = nrows * 2, NGW = F.G * NWAVES;
    for (int uidx = F.bx * NWAVES + F.wave; uidx < nunits; uidx += NGW) {
        const int r = uidx >> 1, kh = uidx & 1;
        int b, nloc, krow0;
        if (r < ML) { b = r / SEQ; const int t = r % SEQ; const int lo = t - 128 < 0 ? 0 : t - 128, hi = t + 128 > SEQ - 1 ? SEQ - 1 : t + 128; nloc = hi - lo + 1; krow0 = b * SEQ + lo; }
        else { b = (r - ML) / CTXL; nloc = 0; krow0 = 0; }
        const int crow0 = ML + b * CTXL, nk = nloc + CTXL;
        { const u32x2 qw = *(const u32x2*)(Z + (size_t)r * INW + ZQ + kh * 256 + 4 * F.lane); const int g = F.lane >> 4, d = (4 * F.lane) & 63;
          qs[(d + 0) * 4 + g] = bflo(qw.x); qs[(d + 1) * 4 + g] = bfhi(qw.x); qs[(d + 2) * 4 + g] = bflo(qw.y); qs[(d + 3) * 4 + g] = bfhi(qw.y); }
        LDS_WAIT(); asm volatile("" ::: "memory");
        for (int c0 = 0; c0 < nk; c0 += 64) {
            const int kk = c0 + F.lane;
            if (kk < nk) {
                const int krow = kk < nloc ? krow0 + kk : crow0 + (kk - nloc);
                const u32x4* kp = (const u32x4*)(Z + (size_t)krow * INW + ZK + kh * 64);
                f32x4 s = (f32x4){0.f, 0.f, 0.f, 0.f};
#pragma unroll
                for (int d8 = 0; d8 < 8; ++d8) { float kf[8]; unpack8(kp[d8], kf);
#pragma unroll
                    for (int q = 0; q < 8; ++q) { const f32x4 qv = *(const LAS f32x4*)(qs + (d8 * 8 + q) * 4); s += qv * kf[q]; } }
                *(LAS f32x4*)(sc + kk * 4) = s;
            }
        }
        LDS_WAIT(); asm volatile("" ::: "memory");
        f32x4 mx; { const float* sk = sinkl + kh * 4; mx = (f32x4){sk[0] * LOG2E, sk[1] * LOG2E, sk[2] * LOG2E, sk[3] * LOG2E}; }
        const f32x4 snk = mx;
        for (int kk = F.lane; kk < nk; kk += 64) { const f32x4 s = *(const LAS f32x4*)(sc + kk * 4); mx.x = fmaxf(mx.x, s.x); mx.y = fmaxf(mx.y, s.y); mx.z = fmaxf(mx.z, s.z); mx.w = fmaxf(mx.w, s.w); }
        mx.x = wave_max(mx.x); mx.y = wave_max(mx.y); mx.z = wave_max(mx.z); mx.w = wave_max(mx.w);
        f32x4 sm = (f32x4){0.f, 0.f, 0.f, 0.f};
        for (int kk = F.lane; kk < nk; kk += 64) { f32x4 s = *(const LAS f32x4*)(sc + kk * 4);
            s.x = exp2f(s.x - mx.x); s.y = exp2f(s.y - mx.y); s.z = exp2f(s.z - mx.z); s.w = exp2f(s.w - mx.w); sm += s; *(LAS f32x4*)(sc + kk * 4) = s; }
        sm.x = wave_sum(sm.x) + exp2f(snk.x - mx.x); sm.y = wave_sum(sm.y) + exp2f(snk.y - mx.y); sm.z = wave_sum(sm.z) + exp2f(snk.z - mx.z); sm.w = wave_sum(sm.w) + exp2f(snk.w - mx.w);
        LDS_WAIT(); asm volatile("" ::: "memory");
        f32x4 o = (f32x4){0.f, 0.f, 0.f, 0.f};
        const bf16* vb = Z + ZV + kh * 64 + F.lane;
#pragma unroll 4
        for (int kk = 0; kk < nk; ++kk) { const int krow = kk < nloc ? krow0 + kk : crow0 + (kk - nloc);
            const float v = bf2f((unsigned)vb[(size_t)krow * INW]); const f32x4 p = *(const LAS f32x4*)(sc + kk * 4); o += p * v; }
        bf16* op = MIX + (size_t)r * MIXW + kh * 256 + F.lane;
        op[0] = (bf16)f2bf(o.x / sm.x); op[64] = (bf16)f2bf(o.y / sm.y); op[128] = (bf16)f2bf(o.z / sm.z); op[192] = (bf16)f2bf(o.w / sm.w);
        LDS_WAIT(); asm volatile("" ::: "memory");
    }
}

typedef float f32x16 __attribute__((ext_vector_type(16)));
typedef short s16x4 __attribute__((ext_vector_type(4)));
typedef __bf16 bf16x2_t __attribute__((ext_vector_type(2)));
__device__ __forceinline__ unsigned cvtpk(float lo, float hi) { f32x2 v = {lo, hi}; bf16x2_t b = __builtin_convertvector(v, bf16x2_t); return __builtin_bit_cast(unsigned, b); }
__device__ __forceinline__ s16x4 vtr(const LAS unsigned char* p) { return __builtin_bit_cast(s16x4, __builtin_amdgcn_ds_read_tr16_b64_v4i16((LAS s16x4*)p)); }
constexpr int AKP = 144, ATT_V_OFF = 128 * AKP;
__device__ __forceinline__ void attn_unit(Frame& F, const bf16* Z, bf16* MIX, const float* sinkl, const bool isctx, const int b, const int kh, const int qblk) {
    const int qrow0 = isctx ? ML + b * CTXL + qblk * 128 : b * SEQ + qblk * 128;
    const int cbase = ML + b * CTXL;
    const bool has_prev = !isctx && qblk > 0, has_next = !isctx && qblk < 31;
    const int nch = isctx ? 2 : 3 + (has_prev ? 1 : 0) + (has_next ? 1 : 0);
    const int lane = F.lane, r = lane & 31, h = lane >> 5, g = F.wave >> 1, qh = F.wave & 1, head = kh * 4 + g;
    LAS unsigned char* Ks = F.lds; LAS unsigned char* Vs = F.lds + ATT_V_OFF;
    bf16x8 qf[2][4];
#pragma unroll
    for (int sub = 0; sub < 2; ++sub)
#pragma unroll
        for (int ks = 0; ks < 4; ++ks) qf[sub][ks] = *(const bf16x8*)(Z + (size_t)(qrow0 + 64 * qh + 32 * sub + r) * INW + ZQ + head * 64 + 16 * ks + 8 * h);
    const float sk = sinkl[head] * LOG2E;
    float m[2], l[2]; f32x16 O[2][2];
#pragma unroll
    for (int sub = 0; sub < 2; ++sub) { m[sub] = sk; l[sub] = h == 0 ? 1.f : 0.f;
#pragma unroll
        for (int db = 0; db < 2; ++db)
#pragma unroll
            for (int i = 0; i < 16; ++i) O[sub][db][i] = 0.f; }
#define ATT_CHUNK(ci, row0, kind) do { if (isctx) { row0 = cbase + 128 * (ci); kind = 0; } else if ((ci) == 0) { row0 = qrow0; kind = 0; } else if ((ci) <= 2) { row0 = cbase + 128 * ((ci) - 1); kind = 0; } \
        else if ((ci) == 3 && has_prev) { row0 = qrow0 - 128; kind = 1; } else { row0 = qrow0 + 128; kind = 2; } } while (0)
    const int skey = F.tid >> 3, spart = F.tid & 7;
    u32x4 pk0, pk1, pv0, pv1;
#define ATT_LOAD(ci) do { int row0_, kind_; ATT_CHUNK(ci, row0_, kind_); (void)kind_; const bf16* kp_ = Z + (size_t)(row0_ + skey) * INW + ZK + kh * 64 + spart * 8; \
        pk0 = *(const u32x4*)kp_; pk1 = *(const u32x4*)(kp_ + (size_t)64 * INW); pv0 = *(const u32x4*)(kp_ + (ZV - ZK)); pv1 = *(const u32x4*)(kp_ + (size_t)64 * INW + (ZV - ZK)); } while (0)
    ATT_LOAD(0);
    const int grp = (lane >> 4) & 1, q4 = (lane & 15) >> 2, p4 = lane & 3;
    for (int ci = 0; ci < nch; ++ci) {
        __syncthreads();
        *(LAS u32x4*)(Ks + skey * AKP + spart * 16) = pk0; *(LAS u32x4*)(Ks + (skey + 64) * AKP + spart * 16) = pk1;
        *(LAS u32x4*)(Vs + skey * AKP + spart * 16) = pv0; *(LAS u32x4*)(Vs + (skey + 64) * AKP + spart * 16) = pv1;
        if (ci + 1 < nch) ATT_LOAD(ci + 1);
        __syncthreads();
        int row0, kind; ATT_CHUNK(ci, row0, kind); (void)row0;
        for (int t = 0; t < 4; ++t) {
            if (kind == 1 && 32 * t + 31 < 64 * qh) continue;
            if (kind == 2 && 32 * t > 64 * qh + 63) continue;
            bf16x8 kf[4], vf[2][2];
#pragma unroll
            for (int ks = 0; ks < 4; ++ks) kf[ks] = *(const LAS bf16x8*)(Ks + (32 * t + r) * AKP + 32 * ks + 16 * h);
#pragma unroll
            for (int s = 0; s < 2; ++s)
#pragma unroll
                for (int db = 0; db < 2; ++db) { const LAS unsigned char* vp = Vs + (32 * t + 16 * s + 4 * h + q4) * AKP + (32 * db + 16 * grp + 4 * p4) * 2;
                    const s16x4 lo = vtr(vp), hi = vtr(vp + 8 * AKP); vf[s][db] = __builtin_shufflevector(lo, hi, 0, 1, 2, 3, 4, 5, 6, 7); }
#pragma unroll
            for (int sub = 0; sub < 2; ++sub) {
                if (kind == 1 && 32 * t + 31 < 64 * qh + 32 * sub) continue;
                if (kind == 2 && 32 * t > 64 * qh + 32 * sub + 31) continue;
                f32x16 S;
#pragma unroll
                for (int i = 0; i < 16; ++i) S[i] = 0.f;
#pragma unroll
                for (int ks = 0; ks < 4; ++ks) S = __builtin_amdgcn_mfma_f32_32x32x16_bf16(kf[ks], qf[sub][ks], S, 0, 0, 0);
                if (kind != 0) { const int qq = 64 * qh + 32 * sub + r;
#pragma unroll
                    for (int i = 0; i < 16; ++i) { const int kk = 32 * t + (i & 3) + 8 * (i >> 2) + 4 * h; const bool ok = kind == 1 ? (kk >= qq) : (kk <= qq); S[i] = ok ? S[i] : -1.0e30f; } }
                float tmax = S[0];
#pragma unroll
                for (int i = 1; i < 16; ++i) tmax = fmaxf(tmax, S[i]);
                tmax = fmaxf(tmax, __shfl_xor(tmax, 32));
                const float mnew = fmaxf(m[sub], tmax);
                if (__any(mnew > m[sub])) { const float alpha = __builtin_amdgcn_exp2f(m[sub] - mnew); l[sub] *= alpha; m[sub] = mnew;
#pragma unroll
                    for (int db = 0; db < 2; ++db)
#pragma unroll
                        for (int i = 0; i < 16; ++i) O[sub][db][i] *= alpha; }
                float ps = 0.f;
#pragma unroll
                for (int i = 0; i < 16; ++i) { S[i] = __builtin_amdgcn_exp2f(S[i] - m[sub]); ps += S[i]; }
                l[sub] += ps;
                u32x4 w0, w1; w0.x = cvtpk(S[0], S[1]); w0.y = cvtpk(S[2], S[3]); w0.z = cvtpk(S[4], S[5]); w0.w = cvtpk(S[6], S[7]);
                w1.x = cvtpk(S[8], S[9]); w1.y = cvtpk(S[10], S[11]); w1.z = cvtpk(S[12], S[13]); w1.w = cvtpk(S[14], S[15]);
                const bf16x8 P0 = __builtin_bit_cast(bf16x8, w0), P1 = __builtin_bit_cast(bf16x8, w1);
#pragma unroll
                for (int db = 0; db < 2; ++db) { O[sub][db] = __builtin_amdgcn_mfma_f32_32x32x16_bf16(vf[0][db], P0, O[sub][db], 0, 0, 0); O[sub][db] = __builtin_amdgcn_mfma_f32_32x32x16_bf16(vf[1][db], P1, O[sub][db], 0, 0, 0); }
            }
        }
    }
#undef ATT_CHUNK
#undef ATT_LOAD
#pragma unroll
    for (int sub = 0; sub < 2; ++sub) { const float lt = l[sub] + __shfl_xor(l[sub], 32), inv = 1.f / lt;
        bf16* op = MIX + (size_t)(qrow0 + 64 * qh + 32 * sub + r) * MIXW + head * 64 + 4 * h;
#pragma unroll
        for (int db = 0; db < 2; ++db)
#pragma unroll
            for (int gq = 0; gq < 4; ++gq) { u32x2 w; w.x = cvtpk(O[sub][db][4 * gq] * inv, O[sub][db][4 * gq + 1] * inv); w.y = cvtpk(O[sub][db][4 * gq + 2] * inv, O[sub][db][4 * gq + 3] * inv);
                *(u32x2*)(op + 32 * db + 8 * gq) = w; } }
}
__device__ __forceinline__ void attn_mfma_phase(Frame& F, const float* sinkl, const bool with_ctx) {
    const bf16* Z = (const bf16*)(F.ws + WS_Z); bf16* MIX = (bf16*)(F.ws + WS_MIX);
    const int vcu = (F.G % 8 == 0) ? (F.bx % 8) * (F.G / 8) + F.bx / 8 : F.bx;
    for (int u = vcu; u < 256; u += F.G) attn_unit(F, Z, MIX, sinkl, false, u >> 6, (u >> 5) & 1, u & 31);
    if (with_ctx) for (int u = F.bx; u < 16; u += F.G) attn_unit(F, Z, MIX, sinkl, true, u >> 2, (u >> 1) & 1, u & 1);
    __syncthreads();
}

using pg8::Unit;
struct SchedStd {
    const char* A; const char* B; size_t astep, bstep; int nM, nN, G, c, nx, xpm0, xpn;
    __device__ __forceinline__ bool next(int i, Unit& u) const {
        const int L = i * G + c, nwg = nM * nN; if (L >= nwg + nx) return false;
        if (L < nwg) pg8::tile_of(L, nM, nN, u.pm, u.pn); else { u.pm = xpm0 + (L - nwg); u.pn = xpn; }
        u.tag = 0; u.a = A + (size_t)u.pm * astep; u.b = B + (size_t)u.pn * bstep; return true;
    }
};
struct SchedBr {
    const char* A; const char* B; int nM, G, c;
    __device__ __forceinline__ bool next(int i, Unit& u) const {
        const int t = i / 3, br = i - 3 * t; const int L = t * G + c; if (L >= nM * 4) return false;
        pg8::tile_of(L, nM, 4, u.pm, u.pn); u.tag = br;
        u.a = A + ((size_t)u.pm * 256 * MIXW + br * 512) * 2; u.b = B + ((size_t)br * D * 512 + (size_t)u.pn * 256 * 512) * 2; return true;
    }
};
struct SchedMoe {
    const char* A; const char* B; size_t astep, bstep_e, bstep_n; int NJ, G, c; const int* tile;
    __device__ __forceinline__ bool next(int i, Unit& u) const {
        const int nt = __builtin_amdgcn_readfirstlane(__hip_atomic_load(tile + 200, __ATOMIC_RELAXED, __HIP_MEMORY_SCOPE_AGENT));
        const int L = i * G + c; if (L >= nt * NJ) return false;
        u.pm = L % nt; u.pn = L / nt; u.tag = __builtin_amdgcn_readfirstlane(__hip_atomic_load(tile + u.pm, __ATOMIC_RELAXED, __HIP_MEMORY_SCOPE_AGENT));
        u.a = A + (size_t)u.pm * astep; u.b = B + (size_t)u.tag * bstep_e + (size_t)u.pn * bstep_n; return true;
    }
};

struct EpiIn {
    static constexpr bool PERM = true;
    bf16* Z; const float* rope;
    __device__ __forceinline__ void operator()(const f32x4 (&acc)[2][2][4][2], const Unit& u, int wr, int wc, int fr, int fq) const {
        const int row0 = u.pm * 256 + wr * 64 + fr, col0 = u.pn * 256 + wc * 32 + 8 * fq;
        const bool latent = u.pm < 64, gate = u.pn >= 11;
        const float sgn = fq < 2 ? -1.f : 1.f;
#pragma unroll
        for (int ai = 0; ai < 2; ++ai)
#pragma unroll
            for (int m = 0; m < 4; ++m) { const int row = row0 + ai * 128 + m * 16; bf16* rowp = Z + (size_t)row * INW + col0;
                const int pos = (wc & 1) ? (16 * m + fr) : (4 * (u.pm & 15) + 2 * ai + wr);
#pragma unroll
                for (int bj = 0; bj < 2; ++bj) { f32x4 v0 = acc[ai][bj][m][0], v1 = acc[ai][bj][m][1];
                    const bool isq = u.pn < 2, isk = (u.pn == 2 && bj == 0);
                    if (isq || isk) {
                        if (latent) {
                            const f32x4* cs = (const f32x4*)(rope + (size_t)(pos * 16 + 8 * (fq & 1)) * 2);
                            const f32x4 t0 = cs[0], t1 = cs[1], t2 = cs[2], t3 = cs[3];
                            f32x4 p0, p1;
                            p0.x = __shfl_xor(v0.x, 32); p0.y = __shfl_xor(v0.y, 32); p0.z = __shfl_xor(v0.z, 32); p0.w = __shfl_xor(v0.w, 32);
                            p1.x = __shfl_xor(v1.x, 32); p1.y = __shfl_xor(v1.y, 32); p1.z = __shfl_xor(v1.z, 32); p1.w = __shfl_xor(v1.w, 32);
                            v0.x = v0.x * t0.x + p0.x * (sgn * t0.y); v0.y = v0.y * t0.z + p0.y * (sgn * t0.w); v0.z = v0.z * t1.x + p0.z * (sgn * t1.y); v0.w = v0.w * t1.z + p0.w * (sgn * t1.w);
                            v1.x = v1.x * t2.x + p1.x * (sgn * t2.y); v1.y = v1.y * t2.z + p1.y * (sgn * t2.w); v1.z = v1.z * t3.x + p1.z * (sgn * t3.y); v1.w = v1.w * t3.z + p1.w * (sgn * t3.w);
                        }
                        if (isq) { v0 = v0 * QSCALE; v1 = v1 * QSCALE; }
                    }
                    if (gate) {
#pragma unroll
                        for (int q = 0; q < 4; ++q) { v0[q] = 1.f / (1.f + __expf(-v0[q])); v1[q] = 1.f / (1.f + __expf(-v1[q])); } }
                    u32x4 w; w.x = pg8::cvt_pk_bf16(v0[0], v0[1]); w.y = pg8::cvt_pk_bf16(v0[2], v0[3]); w.z = pg8::cvt_pk_bf16(v1[0], v1[1]); w.w = pg8::cvt_pk_bf16(v1[2], v1[3]);
                    *(u32x4*)(rowp + bj * 128) = w; } }
    }
};
struct EpiBr {
    static constexpr bool PERM = false;
    const bf16* Z; float* YACC; bf16* Y;
    __device__ __forceinline__ void operator()(const f32x4 (&acc)[2][2][4][2], const Unit& u, int wr, int wc, int fr, int fq) const {
        const int row0 = u.pm * 256 + wr * 64 + fr, col0 = u.pn * 256 + wc * 32 + 4 * fq; const int br = u.tag;
#pragma unroll
        for (int ai = 0; ai < 2; ++ai)
#pragma unroll
            for (int m = 0; m < 4; ++m) { const int row = row0 + ai * 128 + m * 16;
#pragma unroll
                for (int bj = 0; bj < 2; ++bj)
#pragma unroll
                    for (int n = 0; n < 2; ++n) { const int c = col0 + bj * 128 + n * 16;
                        const u32x2 gw = *(const u32x2*)(Z + (size_t)row * INW + ZG + br * D + c);
                        f32x4 v = acc[ai][bj][m][n]; v.x *= bflo(gw.x); v.y *= bfhi(gw.x); v.z *= bflo(gw.y); v.w *= bfhi(gw.y);
                        float* yp = YACC + (size_t)row * D + c;
                        if (br == 0) *(f32x4*)yp = v;
                        else if (br == 1) *(f32x4*)yp = *(const f32x4*)yp + v;
                        else { v += *(const f32x4*)yp; u32x2 w; w.x = pg8::cvt_pk_bf16(v.x, v.y); w.y = pg8::cvt_pk_bf16(v.z, v.w); *(u32x2*)(Y + (size_t)row * D + c) = w; } } }
    }
};
struct EpiRes {
    static constexpr bool PERM = false;
    const float* rl; const float* rc; float* out; const float* gv;
    __device__ __forceinline__ void operator()(const f32x4 (&acc)[2][2][4][2], const Unit& u, int wr, int wc, int fr, int fq) const {
        const int row0 = u.pm * 256 + wr * 64 + fr, col0 = u.pn * 256 + wc * 32 + 4 * fq;
        const int bidx = u.pm < 64 ? (u.pm >> 4) : 4; const float* g = gv + (size_t)bidx * MODW;
        const float* rbase = u.pm < 64 ? rl : rc - (size_t)ML * D;
        f32x4 gg[2][2];
#pragma unroll
        for (int bj = 0; bj < 2; ++bj)
#pragma unroll
            for (int n = 0; n < 2; ++n) gg[bj][n] = *(const f32x4*)(g + col0 + bj * 128 + n * 16);
#pragma unroll
        for (int ai = 0; ai < 2; ++ai)
#pragma unroll
            for (int m = 0; m < 4; ++m) { const size_t off = (size_t)(row0 + ai * 128 + m * 16) * D + col0;
#pragma unroll
                for (int bj = 0; bj < 2; ++bj)
#pragma unroll
                    for (int n = 0; n < 2; ++n) *(f32x4*)(out + off + bj * 128 + n * 16) = *(const f32x4*)(rbase + off + bj * 128 + n * 16) + gg[bj][n] * acc[ai][bj][m][n]; }
    }
};
struct EpiSwiglu {
    static constexpr bool PERM = true;
    bf16* ACT; int ldc;
    __device__ __forceinline__ void operator()(const f32x4 (&acc)[2][2][4][2], const Unit& u, int wr, int wc, int fr, int fq) const {
        const int row0 = u.pm * 256 + wr * 64 + fr, col0 = u.pn * 128 + wc * 32 + 8 * fq;
#pragma unroll
        for (int ai = 0; ai < 2; ++ai)
#pragma unroll
            for (int m = 0; m < 4; ++m) { f32x4 r[2];
#pragma unroll
                for (int n = 0; n < 2; ++n) { const f32x4 g = acc[ai][0][m][n], up = acc[ai][1][m][n];
#pragma unroll
                    for (int q = 0; q < 4; ++q) r[n][q] = g[q] / (1.f + __expf(-g[q])) * up[q]; }
                u32x4 w; w.x = pg8::cvt_pk_bf16(r[0][0], r[0][1]); w.y = pg8::cvt_pk_bf16(r[0][2], r[0][3]); w.z = pg8::cvt_pk_bf16(r[1][0], r[1][1]); w.w = pg8::cvt_pk_bf16(r[1][2], r[1][3]);
                *(u32x4*)(ACT + (size_t)(row0 + ai * 128 + m * 16) * ldc + col0) = w; }
    }
};
struct EpiPlain {
    static constexpr bool PERM = true;
    bf16* O; int ldc;
    __device__ __forceinline__ void operator()(const f32x4 (&acc)[2][2][4][2], const Unit& u, int wr, int wc, int fr, int fq) const {
        const int row0 = u.pm * 256 + wr * 64 + fr, col0 = u.pn * 256 + wc * 32 + 8 * fq;
#pragma unroll
        for (int ai = 0; ai < 2; ++ai)
#pragma unroll
            for (int m = 0; m < 4; ++m)
#pragma unroll
                for (int bj = 0; bj < 2; ++bj) { const f32x4 v0 = acc[ai][bj][m][0], v1 = acc[ai][bj][m][1];
                    u32x4 w; w.x = pg8::cvt_pk_bf16(v0[0], v0[1]); w.y = pg8::cvt_pk_bf16(v0[2], v0[3]); w.z = pg8::cvt_pk_bf16(v1[0], v1[1]); w.w = pg8::cvt_pk_bf16(v1[2], v1[3]);
                    *(u32x4*)(O + (size_t)(row0 + ai * 128 + m * 16) * ldc + col0 + bj * 128) = w; }
    }
};

#define IN(k) (lo <= (k) && (k) < hi)
#define SEAM(k) do { if (IN(k) && IN((k) + 1)) xcd_barrier(bar); } while (0)
#ifndef DUP_MASK
#define DUP_MASK 0u
#endif
#define REP(k) for (int rep_ = 0; rep_ < (((DUP_MASK >> (k)) & 1u) ? 2 : 1); ++rep_, (((DUP_MASK >> (k)) & 1u) && rep_ == 1 ? xcd_barrier(bar) : (void)0))
#define SITE() do { F.ws = (unsigned char*)karg_p<(int)__builtin_offsetof(Args, ws)>(); int t_ = threadIdx.x; asm volatile("" : "+v"(t_)); F.tid = t_; F.lane = t_ & 63; } while (0)
template <int l> __device__ __forceinline__ void layer_common(Frame& F, const int lo, const int hi, const XcdBarrier& bar, LAS unsigned char* ring) {
    constexpr int pb = 1 + 8 * l;
        if (IN(pb + 0)) REP(pb + 0) { SITE(); const float* modl = (const float*)(F.ws + WS_MODV) + (size_t)l * 5 * MODW; const float* X2 = (const float*)(F.ws + WS_X2);
            const float* xl = l == 0 ? KP(x) : X2; const float* xc = l == 0 ? KP(ctx) : X2 + (size_t)ML * D;
            norm_mod_phase<false>(F, xl, xc, KP(norm1_g) + l * D, modl, 0, 1, MT, nullptr); } SEAM(pb + 0);
        if (IN(pb + 1)) REP(pb + 1) { SITE();
            SchedStd S{(const char*)(F.ws + WS_H), (const char*)(F.ws + WS_WIN) + (size_t)l * INW * D * 2, (size_t)256 * D * 2, (size_t)256 * D * 2, l == 0 ? 68 : 64, 23, F.G, F.bx, l == 0 ? 0 : 4, 64, 2};
            EpiIn E{(bf16*)(F.ws + WS_Z), (const float*)(F.ws + WS_ROPE)};
            pg8::gemm_phase<EpiIn, SchedStd, true, true>(ring, D, D, D, S, E);
        } SEAM(pb + 1);
        if (IN(pb + 2)) REP(pb + 2) { SITE(); const int nrows = l == 0 ? MT : ML; if (ATTN_NAIVE) attn_naive_phase(F, KP(sink) + l * 8, nrows); else attn_mfma_phase(F, KP(sink) + l * 8, l == 0); local_mix_phase(F, KP(conv_w) + (size_t)l * 3 * 512, nrows); } SEAM(pb + 2);
        if (IN(pb + 3)) REP(pb + 3) { SITE();
            SchedBr S{(const char*)(F.ws + WS_MIX), (const char*)(F.ws + WS_WBR) + (size_t)l * 3 * D * 512 * 2, l == 0 ? 68 : 64, F.G, F.bx};
            EpiBr E{(const bf16*)(F.ws + WS_Z), (float*)(F.ws + WS_YACC), (bf16*)(F.ws + WS_Y)};
            pg8::gemm_phase<EpiBr, SchedBr, true, true>(ring, MIXW, 512, 512, S, E);
        } SEAM(pb + 3);
        if (IN(pb + 4)) REP(pb + 4) { SITE(); const float* modl = (const float*)(F.ws + WS_MODV) + (size_t)l * 5 * MODW; const float* X2 = (const float*)(F.ws + WS_X2);
            const float* xl = l == 0 ? KP(x) : X2; const float* xc = l == 0 ? KP(ctx) : X2 + (size_t)ML * D;
            SchedStd S{(const char*)(F.ws + WS_Y), (const char*)(F.ws + WS_WOUT) + (size_t)l * D * D * 2, (size_t)256 * D * 2, (size_t)256 * D * 2, l == 0 ? 68 : 64, 4, F.G, F.bx, 0, 0, 0};
            EpiRes E{xl, xc, (float*)(F.ws + WS_X1), modl + 2 * D};
            pg8::gemm_phase<EpiRes, SchedStd, true, true>(ring, D, D, D, S, E);
        } SEAM(pb + 4);
}
constexpr int N_PHASES = 19;
__global__ void __launch_bounds__(NTHR, 2) mk_fwd(Args args_byval) {
    extern __shared__ __attribute__((aligned(16))) unsigned char lds_raw[];
    Frame F;
    F.lds = (LAS unsigned char*)lds_raw;
    F.tid = threadIdx.x; F.lane = F.tid & 63; F.wave = __builtin_amdgcn_readfirstlane(F.tid >> 6);
    F.G = gridDim.x; F.bx = blockIdx.x;
    SITE();
    volatile LAS unsigned* MISC = (volatile LAS unsigned*)(F.lds + MISC_OFF);
    for (int u = F.tid; u < (LDS_BYTES - LDSCTL_OFF) / 4; u += NTHR) ((LAS unsigned*)(F.lds + LDSCTL_OFF))[u] = 0u;
    __syncthreads();
    const int lo = karg_i<(int)__builtin_offsetof(Args, ph_lo)>(), hi = karg_i<(int)__builtin_offsetof(Args, ph_hi)>();
    const bool fused = (hi - lo) > 1;
    XcdBarrier bar; bar.bar = (unsigned*)(F.ws + WS_CTL) + CW_BAR; bar.x = 0; bar.st = nullptr;
    if (fused) bar = xcd_barrier_post((unsigned*)(F.ws + WS_CTL) + CW_BAR, MISC + 8);
    LAS unsigned char* ring = F.lds;

    if (IN(0)) REP(0) { SITE(); p0_prologue(F); } SEAM(0);

    layer_common<0>(F, lo, hi, bar, ring);
    {
            if (IN(6)) REP(6) { SITE(); const float* X1 = (const float*)(F.ws + WS_X1); norm_mod_phase<false>(F, X1, X1 + (size_t)ML * D, KP(norm2_g), (const float*)(F.ws + WS_MODV), 3, 4, MT, nullptr); } SEAM(6);
            if (IN(7)) REP(7) { SITE();
                SchedStd S{(const char*)(F.ws + WS_H), (const char*)(F.ws + WS_WGU0), (size_t)256 * D * 2, (size_t)256 * D * 2, 68, 22, F.G, F.bx, 0, 0, 0};
                EpiSwiglu E{(bf16*)(F.ws + WS_ACT), DFF};
                pg8::gemm_phase<EpiSwiglu, SchedStd, true, true>(ring, D, D, D, S, E);
            } SEAM(7);
            if (IN(8)) REP(8) { SITE(); const float* X1 = (const float*)(F.ws + WS_X1);
                SchedStd S{(const char*)(F.ws + WS_ACT), (const char*)(F.ws + WS_WDN0), (size_t)256 * DFF * 2, (size_t)256 * DFF * 2, 68, 4, F.G, F.bx, 0, 0, 0};
                EpiRes E{X1, X1 + (size_t)ML * D, (float*)(F.ws + WS_X2), (const float*)(F.ws + WS_MODV) + 5 * D};
                pg8::gemm_phase<EpiRes, SchedStd, true, true>(ring, DFF, DFF, DFF, S, E);
            } SEAM(8);
    }
    layer_common<1>(F, lo, hi, bar, ring);
    {
            if (IN(14)) REP(14) { SITE(); const float* X1 = (const float*)(F.ws + WS_X1); norm_mod_phase<true>(F, X1, X1, KP(norm2_g) + D, (const float*)(F.ws + WS_MODV) + (size_t)5 * MODW, 3, 4, ML, KP(router_w)); } SEAM(14);
            if (IN(15)) REP(15) { SITE(); moe_scatter_phase(F); } SEAM(15);
            if (IN(16)) REP(16) { SITE();
                SchedMoe S{(const char*)(F.ws + WS_H2S), (const char*)(F.ws + WS_WMGU), (size_t)256 * D * 2, (size_t)2 * DFE * D * 2, (size_t)256 * D * 2, 28, F.G, F.bx, (const int*)(F.ws + WS_TILE)};
                EpiSwiglu E{(bf16*)(F.ws + WS_ACT), DFE};
                pg8::gemm_phase<EpiSwiglu, SchedMoe, true, true>(ring, D, D, D, S, E);
            } SEAM(16);
            if (IN(17)) REP(17) { SITE();
                SchedMoe S{(const char*)(F.ws + WS_ACT), (const char*)(F.ws + WS_WMDN), (size_t)256 * DFE * 2, (size_t)D * DFE * 2, (size_t)256 * DFE * 2, 4, F.G, F.bx, (const int*)(F.ws + WS_TILE)};
                EpiPlain E{(bf16*)(F.ws + WS_YS), D};
                pg8::gemm_phase<EpiPlain, SchedMoe, true, true>(ring, DFE, DFE, DFE, S, E);
            } SEAM(17);
            if (IN(18)) REP(18) { SITE(); final_phase(F, KP(final_g), (float*)karg_p<(int)__builtin_offsetof(Args, out)>(), (const float*)(F.ws + WS_MODV) + (size_t)5 * MODW); }
        }

#undef IN
#undef SEAM
}

extern "C" void kernel_launch(void* const* d_in, const int* in_sizes, int n_in, void* d_out, int out_size, void* d_ws, size_t ws_size, hipStream_t stream) {
    static int grid = 0;
    if (grid == 0) {
        if (n_in != 21 || out_size != ML * D || ws_size < WS_END) { fprintf(stderr, "kernel_launch: unexpected sizes (n_in %d, out %d, ws %zu < %zu)\n", n_in, out_size, ws_size, (size_t)WS_END); grid = -1; return; }
        int dev = 0, cus = 0, per_cu = 0;
        if (hipGetDevice(&dev) != hipSuccess || hipDeviceGetAttribute(&cus, hipDeviceAttributeMultiprocessorCount, dev) != hipSuccess) { grid = -1; return; }
        if (hipFuncSetAttribute((const void*)mk_fwd, hipFuncAttributeMaxDynamicSharedMemorySize, LDS_BYTES) != hipSuccess) { fprintf(stderr, "kernel_launch: hipFuncSetAttribute failed\n"); grid = -1; return; }
        if (hipOccupancyMaxActiveBlocksPerMultiprocessor(&per_cu, (const void*)mk_fwd, NTHR, LDS_BYTES) != hipSuccess || per_cu < 1) { fprintf(stderr, "kernel_launch: occupancy query says %d\n", per_cu); per_cu = 1; }
        (void)hipGetLastError();
        grid = cus;
    }
    if (grid < 0) return;
    (void)hipMemsetAsync((char*)d_ws + WS_CTL, 0, CTL_ZERO_BYTES, stream);
    Args a{};
    const float** pp = (const float**)&a;
    for (int i = 0; i < 21; ++i) pp[i] = (const float*)d_in[i];
    a.out = (float*)d_out; a.ws = (unsigned char*)d_ws;
#if MK_FUSED
    a.ph_lo = 0; a.ph_hi = N_PHASES;
    hipLaunchKernelGGL(mk_fwd, dim3(grid), dim3(NTHR), LDS_BYTES, stream, a);
#else
    for (int p = 0; p < N_PHASES; ++p) { a.ph_lo = p; a.ph_hi = p + 1; hipLaunchKernelGGL(mk_fwd, dim3(grid), dim3(NTHR), LDS_BYTES, stream, a); }
#endif
}
```

```cpp
#include <hip/hip_runtime.h>
#include <cstdio>
#include <cstdint>

#ifndef ATTN_NAIVE
#define ATTN_NAIVE 0
#endif
#ifndef MK_FUSED
#define MK_FUSED 1
#endif

#define LAS __attribute__((address_space(3)))
#define GAS __attribute__((address_space(1)))
typedef unsigned short bf16;
typedef short bf16x8 __attribute__((ext_vector_type(8)));
typedef float f32x4 __attribute__((ext_vector_type(4)));
typedef float f32x2 __attribute__((ext_vector_type(2)));
typedef unsigned u32x4 __attribute__((ext_vector_type(4)));
typedef unsigned u32x2 __attribute__((ext_vector_type(2)));
typedef GAS unsigned gu32;

constexpr int D = 1024, NB = 4, SEQ = 4096, ML = NB * SEQ, CTXL = 256, MC = NB * CTXL, MT = ML + MC;
constexpr int INW = 5888, DFF = 2816, DFE = 3584, NE = 8;
constexpr int ZQ = 0, ZK = 512, ZV = 640, ZCX = 768, ZCB = 1280, ZCC = 1792, ZPU = 2304, ZG = 2816;
constexpr int MIXW = 1536;
constexpr int MS = 2 * ML + NE * 256;
constexpr int MODW = 6 * D;
constexpr float EPS = 1e-6f;
constexpr float LOG2E = 1.4426950408889634f, QSCALE = 0.125f * LOG2E;
constexpr int NWAVES = 8, NTHR = 512;

__device__ __forceinline__ unsigned f2bf(float f) { unsigned u = __builtin_bit_cast(unsigned, f); return (u + 0x7fffu + ((u >> 16) & 1u)) >> 16; }
__device__ __forceinline__ unsigned pk2(float lo, float hi) { return f2bf(lo) | (f2bf(hi) << 16); }
__device__ __forceinline__ float bf2f(unsigned b) { return __builtin_bit_cast(float, b << 16); }
__device__ __forceinline__ float bflo(unsigned w) { return __builtin_bit_cast(float, w << 16); }
__device__ __forceinline__ float bfhi(unsigned w) { return __builtin_bit_cast(float, w & 0xffff0000u); }

namespace pg8 {
constexpr int BM = 256, BK = 64, HALF = 128, HTB = HALF * BK * 2, STAGE_BYTES = 8 * HTB, NXCD = 8, WGM = 8;
__host__ __device__ __forceinline__ int lds_byte(int r, int c) { const int st = (r >> 4) * 2 + (c >> 5), rr = r & 15, cc = c & 31, ob = rr * 64 + cc * 2; return st * 1024 + (ob ^ (((ob >> 9) & 1) << 5)); }
__host__ __device__ __forceinline__ void stage_rc(int b, int& R, int& C) { const int st = b / 1024, sb = b % 1024, swz = sb ^ (((sb >> 9) & 1) << 5); R = (st >> 1) * 16 + swz / 64; C = (st & 1) * 32 + (swz % 64) / 2; }
__host__ __device__ __forceinline__ int perm32(int rho) { const int n = rho >> 4, i = rho & 15; return 8 * (i >> 2) + 4 * n + (i & 3); }

struct Unit { int pm, pn, tag; const char* a; const char* b; };

__device__ __forceinline__ void tile_of(int L, int nM, int nN, int& pm, int& pn) {
    const int nwg = nM * nN; int wgid = L;
    { const int q = nwg / NXCD, r = nwg % NXCD, xcd = wgid % NXCD, off = wgid / NXCD; wgid = (xcd < r ? xcd * (q + 1) : r * (q + 1) + (xcd - r) * q) + off; }
    const int nig = WGM * nN, gid = wgid / nig, fm = gid * WGM, gsz = (nM - fm) < WGM ? (nM - fm) : WGM;
    pm = fm + ((wgid % nig) % gsz); pn = (wgid % nig) / gsz;
}

__device__ __forceinline__ unsigned cvt_pk_bf16(float lo, float hi) { unsigned r; asm volatile("v_cvt_pk_bf16_f32 %0, %1, %2" : "=v"(r) : "v"(lo), "v"(hi)); return r; }

template <class Epi, class Sched, bool ALIGN_EPI = false, bool SP2 = false>
__device__ __forceinline__ void gemm_phase(LAS unsigned char* lds, const int lda, const int ldb, const int K, const Sched& S, const Epi& E) {
    int tid_ = threadIdx.x; asm volatile("" : "+v"(tid_));
    const int tid = tid_, wid = __builtin_amdgcn_readfirstlane(tid >> 6), lane = tid & 63, wr = wid >> 2, wc = wid & 3, fr = lane & 15, fq = lane >> 4;
    const int nt = K / BK;
    unsigned voffA[2], voffB[2];
#pragma unroll
    for (int i = 0; i < 2; ++i) { int R, C; stage_rc(tid * 16 + i * 8192, R, C); const int Rb = Epi::PERM ? ((R & ~31) + perm32(R & 31)) : R;
        voffA[i] = (unsigned)(R * lda + C) * 2u; voffB[i] = (unsigned)(Rb * ldb + C) * 2u; }
    const size_t kstep = (size_t)(BK * 2);
    const size_t hstepA = (size_t)HALF * lda * 2, hstepB = (size_t)HALF * ldb * 2;
    const unsigned ldsw = (unsigned)wid * 1024u;
    const int aoff = lds_byte(wr * 64 + fr, fq * 8), boff = lds_byte(wc * 32 + fr, fq * 8);
#define PG8_SA(b, h) (((b) * 2 + (h)) * HTB)
#define PG8_SB(b, h) ((4 + (b) * 2 + (h)) * HTB)
#define PG8_STAGE(bufoff, gbase, voff) do { _Pragma("unroll") for (int _i = 0; _i < 2; ++_i) \
        __builtin_amdgcn_global_load_lds((const unsigned*)((const char*)(gbase) + (voff)[_i]), (LAS unsigned*)(lds + (bufoff) + ldsw + _i * 8192), 16, 0, 0); } while (0)
#define PG8_LDA(dst, b, h) do { _Pragma("unroll") for (int m = 0; m < 4; ++m) _Pragma("unroll") for (int k = 0; k < 2; ++k) dst[m][k] = *(const LAS bf16x8*)(lds + PG8_SA(b, h) + aoff + m * 2048 + k * 1024); } while (0)
#define PG8_LDB(dst, b, h) do { _Pragma("unroll") for (int n = 0; n < 2; ++n) _Pragma("unroll") for (int k = 0; k < 2; ++k) dst[n][k] = *(const LAS bf16x8*)(lds + PG8_SB(b, h) + boff + n * 2048 + k * 1024); } while (0)
#define PG8_MMA(ai, bj, At, Bt) do { __builtin_amdgcn_s_setprio(1); _Pragma("unroll") for (int m = 0; m < 4; ++m) _Pragma("unroll") for (int n = 0; n < 2; ++n) _Pragma("unroll") for (int k = 0; k < 2; ++k) \
        acc[ai][bj][m][n] = __builtin_amdgcn_mfma_f32_16x16x32_bf16(Bt[n][k], At[m][k], acc[ai][bj][m][n], 0, 0, 0); __builtin_amdgcn_s_setprio(0); } while (0)
#define PG8_WAIT_V(n) asm volatile("s_waitcnt vmcnt(" #n ")" ::: "memory")
#define PG8_WAIT_L(n) asm volatile("s_waitcnt lgkmcnt(" #n ")" ::: "memory")
#define PG8_BAR __builtin_amdgcn_s_barrier()
#define PG8_SCHED __builtin_amdgcn_sched_barrier(0)
    Unit cur, nxt; int ui = 0;
    if (!S.next(0, cur)) return;
    f32x4 acc[2][2][4][2];
#pragma unroll
    for (int a = 0; a < 2; ++a)
#pragma unroll
        for (int b = 0; b < 2; ++b)
#pragma unroll
            for (int m = 0; m < 4; ++m)
#pragma unroll
                for (int n = 0; n < 2; ++n) acc[a][b][m][n] = (f32x4){0.f, 0.f, 0.f, 0.f};
    bf16x8 At[4][2], B0[2][2], B1[2][2];
    const char* cA = cur.a; const char* cB = cur.b;
    if constexpr (SP2) {
        PG8_STAGE(PG8_SB(0, 0), cB, voffB); PG8_STAGE(PG8_SB(0, 1), cB + hstepB, voffB); PG8_STAGE(PG8_SA(0, 0), cA, voffA); PG8_STAGE(PG8_SA(0, 1), cA + hstepA, voffA);
        if (wr == 1) PG8_BAR;
        PG8_WAIT_V(2); PG8_BAR;
        PG8_STAGE(PG8_SB(1, 0), cB + kstep, voffB); PG8_STAGE(PG8_SA(1, 0), cA + kstep, voffA); PG8_STAGE(PG8_SB(1, 1), cB + hstepB + kstep, voffB);
        PG8_WAIT_V(6); PG8_BAR;
    } else {
        PG8_STAGE(PG8_SB(0, 0), cB, voffB); PG8_STAGE(PG8_SA(0, 0), cA, voffA); PG8_STAGE(PG8_SB(0, 1), cB + hstepB, voffB); PG8_STAGE(PG8_SA(0, 1), cA + hstepA, voffA);
        if (wr == 1) PG8_BAR;
        PG8_WAIT_V(4); PG8_BAR;
        PG8_STAGE(PG8_SB(1, 0), cB + kstep, voffB); PG8_STAGE(PG8_SA(1, 0), cA + kstep, voffA); PG8_STAGE(PG8_SB(1, 1), cB + hstepB + kstep, voffB);
        PG8_WAIT_V(6); PG8_BAR;
    }
    for (;;) {
        const bool has_next = S.next(ui + 1, nxt);
        const char* nA = has_next ? nxt.a : cA; const char* nB = has_next ? nxt.b : cB;
        for (int t = 0; t < nt; t += 2) {
            const bool last = (t == nt - 2);
            const char* a1 = cA + (size_t)(t + 1) * kstep;
            const char* a2 = last ? nA : cA + (size_t)(t + 2) * kstep; const char* b2 = last ? nB : cB + (size_t)(t + 2) * kstep;
            const char* a3 = a2 + kstep; const char* b3 = b2 + kstep;
            if constexpr (SP2) {
            PG8_LDB(B0, 0, 0); PG8_LDB(B1, 0, 1); PG8_SCHED; PG8_LDA(At, 0, 0); PG8_STAGE(PG8_SA(1, 1), a1 + hstepA, voffA);
            PG8_WAIT_V(8); PG8_WAIT_L(0); PG8_BAR; PG8_MMA(0, 0, At, B0); PG8_MMA(0, 1, At, B1); PG8_BAR; PG8_SCHED;
            PG8_LDA(At, 0, 1); PG8_STAGE(PG8_SB(0, 0), b2, voffB); PG8_STAGE(PG8_SB(0, 1), b2 + hstepB, voffB); PG8_STAGE(PG8_SA(0, 0), a2, voffA);
            PG8_WAIT_V(8); PG8_WAIT_L(0); PG8_BAR; PG8_MMA(1, 0, At, B0); PG8_MMA(1, 1, At, B1); PG8_BAR; PG8_SCHED;
            PG8_LDB(B0, 1, 0); PG8_LDB(B1, 1, 1); PG8_SCHED; PG8_LDA(At, 1, 0); PG8_STAGE(PG8_SA(0, 1), a2 + hstepA, voffA);
            PG8_WAIT_V(8); PG8_WAIT_L(0); PG8_BAR; PG8_MMA(0, 0, At, B0); PG8_MMA(0, 1, At, B1); PG8_BAR; PG8_SCHED;
            PG8_LDA(At, 1, 1); PG8_STAGE(PG8_SB(1, 0), b3, voffB); PG8_STAGE(PG8_SB(1, 1), b3 + hstepB, voffB); PG8_STAGE(PG8_SA(1, 0), a3, voffA);
            PG8_WAIT_V(8); PG8_WAIT_L(0); PG8_BAR; PG8_MMA(1, 0, At, B0); PG8_MMA(1, 1, At, B1); PG8_BAR; PG8_SCHED;
            } else {
            PG8_LDB(B0, 0, 0); PG8_SCHED; PG8_LDA(At, 0, 0); PG8_STAGE(PG8_SA(1, 1), a1 + hstepA, voffA);
            PG8_WAIT_L(8); PG8_BAR; PG8_WAIT_L(0); PG8_MMA(0, 0, At, B0); PG8_BAR; PG8_SCHED;
            PG8_LDB(B1, 0, 1); PG8_STAGE(PG8_SB(0, 0), b2, voffB);
            PG8_BAR; PG8_WAIT_L(0); PG8_MMA(0, 1, At, B1); PG8_BAR;
            PG8_LDA(At, 0, 1); PG8_STAGE(PG8_SA(0, 0), a2, voffA);
            PG8_BAR; PG8_WAIT_L(0); PG8_MMA(1, 0, At, B0); PG8_BAR; PG8_SCHED;
            PG8_STAGE(PG8_SB(0, 1), b2 + hstepB, voffB);
            PG8_WAIT_V(6); PG8_BAR; PG8_MMA(1, 1, At, B1); PG8_BAR;
            PG8_LDB(B0, 1, 0); PG8_SCHED; PG8_LDA(At, 1, 0); PG8_STAGE(PG8_SA(0, 1), a2 + hstepA, voffA);
            PG8_WAIT_L(8); PG8_BAR; PG8_WAIT_L(0); PG8_MMA(0, 0, At, B0); PG8_BAR; PG8_SCHED;
            PG8_LDB(B1, 1, 1); PG8_STAGE(PG8_SB(1, 0), b3, voffB);
            PG8_BAR; PG8_WAIT_L(0); PG8_MMA(0, 1, At, B1); PG8_BAR;
            PG8_LDA(At, 1, 1); PG8_STAGE(PG8_SA(1, 0), a3, voffA);
            PG8_BAR; PG8_WAIT_L(0); PG8_MMA(1, 0, At, B0); PG8_BAR; PG8_SCHED;
            PG8_STAGE(PG8_SB(1, 1), b3 + hstepB, voffB);
            PG8_WAIT_V(6); PG8_BAR; PG8_MMA(1, 1, At, B1); PG8_BAR;
            }
            if constexpr (Epi::MIDHOOK) { if (((t + 2) & 7) == 0 && !last) E.mid(acc, cur, (t + 2) >> 3, wr, wc, fr, fq); }
        }
        if constexpr (ALIGN_EPI) { if (wr == 0) PG8_BAR; }
        E(acc, cur, wr, wc, fr, fq);
        if (!has_next) break;
#pragma unroll
        for (int a = 0; a < 2; ++a)
#pragma unroll
            for (int b = 0; b < 2; ++b)
#pragma unroll
                for (int m = 0; m < 4; ++m)
#pragma unroll
                    for (int n = 0; n < 2; ++n) acc[a][b][m][n] = (f32x4){0.f, 0.f, 0.f, 0.f};
        cur = nxt; cA = nA; cB = nB; ++ui;
        if constexpr (ALIGN_EPI) { if (wr == 1) PG8_BAR; }
    }
    PG8_WAIT_V(0);
    if constexpr (!ALIGN_EPI) { if (wr == 0) PG8_BAR; }
    PG8_BAR;
#undef PG8_SA
#undef PG8_SB
#undef PG8_STAGE
#undef PG8_LDA
#undef PG8_LDB
#undef PG8_MMA
#undef PG8_WAIT_V
#undef PG8_WAIT_L
#undef PG8_BAR
#undef PG8_SCHED
}
}

constexpr size_t MiB = 1u << 20;
constexpr size_t al256(size_t x) { return (x + 255) & ~(size_t)255; }
constexpr size_t WS_CTL = 0, CTL_ZERO_BYTES = 1 * MiB;
constexpr size_t WS_MODV = 1 * MiB;
constexpr size_t WS_ROPE = WS_MODV + al256((size_t)2 * 5 * MODW * 4);
constexpr size_t WS_CNTWG = WS_ROPE + al256(64 * 16 * 2 * 4);
constexpr size_t WS_TOKE = WS_CNTWG + al256(256 * 8 * 4);
constexpr size_t WS_TOKP = WS_TOKE + al256((size_t)ML * 2 * 4);
constexpr size_t WS_TOKW = WS_TOKP + al256((size_t)ML * 2 * 4);
constexpr size_t WS_TOKS = WS_TOKW + al256((size_t)ML * 2 * 4);
constexpr size_t WS_TILE = WS_TOKS + al256((size_t)ML * 2 * 4);
constexpr size_t WS_WIN = 4 * MiB;
constexpr size_t WS_WBR = WS_WIN + (size_t)2 * INW * D * 2;
constexpr size_t WS_WOUT = WS_WBR + (size_t)2 * 3 * D * 512 * 2;
constexpr size_t WS_WGU0 = WS_WOUT + (size_t)2 * D * D * 2;
constexpr size_t WS_WDN0 = WS_WGU0 + (size_t)2 * DFF * D * 2;
constexpr size_t WS_WMGU = WS_WDN0 + (size_t)D * DFF * 2;
constexpr size_t WS_WMDN = WS_WMGU + (size_t)NE * 2 * DFE * D * 2;
constexpr size_t WS_H = WS_WMDN + (size_t)NE * D * DFE * 2;
constexpr size_t WS_Z = WS_H + (size_t)MT * D * 2;
constexpr size_t WS_MIX = WS_Z + (size_t)MT * INW * 2;
constexpr size_t WS_ACT = WS_Z;
constexpr size_t WS_YACC = WS_MIX + (size_t)MT * MIXW * 2;
constexpr size_t WS_H2S = WS_YACC;
constexpr size_t WS_Y = WS_YACC + (size_t)MT * D * 4;
constexpr size_t WS_X1 = WS_Y + (size_t)MT * D * 2;
constexpr size_t WS_X2 = WS_X1 + (size_t)MT * D * 4;
constexpr size_t WS_YS = WS_X2;
constexpr size_t WS_END = WS_X2 + (size_t)MT * D * 4;
static_assert((size_t)MS * DFE * 2 <= (size_t)MT * INW * 2 + (size_t)MT * MIXW * 2, "ACT overlay");
static_assert((size_t)MS * D * 2 <= (size_t)MT * D * 4, "H2S / YS overlays");
static_assert(WS_TILE + 1024 <= WS_WIN, "small tables");
constexpr int CW_BAR = 4096;

constexpr int RING_BYTES = 131072;
constexpr int LDSCTL_OFF = 146944, MISC_OFF = LDSCTL_OFF + 320;
constexpr int LDS_BYTES = 147456;

#define XB_TMO      128
#define XB_XCNT(j)  (256  + 64 * (j))
#define XB_XSUB(j)  (1280 + 64 * (j))
#define XB_XGEN(j)  (2304 + 64 * (j))
#define XB_TOP      3328
#define XB_TOPGEN   3392
#define XCD_BAR_WORDS 3456
#define XB_SPIN_CAP (1u << 18)
__device__ __forceinline__ unsigned xb_ld(unsigned* p)              { return __hip_atomic_load(p, __ATOMIC_RELAXED, __HIP_MEMORY_SCOPE_AGENT); }
__device__ __forceinline__ unsigned xb_add(unsigned* p, unsigned v) { return __hip_atomic_fetch_add(p, v, __ATOMIC_RELAXED, __HIP_MEMORY_SCOPE_AGENT); }
__device__ __forceinline__ unsigned xb_xcc_id() { return (unsigned)__builtin_amdgcn_s_getreg((3 << 11) | 20) & 0xFu; }
#define XB_SPIN(cond, bar) do { unsigned _sp = 0; while (cond) { __builtin_amdgcn_s_sleep(1); \
    if ((++_sp & 255u) == 0u) { if (xb_ld(&(bar)[XB_TMO])) break; if (_sp > XB_SPIN_CAP) { atomicAdd(&(bar)[XB_TMO], 1u); break; } } } } while (0)
struct XcdBarrier { unsigned* bar; unsigned x; volatile LAS unsigned* st; };
__device__ __forceinline__ XcdBarrier xcd_barrier_post(unsigned* bar, volatile LAS unsigned* st) {
    XcdBarrier b; b.bar = bar; b.x = xb_xcc_id(); b.st = st;
    if (threadIdx.x == 0) (void)xb_add(&bar[XB_XCNT(b.x)], 1u);
    return b;
}
__device__ __forceinline__ void xcd_barrier_complete(unsigned* bar, unsigned x, unsigned& nloc, unsigned& nx) {
    const unsigned G = gridDim.x * gridDim.y * gridDim.z;
    unsigned sum, cnt, mine, sp = 0u;
    for (;;) {
        sum = 0u; cnt = 0u; mine = 0u;
#pragma unroll
        for (unsigned j = 0; j < 16; ++j) { const unsigned c = xb_ld(&bar[XB_XCNT(j)]); sum += c; cnt += (c > 0u) ? 1u : 0u; mine = (j == x) ? c : mine; }
        if (sum == G) break;
        __builtin_amdgcn_s_sleep(1);
        if ((++sp & 255u) == 0u) { if (xb_ld(&bar[XB_TMO])) break; if (sp > XB_SPIN_CAP) { atomicAdd(&bar[XB_TMO], 1u); break; } }
    }
    nloc = mine > 0u ? mine : 1u; nx = cnt > 0u ? cnt : 1u;
}
__device__ __attribute__((noinline)) void xcd_barrier_leader(unsigned* bar, unsigned bx_, volatile LAS unsigned* st) {
    {
        XcdBarrier b; b.bar = bar; b.x = bx_; b.st = st;
        __builtin_amdgcn_s_waitcnt(0);
        unsigned nloc = b.st[0], nx = b.st[1];
        if (nloc == 0u) { xcd_barrier_complete(bar, b.x, nloc, nx); b.st[0] = nloc; b.st[1] = nx; }
        const unsigned old = xb_add(&bar[XB_XSUB(b.x)], 1u);
        const unsigned gen = old / nloc;
        if (old + 1u == (gen + 1u) * nloc) {
            __builtin_amdgcn_fence(__ATOMIC_RELEASE, "agent");
            asm volatile("s_waitcnt vmcnt(0)" ::: "memory");
            const unsigned og = xb_add(&bar[XB_TOP], 1u);
            const unsigned tg = og / nx;
            if (og + 1u == (tg + 1u) * nx) xb_add(&bar[XB_TOPGEN], 1u);
            else XB_SPIN(xb_ld(&bar[XB_TOPGEN]) == tg, bar);
            __builtin_amdgcn_fence(__ATOMIC_ACQUIRE, "agent");
            xb_add(&bar[XB_XGEN(b.x)], 1u);
            asm volatile("s_waitcnt vmcnt(0)" ::: "memory");
        } else {
            XB_SPIN(xb_ld(&bar[XB_XGEN(b.x)]) == gen, bar);
            __builtin_amdgcn_fence(__ATOMIC_ACQUIRE, "agent");
            asm volatile("s_waitcnt vmcnt(0)" ::: "memory");
        }
    }
}
__device__ __forceinline__ void xcd_barrier(const XcdBarrier& b) {
    asm volatile("s_waitcnt vmcnt(0)" ::: "memory");
    __syncthreads();
    if (threadIdx.x == 0) xcd_barrier_leader(b.bar, b.x, b.st);
    __syncthreads();
}

struct Args {
    const float *x, *c, *ctx, *c_ctx, *norm1_g, *norm2_g, *final_g, *w_mod, *b_mod, *w_in, *conv_w, *sink, *pool_w, *pool_scale, *w_branch, *w_out,
                *ffn_w_gu, *ffn_w_down, *router_w, *moe_w_gu, *moe_w_down;
    float* out; unsigned char* ws; int ph_lo, ph_hi;
};
template <int OFF> __device__ __forceinline__ const void* karg_p() { const void* r; asm volatile("s_load_dwordx2 %0, %1, %2\n\ts_waitcnt lgkmcnt(0)" : "=s"(r) : "s"(__builtin_amdgcn_kernarg_segment_ptr()), "i"(OFF)); return r; }
template <int OFF> __device__ __forceinline__ int karg_i() { int r; asm volatile("s_load_dword %0, %1, %2\n\ts_waitcnt lgkmcnt(0)" : "=s"(r) : "s"(__builtin_amdgcn_kernarg_segment_ptr()), "i"(OFF)); return r; }
#define KP(field) ((const float*)karg_p<(int)__builtin_offsetof(Args, field)>())
struct Frame {
    LAS unsigned char* lds;
    int tid, lane, wave, G, bx;
    unsigned char* ws;
};
__device__ __forceinline__ float wave_sum(float v) {
#pragma unroll
    for (int o = 1; o < 64; o <<= 1) v += __shfl_xor(v, o);
    return v;
}
__device__ __forceinline__ float wave_max(float v) {
#pragma unroll
    for (int o = 1; o < 64; o <<= 1) v = fmaxf(v, __shfl_xor(v, o));
    return v;
}
#define LDS_WAIT() asm volatile("s_waitcnt lgkmcnt(0)" ::: "memory")

__device__ __forceinline__ void p0_transpose_item(const float* W, int ldw, bf16* WT, int ldt, int koff, int k0, int n0, int drow0, LAS float* scr, int lane) {
    f32x4 v[16];
    const int rl = lane >> 4, c4 = 4 * (lane & 15);
#pragma unroll
    for (int i = 0; i < 16; ++i) v[i] = __builtin_nontemporal_load((const f32x4*)(W + (size_t)(k0 + 4 * i + rl) * ldw + n0 + c4));
#pragma unroll
    for (int i = 0; i < 16; ++i) { LAS float* p = scr + (4 * i + rl) * 65 + c4; p[0] = v[i].x; p[1] = v[i].y; p[2] = v[i].z; p[3] = v[i].w; }
    LDS_WAIT(); asm volatile("" ::: "memory");
    const int c = lane & 7;
#pragma unroll
    for (int j = 0; j < 8; ++j) { const int n = (lane >> 3) + 8 * j; const LAS float* sp = scr + (8 * c) * 65 + n;
        u32x4 o; o.x = pk2(sp[0 * 65], sp[1 * 65]); o.y = pk2(sp[2 * 65], sp[3 * 65]); o.z = pk2(sp[4 * 65], sp[5 * 65]); o.w = pk2(sp[6 * 65], sp[7 * 65]);
        *(u32x4*)(WT + (size_t)(drow0 + n) * ldt + koff + k0 + 8 * c) = o; }
    LDS_WAIT(); asm volatile("" ::: "memory");
}
__device__ __forceinline__ void p0_job_item(const float* W, int K, int N, bf16* WT, int ldt, int koff, int IL, int item, LAS float* scr, int lane) {
    const int nblk = N / 64, kb = item / nblk, nb = item % nblk, n0 = 64 * nb;
    int drow0 = n0;
    if (IL > 0) { const int half = n0 >= IL ? 1 : 0, f = n0 - half * IL; drow0 = 256 * (f / 128) + 128 * half + (f % 128); }
    p0_transpose_item(W, N, WT, ldt, koff, 64 * kb, n0, drow0, scr, lane);
}
__device__ __forceinline__ void p0_prologue(Frame& F) {
    LAS float* scr = (LAS float*)(F.lds + F.wave * 16640);
    const int gw = F.bx * NWAVES + F.wave, NGW = F.G * NWAVES;
    constexpr int I_IN = (D / 64) * (INW / 64), I_BR = (512 / 64) * (D / 64), I_OUT = (D / 64) * (D / 64), I_GU0 = (D / 64) * (2 * DFF / 64), I_DN0 = (DFF / 64) * (D / 64),
                  I_MGU = (D / 64) * (2 * DFE / 64), I_MDN = (DFE / 64) * (D / 64);
    constexpr int NITEMS = 2 * I_IN + 4 * I_BR + 2 * I_OUT + I_GU0 + I_DN0 + NE * I_MGU + NE * I_MDN;
    bf16* const wsb = (bf16*)F.ws;
    for (int it = gw; it < NITEMS; it += NGW) {
        int r = it;
        if (r < NE * I_MGU) { const int e = r / I_MGU; p0_job_item(KP(moe_w_gu) + (size_t)e * D * 2 * DFE, D, 2 * DFE, (bf16*)(F.ws + WS_WMGU) + (size_t)e * 2 * DFE * D, D, 0, DFE, r % I_MGU, scr, F.lane); continue; } r -= NE * I_MGU;
        if (r < NE * I_MDN) { const int e = r / I_MDN; p0_job_item(KP(moe_w_down) + (size_t)e * DFE * D, DFE, D, (bf16*)(F.ws + WS_WMDN) + (size_t)e * D * DFE, DFE, 0, 0, r % I_MDN, scr, F.lane); continue; } r -= NE * I_MDN;
        if (r < 2 * I_IN) { const int l = r / I_IN; p0_job_item(KP(w_in) + (size_t)l * D * INW, D, INW, (bf16*)(F.ws + WS_WIN) + (size_t)l * INW * D, D, 0, 0, r % I_IN, scr, F.lane); continue; } r -= 2 * I_IN;
        if (r < 4 * I_BR) { const int j = r / I_BR, l = j >> 1, b = j & 1; p0_job_item(KP(w_branch) + (size_t)(l * 3 + b) * 512 * D, 512, D, (bf16*)(F.ws + WS_WBR) + (size_t)l * D * MIXW, MIXW, 512 * b, 0, r % I_BR, scr, F.lane); continue; } r -= 4 * I_BR;
        if (r < 2 * I_OUT) { const int l = r / I_OUT; p0_job_item(KP(w_out) + (size_t)l * D * D, D, D, (bf16*)(F.ws + WS_WOUT) + (size_t)l * D * D, D, 0, 0, r % I_OUT, scr, F.lane); continue; } r -= 2 * I_OUT;
        if (r < I_GU0) { p0_job_item(KP(ffn_w_gu), D, 2 * DFF, (bf16*)(F.ws + WS_WGU0), D, 0, DFF, r, scr, F.lane); continue; } r -= I_GU0;
        p0_job_item(KP(ffn_w_down), DFF, D, (bf16*)(F.ws + WS_WDN0), DFF, 0, 0, r, scr, F.lane);
    }
    (void)wsb;
    __syncthreads();
    constexpr int I_MOD = 2 * (MODW / 64), I_FOLD = 2 * 4 * (D / 64);
    for (int it = F.bx; it < I_MOD + I_FOLD + 1; it += F.G) {
        if (it < I_MOD) {
            const int l = it / (MODW / 64), cb = it % (MODW / 64);
            LAS float* sv = (LAS float*)F.lds;
            LAS float* red = (LAS float*)(F.lds + 32768);
            for (int i = F.tid; i < 5 * D; i += NTHR) { const int r = i / D, k = i % D; const float v = r < 4 ? KP(c)[r * D + k] : KP(c_ctx)[k]; sv[i] = v / (1.f + __expf(-v)); }
            __syncthreads();
            const int col = cb * 64 + F.lane; const float* wp = KP(w_mod) + (size_t)l * D * MODW + col;
            float a0 = 0.f, a1 = 0.f, a2 = 0.f, a3 = 0.f, a4 = 0.f;
#pragma unroll 8
            for (int kk = 0; kk < 128; ++kk) { const int k = F.wave * 128 + kk; const float w = wp[(size_t)k * MODW];
                a0 += sv[k] * w; a1 += sv[D + k] * w; a2 += sv[2 * D + k] * w; a3 += sv[3 * D + k] * w; a4 += sv[4 * D + k] * w; }
            red[(F.wave * 5 + 0) * 64 + F.lane] = a0; red[(F.wave * 5 + 1) * 64 + F.lane] = a1; red[(F.wave * 5 + 2) * 64 + F.lane] = a2;
            red[(F.wave * 5 + 3) * 64 + F.lane] = a3; red[(F.wave * 5 + 4) * 64 + F.lane] = a4;
            __syncthreads();
            if (F.tid < 320) { const int r = F.tid / 64, ln = F.tid % 64; float s = 0.f;
#pragma unroll
                for (int w = 0; w < 8; ++w) s += red[(w * 5 + r) * 64 + ln];
                const int cc = cb * 64 + ln;
                ((float*)(F.ws + WS_MODV))[(size_t)(l * 5 + r) * MODW + cc] = s + KP(b_mod)[l * MODW + cc]; }
            __syncthreads();
        } else if (it < I_MOD + I_FOLD) {
            const int r = it - I_MOD, l = r / 64, g = (r % 64) / 16, nb = r % 16;
            LAS float* pw = (LAS float*)F.lds;
            const float* pws = KP(pool_w) + (size_t)(l * 4 + g) * 128 * 128;
            for (int i = F.tid; i < 128 * 128; i += NTHR) pw[i] = pws[i];
            __syncthreads();
            const int n = nb * 64 + F.lane; const float* w2 = KP(w_branch) + (size_t)(l * 3 + 2) * 512 * D + (size_t)(128 * g) * D + n;
            const float* ps = KP(pool_scale) + l * 512 + 128 * g;
            float acc[16];
#pragma unroll
            for (int q = 0; q < 16; ++q) acc[q] = 0.f;
            for (int j = 0; j < 128; ++j) { const float wv = w2[(size_t)j * D] * ps[j];
#pragma unroll
                for (int q = 0; q < 16; ++q) acc[q] += pw[(F.wave * 16 + q) * 128 + j] * wv; }
            bf16* dst = (bf16*)(F.ws + WS_WBR) + (size_t)l * D * MIXW + (size_t)n * MIXW + 1024 + 128 * g + F.wave * 16;
            u32x4 o0, o1; o0.x = pk2(acc[0], acc[1]); o0.y = pk2(acc[2], acc[3]); o0.z = pk2(acc[4], acc[5]); o0.w = pk2(acc[6], acc[7]);
            o1.x = pk2(acc[8], acc[9]); o1.y = pk2(acc[10], acc[11]); o1.z = pk2(acc[12], acc[13]); o1.w = pk2(acc[14], acc[15]);
            *(u32x4*)dst = o0; *(u32x4*)(dst + 8) = o1;
            __syncthreads();
        } else {
            for (int i = F.tid; i < 64 * 16; i += NTHR) { const int pos = i / 16, fi = i % 16;
                const float inv = powf(10000.0f, -(float)fi / 16.0f); const float ang = (float)pos * inv;
                ((float*)(F.ws + WS_ROPE))[2 * i] = cosf(ang); ((float*)(F.ws + WS_ROPE))[2 * i + 1] = sinf(ang); }
        }
    }
}

template <bool ROUTER>
__device__ __forceinline__ void norm_mod_phase(Frame& F, const float* xl, const float* xc, const float* gvec, const float* modl, int shi, int sci, int nrows, const float* router_w) {
    bf16* H = (bf16*)(F.ws + WS_H);
    LAS int* lcnt = (LAS int*)F.lds;
    if (ROUTER) { if (F.tid < 8) lcnt[F.tid] = 0; __syncthreads(); }
    const int nloop = ROUTER ? 8 : (nrows + F.G * NWAVES - 1) / (F.G * NWAVES);
    for (int i = 0; i < nloop; ++i) {
        const int r = ROUTER ? (F.bx * 64 + F.wave + 8 * i) : ((i * F.G + F.bx) * NWAVES + F.wave);
        if (r >= nrows) continue;
        const int bidx = r < ML ? r / SEQ : 4;
        const float* xr = r < ML ? xl + (size_t)r * D : xc + (size_t)(r - ML) * D;
        const float* mv = modl + (size_t)bidx * MODW;
        f32x4 v[4]; float ss = 0.f;
#pragma unroll
        for (int j = 0; j < 4; ++j) { v[j] = *(const f32x4*)(xr + 4 * F.lane + 256 * j); ss += (v[j].x * v[j].x + v[j].y * v[j].y) + (v[j].z * v[j].z + v[j].w * v[j].w); }
        const float rstd = 1.0f / sqrtf(wave_sum(ss) * (1.f / D) + EPS);
#pragma unroll
        for (int j = 0; j < 4; ++j) { const int c = 4 * F.lane + 256 * j;
            const f32x4 g = *(const f32x4*)(gvec + c), sh = *(const f32x4*)(mv + shi * D + c), sc = *(const f32x4*)(mv + sci * D + c);
            v[j] = (v[j] * rstd * g) * (sc + 1.0f) + sh;
            u32x2 o; o.x = pk2(v[j].x, v[j].y); o.y = pk2(v[j].z, v[j].w);
            *(u32x2*)(H + (size_t)r * D + c) = o; }
        if (ROUTER) {
            float lg[8];
#pragma unroll
            for (int e = 0; e < 8; ++e) lg[e] = 0.f;
#pragma unroll
            for (int j = 0; j < 4; ++j)
#pragma unroll
                for (int q = 0; q < 4; ++q) { const int c = 4 * F.lane + 256 * j + q; const f32x4 w0 = *(const f32x4*)(router_w + (size_t)c * 8), w1 = *(const f32x4*)(router_w + (size_t)c * 8 + 4); const float hv = v[j][q];
                    lg[0] += hv * w0.x; lg[1] += hv * w0.y; lg[2] += hv * w0.z; lg[3] += hv * w0.w; lg[4] += hv * w1.x; lg[5] += hv * w1.y; lg[6] += hv * w1.z; lg[7] += hv * w1.w; }
#pragma unroll
            for (int e = 0; e < 8; ++e) lg[e] = wave_sum(lg[e]);
            int e1 = 0; float v1 = lg[0];
#pragma unroll
            for (int e = 1; e < 8; ++e) if (lg[e] > v1) { v1 = lg[e]; e1 = e; }
            int e2 = -1; float v2 = -3.0e38f;
#pragma unroll
            for (int e = 0; e < 8; ++e) if (e != e1 && lg[e] > v2) { v2 = lg[e]; e2 = e; }
            const float ex = __expf(v2 - v1), w1 = 1.f / (1.f + ex), w2 = ex * w1;
            if (F.lane == 0) {
                const int p1 = atomicAdd((int*)&lcnt[e1], 1), p2 = atomicAdd((int*)&lcnt[e2], 1);
                int* te = (int*)(F.ws + WS_TOKE) + 2 * r; te[0] = e1; te[1] = e2;
                int* tp = (int*)(F.ws + WS_TOKP) + 2 * r; tp[0] = p1; tp[1] = p2;
                float* tw = (float*)(F.ws + WS_TOKW) + 2 * r; tw[0] = w1; tw[1] = w2;
            }
        }
    }
    if (ROUTER) { __syncthreads(); if (F.tid < 8) ((int*)(F.ws + WS_CNTWG))[F.bx * 8 + F.tid] = lcnt[F.tid]; __syncthreads(); }
}

__device__ __forceinline__ void moe_scatter_phase(Frame& F) {
    LAS int* tab = (LAS int*)F.lds;
    const int* cw = (const int*)(F.ws + WS_CNTWG);
    if (F.tid < 32) tab[F.tid] = 0;
    __syncthreads();
    for (int idx = F.tid; idx < F.G * 8; idx += NTHR) {
        const int c = __hip_atomic_load(cw + idx, __ATOMIC_RELAXED, __HIP_MEMORY_SCOPE_AGENT); const int w = idx >> 3, e = idx & 7;
        atomicAdd((int*)&tab[16 + e], c); if (w < F.bx) atomicAdd((int*)&tab[8 + e], c);
    }
    __syncthreads();
    if (F.tid == 0) { int off = 0; for (int e = 0; e < 8; ++e) { tab[e] = off; off += ((tab[16 + e] + 255) / 256) * 256; } tab[24] = off / 256;
        if (F.bx == 0) { int* tl = (int*)(F.ws + WS_TILE); int t = 0; for (int e = 0; e < 8; ++e) { const int n = (tab[16 + e] + 255) / 256; for (int q = 0; q < n; ++q) tl[t++] = e; } tl[200] = t; } }
    __syncthreads();
    const bf16* H = (const bf16*)(F.ws + WS_H); bf16* HS = (bf16*)(F.ws + WS_H2S);
    for (int i = 0; i < 8; ++i) {
        const int r = F.bx * 64 + F.wave + 8 * i; if (r >= ML) continue;
        const int* te = (const int*)(F.ws + WS_TOKE) + 2 * r; const int* tp = (const int*)(F.ws + WS_TOKP) + 2 * r;
        const int e1 = te[0], e2 = te[1];
        const int s1 = tab[e1] + tab[8 + e1] + tp[0], s2 = tab[e2] + tab[8 + e2] + tp[1];
        if (F.lane == 0) { int* ts = (int*)(F.ws + WS_TOKS) + 2 * r; ts[0] = s1; ts[1] = s2; }
        const u32x4* src = (const u32x4*)(H + (size_t)r * D);
        const u32x4 a = src[F.lane], b = src[64 + F.lane];
        u32x4* d1 = (u32x4*)(HS + (size_t)s1 * D); u32x4* d2 = (u32x4*)(HS + (size_t)s2 * D);
        d1[F.lane] = a; d1[64 + F.lane] = b; d2[F.lane] = a; d2[64 + F.lane] = b;
    }
}

__device__ __forceinline__ void final_phase(Frame& F, const float* final_g, float* out, const float* modl) {
    const float* X1 = (const float*)(F.ws + WS_X1); const bf16* YS = (const bf16*)(F.ws + WS_YS);
    const int NGW = F.G * NWAVES;
    for (int r = F.bx * NWAVES + F.wave; r < ML; r += NGW) {
        const int bidx = r / SEQ; const float* g2 = modl + (size_t)bidx * MODW + 5 * D;
        const int* ts = (const int*)(F.ws + WS_TOKS) + 2 * r; const float* tw = (const float*)(F.ws + WS_TOKW) + 2 * r;
        const int s1 = ts[0], s2 = ts[1]; const float w1 = tw[0], w2 = tw[1];
        f32x4 v[4]; float ss = 0.f;
#pragma unroll
        for (int j = 0; j < 4; ++j) { const int c = 4 * F.lane + 256 * j;
            const f32x4 xv = *(const f32x4*)(X1 + (size_t)r * D + c), g = *(const f32x4*)(g2 + c);
            const u32x2 y1 = *(const u32x2*)(YS + (size_t)s1 * D + c), y2 = *(const u32x2*)(YS + (size_t)s2 * D + c);
            f32x4 f; f.x = w1 * bflo(y1.x) + w2 * bflo(y2.x); f.y = w1 * bfhi(y1.x) + w2 * bfhi(y2.x); f.z = w1 * bflo(y1.y) + w2 * bflo(y2.y); f.w = w1 * bfhi(y1.y) + w2 * bfhi(y2.y);
            v[j] = xv + g * f; ss += (v[j].x * v[j].x + v[j].y * v[j].y) + (v[j].z * v[j].z + v[j].w * v[j].w); }
        const float rstd = 1.0f / sqrtf(wave_sum(ss) * (1.f / D) + EPS);
#pragma unroll
        for (int j = 0; j < 4; ++j) { const int c = 4 * F.lane + 256 * j; const f32x4 g = *(const f32x4*)(final_g + c);
            *(f32x4*)(out + (size_t)r * D + c) = v[j] * rstd * g; }
    }
}

__device__ __forceinline__ void unpack8(const u32x4 w, float (&f)[8]) { f[0] = bflo(w.x); f[1] = bfhi(w.x); f[2] = bflo(w.y); f[3] = bfhi(w.y); f[4] = bflo(w.z); f[5] = bfhi(w.z); f[6] = bflo(w.w); f[7] = bfhi(w.w); }
__device__ __forceinline__ void local_mix_phase(Frame& F, const float* cw, int nrows) {
    const bf16* Z = (const bf16*)(F.ws + WS_Z); bf16* MIX = (bf16*)(F.ws + WS_MIX);
    const int total = nrows * 64, stride = F.G * NTHR;
    for (int idx = F.bx * NTHR + F.tid; idx < total; idx += stride) {
        const int r = idx >> 6, cg = idx & 63, c0 = cg * 8;
        int t, L, base;
        if (r < ML) { t = r % SEQ; L = SEQ; base = r - t; } else { const int rc = r - ML; t = rc % CTXL; L = CTXL; base = r - t; }
        float o[8];
#pragma unroll
        for (int q = 0; q < 8; ++q) o[q] = 0.f;
#pragma unroll
        for (int j = 0; j < 3; ++j) { const int tt = t - 1 + j; if (tt < 0 || tt >= L) continue;
            const bf16* zr = Z + (size_t)(base + tt) * INW; float cx[8], cc[8];
            unpack8(*(const u32x4*)(zr + ZCX + c0), cx); unpack8(*(const u32x4*)(zr + ZCC + c0), cc);
            const f32x4 w0 = *(const f32x4*)(cw + j * 512 + c0), w1 = *(const f32x4*)(cw + j * 512 + c0 + 4);
            o[0] += w0.x * (cc[0] * cx[0]); o[1] += w0.y * (cc[1] * cx[1]); o[2] += w0.z * (cc[2] * cx[2]); o[3] += w0.w * (cc[3] * cx[3]);
            o[4] += w1.x * (cc[4] * cx[4]); o[5] += w1.y * (cc[5] * cx[5]); o[6] += w1.z * (cc[6] * cx[6]); o[7] += w1.w * (cc[7] * cx[7]); }
        { float cb[8]; unpack8(*(const u32x4*)(Z + (size_t)r * INW + ZCB + c0), cb);
          u32x4 w; w.x = pk2(cb[0] * o[0], cb[1] * o[1]); w.y = pk2(cb[2] * o[2], cb[3] * o[3]); w.z = pk2(cb[4] * o[4], cb[5] * o[5]); w.w = pk2(cb[6] * o[6], cb[7] * o[7]);
          *(u32x4*)(MIX + (size_t)r * MIXW + 512 + c0) = w; }
        { const int hw = 1 << (c0 >> 7); const int lo = t - hw < 0 ? 0 : t - hw, hi = t + hw > L ? L : t + hw;
          float s[8];
#pragma unroll
          for (int q = 0; q < 8; ++q) s[q] = 0.f;
          for (int tt = lo; tt < hi; ++tt) { float u[8]; unpack8(*(const u32x4*)(Z + (size_t)(base + tt) * INW + ZPU + c0), u);
#pragma unroll
              for (int q = 0; q < 8; ++q) s[q] += u[q]; }
          float u0[8]; unpack8(*(const u32x4*)(Z + (size_t)r * INW + ZPU + c0), u0);
          const float inv = 1.0f / (float)(hi - lo);
          u32x4 w; w.x = pk2(s[0] * inv - u0[0], s[1] * inv - u0[1]); w.y = pk2(s[2] * inv - u0[2], s[3] * inv - u0[3]);
          w.z = pk2(s[4] * inv - u0[4], s[5] * inv - u0[5]); w.w = pk2(s[6] * inv - u0[6], s[7] * inv - u0[7]);
          *(u32x4*)(MIX + (size_t)r * MIXW + 1024 + c0) = w; }
    }
}

__device__ __forceinline__ void attn_naive_phase(Frame& F, const float* sinkl, int nrows) {
    const bf16* Z = (const bf16*)(F.ws + WS_Z); bf16* MIX = (bf16*)(F.ws + WS_MIX);
    LAS float* qs = (LAS float*)(F.lds + F.wave * 10240);
    LAS float* sc = qs + 256;
    const int nunits = nrows * 2, NGW = F.G * NWAVES;
    for (int uidx = F.bx * NWAVES + F.wave; uidx < nunits; uidx += NGW) {
        const int r = uidx >> 1, kh = uidx & 1;
        int b, nloc, krow0;
        if (r < ML) { b = r / SEQ; const int t = r % SEQ; const int lo = t - 128 < 0 ? 0 : t - 128, hi = t + 128 > SEQ - 1 ? SEQ - 1 : t + 128; nloc = hi - lo + 1; krow0 = b * SEQ + lo; }
        else { b = (r - ML) / CTXL; nloc = 0; krow0 = 0; }
        const int crow0 = ML + b * CTXL, nk = nloc + CTXL;
        { const u32x2 qw = *(const u32x2*)(Z + (size_t)r * INW + ZQ + kh * 256 + 4 * F.lane); const int g = F.lane >> 4, d = (4 * F.lane) & 63;
          qs[(d + 0) * 4 + g] = bflo(qw.x); qs[(d + 1) * 4 + g] = bfhi(qw.x); qs[(d + 2) * 4 + g] = bflo(qw.y); qs[(d + 3) * 4 + g] = bfhi(qw.y); }
        LDS_WAIT(); asm volatile("" ::: "memory");
        for (int c0 = 0; c0 < nk; c0 += 64) {
            const int kk = c0 + F.lane;
            if (kk < nk) {
                const int krow = kk < nloc ? krow0 + kk : crow0 + (kk - nloc);
                const u32x4* kp = (const u32x4*)(Z + (size_t)krow * INW + ZK + kh * 64);
                f32x4 s = (f32x4){0.f, 0.f, 0.f, 0.f};
#pragma unroll
                for (int d8 = 0; d8 < 8; ++d8) { float kf[8]; unpack8(kp[d8], kf);
#pragma unroll
                    for (int q = 0; q < 8; ++q) { const f32x4 qv = *(const LAS f32x4*)(qs + (d8 * 8 + q) * 4); s += qv * kf[q]; } }
                *(LAS f32x4*)(sc + kk * 4) = s;
            }
        }
        LDS_WAIT(); asm volatile("" ::: "memory");
        f32x4 mx; { const float* sk = sinkl + kh * 4; mx = (f32x4){sk[0] * LOG2E, sk[1] * LOG2E, sk[2] * LOG2E, sk[3] * LOG2E}; }
        const f32x4 snk = mx;
        for (int kk = F.lane; kk < nk; kk += 64) { const f32x4 s = *(const LAS f32x4*)(sc + kk * 4); mx.x = fmaxf(mx.x, s.x); mx.y = fmaxf(mx.y, s.y); mx.z = fmaxf(mx.z, s.z); mx.w = fmaxf(mx.w, s.w); }
        mx.x = wave_max(mx.x); mx.y = wave_max(mx.y); mx.z = wave_max(mx.z); mx.w = wave_max(mx.w);
        f32x4 sm = (f32x4){0.f, 0.f, 0.f, 0.f};
        for (int kk = F.lane; kk < nk; kk += 64) { f32x4 s = *(const LAS f32x4*)(sc + kk * 4);
            s.x = exp2f(s.x - mx.x); s.y = exp2f(s.y - mx.y); s.z = exp2f(s.z - mx.z); s.w = exp2f(s.w - mx.w); sm += s; *(LAS f32x4*)(sc + kk * 4) = s; }
        sm.x = wave_sum(sm.x) + exp2f(snk.x - mx.x); sm.y = wave_sum(sm.y) + exp2f(snk.y - mx.y); sm.z = wave_sum(sm.z) + exp2f(snk.z - mx.z); sm.w = wave_sum(sm.w) + exp2f(snk.w - mx.w);
        LDS_WAIT(); asm volatile("" ::: "memory");
        f32x4 o = (f32x4){0.f, 0.f, 0.f, 0.f};
        const bf16* vb = Z + ZV + kh * 64 + F.lane;
#pragma unroll 4
        for (int kk = 0; kk < nk; ++kk) { const int krow = kk < nloc ? krow0 + kk : crow0 + (kk - nloc);
            const float v = bf2f((unsigned)vb[(size_t)krow * INW]); const f32x4 p = *(const LAS f32x4*)(sc + kk * 4); o += p * v; }
        bf16* op = MIX + (size_t)r * MIXW + kh * 256 + F.lane;
        op[0] = (bf16)f2bf(o.x / sm.x); op[64] = (bf16)f2bf(o.y / sm.y); op[128] = (bf16)f2bf(o.z / sm.z); op[192] = (bf16)f2bf(o.w / sm.w);
        LDS_WAIT(); asm volatile("" ::: "memory");
    }
}

typedef float f32x16 __attribute__((ext_vector_type(16)));
typedef short s16x4 __attribute__((ext_vector_type(4)));
typedef __bf16 bf16x2_t __attribute__((ext_vector_type(2)));
__device__ __forceinline__ unsigned cvtpk(float lo, float hi) { f32x2 v = {lo, hi}; bf16x2_t b = __builtin_convertvector(v, bf16x2_t); return __builtin_bit_cast(unsigned, b); }
__device__ __forceinline__ s16x4 vtr(const LAS unsigned char* p) { return __builtin_bit_cast(s16x4, __builtin_amdgcn_ds_read_tr16_b64_v4i16((LAS s16x4*)p)); }
constexpr int AKP = 144, ATT_V_OFF = 128 * AKP;
__device__ __forceinline__ void attn_unit(Frame& F, const bf16* Z, bf16* MIX, const float* sinkl, const bool isctx, const int b, const int kh, const int qblk) {
    const int qrow0 = isctx ? ML + b * CTXL + qblk * 128 : b * SEQ + qblk * 128;
    const int cbase = ML + b * CTXL;
    const bool has_prev = !isctx && qblk > 0, has_next = !isctx && qblk < 31;
    const int nch = isctx ? 2 : 3 + (has_prev ? 1 : 0) + (has_next ? 1 : 0);
    const int lane = F.lane, r = lane & 31, h = lane >> 5, g = F.wave >> 1, qh = F.wave & 1, head = kh * 4 + g;
    LAS unsigned char* Ks = F.lds; LAS unsigned char* Vs = F.lds + ATT_V_OFF;
    bf16x8 qf[2][4];
#pragma unroll
    for (int sub = 0; sub < 2; ++sub)
#pragma unroll
        for (int ks = 0; ks < 4; ++ks) qf[sub][ks] = *(const bf16x8*)(Z + (size_t)(qrow0 + 64 * qh + 32 * sub + r) * INW + ZQ + head * 64 + 16 * ks + 8 * h);
    const float sk = sinkl[head] * LOG2E;
    float m[2], l[2]; f32x16 O[2][2];
#pragma unroll
    for (int sub = 0; sub < 2; ++sub) { m[sub] = sk; l[sub] = h == 0 ? 1.f : 0.f;
#pragma unroll
        for (int db = 0; db < 2; ++db)
#pragma unroll
            for (int i = 0; i < 16; ++i) O[sub][db][i] = 0.f; }
#define ATT_CHUNK(ci, row0, kind) do { if (isctx) { row0 = cbase + 128 * (ci); kind = 0; } else if ((ci) == 0) { row0 = qrow0; kind = 0; } else if ((ci) <= 2) { row0 = cbase + 128 * ((ci) - 1); kind = 0; } \
        else if ((ci) == 3 && has_prev) { row0 = qrow0 - 128; kind = 1; } else { row0 = qrow0 + 128; kind = 2; } } while (0)
    const int skey = F.tid >> 3, spart = F.tid & 7;
    u32x4 pk0, pk1, pv0, pv1;
#define ATT_LOAD(ci) do { int row0_, kind_; ATT_CHUNK(ci, row0_, kind_); (void)kind_; const bf16* kp_ = Z + (size_t)(row0_ + skey) * INW + ZK + kh * 64 + spart * 8; \
        pk0 = *(const u32x4*)kp_; pk1 = *(const u32x4*)(kp_ + (size_t)64 * INW); pv0 = *(const u32x4*)(kp_ + (ZV - ZK)); pv1 = *(const u32x4*)(kp_ + (size_t)64 * INW + (ZV - ZK)); } while (0)
    ATT_LOAD(0);
    const int grp = (lane >> 4) & 1, q4 = (lane & 15) >> 2, p4 = lane & 3;
    for (int ci = 0; ci < nch; ++ci) {
        __syncthreads();
        *(LAS u32x4*)(Ks + skey * AKP + spart * 16) = pk0; *(LAS u32x4*)(Ks + (skey + 64) * AKP + spart * 16) = pk1;
        *(LAS u32x4*)(Vs + skey * AKP + spart * 16) = pv0; *(LAS u32x4*)(Vs + (skey + 64) * AKP + spart * 16) = pv1;
        if (ci + 1 < nch) ATT_LOAD(ci + 1);
        __syncthreads();
        int row0, kind; ATT_CHUNK(ci, row0, kind); (void)row0;
        for (int t = 0; t < 4; ++t) {
            if (kind == 1 && 32 * t + 31 < 64 * qh) continue;
            if (kind == 2 && 32 * t > 64 * qh + 63) continue;
            bf16x8 kf[4], vf[2][2];
#pragma unroll
            for (int ks = 0; ks < 4; ++ks) kf[ks] = *(const LAS bf16x8*)(Ks + (32 * t + r) * AKP + 32 * ks + 16 * h);
#pragma unroll
            for (int s = 0; s < 2; ++s)
#pragma unroll
                for (int db = 0; db < 2; ++db) { const LAS unsigned char* vp = Vs + (32 * t + 16 * s + 4 * h + q4) * AKP + (32 * db + 16 * grp + 4 * p4) * 2;
                    const s16x4 lo = vtr(vp), hi = vtr(vp + 8 * AKP); vf[s][db] = __builtin_shufflevector(lo, hi, 0, 1, 2, 3, 4, 5, 6, 7); }
#pragma unroll
            for (int sub = 0; sub < 2; ++sub) {
                if (kind == 1 && 32 * t + 31 < 64 * qh + 32 * sub) continue;
                if (kind == 2 && 32 * t > 64 * qh + 32 * sub + 31) continue;
                f32x16 S;
#pragma unroll
                for (int i = 0; i < 16; ++i) S[i] = 0.f;
#pragma unroll
                for (int ks = 0; ks < 4; ++ks) S = __builtin_amdgcn_mfma_f32_32x32x16_bf16(kf[ks], qf[sub][ks], S, 0, 0, 0);
                if (kind != 0) { const int qq = 64 * qh + 32 * sub + r;
#pragma unroll
                    for (int i = 0; i < 16; ++i) { const int kk = 32 * t + (i & 3) + 8 * (i >> 2) + 4 * h; const bool ok = kind == 1 ? (kk >= qq) : (kk <= qq); S[i] = ok ? S[i] : -1.0e30f; } }
                float tmax = S[0];
#pragma unroll
                for (int i = 1; i < 16; ++i) tmax = fmaxf(tmax, S[i]);
                tmax = fmaxf(tmax, __shfl_xor(tmax, 32));
                const float mnew = fmaxf(m[sub], tmax);
                if (__any(mnew > m[sub])) { const float alpha = __builtin_amdgcn_exp2f(m[sub] - mnew); l[sub] *= alpha; m[sub] = mnew;
#pragma unroll
                    for (int db = 0; db < 2; ++db)
#pragma unroll
                        for (int i = 0; i < 16; ++i) O[sub][db][i] *= alpha; }
                float ps = 0.f;
#pragma unroll
                for (int i = 0; i < 16; ++i) { S[i] = __builtin_amdgcn_exp2f(S[i] - m[sub]); ps += S[i]; }
                l[sub] += ps;
                u32x4 w0, w1; w0.x = cvtpk(S[0], S[1]); w0.y = cvtpk(S[2], S[3]); w0.z = cvtpk(S[4], S[5]); w0.w = cvtpk(S[6], S[7]);
                w1.x = cvtpk(S[8], S[9]); w1.y = cvtpk(S[10], S[11]); w1.z = cvtpk(S[12], S[13]); w1.w = cvtpk(S[14], S[15]);
                const bf16x8 P0 = __builtin_bit_cast(bf16x8, w0), P1 = __builtin_bit_cast(bf16x8, w1);
#pragma unroll
                for (int db = 0; db < 2; ++db) { O[sub][db] = __builtin_amdgcn_mfma_f32_32x32x16_bf16(vf[0][db], P0, O[sub][db], 0, 0, 0); O[sub][db] = __builtin_amdgcn_mfma_f32_32x32x16_bf16(vf[1][db], P1, O[sub][db], 0, 0, 0); }
            }
        }
    }
#undef ATT_CHUNK
#undef ATT_LOAD
#pragma unroll
    for (int sub = 0; sub < 2; ++sub) { const float lt = l[sub] + __shfl_xor(l[sub], 32), inv = 1.f / lt;
        bf16* op = MIX + (size_t)(qrow0 + 64 * qh + 32 * sub + r) * MIXW + head * 64 + 4 * h;
#pragma unroll
        for (int db = 0; db < 2; ++db)
#pragma unroll
            for (int gq = 0; gq < 4; ++gq) { u32x2 w; w.x = cvtpk(O[sub][db][4 * gq] * inv, O[sub][db][4 * gq + 1] * inv); w.y = cvtpk(O[sub][db][4 * gq + 2] * inv, O[sub][db][4 * gq + 3] * inv);
                *(u32x2*)(op + 32 * db + 8 * gq) = w; } }
}
__device__ __forceinline__ void attn_mfma_phase(Frame& F, const float* sinkl, const bool with_ctx) {
    const bf16* Z = (const bf16*)(F.ws + WS_Z); bf16* MIX = (bf16*)(F.ws + WS_MIX);
    const int vcu = (F.G % 8 == 0) ? (F.bx % 8) * (F.G / 8) + F.bx / 8 : F.bx;
    for (int u = vcu; u < 256; u += F.G) attn_unit(F, Z, MIX, sinkl, false, u >> 6, (u >> 5) & 1, u & 31);
    if (with_ctx) for (int u = F.bx; u < 16; u += F.G) attn_unit(F, Z, MIX, sinkl, true, u >> 2, (u >> 1) & 1, u & 1);
    __syncthreads();
}

using pg8::Unit;
struct SchedStd {
    const char* A; const char* B; size_t astep, bstep; int nM, nN, G, c, nx, xpm0, xpn;
    __device__ __forceinline__ bool next(int i, Unit& u) const {
        const int L = i * G + c, nwg = nM * nN; if (L >= nwg + nx) return false;
        if (L < nwg) pg8::tile_of(L, nM, nN, u.pm, u.pn); else { u.pm = xpm0 + (L - nwg); u.pn = xpn; }
        u.tag = 0; u.a = A + (size_t)u.pm * astep; u.b = B + (size_t)u.pn * bstep; return true;
    }
};
struct SchedMoe {
    const char* A; const char* B; size_t astep, bstep_e, bstep_n; int NJ, G, c; const int* tile;
    __device__ __forceinline__ bool next(int i, Unit& u) const {
        const int nt = __builtin_amdgcn_readfirstlane(__hip_atomic_load(tile + 200, __ATOMIC_RELAXED, __HIP_MEMORY_SCOPE_AGENT));
        const int L = i * G + c; if (L >= nt * NJ) return false;
        u.pm = L % nt; u.pn = L / nt; u.tag = __builtin_amdgcn_readfirstlane(__hip_atomic_load(tile + u.pm, __ATOMIC_RELAXED, __HIP_MEMORY_SCOPE_AGENT));
        u.a = A + (size_t)u.pm * astep; u.b = B + (size_t)u.tag * bstep_e + (size_t)u.pn * bstep_n; return true;
    }
};

struct EpiIn {
    static constexpr bool PERM = true, MIDHOOK = false;
    bf16* Z; const float* rope;
    __device__ __forceinline__ void operator()(const f32x4 (&acc)[2][2][4][2], const Unit& u, int wr, int wc, int fr, int fq) const {
        const int row0 = u.pm * 256 + wr * 64 + fr, col0 = u.pn * 256 + wc * 32 + 8 * fq;
        const bool latent = u.pm < 64, gate = u.pn >= 11;
        const float sgn = fq < 2 ? -1.f : 1.f;
#pragma unroll
        for (int ai = 0; ai < 2; ++ai)
#pragma unroll
            for (int m = 0; m < 4; ++m) { const int row = row0 + ai * 128 + m * 16; bf16* rowp = Z + (size_t)row * INW + col0;
                const int pos = (wc & 1) ? (16 * m + fr) : (4 * (u.pm & 15) + 2 * ai + wr);
#pragma unroll
                for (int bj = 0; bj < 2; ++bj) { f32x4 v0 = acc[ai][bj][m][0], v1 = acc[ai][bj][m][1];
                    const bool isq = u.pn < 2, isk = (u.pn == 2 && bj == 0);
                    if (isq || isk) {
                        if (latent) {
                            const f32x4* cs = (const f32x4*)(rope + (size_t)(pos * 16 + 8 * (fq & 1)) * 2);
                            const f32x4 t0 = cs[0], t1 = cs[1], t2 = cs[2], t3 = cs[3];
                            f32x4 p0, p1;
                            p0.x = __shfl_xor(v0.x, 32); p0.y = __shfl_xor(v0.y, 32); p0.z = __shfl_xor(v0.z, 32); p0.w = __shfl_xor(v0.w, 32);
                            p1.x = __shfl_xor(v1.x, 32); p1.y = __shfl_xor(v1.y, 32); p1.z = __shfl_xor(v1.z, 32); p1.w = __shfl_xor(v1.w, 32);
                            v0.x = v0.x * t0.x + p0.x * (sgn * t0.y); v0.y = v0.y * t0.z + p0.y * (sgn * t0.w); v0.z = v0.z * t1.x + p0.z * (sgn * t1.y); v0.w = v0.w * t1.z + p0.w * (sgn * t1.w);
                            v1.x = v1.x * t2.x + p1.x * (sgn * t2.y); v1.y = v1.y * t2.z + p1.y * (sgn * t2.w); v1.z = v1.z * t3.x + p1.z * (sgn * t3.y); v1.w = v1.w * t3.z + p1.w * (sgn * t3.w);
                        }
                        if (isq) { v0 = v0 * QSCALE; v1 = v1 * QSCALE; }
                    }
                    if (gate) {
#pragma unroll
                        for (int q = 0; q < 4; ++q) { v0[q] = 1.f / (1.f + __expf(-v0[q])); v1[q] = 1.f / (1.f + __expf(-v1[q])); } }
                    u32x4 w; w.x = pg8::cvt_pk_bf16(v0[0], v0[1]); w.y = pg8::cvt_pk_bf16(v0[2], v0[3]); w.z = pg8::cvt_pk_bf16(v1[0], v1[1]); w.w = pg8::cvt_pk_bf16(v1[2], v1[3]);
                    *(u32x4*)(rowp + bj * 128) = w; } }
    }
};
struct EpiBrG {
    static constexpr bool PERM = true, MIDHOOK = true;
    const bf16* Z; bf16* Y;
    __device__ __forceinline__ void mid(f32x4 (&acc)[2][2][4][2], const Unit& u, int seg, int wr, int wc, int fr, int fq) const {
        const int row0 = u.pm * 256 + wr * 64 + fr, col0 = u.pn * 256 + wc * 32 + 8 * fq;
#pragma unroll
        for (int ai = 0; ai < 2; ++ai)
#pragma unroll
            for (int m = 0; m < 4; ++m) { const bf16* gp = Z + (size_t)(row0 + ai * 128 + m * 16) * INW + ZG + (seg - 1) * D + col0;
#pragma unroll
                for (int bj = 0; bj < 2; ++bj) { const u32x4 ga = *(const u32x4*)(gp + bj * 128), gb = *(const u32x4*)(gp + D + bj * 128);
                    f32x4 r0, r1;
                    r0.x = bflo(ga.x) * __builtin_amdgcn_rcpf(bflo(gb.x)); r0.y = bfhi(ga.x) * __builtin_amdgcn_rcpf(bfhi(gb.x)); r0.z = bflo(ga.y) * __builtin_amdgcn_rcpf(bflo(gb.y)); r0.w = bfhi(ga.y) * __builtin_amdgcn_rcpf(bfhi(gb.y));
                    r1.x = bflo(ga.z) * __builtin_amdgcn_rcpf(bflo(gb.z)); r1.y = bfhi(ga.z) * __builtin_amdgcn_rcpf(bfhi(gb.z)); r1.z = bflo(ga.w) * __builtin_amdgcn_rcpf(bflo(gb.w)); r1.w = bfhi(ga.w) * __builtin_amdgcn_rcpf(bfhi(gb.w));
                    acc[ai][bj][m][0] *= r0; acc[ai][bj][m][1] *= r1; } }
    }
    __device__ __forceinline__ void operator()(const f32x4 (&acc)[2][2][4][2], const Unit& u, int wr, int wc, int fr, int fq) const {
        const int row0 = u.pm * 256 + wr * 64 + fr, col0 = u.pn * 256 + wc * 32 + 8 * fq;
#pragma unroll
        for (int ai = 0; ai < 2; ++ai)
#pragma unroll
            for (int m = 0; m < 4; ++m) { const size_t row = (size_t)(row0 + ai * 128 + m * 16); const bf16* gp = Z + row * INW + ZG + 2 * D + col0;
#pragma unroll
                for (int bj = 0; bj < 2; ++bj) { const u32x4 g = *(const u32x4*)(gp + bj * 128); const f32x4 v0 = acc[ai][bj][m][0], v1 = acc[ai][bj][m][1];
                    u32x4 w; w.x = pg8::cvt_pk_bf16(v0[0] * bflo(g.x), v0[1] * bfhi(g.x)); w.y = pg8::cvt_pk_bf16(v0[2] * bflo(g.y), v0[3] * bfhi(g.y));
                    w.z = pg8::cvt_pk_bf16(v1[0] * bflo(g.z), v1[1] * bfhi(g.z)); w.w = pg8::cvt_pk_bf16(v1[2] * bflo(g.w), v1[3] * bfhi(g.w));
                    *(u32x4*)(Y + row * D + col0 + bj * 128) = w; } }
    }
};
struct EpiRes {
    static constexpr bool PERM = false, MIDHOOK = false;
    const float* rl; const float* rc; float* out; const float* gv;
    __device__ __forceinline__ void operator()(const f32x4 (&acc)[2][2][4][2], const Unit& u, int wr, int wc, int fr, int fq) const {
        const int row0 = u.pm * 256 + wr * 64 + fr, col0 = u.pn * 256 + wc * 32 + 4 * fq;
        const int bidx = u.pm < 64 ? (u.pm >> 4) : 4; const float* g = gv + (size_t)bidx * MODW;
        const float* rbase = u.pm < 64 ? rl : rc - (size_t)ML * D;
        f32x4 gg[2][2];
#pragma unroll
        for (int bj = 0; bj < 2; ++bj)
#pragma unroll
            for (int n = 0; n < 2; ++n) gg[bj][n] = *(const f32x4*)(g + col0 + bj * 128 + n * 16);
#pragma unroll
        for (int ai = 0; ai < 2; ++ai)
#pragma unroll
            for (int m = 0; m < 4; ++m) { const size_t off = (size_t)(row0 + ai * 128 + m * 16) * D + col0;
#pragma unroll
                for (int bj = 0; bj < 2; ++bj)
#pragma unroll
                    for (int n = 0; n < 2; ++n) *(f32x4*)(out + off + bj * 128 + n * 16) = *(const f32x4*)(rbase + off + bj * 128 + n * 16) + gg[bj][n] * acc[ai][bj][m][n]; }
    }
};
struct EpiSwiglu {
    static constexpr bool PERM = true, MIDHOOK = false;
    bf16* ACT; int ldc;
    __device__ __forceinline__ void operator()(const f32x4 (&acc)[2][2][4][2], const Unit& u, int wr, int wc, int fr, int fq) const {
        const int row0 = u.pm * 256 + wr * 64 + fr, col0 = u.pn * 128 + wc * 32 + 8 * fq;
#pragma unroll
        for (int ai = 0; ai < 2; ++ai)
#pragma unroll
            for (int m = 0; m < 4; ++m) { f32x4 r[2];
#pragma unroll
                for (int n = 0; n < 2; ++n) { const f32x4 g = acc[ai][0][m][n], up = acc[ai][1][m][n];
#pragma unroll
                    for (int q = 0; q < 4; ++q) r[n][q] = g[q] / (1.f + __expf(-g[q])) * up[q]; }
                u32x4 w; w.x = pg8::cvt_pk_bf16(r[0][0], r[0][1]); w.y = pg8::cvt_pk_bf16(r[0][2], r[0][3]); w.z = pg8::cvt_pk_bf16(r[1][0], r[1][1]); w.w = pg8::cvt_pk_bf16(r[1][2], r[1][3]);
                *(u32x4*)(ACT + (size_t)(row0 + ai * 128 + m * 16) * ldc + col0) = w; }
    }
};
struct EpiPlain {
    static constexpr bool PERM = true, MIDHOOK = false;
    bf16* O; int ldc;
    __device__ __forceinline__ void operator()(const f32x4 (&acc)[2][2][4][2], const Unit& u, int wr, int wc, int fr, int fq) const {
        const int row0 = u.pm * 256 + wr * 64 + fr, col0 = u.pn * 256 + wc * 32 + 8 * fq;
#pragma unroll
        for (int ai = 0; ai < 2; ++ai)
#pragma unroll
            for (int m = 0; m < 4; ++m)
#pragma unroll
                for (int bj = 0; bj < 2; ++bj) { const f32x4 v0 = acc[ai][bj][m][0], v1 = acc[ai][bj][m][1];
                    u32x4 w; w.x = pg8::cvt_pk_bf16(v0[0], v0[1]); w.y = pg8::cvt_pk_bf16(v0[2], v0[3]); w.z = pg8::cvt_pk_bf16(v1[0], v1[1]); w.w = pg8::cvt_pk_bf16(v1[2], v1[3]);
                    *(u32x4*)(O + (size_t)(row0 + ai * 128 + m * 16) * ldc + col0 + bj * 128) = w; }
    }
};

#define IN(k) (lo <= (k) && (k) < hi)
#define SEAM(k) do { if (IN(k) && IN((k) + 1)) xcd_barrier(bar); } while (0)
#ifndef DUP_MASK
#define DUP_MASK 0u
#endif
#define REP(k) for (int rep_ = 0; rep_ < (((DUP_MASK >> (k)) & 1u) ? 2 : 1); ++rep_, (((DUP_MASK >> (k)) & 1u) && rep_ == 1 ? xcd_barrier(bar) : (void)0))
#define SITE() do { F.ws = (unsigned char*)karg_p<(int)__builtin_offsetof(Args, ws)>(); int t_ = threadIdx.x; asm volatile("" : "+v"(t_)); F.tid = t_; F.lane = t_ & 63; } while (0)
template <int l> __device__ __forceinline__ void layer_common(Frame& F, const int lo, const int hi, const XcdBarrier& bar, LAS unsigned char* ring) {
    constexpr int pb = 1 + 8 * l;
        if (IN(pb + 0)) REP(pb + 0) { SITE(); const float* modl = (const float*)(F.ws + WS_MODV) + (size_t)l * 5 * MODW; const float* X2 = (const float*)(F.ws + WS_X2);
            const float* xl = l == 0 ? KP(x) : X2; const float* xc = l == 0 ? KP(ctx) : X2 + (size_t)ML * D;
            norm_mod_phase<false>(F, xl, xc, KP(norm1_g) + l * D, modl, 0, 1, MT, nullptr); } SEAM(pb + 0);
        if (IN(pb + 1)) REP(pb + 1) { SITE();
            SchedStd S{(const char*)(F.ws + WS_H), (const char*)(F.ws + WS_WIN) + (size_t)l * INW * D * 2, (size_t)256 * D * 2, (size_t)256 * D * 2, l == 0 ? 68 : 64, 23, F.G, F.bx, l == 0 ? 0 : 4, 64, 2};
            EpiIn E{(bf16*)(F.ws + WS_Z), (const float*)(F.ws + WS_ROPE)};
            pg8::gemm_phase<EpiIn, SchedStd, true, true>(ring, D, D, D, S, E);
        } SEAM(pb + 1);
        if (IN(pb + 2)) REP(pb + 2) { SITE(); const int nrows = l == 0 ? MT : ML; if (ATTN_NAIVE) attn_naive_phase(F, KP(sink) + l * 8, nrows); else attn_mfma_phase(F, KP(sink) + l * 8, l == 0); local_mix_phase(F, KP(conv_w) + (size_t)l * 3 * 512, nrows); } SEAM(pb + 2);
        if (IN(pb + 3)) REP(pb + 3) { SITE();
            SchedStd S{(const char*)(F.ws + WS_MIX), (const char*)(F.ws + WS_WBR) + (size_t)l * D * MIXW * 2, (size_t)256 * MIXW * 2, (size_t)256 * MIXW * 2, l == 0 ? 68 : 64, 4, F.G, F.bx, 0, 0, 0};
            EpiBrG E{(const bf16*)(F.ws + WS_Z), (bf16*)(F.ws + WS_Y)};
            pg8::gemm_phase<EpiBrG, SchedStd, true, true>(ring, MIXW, MIXW, MIXW, S, E);
        } SEAM(pb + 3);
        if (IN(pb + 4)) REP(pb + 4) { SITE(); const float* modl = (const float*)(F.ws + WS_MODV) + (size_t)l * 5 * MODW; const float* X2 = (const float*)(F.ws + WS_X2);
            const float* xl = l == 0 ? KP(x) : X2; const float* xc = l == 0 ? KP(ctx) : X2 + (size_t)ML * D;
            SchedStd S{(const char*)(F.ws + WS_Y), (const char*)(F.ws + WS_WOUT) + (size_t)l * D * D * 2, (size_t)256 * D * 2, (size_t)256 * D * 2, l == 0 ? 68 : 64, 4, F.G, F.bx, 0, 0, 0};
            EpiRes E{xl, xc, (float*)(F.ws + WS_X1), modl + 2 * D};
            pg8::gemm_phase<EpiRes, SchedStd, true, true>(ring, D, D, D, S, E);
        } SEAM(pb + 4);
}
constexpr int N_PHASES = 19;
__global__ void __launch_bounds__(NTHR, 2) mk_fwd(Args args_byval) {
    extern __shared__ __attribute__((aligned(16))) unsigned char lds_raw[];
    Frame F;
    F.lds = (LAS unsigned char*)lds_raw;
    F.tid = threadIdx.x; F.lane = F.tid & 63; F.wave = __builtin_amdgcn_readfirstlane(F.tid >> 6);
    F.G = gridDim.x; F.bx = blockIdx.x;
    SITE();
    volatile LAS unsigned* MISC = (volatile LAS unsigned*)(F.lds + MISC_OFF);
    for (int u = F.tid; u < (LDS_BYTES - LDSCTL_OFF) / 4; u += NTHR) ((LAS unsigned*)(F.lds + LDSCTL_OFF))[u] = 0u;
    __syncthreads();
    const int lo = karg_i<(int)__builtin_offsetof(Args, ph_lo)>(), hi = karg_i<(int)__builtin_offsetof(Args, ph_hi)>();
    const bool fused = (hi - lo) > 1;
    XcdBarrier bar; bar.bar = (unsigned*)(F.ws + WS_CTL) + CW_BAR; bar.x = 0; bar.st = nullptr;
    if (fused) bar = xcd_barrier_post((unsigned*)(F.ws + WS_CTL) + CW_BAR, MISC + 8);
    LAS unsigned char* ring = F.lds;

    if (IN(0)) REP(0) { SITE(); p0_prologue(F); } SEAM(0);

    layer_common<0>(F, lo, hi, bar, ring);
    {
            if (IN(6)) REP(6) { SITE(); const float* X1 = (const float*)(F.ws + WS_X1); norm_mod_phase<false>(F, X1, X1 + (size_t)ML * D, KP(norm2_g), (const float*)(F.ws + WS_MODV), 3, 4, MT, nullptr); } SEAM(6);
            if (IN(7)) REP(7) { SITE();
                SchedStd S{(const char*)(F.ws + WS_H), (const char*)(F.ws + WS_WGU0), (size_t)256 * D * 2, (size_t)256 * D * 2, 68, 22, F.G, F.bx, 0, 0, 0};
                EpiSwiglu E{(bf16*)(F.ws + WS_ACT), DFF};
                pg8::gemm_phase<EpiSwiglu, SchedStd, true, true>(ring, D, D, D, S, E);
            } SEAM(7);
            if (IN(8)) REP(8) { SITE(); const float* X1 = (const float*)(F.ws + WS_X1);
                SchedStd S{(const char*)(F.ws + WS_ACT), (const char*)(F.ws + WS_WDN0), (size_t)256 * DFF * 2, (size_t)256 * DFF * 2, 68, 4, F.G, F.bx, 0, 0, 0};
                EpiRes E{X1, X1 + (size_t)ML * D, (float*)(F.ws + WS_X2), (const float*)(F.ws + WS_MODV) + 5 * D};
                pg8::gemm_phase<EpiRes, SchedStd, true, true>(ring, DFF, DFF, DFF, S, E);
            } SEAM(8);
    }
    layer_common<1>(F, lo, hi, bar, ring);
    {
            if (IN(14)) REP(14) { SITE(); const float* X1 = (const float*)(F.ws + WS_X1); norm_mod_phase<true>(F, X1, X1, KP(norm2_g) + D, (const float*)(F.ws + WS_MODV) + (size_t)5 * MODW, 3, 4, ML, KP(router_w)); } SEAM(14);
            if (IN(15)) REP(15) { SITE(); moe_scatter_phase(F); } SEAM(15);
            if (IN(16)) REP(16) { SITE();
                SchedMoe S{(const char*)(F.ws + WS_H2S), (const char*)(F.ws + WS_WMGU), (size_t)256 * D * 2, (size_t)2 * DFE * D * 2, (size_t)256 * D * 2, 28, F.G, F.bx, (const int*)(F.ws + WS_TILE)};
                EpiSwiglu E{(bf16*)(F.ws + WS_ACT), DFE};
                pg8::gemm_phase<EpiSwiglu, SchedMoe, true, true>(ring, D, D, D, S, E);
            } SEAM(16);
            if (IN(17)) REP(17) { SITE();
                SchedMoe S{(const char*)(F.ws + WS_ACT), (const char*)(F.ws + WS_WMDN), (size_t)256 * DFE * 2, (size_t)D * DFE * 2, (size_t)256 * DFE * 2, 4, F.G, F.bx, (const int*)(F.ws + WS_TILE)};
                EpiPlain E{(bf16*)(F.ws + WS_YS), D};
                pg8::gemm_phase<EpiPlain, SchedMoe, true, true>(ring, DFE, DFE, DFE, S, E);
            } SEAM(17);
            if (IN(18)) REP(18) { SITE(); final_phase(F, KP(final_g), (float*)karg_p<(int)__builtin_offsetof(Args, out)>(), (const float*)(F.ws + WS_MODV) + (size_t)5 * MODW); }
        }

#undef IN
#undef SEAM
}

extern "C" void kernel_launch(void* const* d_in, const int* in_sizes, int n_in, void* d_out, int out_size, void* d_ws, size_t ws_size, hipStream_t stream) {
    static int grid = 0;
    if (grid == 0) {
        if (n_in != 21 || out_size != ML * D || ws_size < WS_END) { fprintf(stderr, "kernel_launch: unexpected sizes (n_in %d, out %d, ws %zu < %zu)\n", n_in, out_size, ws_size, (size_t)WS_END); grid = -1; return; }
        int dev = 0, cus = 0, per_cu = 0;
        if (hipGetDevice(&dev) != hipSuccess || hipDeviceGetAttribute(&cus, hipDeviceAttributeMultiprocessorCount, dev) != hipSuccess) { grid = -1; return; }
        if (hipFuncSetAttribute((const void*)mk_fwd, hipFuncAttributeMaxDynamicSharedMemorySize, LDS_BYTES) != hipSuccess) { fprintf(stderr, "kernel_launch: hipFuncSetAttribute failed\n"); grid = -1; return; }
        if (hipOccupancyMaxActiveBlocksPerMultiprocessor(&per_cu, (const void*)mk_fwd, NTHR, LDS_BYTES) != hipSuccess || per_cu < 1) { fprintf(stderr, "kernel_launch: occupancy query says %d\n", per_cu); per_cu = 1; }
        (void)hipGetLastError();
        grid = cus;
    }
    if (grid < 0) return;
    (void)hipMemsetAsync((char*)d_ws + WS_CTL, 0, CTL_ZERO_BYTES, stream);
    Args a{};
    const float** pp = (const float**)&a;
    for (int i = 0; i < 21; ++i) pp[i] = (const float*)d_in[i];
    a.out = (float*)d_out; a.ws = (unsigned char*)d_ws;
#if MK_FUSED
    a.ph_lo = 0; a.ph_hi = N_PHASES;
    hipLaunchKernelGGL(mk_fwd, dim3(grid), dim3(NTHR), LDS_BYTES, stream, a);
#else
    for (int p = 0; p < N_PHASES; ++p) { a.ph_lo = p; a.ph_hi = p + 1; hipLaunchKernelGGL(mk_fwd, dim3(grid), dim3(NTHR), LDS_BYTES, stream, a); }
#endif
}
```

```cpp
#include <hip/hip_runtime.h>
#include <cstdio>
#include <cstdint>

#ifndef ATTN_NAIVE
#define ATTN_NAIVE 0
#endif
#ifndef FFN0_FP8
#define FFN0_FP8 0
#endif
#ifndef MK_FUSED
#define MK_FUSED 1
#endif

#define LAS __attribute__((address_space(3)))
#define GAS __attribute__((address_space(1)))
typedef unsigned short bf16;
typedef short bf16x8 __attribute__((ext_vector_type(8)));
typedef float f32x4 __attribute__((ext_vector_type(4)));
typedef float f32x2 __attribute__((ext_vector_type(2)));
typedef unsigned u32x4 __attribute__((ext_vector_type(4)));
typedef unsigned u32x2 __attribute__((ext_vector_type(2)));
typedef GAS unsigned gu32;

constexpr int D = 1024, NB = 4, SEQ = 4096, ML = NB * SEQ, CTXL = 256, MC = NB * CTXL, MT = ML + MC;
constexpr int INW = 5888, DFF = 2816, DFE = 3584, NE = 8;
constexpr int ZQ = 0, ZK = 512, ZV = 640, ZCX = 768, ZCB = 1280, ZCC = 1792, ZPU = 2304, ZG = 2816;
constexpr int MIXW = 1536;
constexpr int MS = 2 * ML + NE * 256;
constexpr int MODW = 6 * D;
constexpr float EPS = 1e-6f;
constexpr float LOG2E = 1.4426950408889634f, QSCALE = 0.125f * LOG2E;
constexpr int NWAVES = 8, NTHR = 512;

__device__ __forceinline__ unsigned f2bf(float f) { unsigned u = __builtin_bit_cast(unsigned, f); return (u + 0x7fffu + ((u >> 16) & 1u)) >> 16; }
__device__ __forceinline__ unsigned pk2(float lo, float hi) { return f2bf(lo) | (f2bf(hi) << 16); }
__device__ __forceinline__ float bf2f(unsigned b) { return __builtin_bit_cast(float, b << 16); }
__device__ __forceinline__ unsigned pk4_fp8(float a, float b, float c, float d) { int w = 0; w = __builtin_amdgcn_cvt_pk_fp8_f32(a, b, w, false); w = __builtin_amdgcn_cvt_pk_fp8_f32(c, d, w, true); return (unsigned)w; }
constexpr float W8SCALE = 256.0f;
__device__ __forceinline__ float bflo(unsigned w) { return __builtin_bit_cast(float, w << 16); }
__device__ __forceinline__ float bfhi(unsigned w) { return __builtin_bit_cast(float, w & 0xffff0000u); }

namespace pg8 {
constexpr int BM = 256, BK = 64, HALF = 128, HTB = HALF * BK * 2, STAGE_BYTES = 8 * HTB, NXCD = 8, WGM = 8;
__host__ __device__ __forceinline__ int lds_byte(int r, int c) { const int st = (r >> 4) * 2 + (c >> 5), rr = r & 15, cc = c & 31, ob = rr * 64 + cc * 2; return st * 1024 + (ob ^ (((ob >> 9) & 1) << 5)); }
__host__ __device__ __forceinline__ void stage_rc(int b, int& R, int& C) { const int st = b / 1024, sb = b % 1024, swz = sb ^ (((sb >> 9) & 1) << 5); R = (st >> 1) * 16 + swz / 64; C = (st & 1) * 32 + (swz % 64) / 2; }
__host__ __device__ __forceinline__ int perm32(int rho) { const int n = rho >> 4, i = rho & 15; return 8 * (i >> 2) + 4 * n + (i & 3); }

struct Unit { int pm, pn, tag; const char* a; const char* b; };

__device__ __forceinline__ void tile_of(int L, int nM, int nN, int& pm, int& pn) {
    const int nwg = nM * nN; int wgid = L;
    { const int q = nwg / NXCD, r = nwg % NXCD, xcd = wgid % NXCD, off = wgid / NXCD; wgid = (xcd < r ? xcd * (q + 1) : r * (q + 1) + (xcd - r) * q) + off; }
    const int nig = WGM * nN, gid = wgid / nig, fm = gid * WGM, gsz = (nM - fm) < WGM ? (nM - fm) : WGM;
    pm = fm + ((wgid % nig) % gsz); pn = (wgid % nig) / gsz;
}

__device__ __forceinline__ unsigned cvt_pk_bf16(float lo, float hi) { unsigned r; asm volatile("v_cvt_pk_bf16_f32 %0, %1, %2" : "=v"(r) : "v"(lo), "v"(hi)); return r; }

typedef int i32x8 __attribute__((ext_vector_type(8)));
typedef int i32x4 __attribute__((ext_vector_type(4)));
template <class Epi, class Sched, bool ALIGN_EPI = false, bool SP2 = false, bool FP8 = false>
__device__ __forceinline__ void gemm_phase(LAS unsigned char* lds, const int lda, const int ldb, const int K, const Sched& S, const Epi& E) {
    int tid_ = threadIdx.x; asm volatile("" : "+v"(tid_));
    const int tid = tid_, wid = __builtin_amdgcn_readfirstlane(tid >> 6), lane = tid & 63, wr = wid >> 2, wc = wid & 3, fr = lane & 15, fq = lane >> 4;
    const int nt = K / 128;
    unsigned voffA[2], voffB[2];
#pragma unroll
    for (int i = 0; i < 2; ++i) { int R, C; stage_rc(tid * 16 + i * 8192, R, C); const int Rb = Epi::PERM ? ((R & ~31) + perm32(R & 31)) : R;
        voffA[i] = (unsigned)(R * lda + C * 2); voffB[i] = (unsigned)(Rb * ldb + C * 2); }
    const size_t kstep = (size_t)(BK * 2);
    const size_t hstepA = (size_t)HALF * lda, hstepB = (size_t)HALF * ldb;
    const unsigned ldsw = (unsigned)wid * 1024u;
    const int aoff = lds_byte(wr * 64 + fr, fq * 8), boff = lds_byte(wc * 32 + fr, fq * 8);
#define PG8_SA(b, h) (((b) * 2 + (h)) * HTB)
#define PG8_SB(b, h) ((4 + (b) * 2 + (h)) * HTB)
#define PG8_STAGE(bufoff, gbase, voff) do { _Pragma("unroll") for (int _i = 0; _i < 2; ++_i) \
        __builtin_amdgcn_global_load_lds((const unsigned*)((const char*)(gbase) + (voff)[_i]), (LAS unsigned*)(lds + (bufoff) + ldsw + _i * 8192), 16, 0, 0); } while (0)
#define PG8_RD(off) __builtin_bit_cast(i32x4, *(const LAS bf16x8*)(lds + (off)))
#define PG8_LDA(dst, b, h) do { _Pragma("unroll") for (int m = 0; m < 4; ++m) dst[m] = __builtin_shufflevector(PG8_RD(PG8_SA(b, h) + aoff + m * 2048), PG8_RD(PG8_SA(b, h) + aoff + m * 2048 + 1024), 0, 1, 2, 3, 4, 5, 6, 7); } while (0)
#define PG8_LDB(dst, b, h) do { _Pragma("unroll") for (int n = 0; n < 2; ++n) dst[n] = __builtin_shufflevector(PG8_RD(PG8_SB(b, h) + boff + n * 2048), PG8_RD(PG8_SB(b, h) + boff + n * 2048 + 1024), 0, 1, 2, 3, 4, 5, 6, 7); } while (0)
#define PG8_LO(x) __builtin_bit_cast(bf16x8, __builtin_shufflevector((x), (x), 0, 1, 2, 3))
#define PG8_HI(x) __builtin_bit_cast(bf16x8, __builtin_shufflevector((x), (x), 4, 5, 6, 7))
#define PG8_MMA(ai, bj, At, Bt) do { __builtin_amdgcn_s_setprio(1); _Pragma("unroll") for (int m = 0; m < 4; ++m) _Pragma("unroll") for (int n = 0; n < 2; ++n) { \
        if constexpr (FP8) asm volatile("s_nop 1\n\tv_mfma_scale_f32_16x16x128_f8f6f4 %0, %1, %2, %0, %3, %4 op_sel_hi:[0,0,0]" : "+v"(acc[ai][bj][m][n]) : "v"(Bt[n]), "v"(At[m]), "v"(sc_w), "v"(sc_a)); \
        else { acc[ai][bj][m][n] = __builtin_amdgcn_mfma_f32_16x16x32_bf16(PG8_LO(Bt[n]), PG8_LO(At[m]), acc[ai][bj][m][n], 0, 0, 0); \
               acc[ai][bj][m][n] = __builtin_amdgcn_mfma_f32_16x16x32_bf16(PG8_HI(Bt[n]), PG8_HI(At[m]), acc[ai][bj][m][n], 0, 0, 0); } } __builtin_amdgcn_s_setprio(0); } while (0)
#define PG8_WAIT_V(n) asm volatile("s_waitcnt vmcnt(" #n ")" ::: "memory")
#define PG8_WAIT_L(n) asm volatile("s_waitcnt lgkmcnt(" #n ")" ::: "memory")
#define PG8_BAR __builtin_amdgcn_s_barrier()
#define PG8_SCHED __builtin_amdgcn_sched_barrier(0)
    Unit cur, nxt; int ui = 0;
    if (!S.next(0, cur)) return;
    f32x4 acc[2][2][4][2];
#pragma unroll
    for (int a = 0; a < 2; ++a)
#pragma unroll
        for (int b = 0; b < 2; ++b)
#pragma unroll
            for (int m = 0; m < 4; ++m)
#pragma unroll
                for (int n = 0; n < 2; ++n) acc[a][b][m][n] = (f32x4){0.f, 0.f, 0.f, 0.f};
    i32x8 At[4], B0[2], B1[2];
    const int sc_w = 0x77777777, sc_a = 0x7f7f7f7f;
    const char* cA = cur.a; const char* cB = cur.b;
    if constexpr (SP2) {
        PG8_STAGE(PG8_SB(0, 0), cB, voffB); PG8_STAGE(PG8_SB(0, 1), cB + hstepB, voffB); PG8_STAGE(PG8_SA(0, 0), cA, voffA); PG8_STAGE(PG8_SA(0, 1), cA + hstepA, voffA);
        if (wr == 1) PG8_BAR;
        PG8_WAIT_V(2); PG8_BAR;
        PG8_STAGE(PG8_SB(1, 0), cB + kstep, voffB); PG8_STAGE(PG8_SA(1, 0), cA + kstep, voffA); PG8_STAGE(PG8_SB(1, 1), cB + hstepB + kstep, voffB);
        PG8_WAIT_V(6); PG8_BAR;
    } else {
        PG8_STAGE(PG8_SB(0, 0), cB, voffB); PG8_STAGE(PG8_SA(0, 0), cA, voffA); PG8_STAGE(PG8_SB(0, 1), cB + hstepB, voffB); PG8_STAGE(PG8_SA(0, 1), cA + hstepA, voffA);
        if (wr == 1) PG8_BAR;
        PG8_WAIT_V(4); PG8_BAR;
        PG8_STAGE(PG8_SB(1, 0), cB + kstep, voffB); PG8_STAGE(PG8_SA(1, 0), cA + kstep, voffA); PG8_STAGE(PG8_SB(1, 1), cB + hstepB + kstep, voffB);
        PG8_WAIT_V(6); PG8_BAR;
    }
    for (;;) {
        const bool has_next = S.next(ui + 1, nxt);
        const char* nA = has_next ? nxt.a : cA; const char* nB = has_next ? nxt.b : cB;
        for (int t = 0; t < nt; t += 2) {
            const bool last = (t == nt - 2);
            const char* a1 = cA + (size_t)(t + 1) * kstep;
            const char* a2 = last ? nA : cA + (size_t)(t + 2) * kstep; const char* b2 = last ? nB : cB + (size_t)(t + 2) * kstep;
            const char* a3 = a2 + kstep; const char* b3 = b2 + kstep;
            if constexpr (SP2) {
            PG8_LDB(B0, 0, 0); PG8_LDB(B1, 0, 1); PG8_SCHED; PG8_LDA(At, 0, 0); PG8_STAGE(PG8_SA(1, 1), a1 + hstepA, voffA);
            PG8_WAIT_V(8); PG8_WAIT_L(0); PG8_BAR; PG8_MMA(0, 0, At, B0); PG8_MMA(0, 1, At, B1); PG8_BAR; PG8_SCHED;
            PG8_LDA(At, 0, 1); PG8_STAGE(PG8_SB(0, 0), b2, voffB); PG8_STAGE(PG8_SB(0, 1), b2 + hstepB, voffB); PG8_STAGE(PG8_SA(0, 0), a2, voffA);
            PG8_WAIT_V(8); PG8_WAIT_L(0); PG8_BAR; PG8_MMA(1, 0, At, B0); PG8_MMA(1, 1, At, B1); PG8_BAR; PG8_SCHED;
            PG8_LDB(B0, 1, 0); PG8_LDB(B1, 1, 1); PG8_SCHED; PG8_LDA(At, 1, 0); PG8_STAGE(PG8_SA(0, 1), a2 + hstepA, voffA);
            PG8_WAIT_V(8); PG8_WAIT_L(0); PG8_BAR; PG8_MMA(0, 0, At, B0); PG8_MMA(0, 1, At, B1); PG8_BAR; PG8_SCHED;
            PG8_LDA(At, 1, 1); PG8_STAGE(PG8_SB(1, 0), b3, voffB); PG8_STAGE(PG8_SB(1, 1), b3 + hstepB, voffB); PG8_STAGE(PG8_SA(1, 0), a3, voffA);
            PG8_WAIT_V(8); PG8_WAIT_L(0); PG8_BAR; PG8_MMA(1, 0, At, B0); PG8_MMA(1, 1, At, B1); PG8_BAR; PG8_SCHED;
            } else {
            PG8_LDB(B0, 0, 0); PG8_SCHED; PG8_LDA(At, 0, 0); PG8_STAGE(PG8_SA(1, 1), a1 + hstepA, voffA);
            PG8_WAIT_L(8); PG8_BAR; PG8_WAIT_L(0); PG8_MMA(0, 0, At, B0); PG8_BAR; PG8_SCHED;
            PG8_LDB(B1, 0, 1); PG8_STAGE(PG8_SB(0, 0), b2, voffB);
            PG8_BAR; PG8_WAIT_L(0); PG8_MMA(0, 1, At, B1); PG8_BAR;
            PG8_LDA(At, 0, 1); PG8_STAGE(PG8_SA(0, 0), a2, voffA);
            PG8_BAR; PG8_WAIT_L(0); PG8_MMA(1, 0, At, B0); PG8_BAR; PG8_SCHED;
            PG8_STAGE(PG8_SB(0, 1), b2 + hstepB, voffB);
            PG8_WAIT_V(6); PG8_BAR; PG8_MMA(1, 1, At, B1); PG8_BAR;
            PG8_LDB(B0, 1, 0); PG8_SCHED; PG8_LDA(At, 1, 0); PG8_STAGE(PG8_SA(0, 1), a2 + hstepA, voffA);
            PG8_WAIT_L(8); PG8_BAR; PG8_WAIT_L(0); PG8_MMA(0, 0, At, B0); PG8_BAR; PG8_SCHED;
            PG8_LDB(B1, 1, 1); PG8_STAGE(PG8_SB(1, 0), b3, voffB);
            PG8_BAR; PG8_WAIT_L(0); PG8_MMA(0, 1, At, B1); PG8_BAR;
            PG8_LDA(At, 1, 1); PG8_STAGE(PG8_SA(1, 0), a3, voffA);
            PG8_BAR; PG8_WAIT_L(0); PG8_MMA(1, 0, At, B0); PG8_BAR; PG8_SCHED;
            PG8_STAGE(PG8_SB(1, 1), b3 + hstepB, voffB);
            PG8_WAIT_V(6); PG8_BAR; PG8_MMA(1, 1, At, B1); PG8_BAR;
            }
            if constexpr (Epi::MIDHOOK) { if (((t + 2) & 7) == 0 && !last) { int fr_ = fr, fq_ = fq; asm volatile("" : "+v"(fr_), "+v"(fq_)); E.mid(acc, cur, (t + 2) >> 3, wr, wc, fr_, fq_); } }
        }
        if constexpr (ALIGN_EPI) { if (wr == 0) PG8_BAR; }
        if constexpr (FP8) asm volatile("s_nop 15\n\ts_nop 15" ::: "memory");
        { int fr_ = fr, fq_ = fq; asm volatile("" : "+v"(fr_), "+v"(fq_));
          E(acc, cur, wr, wc, fr_, fq_); }
        if (!has_next) break;
#pragma unroll
        for (int a = 0; a < 2; ++a)
#pragma unroll
            for (int b = 0; b < 2; ++b)
#pragma unroll
                for (int m = 0; m < 4; ++m)
#pragma unroll
                    for (int n = 0; n < 2; ++n) acc[a][b][m][n] = (f32x4){0.f, 0.f, 0.f, 0.f};
        cur = nxt; cA = nA; cB = nB; ++ui;
        if constexpr (ALIGN_EPI) { if (wr == 1) PG8_BAR; }
    }
    PG8_WAIT_V(0);
    if constexpr (!ALIGN_EPI) { if (wr == 0) PG8_BAR; }
    PG8_BAR;
#undef PG8_SA
#undef PG8_SB
#undef PG8_STAGE
#undef PG8_LDA
#undef PG8_LDB
#undef PG8_MMA
#undef PG8_RD
#undef PG8_LO
#undef PG8_HI
#undef PG8_WAIT_V
#undef PG8_WAIT_L
#undef PG8_BAR
#undef PG8_SCHED
}
}

constexpr size_t MiB = 1u << 20;
constexpr size_t al256(size_t x) { return (x + 255) & ~(size_t)255; }
constexpr size_t WS_CTL = 0, CTL_ZERO_BYTES = 1 * MiB;
constexpr size_t WS_MODV = 1 * MiB;
constexpr size_t WS_ROPE = WS_MODV + al256((size_t)2 * 5 * MODW * 4);
constexpr size_t WS_CNTWG = WS_ROPE + al256(64 * 16 * 2 * 4);
constexpr size_t WS_TOKE = WS_CNTWG + al256(256 * 8 * 4);
constexpr size_t WS_TOKP = WS_TOKE + al256((size_t)ML * 2 * 4);
constexpr size_t WS_TOKW = WS_TOKP + al256((size_t)ML * 2 * 4);
constexpr size_t WS_TOKS = WS_TOKW + al256((size_t)ML * 2 * 4);
constexpr size_t WS_TILE = WS_TOKS + al256((size_t)ML * 2 * 4);
constexpr size_t WS_WIN = 4 * MiB;
constexpr size_t WS_WBR = WS_WIN + (size_t)2 * INW * D * 2;
constexpr size_t WS_WOUT = WS_WBR + (size_t)2 * 3 * D * 512 * 2;
constexpr size_t WS_WGU0 = WS_WOUT + (size_t)2 * D * D * 2;
constexpr size_t WS_WDN0 = WS_WGU0 + (size_t)2 * DFF * D * 2;
constexpr size_t WS_WMGU = WS_WDN0 + (size_t)D * DFF * 2;
constexpr size_t WS_WMDN = WS_WMGU + (size_t)NE * 2 * DFE * D * 2;
constexpr size_t WS_H = WS_WMDN + (size_t)NE * D * DFE * 2;
constexpr size_t WS_Z = WS_H + (size_t)MT * D * 2;
constexpr size_t WS_MIX = WS_Z + (size_t)MT * INW * 2;
constexpr size_t WS_ACT = WS_Z;
constexpr size_t WS_YACC = WS_MIX + (size_t)MT * MIXW * 2;
constexpr size_t WS_H2S = WS_YACC;
constexpr size_t WS_Y = WS_YACC + (size_t)MT * D * 4;
constexpr size_t WS_X1 = WS_Y + (size_t)MT * D * 2;
constexpr size_t WS_X2 = WS_X1 + (size_t)MT * D * 4;
constexpr size_t WS_YS = WS_X2;
constexpr size_t WS_END = WS_X2 + (size_t)MT * D * 4;
static_assert((size_t)MS * DFE * 2 <= (size_t)MT * INW * 2 + (size_t)MT * MIXW * 2, "ACT overlay");
static_assert((size_t)MS * D * 2 <= (size_t)MT * D * 4, "H2S / YS overlays");
static_assert(WS_TILE + 1024 <= WS_WIN, "small tables");
constexpr int CW_BAR = 4096;

constexpr int RING_BYTES = 131072;
constexpr int LDSCTL_OFF = 146944, MISC_OFF = LDSCTL_OFF + 320;
constexpr int LDS_BYTES = 147456;

#define XB_TMO      128
#define XB_XCNT(j)  (256  + 64 * (j))
#define XB_XSUB(j)  (1280 + 64 * (j))
#define XB_XGEN(j)  (2304 + 64 * (j))
#define XB_TOP      3328
#define XB_TOPGEN   3392
#define XCD_BAR_WORDS 3456
#define XB_SPIN_CAP (1u << 18)
__device__ __forceinline__ unsigned xb_ld(unsigned* p)              { return __hip_atomic_load(p, __ATOMIC_RELAXED, __HIP_MEMORY_SCOPE_AGENT); }
__device__ __forceinline__ unsigned xb_add(unsigned* p, unsigned v) { return __hip_atomic_fetch_add(p, v, __ATOMIC_RELAXED, __HIP_MEMORY_SCOPE_AGENT); }
__device__ __forceinline__ unsigned xb_xcc_id() { return (unsigned)__builtin_amdgcn_s_getreg((3 << 11) | 20) & 0xFu; }
#define XB_SPIN(cond, bar) do { unsigned _sp = 0; while (cond) { __builtin_amdgcn_s_sleep(1); \
    if ((++_sp & 255u) == 0u) { if (xb_ld(&(bar)[XB_TMO])) break; if (_sp > XB_SPIN_CAP) { atomicAdd(&(bar)[XB_TMO], 1u); break; } } } } while (0)
struct XcdBarrier { unsigned* bar; unsigned x; volatile LAS unsigned* st; };
__device__ __forceinline__ XcdBarrier xcd_barrier_post(unsigned* bar, volatile LAS unsigned* st) {
    XcdBarrier b; b.bar = bar; b.x = xb_xcc_id(); b.st = st;
    if (threadIdx.x == 0) (void)xb_add(&bar[XB_XCNT(b.x)], 1u);
    return b;
}
__device__ __forceinline__ void xcd_barrier_complete(unsigned* bar, unsigned x, unsigned& nloc, unsigned& nx) {
    const unsigned G = gridDim.x * gridDim.y * gridDim.z;
    unsigned sum, cnt, mine, sp = 0u;
    for (;;) {
        sum = 0u; cnt = 0u; mine = 0u;
#pragma unroll
        for (unsigned j = 0; j < 16; ++j) { const unsigned c = xb_ld(&bar[XB_XCNT(j)]); sum += c; cnt += (c > 0u) ? 1u : 0u; mine = (j == x) ? c : mine; }
        if (sum == G) break;
        __builtin_amdgcn_s_sleep(1);
        if ((++sp & 255u) == 0u) { if (xb_ld(&bar[XB_TMO])) break; if (sp > XB_SPIN_CAP) { atomicAdd(&bar[XB_TMO], 1u); break; } }
    }
    nloc = mine > 0u ? mine : 1u; nx = cnt > 0u ? cnt : 1u;
}
__device__ __attribute__((noinline)) void xcd_barrier_leader(unsigned* bar, unsigned bx_, volatile LAS unsigned* st) {
    {
        XcdBarrier b; b.bar = bar; b.x = bx_; b.st = st;
        __builtin_amdgcn_s_waitcnt(0);
        unsigned nloc = b.st[0], nx = b.st[1];
        if (nloc == 0u) { xcd_barrier_complete(bar, b.x, nloc, nx); b.st[0] = nloc; b.st[1] = nx; }
        const unsigned old = xb_add(&bar[XB_XSUB(b.x)], 1u);
        const unsigned gen = old / nloc;
        if (old + 1u == (gen + 1u) * nloc) {
            __builtin_amdgcn_fence(__ATOMIC_RELEASE, "agent");
            asm volatile("s_waitcnt vmcnt(0)" ::: "memory");
            const unsigned og = xb_add(&bar[XB_TOP], 1u);
            const unsigned tg = og / nx;
            if (og + 1u == (tg + 1u) * nx) xb_add(&bar[XB_TOPGEN], 1u);
            else XB_SPIN(xb_ld(&bar[XB_TOPGEN]) == tg, bar);
            __builtin_amdgcn_fence(__ATOMIC_ACQUIRE, "agent");
            xb_add(&bar[XB_XGEN(b.x)], 1u);
            asm volatile("s_waitcnt vmcnt(0)" ::: "memory");
        } else {
            XB_SPIN(xb_ld(&bar[XB_XGEN(b.x)]) == gen, bar);
            __builtin_amdgcn_fence(__ATOMIC_ACQUIRE, "agent");
            asm volatile("s_waitcnt vmcnt(0)" ::: "memory");
        }
    }
}
__device__ __forceinline__ void xcd_barrier(const XcdBarrier& b) {
    asm volatile("s_waitcnt vmcnt(0)" ::: "memory");
    __syncthreads();
    if (threadIdx.x == 0) xcd_barrier_leader(b.bar, b.x, b.st);
    __syncthreads();
}

struct Args {
    const float *x, *c, *ctx, *c_ctx, *norm1_g, *norm2_g, *final_g, *w_mod, *b_mod, *w_in, *conv_w, *sink, *pool_w, *pool_scale, *w_branch, *w_out,
                *ffn_w_gu, *ffn_w_down, *router_w, *moe_w_gu, *moe_w_down;
    float* out; unsigned char* ws; int ph_lo, ph_hi;
};
template <int OFF> __device__ __forceinline__ const void* karg_p() { const void* r; asm volatile("s_load_dwordx2 %0, %1, %2\n\ts_waitcnt lgkmcnt(0)" : "=s"(r) : "s"(__builtin_amdgcn_kernarg_segment_ptr()), "i"(OFF)); return r; }
template <int OFF> __device__ __forceinline__ int karg_i() { int r; asm volatile("s_load_dword %0, %1, %2\n\ts_waitcnt lgkmcnt(0)" : "=s"(r) : "s"(__builtin_amdgcn_kernarg_segment_ptr()), "i"(OFF)); return r; }
#define KP(field) ((const float*)karg_p<(int)__builtin_offsetof(Args, field)>())
struct Frame {
    LAS unsigned char* lds;
    int tid, lane, wave, G, bx;
    unsigned char* ws;
};
__device__ __forceinline__ float wave_sum(float v) {
#pragma unroll
    for (int o = 1; o < 64; o <<= 1) v += __shfl_xor(v, o);
    return v;
}
__device__ __forceinline__ float wave_max(float v) {
#pragma unroll
    for (int o = 1; o < 64; o <<= 1) v = fmaxf(v, __shfl_xor(v, o));
    return v;
}
#define LDS_WAIT() asm volatile("s_waitcnt lgkmcnt(0)" ::: "memory")

template <bool F8>
__device__ __forceinline__ void p0_transpose_item(const float* W, int ldw, bf16* WT, int ldt, int koff, int k0, int n0, int drow0, LAS float* scr, int lane) {
    f32x4 v[16];
    const int rl = lane >> 4, c4 = 4 * (lane & 15);
#pragma unroll
    for (int i = 0; i < 16; ++i) v[i] = __builtin_nontemporal_load((const f32x4*)(W + (size_t)(k0 + 4 * i + rl) * ldw + n0 + c4));
#pragma unroll
    for (int i = 0; i < 16; ++i) { LAS float* p = scr + (4 * i + rl) * 65 + c4; p[0] = v[i].x; p[1] = v[i].y; p[2] = v[i].z; p[3] = v[i].w; }
    LDS_WAIT(); asm volatile("" ::: "memory");
    const int c = lane & 7;
#pragma unroll
    for (int j = 0; j < 8; ++j) { const int n = (lane >> 3) + 8 * j; const LAS float* sp = scr + (8 * c) * 65 + n;
        if constexpr (F8) { u32x2 o; o.x = pk4_fp8(sp[0 * 65] * W8SCALE, sp[1 * 65] * W8SCALE, sp[2 * 65] * W8SCALE, sp[3 * 65] * W8SCALE); o.y = pk4_fp8(sp[4 * 65] * W8SCALE, sp[5 * 65] * W8SCALE, sp[6 * 65] * W8SCALE, sp[7 * 65] * W8SCALE);
            *(u32x2*)((unsigned char*)WT + (size_t)(drow0 + n) * ldt + koff + k0 + 8 * c) = o; }
        else { u32x4 o; o.x = pk2(sp[0 * 65], sp[1 * 65]); o.y = pk2(sp[2 * 65], sp[3 * 65]); o.z = pk2(sp[4 * 65], sp[5 * 65]); o.w = pk2(sp[6 * 65], sp[7 * 65]);
            *(u32x4*)(WT + (size_t)(drow0 + n) * ldt + koff + k0 + 8 * c) = o; } }
    LDS_WAIT(); asm volatile("" ::: "memory");
}
template <bool F8>
__device__ __forceinline__ void p0_job_item(const float* W, int K, int N, bf16* WT, int ldt, int koff, int IL, int item, LAS float* scr, int lane) {
    const int nblk = N / 64, kb = item / nblk, nb = item % nblk, n0 = 64 * nb;
    int drow0 = n0;
    if (IL > 0) { const int half = n0 >= IL ? 1 : 0, f = n0 - half * IL; drow0 = 256 * (f / 128) + 128 * half + (f % 128); }
    p0_transpose_item<F8>(W, N, WT, ldt, koff, 64 * kb, n0, drow0, scr, lane);
}
__device__ __forceinline__ void p0_prologue(Frame& F) {
    LAS float* scr = (LAS float*)(F.lds + F.wave * 16640);
    const int gw = F.bx * NWAVES + F.wave, NGW = F.G * NWAVES;
    constexpr int I_IN = (D / 64) * (INW / 64), I_BR = (512 / 64) * (D / 64), I_OUT = (D / 64) * (D / 64), I_GU0 = (D / 64) * (2 * DFF / 64), I_DN0 = (DFF / 64) * (D / 64),
                  I_MGU = (D / 64) * (2 * DFE / 64), I_MDN = (DFE / 64) * (D / 64);
    constexpr int NITEMS = 2 * I_IN + 4 * I_BR + 2 * I_OUT + I_GU0 + I_DN0 + NE * I_MGU + NE * I_MDN;
    bf16* const wsb = (bf16*)F.ws;
    for (int it = gw; it < NITEMS; it += NGW) {
        int r = it;
        if (r < NE * I_MGU) { const int e = r / I_MGU; p0_job_item<true>(KP(moe_w_gu) + (size_t)e * D * 2 * DFE, D, 2 * DFE, (bf16*)(F.ws + WS_WMGU + (size_t)e * 2 * DFE * D), D, 0, DFE, r % I_MGU, scr, F.lane); continue; } r -= NE * I_MGU;
        if (r < NE * I_MDN) { const int e = r / I_MDN; p0_job_item<true>(KP(moe_w_down) + (size_t)e * DFE * D, DFE, D, (bf16*)(F.ws + WS_WMDN + (size_t)e * D * DFE), DFE, 0, 0, r % I_MDN, scr, F.lane); continue; } r -= NE * I_MDN;
        if (r < 2 * I_IN) { const int l = r / I_IN; p0_job_item<false>(KP(w_in) + (size_t)l * D * INW, D, INW, (bf16*)(F.ws + WS_WIN) + (size_t)l * INW * D, D, 0, 0, r % I_IN, scr, F.lane); continue; } r -= 2 * I_IN;
        if (r < 4 * I_BR) { const int j = r / I_BR, l = j >> 1, b = j & 1; p0_job_item<false>(KP(w_branch) + (size_t)(l * 3 + b) * 512 * D, 512, D, (bf16*)(F.ws + WS_WBR) + (size_t)l * D * MIXW, MIXW, 512 * b, 0, r % I_BR, scr, F.lane); continue; } r -= 4 * I_BR;
        if (r < 2 * I_OUT) { const int l = r / I_OUT; p0_job_item<false>(KP(w_out) + (size_t)l * D * D, D, D, (bf16*)(F.ws + WS_WOUT) + (size_t)l * D * D, D, 0, 0, r % I_OUT, scr, F.lane); continue; } r -= 2 * I_OUT;
        if (r < I_GU0) { p0_job_item<FFN0_FP8 != 0>(KP(ffn_w_gu), D, 2 * DFF, (bf16*)(F.ws + WS_WGU0), D, 0, DFF, r, scr, F.lane); continue; } r -= I_GU0;
        p0_job_item<FFN0_FP8 != 0>(KP(ffn_w_down), DFF, D, (bf16*)(F.ws + WS_WDN0), DFF, 0, 0, r, scr, F.lane);
    }
    (void)wsb;
    __syncthreads();
    constexpr int I_MOD = 2 * (MODW / 64), I_FOLD = 2 * 4 * (D / 64);
    for (int it = F.bx; it < I_MOD + I_FOLD + 1; it += F.G) {
        if (it < I_MOD) {
            const int l = it / (MODW / 64), cb = it % (MODW / 64);
            LAS float* sv = (LAS float*)F.lds;
            LAS float* red = (LAS float*)(F.lds + 32768);
            for (int i = F.tid; i < 5 * D; i += NTHR) { const int r = i / D, k = i % D; const float v = r < 4 ? KP(c)[r * D + k] : KP(c_ctx)[k]; sv[i] = v / (1.f + __expf(-v)); }
            __syncthreads();
            const int col = cb * 64 + F.lane; const float* wp = KP(w_mod) + (size_t)l * D * MODW + col;
            float a0 = 0.f, a1 = 0.f, a2 = 0.f, a3 = 0.f, a4 = 0.f;
#pragma unroll 8
            for (int kk = 0; kk < 128; ++kk) { const int k = F.wave * 128 + kk; const float w = wp[(size_t)k * MODW];
                a0 += sv[k] * w; a1 += sv[D + k] * w; a2 += sv[2 * D + k] * w; a3 += sv[3 * D + k] * w; a4 += sv[4 * D + k] * w; }
            red[(F.wave * 5 + 0) * 64 + F.lane] = a0; red[(F.wave * 5 + 1) * 64 + F.lane] = a1; red[(F.wave * 5 + 2) * 64 + F.lane] = a2;
            red[(F.wave * 5 + 3) * 64 + F.lane] = a3; red[(F.wave * 5 + 4) * 64 + F.lane] = a4;
            __syncthreads();
            if (F.tid < 320) { const int r = F.tid / 64, ln = F.tid % 64; float s = 0.f;
#pragma unroll
                for (int w = 0; w < 8; ++w) s += red[(w * 5 + r) * 64 + ln];
                const int cc = cb * 64 + ln;
                ((float*)(F.ws + WS_MODV))[(size_t)(l * 5 + r) * MODW + cc] = s + KP(b_mod)[l * MODW + cc]; }
            __syncthreads();
        } else if (it < I_MOD + I_FOLD) {
            const int r = it - I_MOD, l = r / 64, g = (r % 64) / 16, nb = r % 16;
            LAS float* pw = (LAS float*)F.lds;
            const float* pws = KP(pool_w) + (size_t)(l * 4 + g) * 128 * 128;
            for (int i = F.tid; i < 128 * 128; i += NTHR) pw[i] = pws[i];
            __syncthreads();
            const int n = nb * 64 + F.lane; const float* w2 = KP(w_branch) + (size_t)(l * 3 + 2) * 512 * D + (size_t)(128 * g) * D + n;
            const float* ps = KP(pool_scale) + l * 512 + 128 * g;
            float acc[16];
#pragma unroll
            for (int q = 0; q < 16; ++q) acc[q] = 0.f;
            for (int j = 0; j < 128; ++j) { const float wv = w2[(size_t)j * D] * ps[j];
#pragma unroll
                for (int q = 0; q < 16; ++q) acc[q] += pw[(F.wave * 16 + q) * 128 + j] * wv; }
            bf16* dst = (bf16*)(F.ws + WS_WBR) + (size_t)l * D * MIXW + (size_t)n * MIXW + 1024 + 128 * g + F.wave * 16;
            u32x4 o0, o1; o0.x = pk2(acc[0], acc[1]); o0.y = pk2(acc[2], acc[3]); o0.z = pk2(acc[4], acc[5]); o0.w = pk2(acc[6], acc[7]);
            o1.x = pk2(acc[8], acc[9]); o1.y = pk2(acc[10], acc[11]); o1.z = pk2(acc[12], acc[13]); o1.w = pk2(acc[14], acc[15]);
            *(u32x4*)dst = o0; *(u32x4*)(dst + 8) = o1;
            __syncthreads();
        } else {
            for (int i = F.tid; i < 64 * 16; i += NTHR) { const int pos = i / 16, fi = i % 16;
                const float inv = powf(10000.0f, -(float)fi / 16.0f); const float ang = (float)pos * inv;
                ((float*)(F.ws + WS_ROPE))[2 * i] = cosf(ang); ((float*)(F.ws + WS_ROPE))[2 * i + 1] = sinf(ang); }
        }
    }
}

template <bool ROUTER, bool OUT8 = false>
__device__ __forceinline__ void norm_mod_phase(Frame& F, const float* xl, const float* xc, const float* gvec, const float* modl, int shi, int sci, int nrows, const float* router_w) {
    bf16* H = (bf16*)(F.ws + WS_H);
    LAS int* lcnt = (LAS int*)F.lds;
    if (ROUTER) { if (F.tid < 8) lcnt[F.tid] = 0; __syncthreads(); }
    const int nloop = ROUTER ? 8 : (nrows + F.G * NWAVES - 1) / (F.G * NWAVES);
    for (int i = 0; i < nloop; ++i) {
        const int r = ROUTER ? (F.bx * 64 + F.wave + 8 * i) : ((i * F.G + F.bx) * NWAVES + F.wave);
        if (r >= nrows) continue;
        const int bidx = r < ML ? r / SEQ : 4;
        const float* xr = r < ML ? xl + (size_t)r * D : xc + (size_t)(r - ML) * D;
        const float* mv = modl + (size_t)bidx * MODW;
        f32x4 v[4]; float ss = 0.f;
#pragma unroll
        for (int j = 0; j < 4; ++j) { v[j] = *(const f32x4*)(xr + 4 * F.lane + 256 * j); ss += (v[j].x * v[j].x + v[j].y * v[j].y) + (v[j].z * v[j].z + v[j].w * v[j].w); }
        const float rstd = 1.0f / sqrtf(wave_sum(ss) * (1.f / D) + EPS);
#pragma unroll
        for (int j = 0; j < 4; ++j) { const int c = 4 * F.lane + 256 * j;
            const f32x4 g = *(const f32x4*)(gvec + c), sh = *(const f32x4*)(mv + shi * D + c), sc = *(const f32x4*)(mv + sci * D + c);
            v[j] = (v[j] * rstd * g) * (sc + 1.0f) + sh;
            if constexpr (OUT8) *(unsigned*)((unsigned char*)H + (size_t)r * D + c) = pk4_fp8(v[j].x, v[j].y, v[j].z, v[j].w);
            else { u32x2 o; o.x = pk2(v[j].x, v[j].y); o.y = pk2(v[j].z, v[j].w); *(u32x2*)(H + (size_t)r * D + c) = o; } }
        if (ROUTER) {
            float lg[8];
#pragma unroll
            for (int e = 0; e < 8; ++e) lg[e] = 0.f;
#pragma unroll
            for (int j = 0; j < 4; ++j)
#pragma unroll
                for (int q = 0; q < 4; ++q) { const int c = 4 * F.lane + 256 * j + q; const f32x4 w0 = *(const f32x4*)(router_w + (size_t)c * 8), w1 = *(const f32x4*)(router_w + (size_t)c * 8 + 4); const float hv = v[j][q];
                    lg[0] += hv * w0.x; lg[1] += hv * w0.y; lg[2] += hv * w0.z; lg[3] += hv * w0.w; lg[4] += hv * w1.x; lg[5] += hv * w1.y; lg[6] += hv * w1.z; lg[7] += hv * w1.w; }
#pragma unroll
            for (int e = 0; e < 8; ++e) lg[e] = wave_sum(lg[e]);
            int e1 = 0; float v1 = lg[0];
#pragma unroll
            for (int e = 1; e < 8; ++e) if (lg[e] > v1) { v1 = lg[e]; e1 = e; }
            int e2 = -1; float v2 = -3.0e38f;
#pragma unroll
            for (int e = 0; e < 8; ++e) if (e != e1 && lg[e] > v2) { v2 = lg[e]; e2 = e; }
            const float ex = __expf(v2 - v1), w1 = 1.f / (1.f + ex), w2 = ex * w1;
            if (F.lane == 0) {
                const int p1 = atomicAdd((int*)&lcnt[e1], 1), p2 = atomicAdd((int*)&lcnt[e2], 1);
                int* te = (int*)(F.ws + WS_TOKE) + 2 * r; te[0] = e1; te[1] = e2;
                int* tp = (int*)(F.ws + WS_TOKP) + 2 * r; tp[0] = p1; tp[1] = p2;
                float* tw = (float*)(F.ws + WS_TOKW) + 2 * r; tw[0] = w1; tw[1] = w2;
            }
        }
    }
    if (ROUTER) { __syncthreads(); if (F.tid < 8) ((int*)(F.ws + WS_CNTWG))[F.bx * 8 + F.tid] = lcnt[F.tid]; __syncthreads(); }
}

__device__ __forceinline__ void moe_scatter_phase(Frame& F) {
    LAS int* tab = (LAS int*)F.lds;
    const int* cw = (const int*)(F.ws + WS_CNTWG);
    if (F.tid < 32) tab[F.tid] = 0;
    __syncthreads();
    for (int idx = F.tid; idx < F.G * 8; idx += NTHR) {
        const int c = __hip_atomic_load(cw + idx, __ATOMIC_RELAXED, __HIP_MEMORY_SCOPE_AGENT); const int w = idx >> 3, e = idx & 7;
        atomicAdd((int*)&tab[16 + e], c); if (w < F.bx) atomicAdd((int*)&tab[8 + e], c);
    }
    __syncthreads();
    if (F.tid == 0) { int off = 0; for (int e = 0; e < 8; ++e) { tab[e] = off; off += ((tab[16 + e] + 255) / 256) * 256; } tab[24] = off / 256;
        if (F.bx == 0) { int* tl = (int*)(F.ws + WS_TILE); int t = 0; for (int e = 0; e < 8; ++e) { const int n = (tab[16 + e] + 255) / 256; for (int q = 0; q < n; ++q) tl[t++] = e; } tl[200] = t; } }
    __syncthreads();
    const bf16* H = (const bf16*)(F.ws + WS_H); bf16* HS = (bf16*)(F.ws + WS_H2S);
    for (int i = 0; i < 8; ++i) {
        const int r = F.bx * 64 + F.wave + 8 * i; if (r >= ML) continue;
        const int* te = (const int*)(F.ws + WS_TOKE) + 2 * r; const int* tp = (const int*)(F.ws + WS_TOKP) + 2 * r;
        const int e1 = te[0], e2 = te[1];
        const int s1 = tab[e1] + tab[8 + e1] + tp[0], s2 = tab[e2] + tab[8 + e2] + tp[1];
        if (F.lane == 0) { int* ts = (int*)(F.ws + WS_TOKS) + 2 * r; ts[0] = s1; ts[1] = s2; }
        const u32x4 a = ((const u32x4*)((const unsigned char*)H + (size_t)r * D))[F.lane];
        ((u32x4*)((unsigned char*)HS + (size_t)s1 * D))[F.lane] = a; ((u32x4*)((unsigned char*)HS + (size_t)s2 * D))[F.lane] = a;
    }
}

__device__ __forceinline__ void final_phase(Frame& F, const float* final_g, float* out, const float* modl) {
    const float* X1 = (const float*)(F.ws + WS_X1); const bf16* YS = (const bf16*)(F.ws + WS_YS);
    const int NGW = F.G * NWAVES;
    for (int r = F.bx * NWAVES + F.wave; r < ML; r += NGW) {
        const int bidx = r / SEQ; const float* g2 = modl + (size_t)bidx * MODW + 5 * D;
        const int* ts = (const int*)(F.ws + WS_TOKS) + 2 * r; const float* tw = (const float*)(F.ws + WS_TOKW) + 2 * r;
        const int s1 = ts[0], s2 = ts[1]; const float w1 = tw[0], w2 = tw[1];
        f32x4 v[4]; float ss = 0.f;
#pragma unroll
        for (int j = 0; j < 4; ++j) { const int c = 4 * F.lane + 256 * j;
            const f32x4 xv = *(const f32x4*)(X1 + (size_t)r * D + c), g = *(const f32x4*)(g2 + c);
            const u32x2 y1 = *(const u32x2*)(YS + (size_t)s1 * D + c), y2 = *(const u32x2*)(YS + (size_t)s2 * D + c);
            f32x4 f; f.x = w1 * bflo(y1.x) + w2 * bflo(y2.x); f.y = w1 * bfhi(y1.x) + w2 * bfhi(y2.x); f.z = w1 * bflo(y1.y) + w2 * bflo(y2.y); f.w = w1 * bfhi(y1.y) + w2 * bfhi(y2.y);
            v[j] = xv + g * f; ss += (v[j].x * v[j].x + v[j].y * v[j].y) + (v[j].z * v[j].z + v[j].w * v[j].w); }
        const float rstd = 1.0f / sqrtf(wave_sum(ss) * (1.f / D) + EPS);
#pragma unroll
        for (int j = 0; j < 4; ++j) { const int c = 4 * F.lane + 256 * j; const f32x4 g = *(const f32x4*)(final_g + c);
            *(f32x4*)(out + (size_t)r * D + c) = v[j] * rstd * g; }
    }
}

__device__ __forceinline__ void unpack8(const u32x4 w, float (&f)[8]) { f[0] = bflo(w.x); f[1] = bfhi(w.x); f[2] = bflo(w.y); f[3] = bfhi(w.y); f[4] = bflo(w.z); f[5] = bfhi(w.z); f[6] = bflo(w.w); f[7] = bfhi(w.w); }
__device__ __forceinline__ void local_mix_phase(Frame& F, const float* cw, int nrows) {
    const bf16* Z = (const bf16*)(F.ws + WS_Z); bf16* MIX = (bf16*)(F.ws + WS_MIX);
    const int total = nrows * 64, stride = F.G * NTHR;
    for (int idx = F.bx * NTHR + F.tid; idx < total; idx += stride) {
        const int r = idx >> 6, cg = idx & 63, c0 = cg * 8;
        int t, L, base;
        if (r < ML) { t = r % SEQ; L = SEQ; base = r - t; } else { const int rc = r - ML; t = rc % CTXL; L = CTXL; base = r - t; }
        float o[8];
#pragma unroll
        for (int q = 0; q < 8; ++q) o[q] = 0.f;
#pragma unroll
        for (int j = 0; j < 3; ++j) { const int tt = t - 1 + j; if (tt < 0 || tt >= L) continue;
            const bf16* zr = Z + (size_t)(base + tt) * INW; float cx[8], cc[8];
            unpack8(*(const u32x4*)(zr + ZCX + c0), cx); unpack8(*(const u32x4*)(zr + ZCC + c0), cc);
            const f32x4 w0 = *(const f32x4*)(cw + j * 512 + c0), w1 = *(const f32x4*)(cw + j * 512 + c0 + 4);
            o[0] += w0.x * (cc[0] * cx[0]); o[1] += w0.y * (cc[1] * cx[1]); o[2] += w0.z * (cc[2] * cx[2]); o[3] += w0.w * (cc[3] * cx[3]);
            o[4] += w1.x * (cc[4] * cx[4]); o[5] += w1.y * (cc[5] * cx[5]); o[6] += w1.z * (cc[6] * cx[6]); o[7] += w1.w * (cc[7] * cx[7]); }
        { float cb[8]; unpack8(*(const u32x4*)(Z + (size_t)r * INW + ZCB + c0), cb);
          u32x4 w; w.x = pk2(cb[0] * o[0], cb[1] * o[1]); w.y = pk2(cb[2] * o[2], cb[3] * o[3]); w.z = pk2(cb[4] * o[4], cb[5] * o[5]); w.w = pk2(cb[6] * o[6], cb[7] * o[7]);
          *(u32x4*)(MIX + (size_t)r * MIXW + 512 + c0) = w; }
        { const int hw = 1 << (c0 >> 7); const int lo = t - hw < 0 ? 0 : t - hw, hi = t + hw > L ? L : t + hw;
          float s[8];
#pragma unroll
          for (int q = 0; q < 8; ++q) s[q] = 0.f;
          for (int tt = lo; tt < hi; ++tt) { float u[8]; unpack8(*(const u32x4*)(Z + (size_t)(base + tt) * INW + ZPU + c0), u);
#pragma unroll
              for (int q = 0; q < 8; ++q) s[q] += u[q]; }
          float u0[8]; unpack8(*(const u32x4*)(Z + (size_t)r * INW + ZPU + c0), u0);
          const float inv = 1.0f / (float)(hi - lo);
          u32x4 w; w.x = pk2(s[0] * inv - u0[0], s[1] * inv - u0[1]); w.y = pk2(s[2] * inv - u0[2], s[3] * inv - u0[3]);
          w.z = pk2(s[4] * inv - u0[4], s[5] * inv - u0[5]); w.w = pk2(s[6] * inv - u0[6], s[7] * inv - u0[7]);
          *(u32x4*)(MIX + (size_t)r * MIXW + 1024 + c0) = w; }
    }
}

__device__ __forceinline__ void attn_naive_phase(Frame& F, const float* sinkl, int nrows) {
    const bf16* Z = (const bf16*)(F.ws + WS_Z); bf16* MIX = (bf16*)(F.ws + WS_MIX);
    LAS float* qs = (LAS float*)(F.lds + F.wave * 10240);
    LAS float* sc = qs + 256;
    const int nunits = nrows * 2, NGW = F.G * NWAVES;
    for (int uidx = F.bx * NWAVES + F.wave; uidx < nunits; uidx += NGW) {
        const int r = uidx >> 1, kh = uidx & 1;
        int b, nloc, krow0;
        if (r < ML) { b = r / SEQ; const int t = r % SEQ; const int lo = t - 128 < 0 ? 0 : t - 128, hi = t + 128 > SEQ - 1 ? SEQ - 1 : t + 128; nloc = hi - lo + 1; krow0 = b * SEQ + lo; }
        else { b = (r - ML) / CTXL; nloc = 0; krow0 = 0; }
        const int crow0 = ML + b * CTXL, nk = nloc + CTXL;
        { const u32x2 qw = *(const u32x2*)(Z + (size_t)r * INW + ZQ + kh * 256 + 4 * F.lane); const int g = F.lane >> 4, d = (4 * F.lane) & 63;
          qs[(d + 0) * 4 + g] = bflo(qw.x); qs[(d + 1) * 4 + g] = bfhi(qw.x); qs[(d + 2) * 4 + g] = bflo(qw.y); qs[(d + 3) * 4 + g] = bfhi(qw.y); }
        LDS_WAIT(); asm volatile("" ::: "memory");
        for (int c0 = 0; c0 < nk; c0 += 64) {
            const int kk = c0 + F.lane;
            if (kk < nk) {
                const int krow = kk < nloc ? krow0 + kk : crow0 + (kk - nloc);
                const u32x4* kp = (const u32x4*)(Z + (size_t)krow * INW + ZK + kh * 64);
                f32x4 s = (f32x4){0.f, 0.f, 0.f, 0.f};
#pragma unroll
                for (int d8 = 0; d8 < 8; ++d8) { float kf[8]; unpack8(kp[d8], kf);
#pragma unroll
                    for (int q = 0; q < 8; ++q) { const f32x4 qv = *(const LAS f32x4*)(qs + (d8 * 8 + q) * 4); s += qv * kf[q]; } }
                *(LAS f32x4*)(sc + kk * 4) = s;
            }
        }
        LDS_WAIT(); asm volatile("" ::: "memory");
        f32x4 mx; { const float* sk = sinkl + kh * 4; mx = (f32x4){sk[0] * LOG2E, sk[1] * LOG2E, sk[2] * LOG2E, sk[3] * LOG2E}; }
        const f32x4 snk = mx;
        for (int kk = F.lane; kk < nk; kk += 64) { const f32x4 s = *(const LAS f32x4*)(sc + kk * 4); mx.x = fmaxf(mx.x, s.x); mx.y = fmaxf(mx.y, s.y); mx.z = fmaxf(mx.z, s.z); mx.w = fmaxf(mx.w, s.w); }
        mx.x = wave_max(mx.x); mx.y = wave_max(mx.y); mx.z = wave_max(mx.z); mx.w = wave_max(mx.w);
        f32x4 sm = (f32x4){0.f, 0.f, 0.f, 0.f};
        for (int kk = F.lane; kk < nk; kk += 64) { f32x4 s = *(const LAS f32x4*)(sc + kk * 4);
            s.x = exp2f(s.x - mx.x); s.y = exp2f(s.y - mx.y); s.z = exp2f(s.z - mx.z); s.w = exp2f(s.w - mx.w); sm += s; *(LAS f32x4*)(sc + kk * 4) = s; }
        sm.x = wave_sum(sm.x) + exp2f(snk.x - mx.x); sm.y = wave_sum(sm.y) + exp2f(snk.y - mx.y); sm.z = wave_sum(sm.z) + exp2f(snk.z - mx.z); sm.w = wave_sum(sm.w) + exp2f(snk.w - mx.w);
        LDS_WAIT(); asm volatile("" ::: "memory");
        f32x4 o = (f32x4){0.f, 0.f, 0.f, 0.f};
        const bf16* vb = Z + ZV + kh * 64 + F.lane;
#pragma unroll 4
        for (int kk = 0; kk < nk; ++kk) { const int krow = kk < nloc ? krow0 + kk : crow0 + (kk - nloc);
            const float v = bf2f((unsigned)vb[(size_t)krow * INW]); const f32x4 p = *(const LAS f32x4*)(sc + kk * 4); o += p * v; }
        bf16* op = MIX + (size_t)r * MIXW + kh * 256 + F.lane;
        op[0] = (bf16)f2bf(o.x / sm.x); op[64] = (bf16)f2bf(o.y / sm.y); op[128] = (bf16)f2bf(o.z / sm.z); op[192] = (bf16)f2bf(o.w / sm.w);
        LDS_WAIT(); asm volatile("" ::: "memory");
    }
}

typedef float f32x16 __attribute__((ext_vector_type(16)));
typedef short s16x4 __attribute__((ext_vector_type(4)));
typedef __bf16 bf16x2_t __attribute__((ext_vector_type(2)));
__device__ __forceinline__ unsigned cvtpk(float lo, float hi) { f32x2 v = {lo, hi}; bf16x2_t b = __builtin_convertvector(v, bf16x2_t); return __builtin_bit_cast(unsigned, b); }
__device__ __forceinline__ s16x4 vtr(const LAS unsigned char* p) { return __builtin_bit_cast(s16x4, __builtin_amdgcn_ds_read_tr16_b64_v4i16((LAS s16x4*)p)); }
constexpr int AKP = 144, ATT_V_OFF = 128 * AKP;
__device__ __forceinline__ void attn_unit(Frame& F, const bf16* Z, bf16* MIX, const float* sinkl, const bool isctx, const int b, const int kh, const int qblk) {
    const int qrow0 = isctx ? ML + b * CTXL + qblk * 128 : b * SEQ + qblk * 128;
    const int cbase = ML + b * CTXL;
    const bool has_prev = !isctx && qblk > 0, has_next = !isctx && qblk < 31;
    const int nch = isctx ? 2 : 3 + (has_prev ? 1 : 0) + (has_next ? 1 : 0);
    const int lane = F.lane, r = lane & 31, h = lane >> 5, g = F.wave >> 1, qh = F.wave & 1, head = kh * 4 + g;
    LAS unsigned char* Ks = F.lds; LAS unsigned char* Vs = F.lds + ATT_V_OFF;
    bf16x8 qf[2][4];
#pragma unroll
    for (int sub = 0; sub < 2; ++sub)
#pragma unroll
        for (int ks = 0; ks < 4; ++ks) qf[sub][ks] = *(const bf16x8*)(Z + (size_t)(qrow0 + 64 * qh + 32 * sub + r) * INW + ZQ + head * 64 + 16 * ks + 8 * h);
    const float sk = sinkl[head] * LOG2E;
    float m[2], l[2]; f32x16 O[2][2];
#pragma unroll
    for (int sub = 0; sub < 2; ++sub) { m[sub] = sk; l[sub] = h == 0 ? 1.f : 0.f;
#pragma unroll
        for (int db = 0; db < 2; ++db)
#pragma unroll
            for (int i = 0; i < 16; ++i) O[sub][db][i] = 0.f; }
#define ATT_CHUNK(ci, row0, kind) do { if (isctx) { row0 = cbase + 128 * (ci); kind = 0; } else if ((ci) == 0) { row0 = qrow0; kind = 0; } else if ((ci) <= 2) { row0 = cbase + 128 * ((ci) - 1); kind = 0; } \
        else if ((ci) == 3 && has_prev) { row0 = qrow0 - 128; kind = 1; } else { row0 = qrow0 + 128; kind = 2; } } while (0)
    const int skey = F.tid >> 3, spart = F.tid & 7;
    u32x4 pk0, pk1, pv0, pv1;
#define ATT_LOAD(ci) do { int row0_, kind_; ATT_CHUNK(ci, row0_, kind_); (void)kind_; const bf16* kp_ = Z + (size_t)(row0_ + skey) * INW + ZK + kh * 64 + spart * 8; \
        pk0 = *(const u32x4*)kp_; pk1 = *(const u32x4*)(kp_ + (size_t)64 * INW); pv0 = *(const u32x4*)(kp_ + (ZV - ZK)); pv1 = *(const u32x4*)(kp_ + (size_t)64 * INW + (ZV - ZK)); } while (0)
    ATT_LOAD(0);
    const int grp = (lane >> 4) & 1, q4 = (lane & 15) >> 2, p4 = lane & 3;
    for (int ci = 0; ci < nch; ++ci) {
        __syncthreads();
        *(LAS u32x4*)(Ks + skey * AKP + spart * 16) = pk0; *(LAS u32x4*)(Ks + (skey + 64) * AKP + spart * 16) = pk1;
        *(LAS u32x4*)(Vs + skey * AKP + spart * 16) = pv0; *(LAS u32x4*)(Vs + (skey + 64) * AKP + spart * 16) = pv1;
        if (ci + 1 < nch) ATT_LOAD(ci + 1);
        __syncthreads();
        int row0, kind; ATT_CHUNK(ci, row0, kind); (void)row0;
        int dl = 4 * h - r - 64 * qh; asm volatile("" : "+v"(dl));
        for (int t = 0; t < 4; ++t) {
            if (kind == 1 && 32 * t + 31 < 64 * qh) continue;
            if (kind == 2 && 32 * t > 64 * qh + 63) continue;
            bf16x8 kf[4], vf[2][2];
#pragma unroll
            for (int ks = 0; ks < 4; ++ks) kf[ks] = *(const LAS bf16x8*)(Ks + (32 * t + r) * AKP + 32 * ks + 16 * h);
#pragma unroll
            for (int s = 0; s < 2; ++s)
#pragma unroll
                for (int db = 0; db < 2; ++db) { const LAS unsigned char* vp = Vs + (32 * t + 16 * s + 4 * h + q4) * AKP + (32 * db + 16 * grp + 4 * p4) * 2;
                    const s16x4 lo = vtr(vp), hi = vtr(vp + 8 * AKP); vf[s][db] = __builtin_shufflevector(lo, hi, 0, 1, 2, 3, 4, 5, 6, 7); }
#pragma unroll
            for (int sub = 0; sub < 2; ++sub) {
                if (kind == 1 && 32 * t + 31 < 64 * qh + 32 * sub) continue;
                if (kind == 2 && 32 * t > 64 * qh + 32 * sub + 31) continue;
                f32x16 S;
#pragma unroll
                for (int i = 0; i < 16; ++i) S[i] = 0.f;
#pragma unroll
                for (int ks = 0; ks < 4; ++ks) S = __builtin_amdgcn_mfma_f32_32x32x16_bf16(kf[ks], qf[sub][ks], S, 0, 0, 0);
                if (kind != 0) { const int d0 = dl + 32 * t - 32 * sub;
#pragma unroll
                    for (int i = 0; i < 16; ++i) { const int dd = d0 + (i & 3) + 8 * (i >> 2); const bool ok = kind == 1 ? (dd >= 0) : (dd <= 0); S[i] = ok ? S[i] : -1.0e30f; } }
                float tmax = S[0];
#pragma unroll
                for (int i = 1; i < 16; ++i) tmax = fmaxf(tmax, S[i]);
                tmax = fmaxf(tmax, __shfl_xor(tmax, 32));
                const float mnew = fmaxf(m[sub], tmax);
                if (__any(mnew > m[sub])) { const float alpha = __builtin_amdgcn_exp2f(m[sub] - mnew); l[sub] *= alpha; m[sub] = mnew;
#pragma unroll
                    for (int db = 0; db < 2; ++db)
#pragma unroll
                        for (int i = 0; i < 16; ++i) O[sub][db][i] *= alpha; }
                float ps = 0.f;
#pragma unroll
                for (int i = 0; i < 16; ++i) { S[i] = __builtin_amdgcn_exp2f(S[i] - m[sub]); ps += S[i]; }
                l[sub] += ps;
                u32x4 w0, w1; w0.x = cvtpk(S[0], S[1]); w0.y = cvtpk(S[2], S[3]); w0.z = cvtpk(S[4], S[5]); w0.w = cvtpk(S[6], S[7]);
                w1.x = cvtpk(S[8], S[9]); w1.y = cvtpk(S[10], S[11]); w1.z = cvtpk(S[12], S[13]); w1.w = cvtpk(S[14], S[15]);
                const bf16x8 P0 = __builtin_bit_cast(bf16x8, w0), P1 = __builtin_bit_cast(bf16x8, w1);
#pragma unroll
                for (int db = 0; db < 2; ++db) { O[sub][db] = __builtin_amdgcn_mfma_f32_32x32x16_bf16(vf[0][db], P0, O[sub][db], 0, 0, 0); O[sub][db] = __builtin_amdgcn_mfma_f32_32x32x16_bf16(vf[1][db], P1, O[sub][db], 0, 0, 0); }
            }
        }
    }
#undef ATT_CHUNK
#undef ATT_LOAD
#pragma unroll
    for (int sub = 0; sub < 2; ++sub) { const float lt = l[sub] + __shfl_xor(l[sub], 32), inv = 1.f / lt;
        bf16* op = MIX + (size_t)(qrow0 + 64 * qh + 32 * sub + r) * MIXW + head * 64 + 4 * h;
#pragma unroll
        for (int db = 0; db < 2; ++db)
#pragma unroll
            for (int gq = 0; gq < 4; ++gq) { u32x2 w; w.x = cvtpk(O[sub][db][4 * gq] * inv, O[sub][db][4 * gq + 1] * inv); w.y = cvtpk(O[sub][db][4 * gq + 2] * inv, O[sub][db][4 * gq + 3] * inv);
                *(u32x2*)(op + 32 * db + 8 * gq) = w; } }
}
__device__ __forceinline__ void attn_mfma_phase(Frame& F, const float* sinkl, const bool with_ctx) {
    const bf16* Z = (const bf16*)(F.ws + WS_Z); bf16* MIX = (bf16*)(F.ws + WS_MIX);
    const int vcu = (F.G % 8 == 0) ? (F.bx % 8) * (F.G / 8) + F.bx / 8 : F.bx;
    const int nun = with_ctx ? 272 : 256;
    for (int u = vcu; u < nun; u += F.G) { const bool isctx = u >= 256; const int uu = isctx ? (u - 256) : u;
        attn_unit(F, Z, MIX, sinkl, isctx, isctx ? (uu >> 2) : (uu >> 6), isctx ? ((uu >> 1) & 1) : ((uu >> 5) & 1), isctx ? (uu & 1) : (uu & 31)); }
    __syncthreads();
}

using pg8::Unit;
struct SchedStd {
    const char* A; const char* B; size_t astep, bstep; int nM, nN, G, c, nx, xpm0, xpn;
    __device__ __forceinline__ bool next(int i, Unit& u) const {
        const int L = i * G + c, nwg = nM * nN; if (L >= nwg + nx) return false;
        if (L < nwg) pg8::tile_of(L, nM, nN, u.pm, u.pn); else { u.pm = xpm0 + (L - nwg); u.pn = xpn; }
        u.tag = 0; u.a = A + (size_t)u.pm * astep; u.b = B + (size_t)u.pn * bstep; return true;
    }
};
struct SchedMoe {
    const char* A; const char* B; size_t astep, bstep_e, bstep_n; int NJ, G, c; const int* tile;
    __device__ __forceinline__ bool next(int i, Unit& u) const {
        const int nt = __builtin_amdgcn_readfirstlane(__hip_atomic_load(tile + 200, __ATOMIC_RELAXED, __HIP_MEMORY_SCOPE_AGENT));
        const int L = i * G + c; if (L >= nt * NJ) return false;
        u.pm = L % nt; u.pn = L / nt; u.tag = __builtin_amdgcn_readfirstlane(__hip_atomic_load(tile + u.pm, __ATOMIC_RELAXED, __HIP_MEMORY_SCOPE_AGENT));
        u.a = A + (size_t)u.pm * astep; u.b = B + (size_t)u.tag * bstep_e + (size_t)u.pn * bstep_n; return true;
    }
};

struct EpiIn {
    static constexpr bool PERM = true, MIDHOOK = false;
    bf16* Z; const float* rope;
    __device__ __forceinline__ void operator()(const f32x4 (&acc)[2][2][4][2], const Unit& u, int wr, int wc, int fr, int fq) const {
        const int row0 = u.pm * 256 + wr * 64 + fr, col0 = u.pn * 256 + wc * 32 + 8 * fq;
        const bool latent = u.pm < 64, gate = u.pn >= 11;
        const float sgn = fq < 2 ? -1.f : 1.f;
#pragma unroll
        for (int ai = 0; ai < 2; ++ai)
#pragma unroll
            for (int m = 0; m < 4; ++m) { const int row = row0 + ai * 128 + m * 16; bf16* rowp = Z + (size_t)row * INW + col0;
                const int pos = (wc & 1) ? (16 * m + fr) : (4 * (u.pm & 15) + 2 * ai + wr);
#pragma unroll
                for (int bj = 0; bj < 2; ++bj) { f32x4 v0 = acc[ai][bj][m][0], v1 = acc[ai][bj][m][1];
                    const bool isq = u.pn < 2, isk = (u.pn == 2 && bj == 0);
                    if (isq || isk) {
                        if (latent) {
                            const f32x4* cs = (const f32x4*)(rope + (size_t)(pos * 16 + 8 * (fq & 1)) * 2);
                            const f32x4 t0 = cs[0], t1 = cs[1], t2 = cs[2], t3 = cs[3];
                            f32x4 p0, p1;
                            p0.x = __shfl_xor(v0.x, 32); p0.y = __shfl_xor(v0.y, 32); p0.z = __shfl_xor(v0.z, 32); p0.w = __shfl_xor(v0.w, 32);
                            p1.x = __shfl_xor(v1.x, 32); p1.y = __shfl_xor(v1.y, 32); p1.z = __shfl_xor(v1.z, 32); p1.w = __shfl_xor(v1.w, 32);
                            v0.x = v0.x * t0.x + p0.x * (sgn * t0.y); v0.y = v0.y * t0.z + p0.y * (sgn * t0.w); v0.z = v0.z * t1.x + p0.z * (sgn * t1.y); v0.w = v0.w * t1.z + p0.w * (sgn * t1.w);
                            v1.x = v1.x * t2.x + p1.x * (sgn * t2.y); v1.y = v1.y * t2.z + p1.y * (sgn * t2.w); v1.z = v1.z * t3.x + p1.z * (sgn * t3.y); v1.w = v1.w * t3.z + p1.w * (sgn * t3.w);
                        }
                        if (isq) { v0 = v0 * QSCALE; v1 = v1 * QSCALE; }
                    }
                    if (gate) {
#pragma unroll
                        for (int q = 0; q < 4; ++q) { v0[q] = 1.f / (1.f + __expf(-v0[q])); v1[q] = 1.f / (1.f + __expf(-v1[q])); } }
                    u32x4 w; w.x = pg8::cvt_pk_bf16(v0[0], v0[1]); w.y = pg8::cvt_pk_bf16(v0[2], v0[3]); w.z = pg8::cvt_pk_bf16(v1[0], v1[1]); w.w = pg8::cvt_pk_bf16(v1[2], v1[3]);
                    *(u32x4*)(rowp + bj * 128) = w; } }
    }
};
struct EpiBrG {
    static constexpr bool PERM = true, MIDHOOK = true;
    const bf16* Z; bf16* Y;
    __device__ __forceinline__ void mid(f32x4 (&acc)[2][2][4][2], const Unit& u, int seg, int wr, int wc, int fr, int fq) const {
        const int row0 = u.pm * 256 + wr * 64 + fr, col0 = u.pn * 256 + wc * 32 + 8 * fq;
#pragma unroll
        for (int ai = 0; ai < 2; ++ai)
#pragma unroll
            for (int m = 0; m < 4; ++m) { const bf16* gp = Z + (size_t)(row0 + ai * 128 + m * 16) * INW + ZG + (seg - 1) * D + col0;
#pragma unroll
                for (int bj = 0; bj < 2; ++bj) { const u32x4 ga = *(const u32x4*)(gp + bj * 128), gb = *(const u32x4*)(gp + D + bj * 128);
                    f32x4 r0, r1;
                    r0.x = bflo(ga.x) * __builtin_amdgcn_rcpf(bflo(gb.x)); r0.y = bfhi(ga.x) * __builtin_amdgcn_rcpf(bfhi(gb.x)); r0.z = bflo(ga.y) * __builtin_amdgcn_rcpf(bflo(gb.y)); r0.w = bfhi(ga.y) * __builtin_amdgcn_rcpf(bfhi(gb.y));
                    r1.x = bflo(ga.z) * __builtin_amdgcn_rcpf(bflo(gb.z)); r1.y = bfhi(ga.z) * __builtin_amdgcn_rcpf(bfhi(gb.z)); r1.z = bflo(ga.w) * __builtin_amdgcn_rcpf(bflo(gb.w)); r1.w = bfhi(ga.w) * __builtin_amdgcn_rcpf(bfhi(gb.w));
                    acc[ai][bj][m][0] *= r0; acc[ai][bj][m][1] *= r1; }
                asm volatile("" ::: "memory"); }
    }
    __device__ __forceinline__ void operator()(const f32x4 (&acc)[2][2][4][2], const Unit& u, int wr, int wc, int fr, int fq) const {
        const int row0 = u.pm * 256 + wr * 64 + fr, col0 = u.pn * 256 + wc * 32 + 8 * fq;
#pragma unroll
        for (int ai = 0; ai < 2; ++ai)
#pragma unroll
            for (int m = 0; m < 4; ++m) { const size_t row = (size_t)(row0 + ai * 128 + m * 16); const bf16* gp = Z + row * INW + ZG + 2 * D + col0;
#pragma unroll
                for (int bj = 0; bj < 2; ++bj) { const u32x4 g = *(const u32x4*)(gp + bj * 128); const f32x4 v0 = acc[ai][bj][m][0], v1 = acc[ai][bj][m][1];
                    u32x4 w; w.x = pg8::cvt_pk_bf16(v0[0] * bflo(g.x), v0[1] * bfhi(g.x)); w.y = pg8::cvt_pk_bf16(v0[2] * bflo(g.y), v0[3] * bfhi(g.y));
                    w.z = pg8::cvt_pk_bf16(v1[0] * bflo(g.z), v1[1] * bfhi(g.z)); w.w = pg8::cvt_pk_bf16(v1[2] * bflo(g.w), v1[3] * bfhi(g.w));
                    *(u32x4*)(Y + row * D + col0 + bj * 128) = w; } }
    }
};
struct EpiRes {
    static constexpr bool PERM = false, MIDHOOK = false;
    const float* rl; const float* rc; float* out; const float* gv;
    __device__ __forceinline__ void operator()(const f32x4 (&acc)[2][2][4][2], const Unit& u, int wr, int wc, int fr, int fq) const {
        const int row0 = u.pm * 256 + wr * 64 + fr, col0 = u.pn * 256 + wc * 32 + 4 * fq;
        const int bidx = u.pm < 64 ? (u.pm >> 4) : 4; const float* g = gv + (size_t)bidx * MODW;
        const float* rbase = u.pm < 64 ? rl : rc - (size_t)ML * D;
        f32x4 gg[2][2];
#pragma unroll
        for (int bj = 0; bj < 2; ++bj)
#pragma unroll
            for (int n = 0; n < 2; ++n) gg[bj][n] = *(const f32x4*)(g + col0 + bj * 128 + n * 16);
#pragma unroll
        for (int ai = 0; ai < 2; ++ai)
#pragma unroll
            for (int m = 0; m < 4; ++m) { const size_t off = (size_t)(row0 + ai * 128 + m * 16) * D + col0;
#pragma unroll
                for (int bj = 0; bj < 2; ++bj)
#pragma unroll
                    for (int n = 0; n < 2; ++n) *(f32x4*)(out + off + bj * 128 + n * 16) = *(const f32x4*)(rbase + off + bj * 128 + n * 16) + gg[bj][n] * acc[ai][bj][m][n]; }
    }
};
template <bool F8> struct EpiSwiglu {
    static constexpr bool PERM = true, MIDHOOK = false;
    unsigned char* ACT; int ldc;
    __device__ __forceinline__ void operator()(const f32x4 (&acc)[2][2][4][2], const Unit& u, int wr, int wc, int fr, int fq) const {
        const int row0 = u.pm * 256 + wr * 64 + fr, col0 = u.pn * 128 + wc * 32 + 8 * fq;
#pragma unroll
        for (int ai = 0; ai < 2; ++ai)
#pragma unroll
            for (int m = 0; m < 4; ++m) { f32x4 r[2];
#pragma unroll
                for (int n = 0; n < 2; ++n) { const f32x4 g = acc[ai][0][m][n], up = acc[ai][1][m][n];
#pragma unroll
                    for (int q = 0; q < 4; ++q) r[n][q] = g[q] / (1.f + __expf(-g[q])) * up[q]; }
                if constexpr (F8) { u32x2 w; w.x = pk4_fp8(r[0][0], r[0][1], r[0][2], r[0][3]); w.y = pk4_fp8(r[1][0], r[1][1], r[1][2], r[1][3]);
                    *(u32x2*)(ACT + (size_t)(row0 + ai * 128 + m * 16) * ldc + col0) = w; }
                else { u32x4 w; w.x = pg8::cvt_pk_bf16(r[0][0], r[0][1]); w.y = pg8::cvt_pk_bf16(r[0][2], r[0][3]); w.z = pg8::cvt_pk_bf16(r[1][0], r[1][1]); w.w = pg8::cvt_pk_bf16(r[1][2], r[1][3]);
                    *(u32x4*)((bf16*)ACT + (size_t)(row0 + ai * 128 + m * 16) * ldc + col0) = w; } }
    }
};
struct EpiPlain {
    static constexpr bool PERM = true, MIDHOOK = false;
    bf16* O; int ldc;
    __device__ __forceinline__ void operator()(const f32x4 (&acc)[2][2][4][2], const Unit& u, int wr, int wc, int fr, int fq) const {
        const int row0 = u.pm * 256 + wr * 64 + fr, col0 = u.pn * 256 + wc * 32 + 8 * fq;
#pragma unroll
        for (int ai = 0; ai < 2; ++ai)
#pragma unroll
            for (int m = 0; m < 4; ++m)
#pragma unroll
                for (int bj = 0; bj < 2; ++bj) { const f32x4 v0 = acc[ai][bj][m][0], v1 = acc[ai][bj][m][1];
                    u32x4 w; w.x = pg8::cvt_pk_bf16(v0[0], v0[1]); w.y = pg8::cvt_pk_bf16(v0[2], v0[3]); w.z = pg8::cvt_pk_bf16(v1[0], v1[1]); w.w = pg8::cvt_pk_bf16(v1[2], v1[3]);
                    *(u32x4*)(O + (size_t)(row0 + ai * 128 + m * 16) * ldc + col0 + bj * 128) = w; }
    }
};

#ifndef PHASE_MASK
#define PHASE_MASK 0xFFFFFFFFu
#endif
#define IN(k) (((PHASE_MASK >> (k)) & 1u) && lo <= (k) && (k) < hi)
#define SEAM(k) do { if (IN(k) && IN((k) + 1)) xcd_barrier(bar); } while (0)
#ifndef DUP_MASK
#define DUP_MASK 0u
#endif
#define REP(k) for (int rep_ = 0; rep_ < (((DUP_MASK >> (k)) & 1u) ? 2 : 1); ++rep_, (((DUP_MASK >> (k)) & 1u) && rep_ == 1 ? xcd_barrier(bar) : (void)0))
#define SITE() do { F.ws = (unsigned char*)karg_p<(int)__builtin_offsetof(Args, ws)>(); int t_ = threadIdx.x; asm volatile("" : "+v"(t_)); F.tid = t_; F.lane = t_ & 63; } while (0)
template <int l> __device__ __forceinline__ void layer_common(Frame& F, const int lo, const int hi, const XcdBarrier& bar, LAS unsigned char* ring) {
    constexpr int pb = 1 + 8 * l;
        if (IN(pb + 0)) REP(pb + 0) { SITE(); const float* modl = (const float*)(F.ws + WS_MODV) + (size_t)l * 5 * MODW; const float* X2 = (const float*)(F.ws + WS_X2);
            const float* xl = l == 0 ? KP(x) : X2; const float* xc = l == 0 ? KP(ctx) : X2 + (size_t)ML * D;
            norm_mod_phase<false>(F, xl, xc, KP(norm1_g) + l * D, modl, 0, 1, MT, nullptr); } SEAM(pb + 0);
        if (IN(pb + 1)) REP(pb + 1) { SITE();
            SchedStd S{(const char*)(F.ws + WS_H), (const char*)(F.ws + WS_WIN) + (size_t)l * INW * D * 2, (size_t)256 * D * 2, (size_t)256 * D * 2, l == 0 ? 68 : 64, 23, F.G, F.bx, l == 0 ? 0 : 4, 64, 2};
            EpiIn E{(bf16*)(F.ws + WS_Z), (const float*)(F.ws + WS_ROPE)};
            pg8::gemm_phase<EpiIn, SchedStd, true, true>(ring, D * 2, D * 2, D * 2, S, E);
        } SEAM(pb + 1);
        if (IN(pb + 2)) REP(pb + 2) { SITE(); const int nrows = l == 0 ? MT : ML; if (ATTN_NAIVE) attn_naive_phase(F, KP(sink) + l * 8, nrows); else attn_mfma_phase(F, KP(sink) + l * 8, l == 0); local_mix_phase(F, KP(conv_w) + (size_t)l * 3 * 512, nrows); } SEAM(pb + 2);
        if (IN(pb + 3)) REP(pb + 3) { SITE();
            SchedStd S{(const char*)(F.ws + WS_MIX), (const char*)(F.ws + WS_WBR) + (size_t)l * D * MIXW * 2, (size_t)256 * MIXW * 2, (size_t)256 * MIXW * 2, l == 0 ? 68 : 64, 4, F.G, F.bx, 0, 0, 0};
            EpiBrG E{(const bf16*)(F.ws + WS_Z), (bf16*)(F.ws + WS_Y)};
            pg8::gemm_phase<EpiBrG, SchedStd, true, true>(ring, MIXW * 2, MIXW * 2, MIXW * 2, S, E);
        } SEAM(pb + 3);
        if (IN(pb + 4)) REP(pb + 4) { SITE(); const float* modl = (const float*)(F.ws + WS_MODV) + (size_t)l * 5 * MODW; const float* X2 = (const float*)(F.ws + WS_X2);
            const float* xl = l == 0 ? KP(x) : X2; const float* xc = l == 0 ? KP(ctx) : X2 + (size_t)ML * D;
            SchedStd S{(const char*)(F.ws + WS_Y), (const char*)(F.ws + WS_WOUT) + (size_t)l * D * D * 2, (size_t)256 * D * 2, (size_t)256 * D * 2, l == 0 ? 68 : 64, 4, F.G, F.bx, 0, 0, 0};
            EpiRes E{xl, xc, (float*)(F.ws + WS_X1), modl + 2 * D};
            pg8::gemm_phase<EpiRes, SchedStd, true, true>(ring, D * 2, D * 2, D * 2, S, E);
        } SEAM(pb + 4);
}
constexpr int N_PHASES = 19;
__global__ void __launch_bounds__(NTHR, 2) mk_fwd(Args args_byval) {
    extern __shared__ __attribute__((aligned(16))) unsigned char lds_raw[];
    Frame F;
    F.lds = (LAS unsigned char*)lds_raw;
    F.tid = threadIdx.x; F.lane = F.tid & 63; F.wave = __builtin_amdgcn_readfirstlane(F.tid >> 6);
    F.G = gridDim.x; F.bx = blockIdx.x;
    SITE();
    volatile LAS unsigned* MISC = (volatile LAS unsigned*)(F.lds + MISC_OFF);
    for (int u = F.tid; u < (LDS_BYTES - LDSCTL_OFF) / 4; u += NTHR) ((LAS unsigned*)(F.lds + LDSCTL_OFF))[u] = 0u;
    __syncthreads();
    const int lo = karg_i<(int)__builtin_offsetof(Args, ph_lo)>(), hi = karg_i<(int)__builtin_offsetof(Args, ph_hi)>();
    const bool fused = (hi - lo) > 1;
    XcdBarrier bar; bar.bar = (unsigned*)(F.ws + WS_CTL) + CW_BAR; bar.x = 0; bar.st = nullptr;
    if (fused) bar = xcd_barrier_post((unsigned*)(F.ws + WS_CTL) + CW_BAR, MISC + 8);
    LAS unsigned char* ring = F.lds;

    if (IN(0)) REP(0) { SITE(); p0_prologue(F); } SEAM(0);

    layer_common<0>(F, lo, hi, bar, ring);
    {
            if (IN(6)) REP(6) { SITE(); const float* X1 = (const float*)(F.ws + WS_X1); norm_mod_phase<false, FFN0_FP8 != 0>(F, X1, X1 + (size_t)ML * D, KP(norm2_g), (const float*)(F.ws + WS_MODV), 3, 4, MT, nullptr); } SEAM(6);
            if (IN(7)) REP(7) { SITE();
                constexpr int EB = FFN0_FP8 ? 1 : 2;
                SchedStd S{(const char*)(F.ws + WS_H), (const char*)(F.ws + WS_WGU0), (size_t)256 * D * EB, (size_t)256 * D * EB, 68, 22, F.G, F.bx, 0, 0, 0};
                EpiSwiglu<FFN0_FP8 != 0> E{(unsigned char*)(F.ws + WS_ACT), DFF};
                pg8::gemm_phase<EpiSwiglu<FFN0_FP8 != 0>, SchedStd, true, true, FFN0_FP8 != 0>(ring, D * EB, D * EB, D * EB, S, E);
            } SEAM(7);
            if (IN(8)) REP(8) { SITE(); const float* X1 = (const float*)(F.ws + WS_X1);
                constexpr int EB = FFN0_FP8 ? 1 : 2;
                SchedStd S{(const char*)(F.ws + WS_ACT), (const char*)(F.ws + WS_WDN0), (size_t)256 * DFF * EB, (size_t)256 * DFF * EB, 68, 4, F.G, F.bx, 0, 0, 0};
                EpiRes E{X1, X1 + (size_t)ML * D, (float*)(F.ws + WS_X2), (const float*)(F.ws + WS_MODV) + 5 * D};
                pg8::gemm_phase<EpiRes, SchedStd, true, true, FFN0_FP8 != 0>(ring, DFF * EB, DFF * EB, DFF * EB, S, E);
            } SEAM(8);
    }
    layer_common<1>(F, lo, hi, bar, ring);
    {
            if (IN(14)) REP(14) { SITE(); const float* X1 = (const float*)(F.ws + WS_X1); norm_mod_phase<true, true>(F, X1, X1, KP(norm2_g) + D, (const float*)(F.ws + WS_MODV) + (size_t)5 * MODW, 3, 4, ML, KP(router_w)); } SEAM(14);
            if (IN(15)) REP(15) { SITE(); moe_scatter_phase(F); } SEAM(15);
            if (IN(16)) REP(16) { SITE();
                SchedMoe S{(const char*)(F.ws + WS_H2S), (const char*)(F.ws + WS_WMGU), (size_t)256 * D, (size_t)2 * DFE * D, (size_t)256 * D, 28, F.G, F.bx, (const int*)(F.ws + WS_TILE)};
                EpiSwiglu<true> E{(unsigned char*)(F.ws + WS_ACT), DFE};
                pg8::gemm_phase<EpiSwiglu<true>, SchedMoe, true, true, true>(ring, D, D, D, S, E);
            } SEAM(16);
            if (IN(17)) REP(17) { SITE();
                SchedMoe S{(const char*)(F.ws + WS_ACT), (const char*)(F.ws + WS_WMDN), (size_t)256 * DFE, (size_t)D * DFE, (size_t)256 * DFE, 4, F.G, F.bx, (const int*)(F.ws + WS_TILE)};
                EpiPlain E{(bf16*)(F.ws + WS_YS), D};
                pg8::gemm_phase<EpiPlain, SchedMoe, true, true, true>(ring, DFE, DFE, DFE, S, E);
            } SEAM(17);
            if (IN(18)) REP(18) { SITE(); final_phase(F, KP(final_g), (float*)karg_p<(int)__builtin_offsetof(Args, out)>(), (const float*)(F.ws + WS_MODV) + (size_t)5 * MODW); }
        }

#undef IN
#undef SEAM
}

extern "C" void kernel_launch(void* const* d_in, const int* in_sizes, int n_in, void* d_out, int out_size, void* d_ws, size_t ws_size, hipStream_t stream) {
    static int grid = 0;
    if (grid == 0) {
        if (n_in != 21 || out_size != ML * D || ws_size < WS_END) { fprintf(stderr, "kernel_launch: unexpected sizes (n_in %d, out %d, ws %zu < %zu)\n", n_in, out_size, ws_size, (size_t)WS_END); grid = -1; return; }
        int dev = 0, cus = 0, per_cu = 0;
        if (hipGetDevice(&dev) != hipSuccess || hipDeviceGetAttribute(&cus, hipDeviceAttributeMultiprocessorCount, dev) != hipSuccess) { grid = -1; return; }
        if (hipFuncSetAttribute((const void*)mk_fwd, hipFuncAttributeMaxDynamicSharedMemorySize, LDS_BYTES) != hipSuccess) { fprintf(stderr, "kernel_launch: hipFuncSetAttribute failed\n"); grid = -1; return; }
        if (hipOccupancyMaxActiveBlocksPerMultiprocessor(&per_cu, (const void*)mk_fwd, NTHR, LDS_BYTES) != hipSuccess || per_cu < 1) { fprintf(stderr, "kernel_launch: occupancy query says %d\n", per_cu); per_cu = 1; }
        (void)hipGetLastError();
        grid = cus;
    }
    if (grid < 0) return;
    (void)hipMemsetAsync((char*)d_ws + WS_CTL, 0, CTL_ZERO_BYTES, stream);
    Args a{};
    const float** pp = (const float**)&a;
    for (int i = 0; i < 21; ++i) pp[i] = (const float*)d_in[i];
    a.out = (float*)d_out; a.ws = (unsigned char*)d_ws;
#if MK_FUSED
    a.ph_lo = 0; a.ph_hi = N_PHASES;
    hipLaunchKernelGGL(mk_fwd, dim3(grid), dim3(NTHR), LDS_BYTES, stream, a);
#else
    for (int p = 0; p < N_PHASES; ++p) { a.ph_lo = p; a.ph_hi = p + 1; hipLaunchKernelGGL(mk_fwd, dim3(grid), dim3(NTHR), LDS_BYTES, stream, a); }
#endif
}
```

```cpp
#include <hip/hip_runtime.h>
#include <cstdio>
#include <cstdint>

#ifndef ATTN_NAIVE
#define ATTN_NAIVE 0
#endif
#ifndef FFN0_FP8
#define FFN0_FP8 0
#endif
#ifndef MK_FUSED
#define MK_FUSED 1
#endif

#define LAS __attribute__((address_space(3)))
#define GAS __attribute__((address_space(1)))
typedef unsigned short bf16;
typedef short bf16x8 __attribute__((ext_vector_type(8)));
typedef float f32x4 __attribute__((ext_vector_type(4)));
typedef float f32x2 __attribute__((ext_vector_type(2)));
typedef unsigned u32x4 __attribute__((ext_vector_type(4)));
typedef unsigned u32x2 __attribute__((ext_vector_type(2)));
typedef GAS unsigned gu32;

constexpr int D = 1024, NB = 4, SEQ = 4096, ML = NB * SEQ, CTXL = 256, MC = NB * CTXL, MT = ML + MC;
constexpr int INW = 5888, DFF = 2816, DFE = 3584, NE = 8;
constexpr int ZQ = 0, ZK = 512, ZV = 640, ZCX = 768, ZCB = 1280, ZCC = 1792, ZPU = 2304, ZG = 2816;
constexpr int MIXW = 1536;
constexpr int MS = 2 * ML + NE * 256;
constexpr int MODW = 6 * D;
constexpr float EPS = 1e-6f;
constexpr float LOG2E = 1.4426950408889634f, QSCALE = 0.125f * LOG2E;
constexpr int NWAVES = 8, NTHR = 512;

__device__ __forceinline__ unsigned f2bf(float f) { unsigned u = __builtin_bit_cast(unsigned, f); return (u + 0x7fffu + ((u >> 16) & 1u)) >> 16; }
__device__ __forceinline__ unsigned pk2(float lo, float hi) { return f2bf(lo) | (f2bf(hi) << 16); }
__device__ __forceinline__ float bf2f(unsigned b) { return __builtin_bit_cast(float, b << 16); }
__device__ __forceinline__ unsigned pk4_fp8(float a, float b, float c, float d) { int w = 0; w = __builtin_amdgcn_cvt_pk_fp8_f32(a, b, w, false); w = __builtin_amdgcn_cvt_pk_fp8_f32(c, d, w, true); return (unsigned)w; }
constexpr float W8SCALE = 256.0f;
__device__ __forceinline__ float bflo(unsigned w) { return __builtin_bit_cast(float, w << 16); }
__device__ __forceinline__ float bfhi(unsigned w) { return __builtin_bit_cast(float, w & 0xffff0000u); }

namespace pg8 {
constexpr int BM = 256, BK = 64, HALF = 128, HTB = HALF * BK * 2, STAGE_BYTES = 8 * HTB, NXCD = 8, WGM = 8;
__host__ __device__ __forceinline__ int lds_byte(int r, int c) { const int st = (r >> 4) * 2 + (c >> 5), rr = r & 15, cc = c & 31, ob = rr * 64 + cc * 2; return st * 1024 + (ob ^ (((ob >> 9) & 1) << 5)); }
__host__ __device__ __forceinline__ void stage_rc(int b, int& R, int& C) { const int st = b / 1024, sb = b % 1024, swz = sb ^ (((sb >> 9) & 1) << 5); R = (st >> 1) * 16 + swz / 64; C = (st & 1) * 32 + (swz % 64) / 2; }
__host__ __device__ __forceinline__ int perm32(int rho) { const int n = rho >> 4, i = rho & 15; return 8 * (i >> 2) + 4 * n + (i & 3); }

struct Unit { int pm, pn, tag; const char* a; const char* b; };

__device__ __forceinline__ void tile_of(int L, int nM, int nN, int& pm, int& pn) {
    const int nwg = nM * nN; int wgid = L;
    { const int q = nwg / NXCD, r = nwg % NXCD, xcd = wgid % NXCD, off = wgid / NXCD; wgid = (xcd < r ? xcd * (q + 1) : r * (q + 1) + (xcd - r) * q) + off; }
    const int nig = WGM * nN, gid = wgid / nig, fm = gid * WGM, gsz = (nM - fm) < WGM ? (nM - fm) : WGM;
    pm = fm + ((wgid % nig) % gsz); pn = (wgid % nig) / gsz;
}

typedef __bf16 bf16x2_t __attribute__((ext_vector_type(2)));
__device__ __forceinline__ unsigned cvt_pk_bf16(float lo, float hi) { f32x2 v = {lo, hi}; bf16x2_t b = __builtin_convertvector(v, bf16x2_t); return __builtin_bit_cast(unsigned, b); }

typedef int i32x8 __attribute__((ext_vector_type(8)));
typedef int i32x4 __attribute__((ext_vector_type(4)));
template <class Epi, class Sched, bool ALIGN_EPI = false, bool SP2 = false, bool FP8 = false>
__device__ __forceinline__ void gemm_phase(LAS unsigned char* lds, const int lda, const int ldb, const int K, const Sched& S, const Epi& E) {
    int tid_ = threadIdx.x; asm volatile("" : "+v"(tid_));
    const int tid = tid_, wid = __builtin_amdgcn_readfirstlane(tid >> 6), lane = tid & 63, wr = wid >> 2, wc = wid & 3, fr = lane & 15, fq = lane >> 4;
    const int nt = K / 128;
    unsigned voffA[2], voffB[2];
#pragma unroll
    for (int i = 0; i < 2; ++i) { int R, C; stage_rc(tid * 16 + i * 8192, R, C); const int Rb = Epi::PERM ? ((R & ~31) + perm32(R & 31)) : R;
        voffA[i] = (unsigned)(R * lda + C * 2); voffB[i] = (unsigned)(Rb * ldb + C * 2); }
    const size_t kstep = (size_t)(BK * 2);
    const size_t hstepA = (size_t)HALF * lda, hstepB = (size_t)HALF * ldb;
    const unsigned ldsw = (unsigned)wid * 1024u;
    const int aoff = lds_byte(wr * 64 + fr, fq * 8), boff = lds_byte(wc * 32 + fr, fq * 8);
#define PG8_SA(b, h) (((b) * 2 + (h)) * HTB)
#define PG8_SB(b, h) ((4 + (b) * 2 + (h)) * HTB)
#define PG8_STAGE(bufoff, gbase, voff) do { _Pragma("unroll") for (int _i = 0; _i < 2; ++_i) \
        __builtin_amdgcn_global_load_lds((const unsigned*)((const char*)(gbase) + (voff)[_i]), (LAS unsigned*)(lds + (bufoff) + ldsw + _i * 8192), 16, 0, 0); } while (0)
#define PG8_RD(off) __builtin_bit_cast(i32x4, *(const LAS bf16x8*)(lds + (off)))
#define PG8_LDA(dst, b, h) do { _Pragma("unroll") for (int m = 0; m < 4; ++m) dst[m] = __builtin_shufflevector(PG8_RD(PG8_SA(b, h) + aoff + m * 2048), PG8_RD(PG8_SA(b, h) + aoff + m * 2048 + 1024), 0, 1, 2, 3, 4, 5, 6, 7); } while (0)
#define PG8_LDB(dst, b, h) do { _Pragma("unroll") for (int n = 0; n < 2; ++n) dst[n] = __builtin_shufflevector(PG8_RD(PG8_SB(b, h) + boff + n * 2048), PG8_RD(PG8_SB(b, h) + boff + n * 2048 + 1024), 0, 1, 2, 3, 4, 5, 6, 7); } while (0)
#define PG8_LO(x) __builtin_bit_cast(bf16x8, __builtin_shufflevector((x), (x), 0, 1, 2, 3))
#define PG8_HI(x) __builtin_bit_cast(bf16x8, __builtin_shufflevector((x), (x), 4, 5, 6, 7))
#define PG8_MMA(ai, bj, At, Bt) do { __builtin_amdgcn_s_setprio(1); _Pragma("unroll") for (int m = 0; m < 4; ++m) _Pragma("unroll") for (int n = 0; n < 2; ++n) { \
        if constexpr (FP8) asm volatile("s_nop 1\n\tv_mfma_scale_f32_16x16x128_f8f6f4 %0, %1, %2, %0, %3, %4 op_sel_hi:[0,0,0]" : "+v"(acc[ai][bj][m][n]) : "v"(Bt[n]), "v"(At[m]), "v"(sc_w), "v"(sc_a)); \
        else { acc[ai][bj][m][n] = __builtin_amdgcn_mfma_f32_16x16x32_bf16(PG8_LO(Bt[n]), PG8_LO(At[m]), acc[ai][bj][m][n], 0, 0, 0); \
               acc[ai][bj][m][n] = __builtin_amdgcn_mfma_f32_16x16x32_bf16(PG8_HI(Bt[n]), PG8_HI(At[m]), acc[ai][bj][m][n], 0, 0, 0); } } __builtin_amdgcn_s_setprio(0); } while (0)
#define PG8_WAIT_V(n) asm volatile("s_waitcnt vmcnt(" #n ")" ::: "memory")
#define PG8_WAIT_L(n) asm volatile("s_waitcnt lgkmcnt(" #n ")" ::: "memory")
#define PG8_BAR __builtin_amdgcn_s_barrier()
#define PG8_SCHED __builtin_amdgcn_sched_barrier(0)
    Unit cur, nxt; int ui = 0;
    if (!S.next(0, cur)) return;
    f32x4 acc[2][2][4][2];
#pragma unroll
    for (int a = 0; a < 2; ++a)
#pragma unroll
        for (int b = 0; b < 2; ++b)
#pragma unroll
            for (int m = 0; m < 4; ++m)
#pragma unroll
                for (int n = 0; n < 2; ++n) acc[a][b][m][n] = (f32x4){0.f, 0.f, 0.f, 0.f};
    i32x8 At[4], B0[2], B1[2];
    const int sc_w = 0x77777777, sc_a = 0x7f7f7f7f;
    const char* cA = cur.a; const char* cB = cur.b;
    if constexpr (SP2) {
        PG8_STAGE(PG8_SB(0, 0), cB, voffB); PG8_STAGE(PG8_SB(0, 1), cB + hstepB, voffB); PG8_STAGE(PG8_SA(0, 0), cA, voffA); PG8_STAGE(PG8_SA(0, 1), cA + hstepA, voffA);
        if (wr == 1) PG8_BAR;
        PG8_WAIT_V(2); PG8_BAR;
        PG8_STAGE(PG8_SB(1, 0), cB + kstep, voffB); PG8_STAGE(PG8_SA(1, 0), cA + kstep, voffA); PG8_STAGE(PG8_SB(1, 1), cB + hstepB + kstep, voffB);
        PG8_WAIT_V(6); PG8_BAR;
    } else {
        PG8_STAGE(PG8_SB(0, 0), cB, voffB); PG8_STAGE(PG8_SA(0, 0), cA, voffA); PG8_STAGE(PG8_SB(0, 1), cB + hstepB, voffB); PG8_STAGE(PG8_SA(0, 1), cA + hstepA, voffA);
        if (wr == 1) PG8_BAR;
        PG8_WAIT_V(4); PG8_BAR;
        PG8_STAGE(PG8_SB(1, 0), cB + kstep, voffB); PG8_STAGE(PG8_SA(1, 0), cA + kstep, voffA); PG8_STAGE(PG8_SB(1, 1), cB + hstepB + kstep, voffB);
        PG8_WAIT_V(6); PG8_BAR;
    }
    for (;;) {
        const bool has_next = S.next(ui + 1, nxt);
        const char* nA = has_next ? nxt.a : cA; const char* nB = has_next ? nxt.b : cB;
        for (int t = 0; t < nt; t += 2) {
            const bool last = (t == nt - 2);
            const char* a1 = cA + (size_t)(t + 1) * kstep;
            const char* a2 = last ? nA : cA + (size_t)(t + 2) * kstep; const char* b2 = last ? nB : cB + (size_t)(t + 2) * kstep;
            const char* a3 = a2 + kstep; const char* b3 = b2 + kstep;
            if constexpr (SP2) {
            PG8_LDB(B0, 0, 0); PG8_LDB(B1, 0, 1); PG8_SCHED; PG8_LDA(At, 0, 0); PG8_STAGE(PG8_SA(1, 1), a1 + hstepA, voffA);
            PG8_WAIT_V(8); PG8_WAIT_L(0); PG8_BAR; PG8_MMA(0, 0, At, B0); PG8_MMA(0, 1, At, B1); PG8_BAR; PG8_SCHED;
            PG8_LDA(At, 0, 1); PG8_STAGE(PG8_SB(0, 0), b2, voffB); PG8_STAGE(PG8_SB(0, 1), b2 + hstepB, voffB); PG8_STAGE(PG8_SA(0, 0), a2, voffA);
            PG8_WAIT_V(8); PG8_WAIT_L(0); PG8_BAR; PG8_MMA(1, 0, At, B0); PG8_MMA(1, 1, At, B1); PG8_BAR; PG8_SCHED;
            PG8_LDB(B0, 1, 0); PG8_LDB(B1, 1, 1); PG8_SCHED; PG8_LDA(At, 1, 0); PG8_STAGE(PG8_SA(0, 1), a2 + hstepA, voffA);
            PG8_WAIT_V(8); PG8_WAIT_L(0); PG8_BAR; PG8_MMA(0, 0, At, B0); PG8_MMA(0, 1, At, B1); PG8_BAR; PG8_SCHED;
            PG8_LDA(At, 1, 1); PG8_STAGE(PG8_SB(1, 0), b3, voffB); PG8_STAGE(PG8_SB(1, 1), b3 + hstepB, voffB); PG8_STAGE(PG8_SA(1, 0), a3, voffA);
            PG8_WAIT_V(8); PG8_WAIT_L(0); PG8_BAR; PG8_MMA(1, 0, At, B0); PG8_MMA(1, 1, At, B1); PG8_BAR; PG8_SCHED;
            } else {
            PG8_LDB(B0, 0, 0); PG8_SCHED; PG8_LDA(At, 0, 0); PG8_STAGE(PG8_SA(1, 1), a1 + hstepA, voffA);
            PG8_WAIT_L(8); PG8_BAR; PG8_WAIT_L(0); PG8_MMA(0, 0, At, B0); PG8_BAR; PG8_SCHED;
            PG8_LDB(B1, 0, 1); PG8_STAGE(PG8_SB(0, 0), b2, voffB);
            PG8_BAR; PG8_WAIT_L(0); PG8_MMA(0, 1, At, B1); PG8_BAR;
            PG8_LDA(At, 0, 1); PG8_STAGE(PG8_SA(0, 0), a2, voffA);
            PG8_BAR; PG8_WAIT_L(0); PG8_MMA(1, 0, At, B0); PG8_BAR; PG8_SCHED;
            PG8_STAGE(PG8_SB(0, 1), b2 + hstepB, voffB);
            PG8_WAIT_V(6); PG8_BAR; PG8_MMA(1, 1, At, B1); PG8_BAR;
            PG8_LDB(B0, 1, 0); PG8_SCHED; PG8_LDA(At, 1, 0); PG8_STAGE(PG8_SA(0, 1), a2 + hstepA, voffA);
            PG8_WAIT_L(8); PG8_BAR; PG8_WAIT_L(0); PG8_MMA(0, 0, At, B0); PG8_BAR; PG8_SCHED;
            PG8_LDB(B1, 1, 1); PG8_STAGE(PG8_SB(1, 0), b3, voffB);
            PG8_BAR; PG8_WAIT_L(0); PG8_MMA(0, 1, At, B1); PG8_BAR;
            PG8_LDA(At, 1, 1); PG8_STAGE(PG8_SA(1, 0), a3, voffA);
            PG8_BAR; PG8_WAIT_L(0); PG8_MMA(1, 0, At, B0); PG8_BAR; PG8_SCHED;
            PG8_STAGE(PG8_SB(1, 1), b3 + hstepB, voffB);
            PG8_WAIT_V(6); PG8_BAR; PG8_MMA(1, 1, At, B1); PG8_BAR;
            }
            if constexpr (Epi::MIDHOOK) { if (((t + 2) & 7) == 0 && !last) { int fr_ = fr, fq_ = fq; asm volatile("" : "+v"(fr_), "+v"(fq_)); E.mid(acc, cur, (t + 2) >> 3, wr, wc, fr_, fq_); } }
        }
        if constexpr (ALIGN_EPI) { if (wr == 0) PG8_BAR; }
        if constexpr (FP8) asm volatile("s_nop 15\n\ts_nop 15" ::: "memory");
        { int fr_ = fr, fq_ = fq; asm volatile("" : "+v"(fr_), "+v"(fq_));
          E(acc, cur, wr, wc, fr_, fq_); }
        if (!has_next) break;
#pragma unroll
        for (int a = 0; a < 2; ++a)
#pragma unroll
            for (int b = 0; b < 2; ++b)
#pragma unroll
                for (int m = 0; m < 4; ++m)
#pragma unroll
                    for (int n = 0; n < 2; ++n) acc[a][b][m][n] = (f32x4){0.f, 0.f, 0.f, 0.f};
        cur = nxt; cA = nA; cB = nB; ++ui;
        if constexpr (ALIGN_EPI) { if (wr == 1) PG8_BAR; }
    }
    PG8_WAIT_V(0);
    if constexpr (!ALIGN_EPI) { if (wr == 0) PG8_BAR; }
    PG8_BAR;
#undef PG8_SA
#undef PG8_SB
#undef PG8_STAGE
#undef PG8_LDA
#undef PG8_LDB
#undef PG8_MMA
#undef PG8_RD
#undef PG8_LO
#undef PG8_HI
#undef PG8_WAIT_V
#undef PG8_WAIT_L
#undef PG8_BAR
#undef PG8_SCHED
}
}

constexpr size_t MiB = 1u << 20;
constexpr size_t al256(size_t x) { return (x + 255) & ~(size_t)255; }
constexpr size_t WS_CTL = 0, CTL_ZERO_BYTES = 1 * MiB;
constexpr size_t WS_MODV = 1 * MiB;
constexpr size_t WS_ROPE = WS_MODV + al256((size_t)2 * 5 * MODW * 4);
constexpr size_t WS_CNTWG = WS_ROPE + al256(64 * 16 * 2 * 4);
constexpr size_t WS_TOKE = WS_CNTWG + al256(256 * 8 * 4);
constexpr size_t WS_TOKP = WS_TOKE + al256((size_t)ML * 2 * 4);
constexpr size_t WS_TOKW = WS_TOKP + al256((size_t)ML * 2 * 4);
constexpr size_t WS_TOKS = WS_TOKW + al256((size_t)ML * 2 * 4);
constexpr size_t WS_TILE = WS_TOKS + al256((size_t)ML * 2 * 4);
constexpr size_t WS_WIN = 4 * MiB;
constexpr size_t WS_WBR = WS_WIN + (size_t)2 * INW * D * 2;
constexpr size_t WS_WOUT = WS_WBR + (size_t)2 * 3 * D * 512 * 2;
constexpr size_t WS_WGU0 = WS_WOUT + (size_t)2 * D * D * 2;
constexpr size_t WS_WDN0 = WS_WGU0 + (size_t)2 * DFF * D * 2;
constexpr size_t WS_WMGU = WS_WDN0 + (size_t)D * DFF * 2;
constexpr size_t WS_WMDN = WS_WMGU + (size_t)NE * 2 * DFE * D * 2;
constexpr size_t WS_H = WS_WMDN + (size_t)NE * D * DFE * 2;
constexpr size_t WS_Z = WS_H + (size_t)MT * D * 2;
constexpr size_t WS_MIX = WS_Z + (size_t)MT * INW * 2;
constexpr size_t WS_ACT = WS_Z;
constexpr size_t WS_YACC = WS_MIX + (size_t)MT * MIXW * 2;
constexpr size_t WS_H2S = WS_YACC;
constexpr size_t WS_Y = WS_YACC + (size_t)MT * D * 4;
constexpr size_t WS_X1 = WS_Y + (size_t)MT * D * 2;
constexpr size_t WS_X2 = WS_X1 + (size_t)MT * D * 4;
constexpr size_t WS_YS = WS_X2;
constexpr size_t WS_H8 = WS_X2 + (size_t)MT * D * 4;
constexpr size_t WS_WIN8 = WS_H8 + (size_t)MT * D;
constexpr size_t WS_END = WS_WIN8 + (size_t)2 * 3 * D * D;
static_assert((size_t)MS * DFE * 2 <= (size_t)MT * INW * 2 + (size_t)MT * MIXW * 2, "ACT overlay");
static_assert((size_t)MS * D * 2 <= (size_t)MT * D * 4, "H2S / YS overlays");
static_assert(WS_TILE + 1024 <= WS_WIN, "small tables");
constexpr int CW_BAR = 4096;

constexpr int RING_BYTES = 131072;
constexpr int LDSCTL_OFF = 146944, MISC_OFF = LDSCTL_OFF + 320;
constexpr int LDS_BYTES = 147456;

#define XB_TMO      128
#define XB_XCNT(j)  (256  + 64 * (j))
#define XB_XSUB(j)  (1280 + 64 * (j))
#define XB_XGEN(j)  (2304 + 64 * (j))
#define XB_TOP      3328
#define XB_TOPGEN   3392
#define XCD_BAR_WORDS 3456
#define XB_SPIN_CAP (1u << 18)
__device__ __forceinline__ unsigned xb_ld(unsigned* p)              { return __hip_atomic_load(p, __ATOMIC_RELAXED, __HIP_MEMORY_SCOPE_AGENT); }
__device__ __forceinline__ unsigned xb_add(unsigned* p, unsigned v) { return __hip_atomic_fetch_add(p, v, __ATOMIC_RELAXED, __HIP_MEMORY_SCOPE_AGENT); }
__device__ __forceinline__ unsigned xb_xcc_id() { return (unsigned)__builtin_amdgcn_s_getreg((3 << 11) | 20) & 0xFu; }
#define XB_SPIN(cond, bar) do { unsigned _sp = 0; while (cond) { __builtin_amdgcn_s_sleep(1); \
    if ((++_sp & 255u) == 0u) { if (xb_ld(&(bar)[XB_TMO])) break; if (_sp > XB_SPIN_CAP) { atomicAdd(&(bar)[XB_TMO], 1u); break; } } } } while (0)
struct XcdBarrier { unsigned* bar; unsigned x; volatile LAS unsigned* st; };
__device__ __forceinline__ XcdBarrier xcd_barrier_post(unsigned* bar, volatile LAS unsigned* st) {
    XcdBarrier b; b.bar = bar; b.x = xb_xcc_id(); b.st = st;
    if (threadIdx.x == 0) (void)xb_add(&bar[XB_XCNT(b.x)], 1u);
    return b;
}
__device__ __forceinline__ void xcd_barrier_complete(unsigned* bar, unsigned x, unsigned& nloc, unsigned& nx) {
    const unsigned G = gridDim.x * gridDim.y * gridDim.z;
    unsigned sum, cnt, mine, sp = 0u;
    for (;;) {
        sum = 0u; cnt = 0u; mine = 0u;
#pragma unroll
        for (unsigned j = 0; j < 16; ++j) { const unsigned c = xb_ld(&bar[XB_XCNT(j)]); sum += c; cnt += (c > 0u) ? 1u : 0u; mine = (j == x) ? c : mine; }
        if (sum == G) break;
        __builtin_amdgcn_s_sleep(1);
        if ((++sp & 255u) == 0u) { if (xb_ld(&bar[XB_TMO])) break; if (sp > XB_SPIN_CAP) { atomicAdd(&bar[XB_TMO], 1u); break; } }
    }
    nloc = mine > 0u ? mine : 1u; nx = cnt > 0u ? cnt : 1u;
}
__device__ __attribute__((noinline)) void xcd_barrier_leader(unsigned* bar, unsigned bx_, volatile LAS unsigned* st) {
    {
        XcdBarrier b; b.bar = bar; b.x = bx_; b.st = st;
        __builtin_amdgcn_s_waitcnt(0);
        unsigned nloc = b.st[0], nx = b.st[1];
        if (nloc == 0u) { xcd_barrier_complete(bar, b.x, nloc, nx); b.st[0] = nloc; b.st[1] = nx; }
        const unsigned old = xb_add(&bar[XB_XSUB(b.x)], 1u);
        const unsigned gen = old / nloc;
        if (old + 1u == (gen + 1u) * nloc) {
            __builtin_amdgcn_fence(__ATOMIC_RELEASE, "agent");
            asm volatile("s_waitcnt vmcnt(0)" ::: "memory");
            const unsigned og = xb_add(&bar[XB_TOP], 1u);
            const unsigned tg = og / nx;
            if (og + 1u == (tg + 1u) * nx) xb_add(&bar[XB_TOPGEN], 1u);
            else XB_SPIN(xb_ld(&bar[XB_TOPGEN]) == tg, bar);
            __builtin_amdgcn_fence(__ATOMIC_ACQUIRE, "agent");
            xb_add(&bar[XB_XGEN(b.x)], 1u);
            asm volatile("s_waitcnt vmcnt(0)" ::: "memory");
        } else {
            XB_SPIN(xb_ld(&bar[XB_XGEN(b.x)]) == gen, bar);
            __builtin_amdgcn_fence(__ATOMIC_ACQUIRE, "agent");
            asm volatile("s_waitcnt vmcnt(0)" ::: "memory");
        }
    }
}
__device__ __forceinline__ void xcd_barrier(const XcdBarrier& b) {
    asm volatile("s_waitcnt vmcnt(0)" ::: "memory");
    __syncthreads();
    if (threadIdx.x == 0) xcd_barrier_leader(b.bar, b.x, b.st);
    __syncthreads();
}

struct Args {
    const float *x, *c, *ctx, *c_ctx, *norm1_g, *norm2_g, *final_g, *w_mod, *b_mod, *w_in, *conv_w, *sink, *pool_w, *pool_scale, *w_branch, *w_out,
                *ffn_w_gu, *ffn_w_down, *router_w, *moe_w_gu, *moe_w_down;
    float* out; unsigned char* ws; int ph_lo, ph_hi;
};
template <int OFF> __device__ __forceinline__ const void* karg_p() { const void* r; asm volatile("s_load_dwordx2 %0, %1, %2\n\ts_waitcnt lgkmcnt(0)" : "=s"(r) : "s"(__builtin_amdgcn_kernarg_segment_ptr()), "i"(OFF)); return r; }
template <int OFF> __device__ __forceinline__ int karg_i() { int r; asm volatile("s_load_dword %0, %1, %2\n\ts_waitcnt lgkmcnt(0)" : "=s"(r) : "s"(__builtin_amdgcn_kernarg_segment_ptr()), "i"(OFF)); return r; }
#define KP(field) ((const float*)karg_p<(int)__builtin_offsetof(Args, field)>())
struct Frame {
    LAS unsigned char* lds;
    int tid, lane, wave, G, bx;
    unsigned char* ws;
};
__device__ __forceinline__ float wave_sum(float v) {
#pragma unroll
    for (int o = 1; o < 64; o <<= 1) v += __shfl_xor(v, o);
    return v;
}
__device__ __forceinline__ float wave_max(float v) {
#pragma unroll
    for (int o = 1; o < 64; o <<= 1) v = fmaxf(v, __shfl_xor(v, o));
    return v;
}
#define LDS_WAIT() asm volatile("s_waitcnt lgkmcnt(0)" ::: "memory")

template <bool F8>
__device__ __forceinline__ void p0_transpose_item(const float* W, int ldw, bf16* WT, int ldt, int koff, int k0, int n0, int drow0, LAS float* scr, int lane) {
    f32x4 v[16];
    const int rl = lane >> 4, c4 = 4 * (lane & 15);
#pragma unroll
    for (int i = 0; i < 16; ++i) v[i] = __builtin_nontemporal_load((const f32x4*)(W + (size_t)(k0 + 4 * i + rl) * ldw + n0 + c4));
#pragma unroll
    for (int i = 0; i < 16; ++i) { LAS float* p = scr + (4 * i + rl) * 65 + c4; p[0] = v[i].x; p[1] = v[i].y; p[2] = v[i].z; p[3] = v[i].w; }
    LDS_WAIT(); asm volatile("" ::: "memory");
    const int c = lane & 7;
#pragma unroll
    for (int j = 0; j < 8; ++j) { const int n = (lane >> 3) + 8 * j; const LAS float* sp = scr + (8 * c) * 65 + n;
        if constexpr (F8) { u32x2 o; o.x = pk4_fp8(sp[0 * 65] * W8SCALE, sp[1 * 65] * W8SCALE, sp[2 * 65] * W8SCALE, sp[3 * 65] * W8SCALE); o.y = pk4_fp8(sp[4 * 65] * W8SCALE, sp[5 * 65] * W8SCALE, sp[6 * 65] * W8SCALE, sp[7 * 65] * W8SCALE);
            *(u32x2*)((unsigned char*)WT + (size_t)(drow0 + n) * ldt + koff + k0 + 8 * c) = o; }
        else { u32x4 o; o.x = pk2(sp[0 * 65], sp[1 * 65]); o.y = pk2(sp[2 * 65], sp[3 * 65]); o.z = pk2(sp[4 * 65], sp[5 * 65]); o.w = pk2(sp[6 * 65], sp[7 * 65]);
            *(u32x4*)(WT + (size_t)(drow0 + n) * ldt + koff + k0 + 8 * c) = o; } }
    LDS_WAIT(); asm volatile("" ::: "memory");
}
template <bool F8>
__device__ __forceinline__ void p0_job_item(const float* W, int ldw, int K, int N, bf16* WT, int ldt, int koff, int IL, int item, LAS float* scr, int lane) {
    const int nblk = N / 64, kb = item / nblk, nb = item % nblk, n0 = 64 * nb;
    int drow0 = n0;
    if (IL > 0) { const int half = n0 >= IL ? 1 : 0, f = n0 - half * IL; drow0 = 256 * (f / 128) + 128 * half + (f % 128); }
    p0_transpose_item<F8>(W, ldw, WT, ldt, koff, 64 * kb, n0, drow0, scr, lane);
}
__device__ __forceinline__ void p0_prologue(Frame& F) {
    LAS float* scr = (LAS float*)(F.lds + F.wave * 16640);
    const int gw = F.bx * NWAVES + F.wave, NGW = F.G * NWAVES;
    constexpr int I_IN = (D / 64) * (ZG / 64), I_IN8 = (D / 64) * (3 * D / 64), I_BR = (512 / 64) * (D / 64), I_OUT = (D / 64) * (D / 64), I_GU0 = (D / 64) * (2 * DFF / 64), I_DN0 = (DFF / 64) * (D / 64),
                  I_MGU = (D / 64) * (2 * DFE / 64), I_MDN = (DFE / 64) * (D / 64);
    constexpr int NITEMS = 2 * I_IN + 2 * I_IN8 + 4 * I_BR + 2 * I_OUT + I_GU0 + I_DN0 + NE * I_MGU + NE * I_MDN;
    bf16* const wsb = (bf16*)F.ws;
    for (int it = gw; it < NITEMS; it += NGW) {
        int r = it;
        if (r < NE * I_MGU) { const int e = r / I_MGU; p0_job_item<true>(KP(moe_w_gu) + (size_t)e * D * 2 * DFE, 2 * DFE, D, 2 * DFE, (bf16*)(F.ws + WS_WMGU + (size_t)e * 2 * DFE * D), D, 0, DFE, r % I_MGU, scr, F.lane); continue; } r -= NE * I_MGU;
        if (r < NE * I_MDN) { const int e = r / I_MDN; p0_job_item<true>(KP(moe_w_down) + (size_t)e * DFE * D, D, DFE, D, (bf16*)(F.ws + WS_WMDN + (size_t)e * D * DFE), DFE, 0, 0, r % I_MDN, scr, F.lane); continue; } r -= NE * I_MDN;
        if (r < 2 * I_IN) { const int l = r / I_IN; p0_job_item<false>(KP(w_in) + (size_t)l * D * INW, INW, D, ZG, (bf16*)(F.ws + WS_WIN) + (size_t)l * ZG * D, D, 0, 0, r % I_IN, scr, F.lane); continue; } r -= 2 * I_IN;
        if (r < 2 * I_IN8) { const int l = r / I_IN8; p0_job_item<true>(KP(w_in) + (size_t)l * D * INW + ZG, INW, D, 3 * D, (bf16*)(F.ws + WS_WIN8 + (size_t)l * 3 * D * D), D, 0, 0, r % I_IN8, scr, F.lane); continue; } r -= 2 * I_IN8;
        if (r < 4 * I_BR) { const int j = r / I_BR, l = j >> 1, b = j & 1; p0_job_item<false>(KP(w_branch) + (size_t)(l * 3 + b) * 512 * D, D, 512, D, (bf16*)(F.ws + WS_WBR) + (size_t)l * D * MIXW, MIXW, 512 * b, 0, r % I_BR, scr, F.lane); continue; } r -= 4 * I_BR;
        if (r < 2 * I_OUT) { const int l = r / I_OUT; p0_job_item<false>(KP(w_out) + (size_t)l * D * D, D, D, D, (bf16*)(F.ws + WS_WOUT) + (size_t)l * D * D, D, 0, 0, r % I_OUT, scr, F.lane); continue; } r -= 2 * I_OUT;
        if (r < I_GU0) { p0_job_item<FFN0_FP8 != 0>(KP(ffn_w_gu), 2 * DFF, D, 2 * DFF, (bf16*)(F.ws + WS_WGU0), D, 0, DFF, r, scr, F.lane); continue; } r -= I_GU0;
        p0_job_item<FFN0_FP8 != 0>(KP(ffn_w_down), D, DFF, D, (bf16*)(F.ws + WS_WDN0), DFF, 0, 0, r, scr, F.lane);
    }
    (void)wsb;
    __syncthreads();
    constexpr int I_MOD = 2 * (MODW / 64), I_FOLD = 2 * 4 * (D / 64);
    for (int it = F.bx; it < I_MOD + I_FOLD + 1; it += F.G) {
        if (it < I_MOD) {
            const int l = it / (MODW / 64), cb = it % (MODW / 64);
            LAS float* sv = (LAS float*)F.lds;
            LAS float* red = (LAS float*)(F.lds + 32768);
            for (int i = F.tid; i < 5 * D; i += NTHR) { const int r = i / D, k = i % D; const float v = r < 4 ? KP(c)[r * D + k] : KP(c_ctx)[k]; sv[i] = v / (1.f + __expf(-v)); }
            __syncthreads();
            const int col = cb * 64 + F.lane; const float* wp = KP(w_mod) + (size_t)l * D * MODW + col;
            float a0 = 0.f, a1 = 0.f, a2 = 0.f, a3 = 0.f, a4 = 0.f;
#pragma unroll 8
            for (int kk = 0; kk < 128; ++kk) { const int k = F.wave * 128 + kk; const float w = wp[(size_t)k * MODW];
                a0 += sv[k] * w; a1 += sv[D + k] * w; a2 += sv[2 * D + k] * w; a3 += sv[3 * D + k] * w; a4 += sv[4 * D + k] * w; }
            red[(F.wave * 5 + 0) * 64 + F.lane] = a0; red[(F.wave * 5 + 1) * 64 + F.lane] = a1; red[(F.wave * 5 + 2) * 64 + F.lane] = a2;
            red[(F.wave * 5 + 3) * 64 + F.lane] = a3; red[(F.wave * 5 + 4) * 64 + F.lane] = a4;
            __syncthreads();
            if (F.tid < 320) { const int r = F.tid / 64, ln = F.tid % 64; float s = 0.f;
#pragma unroll
                for (int w = 0; w < 8; ++w) s += red[(w * 5 + r) * 64 + ln];
                const int cc = cb * 64 + ln;
                ((float*)(F.ws + WS_MODV))[(size_t)(l * 5 + r) * MODW + cc] = s + KP(b_mod)[l * MODW + cc]; }
            __syncthreads();
        } else if (it < I_MOD + I_FOLD) {
            const int r = it - I_MOD, l = r / 64, g = (r % 64) / 16, nb = r % 16;
            LAS float* pw = (LAS float*)F.lds;
            const float* pws = KP(pool_w) + (size_t)(l * 4 + g) * 128 * 128;
            for (int i = F.tid; i < 128 * 128; i += NTHR) pw[i] = pws[i];
            __syncthreads();
            const int n = nb * 64 + F.lane; const float* w2 = KP(w_branch) + (size_t)(l * 3 + 2) * 512 * D + (size_t)(128 * g) * D + n;
            const float* ps = KP(pool_scale) + l * 512 + 128 * g;
            float acc[16];
#pragma unroll
            for (int q = 0; q < 16; ++q) acc[q] = 0.f;
            for (int j = 0; j < 128; ++j) { const float wv = w2[(size_t)j * D] * ps[j];
#pragma unroll
                for (int q = 0; q < 16; ++q) acc[q] += pw[(F.wave * 16 + q) * 128 + j] * wv; }
            bf16* dst = (bf16*)(F.ws + WS_WBR) + (size_t)l * D * MIXW + (size_t)n * MIXW + 1024 + 128 * g + F.wave * 16;
            u32x4 o0, o1; o0.x = pk2(acc[0], acc[1]); o0.y = pk2(acc[2], acc[3]); o0.z = pk2(acc[4], acc[5]); o0.w = pk2(acc[6], acc[7]);
            o1.x = pk2(acc[8], acc[9]); o1.y = pk2(acc[10], acc[11]); o1.z = pk2(acc[12], acc[13]); o1.w = pk2(acc[14], acc[15]);
            *(u32x4*)dst = o0; *(u32x4*)(dst + 8) = o1;
            __syncthreads();
        } else {
            for (int i = F.tid; i < 64 * 16; i += NTHR) { const int pos = i / 16, fi = i % 16;
                const float inv = powf(10000.0f, -(float)fi / 16.0f); const float ang = (float)pos * inv;
                ((float*)(F.ws + WS_ROPE))[2 * i] = cosf(ang); ((float*)(F.ws + WS_ROPE))[2 * i + 1] = sinf(ang); }
        }
    }
}

template <bool ROUTER, int OUTM = 0>
__device__ __forceinline__ void norm_mod_phase(Frame& F, const float* xl, const float* xc, const float* gvec, const float* modl, int shi, int sci, int nrows, const float* router_w) {
    bf16* H = (bf16*)(F.ws + WS_H);
    LAS int* lcnt = (LAS int*)F.lds;
    if (ROUTER) { if (F.tid < 8) lcnt[F.tid] = 0; __syncthreads(); }
    const int nloop = ROUTER ? 8 : (nrows + F.G * NWAVES - 1) / (F.G * NWAVES);
    for (int i = 0; i < nloop; ++i) {
        const int r = ROUTER ? (F.bx * 64 + F.wave + 8 * i) : ((i * F.G + F.bx) * NWAVES + F.wave);
        if (r >= nrows) continue;
        const int bidx = r < ML ? r / SEQ : 4;
        const float* xr = r < ML ? xl + (size_t)r * D : xc + (size_t)(r - ML) * D;
        const float* mv = modl + (size_t)bidx * MODW;
        f32x4 v[4]; float ss = 0.f;
#pragma unroll
        for (int j = 0; j < 4; ++j) { v[j] = *(const f32x4*)(xr + 4 * F.lane + 256 * j); ss += (v[j].x * v[j].x + v[j].y * v[j].y) + (v[j].z * v[j].z + v[j].w * v[j].w); }
        const float rstd = 1.0f / sqrtf(wave_sum(ss) * (1.f / D) + EPS);
#pragma unroll
        for (int j = 0; j < 4; ++j) { const int c = 4 * F.lane + 256 * j;
            const f32x4 g = *(const f32x4*)(gvec + c), sh = *(const f32x4*)(mv + shi * D + c), sc = *(const f32x4*)(mv + sci * D + c);
            v[j] = (v[j] * rstd * g) * (sc + 1.0f) + sh;
            if constexpr (OUTM == 1) *(unsigned*)((unsigned char*)H + (size_t)r * D + c) = pk4_fp8(v[j].x, v[j].y, v[j].z, v[j].w);
            else { u32x2 o; o.x = pk2(v[j].x, v[j].y); o.y = pk2(v[j].z, v[j].w); *(u32x2*)(H + (size_t)r * D + c) = o; }
            if constexpr (OUTM == 2) *(unsigned*)(F.ws + WS_H8 + (size_t)r * D + c) = pk4_fp8(v[j].x, v[j].y, v[j].z, v[j].w); }
        if (ROUTER) {
            float lg[8];
#pragma unroll
            for (int e = 0; e < 8; ++e) lg[e] = 0.f;
#pragma unroll
            for (int j = 0; j < 4; ++j)
#pragma unroll
                for (int q = 0; q < 4; ++q) { const int c = 4 * F.lane + 256 * j + q; const f32x4 w0 = *(const f32x4*)(router_w + (size_t)c * 8), w1 = *(const f32x4*)(router_w + (size_t)c * 8 + 4); const float hv = v[j][q];
                    lg[0] += hv * w0.x; lg[1] += hv * w0.y; lg[2] += hv * w0.z; lg[3] += hv * w0.w; lg[4] += hv * w1.x; lg[5] += hv * w1.y; lg[6] += hv * w1.z; lg[7] += hv * w1.w; }
#pragma unroll
            for (int e = 0; e < 8; ++e) lg[e] = wave_sum(lg[e]);
            int e1 = 0; float v1 = lg[0];
#pragma unroll
            for (int e = 1; e < 8; ++e) if (lg[e] > v1) { v1 = lg[e]; e1 = e; }
            int e2 = -1; float v2 = -3.0e38f;
#pragma unroll
            for (int e = 0; e < 8; ++e) if (e != e1 && lg[e] > v2) { v2 = lg[e]; e2 = e; }
            const float ex = __expf(v2 - v1), w1 = 1.f / (1.f + ex), w2 = ex * w1;
            if (F.lane == 0) {
                const int p1 = atomicAdd((int*)&lcnt[e1], 1), p2 = atomicAdd((int*)&lcnt[e2], 1);
                int* te = (int*)(F.ws + WS_TOKE) + 2 * r; te[0] = e1; te[1] = e2;
                int* tp = (int*)(F.ws + WS_TOKP) + 2 * r; tp[0] = p1; tp[1] = p2;
                float* tw = (float*)(F.ws + WS_TOKW) + 2 * r; tw[0] = w1; tw[1] = w2;
            }
        }
    }
    if (ROUTER) { __syncthreads(); if (F.tid < 8) ((int*)(F.ws + WS_CNTWG))[F.bx * 8 + F.tid] = lcnt[F.tid]; __syncthreads(); }
}

__device__ __forceinline__ void moe_scatter_phase(Frame& F) {
    LAS int* tab = (LAS int*)F.lds;
    const int* cw = (const int*)(F.ws + WS_CNTWG);
    if (F.tid < 32) tab[F.tid] = 0;
    __syncthreads();
    for (int idx = F.tid; idx < F.G * 8; idx += NTHR) {
        const int c = __hip_atomic_load(cw + idx, __ATOMIC_RELAXED, __HIP_MEMORY_SCOPE_AGENT); const int w = idx >> 3, e = idx & 7;
        atomicAdd((int*)&tab[16 + e], c); if (w < F.bx) atomicAdd((int*)&tab[8 + e], c);
    }
    __syncthreads();
    if (F.tid == 0) { int off = 0; for (int e = 0; e < 8; ++e) { tab[e] = off; off += ((tab[16 + e] + 255) / 256) * 256; } tab[24] = off / 256;
        if (F.bx == 0) { int* tl = (int*)(F.ws + WS_TILE); int t = 0; for (int e = 0; e < 8; ++e) { const int n = (tab[16 + e] + 255) / 256; for (int q = 0; q < n; ++q) tl[t++] = e; } tl[200] = t; } }
    __syncthreads();
    const bf16* H = (const bf16*)(F.ws + WS_H); bf16* HS = (bf16*)(F.ws + WS_H2S);
    for (int i = 0; i < 8; ++i) {
        const int r = F.bx * 64 + F.wave + 8 * i; if (r >= ML) continue;
        const int* te = (const int*)(F.ws + WS_TOKE) + 2 * r; const int* tp = (const int*)(F.ws + WS_TOKP) + 2 * r;
        const int e1 = te[0], e2 = te[1];
        const int s1 = tab[e1] + tab[8 + e1] + tp[0], s2 = tab[e2] + tab[8 + e2] + tp[1];
        if (F.lane == 0) { int* ts = (int*)(F.ws + WS_TOKS) + 2 * r; ts[0] = s1; ts[1] = s2; }
        const u32x4 a = ((const u32x4*)((const unsigned char*)H + (size_t)r * D))[F.lane];
        ((u32x4*)((unsigned char*)HS + (size_t)s1 * D))[F.lane] = a; ((u32x4*)((unsigned char*)HS + (size_t)s2 * D))[F.lane] = a;
    }
}

__device__ __forceinline__ void final_phase(Frame& F, const float* final_g, float* out, const float* modl) {
    const float* X1 = (const float*)(F.ws + WS_X1); const bf16* YS = (const bf16*)(F.ws + WS_YS);
    const int NGW = F.G * NWAVES;
    for (int r = F.bx * NWAVES + F.wave; r < ML; r += NGW) {
        const int bidx = r / SEQ; const float* g2 = modl + (size_t)bidx * MODW + 5 * D;
        const int* ts = (const int*)(F.ws + WS_TOKS) + 2 * r; const float* tw = (const float*)(F.ws + WS_TOKW) + 2 * r;
        const int s1 = ts[0], s2 = ts[1]; const float w1 = tw[0], w2 = tw[1];
        f32x4 v[4]; float ss = 0.f;
#pragma unroll
        for (int j = 0; j < 4; ++j) { const int c = 4 * F.lane + 256 * j;
            const f32x4 xv = *(const f32x4*)(X1 + (size_t)r * D + c), g = *(const f32x4*)(g2 + c);
            const u32x2 y1 = *(const u32x2*)(YS + (size_t)s1 * D + c), y2 = *(const u32x2*)(YS + (size_t)s2 * D + c);
            f32x4 f; f.x = w1 * bflo(y1.x) + w2 * bflo(y2.x); f.y = w1 * bfhi(y1.x) + w2 * bfhi(y2.x); f.z = w1 * bflo(y1.y) + w2 * bflo(y2.y); f.w = w1 * bfhi(y1.y) + w2 * bfhi(y2.y);
            v[j] = xv + g * f; ss += (v[j].x * v[j].x + v[j].y * v[j].y) + (v[j].z * v[j].z + v[j].w * v[j].w); }
        const float rstd = 1.0f / sqrtf(wave_sum(ss) * (1.f / D) + EPS);
#pragma unroll
        for (int j = 0; j < 4; ++j) { const int c = 4 * F.lane + 256 * j; const f32x4 g = *(const f32x4*)(final_g + c);
            *(f32x4*)(out + (size_t)r * D + c) = v[j] * rstd * g; }
    }
}

__device__ __forceinline__ void unpack8(const u32x4 w, float (&f)[8]) { f[0] = bflo(w.x); f[1] = bfhi(w.x); f[2] = bflo(w.y); f[3] = bfhi(w.y); f[4] = bflo(w.z); f[5] = bfhi(w.z); f[6] = bflo(w.w); f[7] = bfhi(w.w); }
__device__ __forceinline__ void local_mix_phase(Frame& F, const float* cw, int nrows, const bool skip16) {
    const bf16* Z = (const bf16*)(F.ws + WS_Z); bf16* MIX = (bf16*)(F.ws + WS_MIX);
    const int vcu = (F.G % 8 == 0) ? (F.bx % 8) * (F.G / 8) + F.bx / 8 : F.bx;
    const int nwk = (skip16 && F.G > 32) ? F.G - 16 : F.G, wk = (skip16 && F.G > 32) ? vcu - 16 : vcu;
    const int total = nrows * 64, stride = nwk * NTHR;
    for (int idx = (wk < 0 ? total : wk * NTHR + F.tid); idx < total; idx += stride) {
        const int r = idx >> 6, cg = idx & 63, c0 = cg * 8;
        int t, L, base;
        if (r < ML) { t = r % SEQ; L = SEQ; base = r - t; } else { const int rc = r - ML; t = rc % CTXL; L = CTXL; base = r - t; }
        float o[8];
#pragma unroll
        for (int q = 0; q < 8; ++q) o[q] = 0.f;
#pragma unroll
        for (int j = 0; j < 3; ++j) { const int tt = t - 1 + j; if (tt < 0 || tt >= L) continue;
            const bf16* zr = Z + (size_t)(base + tt) * INW; float cx[8], cc[8];
            unpack8(*(const u32x4*)(zr + ZCX + c0), cx); unpack8(*(const u32x4*)(zr + ZCC + c0), cc);
            const f32x4 w0 = *(const f32x4*)(cw + j * 512 + c0), w1 = *(const f32x4*)(cw + j * 512 + c0 + 4);
            o[0] += w0.x * (cc[0] * cx[0]); o[1] += w0.y * (cc[1] * cx[1]); o[2] += w0.z * (cc[2] * cx[2]); o[3] += w0.w * (cc[3] * cx[3]);
            o[4] += w1.x * (cc[4] * cx[4]); o[5] += w1.y * (cc[5] * cx[5]); o[6] += w1.z * (cc[6] * cx[6]); o[7] += w1.w * (cc[7] * cx[7]); }
        { float cb[8]; unpack8(*(const u32x4*)(Z + (size_t)r * INW + ZCB + c0), cb);
          u32x4 w; w.x = pk2(cb[0] * o[0], cb[1] * o[1]); w.y = pk2(cb[2] * o[2], cb[3] * o[3]); w.z = pk2(cb[4] * o[4], cb[5] * o[5]); w.w = pk2(cb[6] * o[6], cb[7] * o[7]);
          *(u32x4*)(MIX + (size_t)r * MIXW + 512 + c0) = w; }
        { const int hw = 1 << (c0 >> 7); const int lo = t - hw < 0 ? 0 : t - hw, hi = t + hw > L ? L : t + hw;
          float s[8];
#pragma unroll
          for (int q = 0; q < 8; ++q) s[q] = 0.f;
          for (int tt = lo; tt < hi; ++tt) { float u[8]; unpack8(*(const u32x4*)(Z + (size_t)(base + tt) * INW + ZPU + c0), u);
#pragma unroll
              for (int q = 0; q < 8; ++q) s[q] += u[q]; }
          float u0[8]; unpack8(*(const u32x4*)(Z + (size_t)r * INW + ZPU + c0), u0);
          const float inv = 1.0f / (float)(hi - lo);
          u32x4 w; w.x = pk2(s[0] * inv - u0[0], s[1] * inv - u0[1]); w.y = pk2(s[2] * inv - u0[2], s[3] * inv - u0[3]);
          w.z = pk2(s[4] * inv - u0[4], s[5] * inv - u0[5]); w.w = pk2(s[6] * inv - u0[6], s[7] * inv - u0[7]);
          *(u32x4*)(MIX + (size_t)r * MIXW + 1024 + c0) = w; }
    }
}

__device__ __forceinline__ void attn_naive_phase(Frame& F, const float* sinkl, int nrows) {
    const bf16* Z = (const bf16*)(F.ws + WS_Z); bf16* MIX = (bf16*)(F.ws + WS_MIX);
    LAS float* qs = (LAS float*)(F.lds + F.wave * 10240);
    LAS float* sc = qs + 256;
    const int nunits = nrows * 2, NGW = F.G * NWAVES;
    for (int uidx = F.bx * NWAVES + F.wave; uidx < nunits; uidx += NGW) {
        const int r = uidx >> 1, kh = uidx & 1;
        int b, nloc, krow0;
        if (r < ML) { b = r / SEQ; const int t = r % SEQ; const int lo = t - 128 < 0 ? 0 : t - 128, hi = t + 128 > SEQ - 1 ? SEQ - 1 : t + 128; nloc = hi - lo + 1; krow0 = b * SEQ + lo; }
        else { b = (r - ML) / CTXL; nloc = 0; krow0 = 0; }
        const int crow0 = ML + b * CTXL, nk = nloc + CTXL;
        { const u32x2 qw = *(const u32x2*)(Z + (size_t)r * INW + ZQ + kh * 256 + 4 * F.lane); const int g = F.lane >> 4, d = (4 * F.lane) & 63;
          qs[(d + 0) * 4 + g] = bflo(qw.x); qs[(d + 1) * 4 + g] = bfhi(qw.x); qs[(d + 2) * 4 + g] = bflo(qw.y); qs[(d + 3) * 4 + g] = bfhi(qw.y); }
        LDS_WAIT(); asm volatile("" ::: "memory");
        for (int c0 = 0; c0 < nk; c0 += 64) {
            const int kk = c0 + F.lane;
            if (kk < nk) {
                const int krow = kk < nloc ? krow0 + kk : crow0 + (kk - nloc);
                const u32x4* kp = (const u32x4*)(Z + (size_t)krow * INW + ZK + kh * 64);
                f32x4 s = (f32x4){0.f, 0.f, 0.f, 0.f};
#pragma unroll
                for (int d8 = 0; d8 < 8; ++d8) { float kf[8]; unpack8(kp[d8], kf);
#pragma unroll
                    for (int q = 0; q < 8; ++q) { const f32x4 qv = *(const LAS f32x4*)(qs + (d8 * 8 + q) * 4); s += qv * kf[q]; } }
                *(LAS f32x4*)(sc + kk * 4) = s;
            }
        }
        LDS_WAIT(); asm volatile("" ::: "memory");
        f32x4 mx; { const float* sk = sinkl + kh * 4; mx = (f32x4){sk[0] * LOG2E, sk[1] * LOG2E, sk[2] * LOG2E, sk[3] * LOG2E}; }
        const f32x4 snk = mx;
        for (int kk = F.lane; kk < nk; kk += 64) { const f32x4 s = *(const LAS f32x4*)(sc + kk * 4); mx.x = fmaxf(mx.x, s.x); mx.y = fmaxf(mx.y, s.y); mx.z = fmaxf(mx.z, s.z); mx.w = fmaxf(mx.w, s.w); }
        mx.x = wave_max(mx.x); mx.y = wave_max(mx.y); mx.z = wave_max(mx.z); mx.w = wave_max(mx.w);
        f32x4 sm = (f32x4){0.f, 0.f, 0.f, 0.f};
        for (int kk = F.lane; kk < nk; kk += 64) { f32x4 s = *(const LAS f32x4*)(sc + kk * 4);
            s.x = exp2f(s.x - mx.x); s.y = exp2f(s.y - mx.y); s.z = exp2f(s.z - mx.z); s.w = exp2f(s.w - mx.w); sm += s; *(LAS f32x4*)(sc + kk * 4) = s; }
        sm.x = wave_sum(sm.x) + exp2f(snk.x - mx.x); sm.y = wave_sum(sm.y) + exp2f(snk.y - mx.y); sm.z = wave_sum(sm.z) + exp2f(snk.z - mx.z); sm.w = wave_sum(sm.w) + exp2f(snk.w - mx.w);
        LDS_WAIT(); asm volatile("" ::: "memory");
        f32x4 o = (f32x4){0.f, 0.f, 0.f, 0.f};
        const bf16* vb = Z + ZV + kh * 64 + F.lane;
#pragma unroll 4
        for (int kk = 0; kk < nk; ++kk) { const int krow = kk < nloc ? krow0 + kk : crow0 + (kk - nloc);
            const float v = bf2f((unsigned)vb[(size_t)krow * INW]); const f32x4 p = *(const LAS f32x4*)(sc + kk * 4); o += p * v; }
        bf16* op = MIX + (size_t)r * MIXW + kh * 256 + F.lane;
        op[0] = (bf16)f2bf(o.x / sm.x); op[64] = (bf16)f2bf(o.y / sm.y); op[128] = (bf16)f2bf(o.z / sm.z); op[192] = (bf16)f2bf(o.w / sm.w);
        LDS_WAIT(); asm volatile("" ::: "memory");
    }
}

typedef float f32x16 __attribute__((ext_vector_type(16)));
typedef short s16x4 __attribute__((ext_vector_type(4)));
__device__ __forceinline__ unsigned cvtpk(float lo, float hi) { f32x2 v = {lo, hi}; pg8::bf16x2_t b = __builtin_convertvector(v, pg8::bf16x2_t); return __builtin_bit_cast(unsigned, b); }
__device__ __forceinline__ s16x4 vtr(const LAS unsigned char* p) { return __builtin_bit_cast(s16x4, __builtin_amdgcn_ds_read_tr16_b64_v4i16((LAS s16x4*)p)); }
constexpr int AKP = 144, ATT_V_OFF = 128 * AKP;
__device__ __forceinline__ void attn_unit(Frame& F, const bf16* Z, bf16* MIX, const float* sinkl, const bool isctx, const int b, const int kh, const int qblk) {
    const int qrow0 = isctx ? ML + b * CTXL + qblk * 128 : b * SEQ + qblk * 128;
    const int cbase = ML + b * CTXL;
    const bool has_prev = !isctx && qblk > 0, has_next = !isctx && qblk < 31;
    const int nch = isctx ? 2 : 3 + (has_prev ? 1 : 0) + (has_next ? 1 : 0);
    const int lane = F.lane, r = lane & 31, h = lane >> 5, g = F.wave >> 1, qh = F.wave & 1, head = kh * 4 + g;
    LAS unsigned char* Ks = F.lds; LAS unsigned char* Vs = F.lds + ATT_V_OFF;
    bf16x8 qf[2][4];
#pragma unroll
    for (int sub = 0; sub < 2; ++sub)
#pragma unroll
        for (int ks = 0; ks < 4; ++ks) qf[sub][ks] = *(const bf16x8*)(Z + (size_t)(qrow0 + 64 * qh + 32 * sub + r) * INW + ZQ + head * 64 + 16 * ks + 8 * h);
    const float sk = sinkl[head] * LOG2E;
    float m[2], l[2]; f32x16 O[2][2];
#pragma unroll
    for (int sub = 0; sub < 2; ++sub) { m[sub] = sk; l[sub] = h == 0 ? 1.f : 0.f;
#pragma unroll
        for (int db = 0; db < 2; ++db)
#pragma unroll
            for (int i = 0; i < 16; ++i) O[sub][db][i] = 0.f; }
#define ATT_CHUNK(ci, row0, kind) do { if (isctx) { row0 = cbase + 128 * (ci); kind = 0; } else if ((ci) == 0) { row0 = qrow0; kind = 0; } else if ((ci) <= 2) { row0 = cbase + 128 * ((ci) - 1); kind = 0; } \
        else if ((ci) == 3 && has_prev) { row0 = qrow0 - 128; kind = 1; } else { row0 = qrow0 + 128; kind = 2; } } while (0)
    const int skey = F.tid >> 3, spart = F.tid & 7;
    u32x4 pk0, pk1, pv0, pv1;
#define ATT_LOAD(ci) do { int row0_, kind_; ATT_CHUNK(ci, row0_, kind_); (void)kind_; const bf16* kp_ = Z + (size_t)(row0_ + skey) * INW + ZK + kh * 64 + spart * 8; \
        pk0 = *(const u32x4*)kp_; pk1 = *(const u32x4*)(kp_ + (size_t)64 * INW); pv0 = *(const u32x4*)(kp_ + (ZV - ZK)); pv1 = *(const u32x4*)(kp_ + (size_t)64 * INW + (ZV - ZK)); } while (0)
    ATT_LOAD(0);
    const int grp = (lane >> 4) & 1, q4 = (lane & 15) >> 2, p4 = lane & 3;
    for (int ci = 0; ci < nch; ++ci) {
        __syncthreads();
        *(LAS u32x4*)(Ks + skey * AKP + spart * 16) = pk0; *(LAS u32x4*)(Ks + (skey + 64) * AKP + spart * 16) = pk1;
        *(LAS u32x4*)(Vs + skey * AKP + spart * 16) = pv0; *(LAS u32x4*)(Vs + (skey + 64) * AKP + spart * 16) = pv1;
        if (ci + 1 < nch) ATT_LOAD(ci + 1);
        __syncthreads();
        int row0, kind; ATT_CHUNK(ci, row0, kind); (void)row0;
        int dl = 4 * h - r - 64 * qh; asm volatile("" : "+v"(dl));
        for (int t = 0; t < 4; ++t) {
            if (kind == 1 && 32 * t + 31 < 64 * qh) continue;
            if (kind == 2 && 32 * t > 64 * qh + 63) continue;
            bf16x8 kf[4], vf[2][2];
#pragma unroll
            for (int ks = 0; ks < 4; ++ks) kf[ks] = *(const LAS bf16x8*)(Ks + (32 * t + r) * AKP + 32 * ks + 16 * h);
#pragma unroll
            for (int s = 0; s < 2; ++s)
#pragma unroll
                for (int db = 0; db < 2; ++db) { const LAS unsigned char* vp = Vs + (32 * t + 16 * s + 4 * h + q4) * AKP + (32 * db + 16 * grp + 4 * p4) * 2;
                    const s16x4 lo = vtr(vp), hi = vtr(vp + 8 * AKP); vf[s][db] = __builtin_shufflevector(lo, hi, 0, 1, 2, 3, 4, 5, 6, 7); }
#pragma unroll
            for (int sub = 0; sub < 2; ++sub) {
                if (kind == 1 && 32 * t + 31 < 64 * qh + 32 * sub) continue;
                if (kind == 2 && 32 * t > 64 * qh + 32 * sub + 31) continue;
                f32x16 S;
#pragma unroll
                for (int i = 0; i < 16; ++i) S[i] = 0.f;
#pragma unroll
                for (int ks = 0; ks < 4; ++ks) S = __builtin_amdgcn_mfma_f32_32x32x16_bf16(kf[ks], qf[sub][ks], S, 0, 0, 0);
                if (kind != 0) { const int d0 = dl + 32 * t - 32 * sub;
#pragma unroll
                    for (int i = 0; i < 16; ++i) { const int dd = d0 + (i & 3) + 8 * (i >> 2); const bool ok = kind == 1 ? (dd >= 0) : (dd <= 0); S[i] = ok ? S[i] : -1.0e30f; } }
                float tmax = S[0];
#pragma unroll
                for (int i = 1; i < 16; ++i) tmax = fmaxf(tmax, S[i]);
                tmax = fmaxf(tmax, __shfl_xor(tmax, 32));
                const float mnew = fmaxf(m[sub], tmax);
                if (__any(mnew > m[sub])) { const float alpha = __builtin_amdgcn_exp2f(m[sub] - mnew); l[sub] *= alpha; m[sub] = mnew;
#pragma unroll
                    for (int db = 0; db < 2; ++db)
#pragma unroll
                        for (int i = 0; i < 16; ++i) O[sub][db][i] *= alpha; }
                float ps = 0.f;
#pragma unroll
                for (int i = 0; i < 16; ++i) { S[i] = __builtin_amdgcn_exp2f(S[i] - m[sub]); ps += S[i]; }
                l[sub] += ps;
                u32x4 w0, w1; w0.x = cvtpk(S[0], S[1]); w0.y = cvtpk(S[2], S[3]); w0.z = cvtpk(S[4], S[5]); w0.w = cvtpk(S[6], S[7]);
                w1.x = cvtpk(S[8], S[9]); w1.y = cvtpk(S[10], S[11]); w1.z = cvtpk(S[12], S[13]); w1.w = cvtpk(S[14], S[15]);
                const bf16x8 P0 = __builtin_bit_cast(bf16x8, w0), P1 = __builtin_bit_cast(bf16x8, w1);
#pragma unroll
                for (int db = 0; db < 2; ++db) { O[sub][db] = __builtin_amdgcn_mfma_f32_32x32x16_bf16(vf[0][db], P0, O[sub][db], 0, 0, 0); O[sub][db] = __builtin_amdgcn_mfma_f32_32x32x16_bf16(vf[1][db], P1, O[sub][db], 0, 0, 0); }
            }
        }
    }
#undef ATT_CHUNK
#undef ATT_LOAD
#pragma unroll
    for (int sub = 0; sub < 2; ++sub) { const float lt = l[sub] + __shfl_xor(l[sub], 32), inv = 1.f / lt;
        bf16* op = MIX + (size_t)(qrow0 + 64 * qh + 32 * sub + r) * MIXW + head * 64 + 4 * h;
#pragma unroll
        for (int db = 0; db < 2; ++db)
#pragma unroll
            for (int gq = 0; gq < 4; ++gq) { u32x2 w; w.x = cvtpk(O[sub][db][4 * gq] * inv, O[sub][db][4 * gq + 1] * inv); w.y = cvtpk(O[sub][db][4 * gq + 2] * inv, O[sub][db][4 * gq + 3] * inv);
                *(u32x2*)(op + 32 * db + 8 * gq) = w; } }
}
__device__ __forceinline__ void attn_mfma_phase(Frame& F, const float* sinkl, const bool with_ctx) {
    const bf16* Z = (const bf16*)(F.ws + WS_Z); bf16* MIX = (bf16*)(F.ws + WS_MIX);
    const int vcu = (F.G % 8 == 0) ? (F.bx % 8) * (F.G / 8) + F.bx / 8 : F.bx;
    const int nun = with_ctx ? 272 : 256;
    for (int u = vcu; u < nun; u += F.G) { const bool isctx = u >= 256; const int uu = isctx ? (u - 256) : u;
        attn_unit(F, Z, MIX, sinkl, isctx, isctx ? (uu >> 2) : (uu >> 6), isctx ? ((uu >> 1) & 1) : ((uu >> 5) & 1), isctx ? (uu & 1) : (uu & 31)); }
    __syncthreads();
}

using pg8::Unit;
struct SchedStd {
    const char* A; const char* B; size_t astep, bstep; int nM, nN, G, c, nx, xpm0, xpn;
    __device__ __forceinline__ bool next(int i, Unit& u) const {
        const int L = i * G + c, nwg = nM * nN; if (L >= nwg + nx) return false;
        if (L < nwg) pg8::tile_of(L, nM, nN, u.pm, u.pn); else { u.pm = xpm0 + (L - nwg); u.pn = xpn; }
        u.tag = 0; u.a = A + (size_t)u.pm * astep; u.b = B + (size_t)u.pn * bstep; return true;
    }
};
struct SchedMoe {
    const char* A; const char* B; size_t astep, bstep_e, bstep_n; int NJ, G, c; const int* tile;
    __device__ __forceinline__ bool next(int i, Unit& u) const {
        const int nt = __builtin_amdgcn_readfirstlane(__hip_atomic_load(tile + 200, __ATOMIC_RELAXED, __HIP_MEMORY_SCOPE_AGENT));
        const int L = i * G + c; if (L >= nt * NJ) return false;
        u.pm = L % nt; u.pn = L / nt; u.tag = __builtin_amdgcn_readfirstlane(__hip_atomic_load(tile + u.pm, __ATOMIC_RELAXED, __HIP_MEMORY_SCOPE_AGENT));
        u.a = A + (size_t)u.pm * astep; u.b = B + (size_t)u.tag * bstep_e + (size_t)u.pn * bstep_n; return true;
    }
};

struct EpiGate {
    static constexpr bool PERM = true, MIDHOOK = false;
    bf16* Z;
    __device__ __forceinline__ void operator()(const f32x4 (&acc)[2][2][4][2], const Unit& u, int wr, int wc, int fr, int fq) const {
        const int row0 = u.pm * 256 + wr * 64 + fr, col0 = ZG + u.pn * 256 + wc * 32 + 8 * fq;
#pragma unroll
        for (int ai = 0; ai < 2; ++ai)
#pragma unroll
            for (int m = 0; m < 4; ++m)
#pragma unroll
                for (int bj = 0; bj < 2; ++bj) { f32x4 v0 = acc[ai][bj][m][0], v1 = acc[ai][bj][m][1];
#pragma unroll
                    for (int q = 0; q < 4; ++q) { v0[q] = __builtin_amdgcn_rcpf(1.f + __expf(-v0[q])); v1[q] = __builtin_amdgcn_rcpf(1.f + __expf(-v1[q])); }
                    u32x4 w; w.x = pg8::cvt_pk_bf16(v0[0], v0[1]); w.y = pg8::cvt_pk_bf16(v0[2], v0[3]); w.z = pg8::cvt_pk_bf16(v1[0], v1[1]); w.w = pg8::cvt_pk_bf16(v1[2], v1[3]);
                    *(u32x4*)(Z + (size_t)(row0 + ai * 128 + m * 16) * INW + col0 + bj * 128) = w; }
    }
};
struct EpiIn {
    static constexpr bool PERM = true, MIDHOOK = false;
    bf16* Z; const float* rope;
    __device__ __forceinline__ void operator()(const f32x4 (&acc)[2][2][4][2], const Unit& u, int wr, int wc, int fr, int fq) const {
        const int row0 = u.pm * 256 + wr * 64 + fr, col0 = u.pn * 256 + wc * 32 + 8 * fq;
        const bool latent = u.pm < 64, gate = u.pn >= 11;
        const float sgn = fq < 2 ? -1.f : 1.f;
#pragma unroll
        for (int ai = 0; ai < 2; ++ai)
#pragma unroll
            for (int m = 0; m < 4; ++m) { const int row = row0 + ai * 128 + m * 16; bf16* rowp = Z + (size_t)row * INW + col0;
                const int pos = (wc & 1) ? (16 * m + fr) : (4 * (u.pm & 15) + 2 * ai + wr);
#pragma unroll
                for (int bj = 0; bj < 2; ++bj) { f32x4 v0 = acc[ai][bj][m][0], v1 = acc[ai][bj][m][1];
                    const bool isq = u.pn < 2, isk = (u.pn == 2 && bj == 0);
                    if (isq || isk) {
                        if (latent) {
                            const f32x4* cs = (const f32x4*)(rope + (size_t)(pos * 16 + 8 * (fq & 1)) * 2);
                            const f32x4 t0 = cs[0], t1 = cs[1], t2 = cs[2], t3 = cs[3];
                            f32x4 p0, p1;
                            p0.x = __shfl_xor(v0.x, 32); p0.y = __shfl_xor(v0.y, 32); p0.z = __shfl_xor(v0.z, 32); p0.w = __shfl_xor(v0.w, 32);
                            p1.x = __shfl_xor(v1.x, 32); p1.y = __shfl_xor(v1.y, 32); p1.z = __shfl_xor(v1.z, 32); p1.w = __shfl_xor(v1.w, 32);
                            v0.x = v0.x * t0.x + p0.x * (sgn * t0.y); v0.y = v0.y * t0.z + p0.y * (sgn * t0.w); v0.z = v0.z * t1.x + p0.z * (sgn * t1.y); v0.w = v0.w * t1.z + p0.w * (sgn * t1.w);
                            v1.x = v1.x * t2.x + p1.x * (sgn * t2.y); v1.y = v1.y * t2.z + p1.y * (sgn * t2.w); v1.z = v1.z * t3.x + p1.z * (sgn * t3.y); v1.w = v1.w * t3.z + p1.w * (sgn * t3.w);
                        }
                        if (isq) { v0 = v0 * QSCALE; v1 = v1 * QSCALE; }
                    }
                    if (gate) {
#pragma unroll
                        for (int q = 0; q < 4; ++q) { v0[q] = 1.f / (1.f + __expf(-v0[q])); v1[q] = 1.f / (1.f + __expf(-v1[q])); } }
                    u32x4 w; w.x = pg8::cvt_pk_bf16(v0[0], v0[1]); w.y = pg8::cvt_pk_bf16(v0[2], v0[3]); w.z = pg8::cvt_pk_bf16(v1[0], v1[1]); w.w = pg8::cvt_pk_bf16(v1[2], v1[3]);
                    *(u32x4*)(rowp + bj * 128) = w; } }
    }
};
struct EpiBrG {
    static constexpr bool PERM = true, MIDHOOK = true;
    const bf16* Z; bf16* Y;
    __device__ __forceinline__ void mid(f32x4 (&acc)[2][2][4][2], const Unit& u, int seg, int wr, int wc, int fr, int fq) const {
        const int row0 = u.pm * 256 + wr * 64 + fr, col0 = u.pn * 256 + wc * 32 + 8 * fq;
#pragma unroll
        for (int ai = 0; ai < 2; ++ai)
#pragma unroll
            for (int m = 0; m < 4; ++m) { const bf16* gp = Z + (size_t)(row0 + ai * 128 + m * 16) * INW + ZG + (seg - 1) * D + col0;
#pragma unroll
                for (int bj = 0; bj < 2; ++bj) { const u32x4 ga = *(const u32x4*)(gp + bj * 128), gb = *(const u32x4*)(gp + D + bj * 128);
                    f32x4 r0, r1;
                    r0.x = bflo(ga.x) * __builtin_amdgcn_rcpf(bflo(gb.x)); r0.y = bfhi(ga.x) * __builtin_amdgcn_rcpf(bfhi(gb.x)); r0.z = bflo(ga.y) * __builtin_amdgcn_rcpf(bflo(gb.y)); r0.w = bfhi(ga.y) * __builtin_amdgcn_rcpf(bfhi(gb.y));
                    r1.x = bflo(ga.z) * __builtin_amdgcn_rcpf(bflo(gb.z)); r1.y = bfhi(ga.z) * __builtin_amdgcn_rcpf(bfhi(gb.z)); r1.z = bflo(ga.w) * __builtin_amdgcn_rcpf(bflo(gb.w)); r1.w = bfhi(ga.w) * __builtin_amdgcn_rcpf(bfhi(gb.w));
                    acc[ai][bj][m][0] *= r0; acc[ai][bj][m][1] *= r1; }
                asm volatile("" ::: "memory"); }
    }
    __device__ __forceinline__ void operator()(const f32x4 (&acc)[2][2][4][2], const Unit& u, int wr, int wc, int fr, int fq) const {
        const int row0 = u.pm * 256 + wr * 64 + fr, col0 = u.pn * 256 + wc * 32 + 8 * fq;
#pragma unroll
        for (int ai = 0; ai < 2; ++ai)
#pragma unroll
            for (int m = 0; m < 4; ++m) { const size_t row = (size_t)(row0 + ai * 128 + m * 16); const bf16* gp = Z + row * INW + ZG + 2 * D + col0;
#pragma unroll
                for (int bj = 0; bj < 2; ++bj) { const u32x4 g = *(const u32x4*)(gp + bj * 128); const f32x4 v0 = acc[ai][bj][m][0], v1 = acc[ai][bj][m][1];
                    u32x4 w; w.x = pg8::cvt_pk_bf16(v0[0] * bflo(g.x), v0[1] * bfhi(g.x)); w.y = pg8::cvt_pk_bf16(v0[2] * bflo(g.y), v0[3] * bfhi(g.y));
                    w.z = pg8::cvt_pk_bf16(v1[0] * bflo(g.z), v1[1] * bfhi(g.z)); w.w = pg8::cvt_pk_bf16(v1[2] * bflo(g.w), v1[3] * bfhi(g.w));
                    *(u32x4*)(Y + row * D + col0 + bj * 128) = w; } }
    }
};
struct EpiRes {
    static constexpr bool PERM = false, MIDHOOK = false;
    const float* rl; const float* rc; float* out; const float* gv;
    __device__ __forceinline__ void operator()(const f32x4 (&acc)[2][2][4][2], const Unit& u, int wr, int wc, int fr, int fq) const {
        const int row0 = u.pm * 256 + wr * 64 + fr, col0 = u.pn * 256 + wc * 32 + 4 * fq;
        const int bidx = u.pm < 64 ? (u.pm >> 4) : 4; const float* g = gv + (size_t)bidx * MODW;
        const float* rbase = u.pm < 64 ? rl : rc - (size_t)ML * D;
        f32x4 gg[2][2];
#pragma unroll
        for (int bj = 0; bj < 2; ++bj)
#pragma unroll
            for (int n = 0; n < 2; ++n) gg[bj][n] = *(const f32x4*)(g + col0 + bj * 128 + n * 16);
#pragma unroll
        for (int ai = 0; ai < 2; ++ai)
#pragma unroll
            for (int m = 0; m < 4; ++m) { const size_t off = (size_t)(row0 + ai * 128 + m * 16) * D + col0;
#pragma unroll
                for (int bj = 0; bj < 2; ++bj)
#pragma unroll
                    for (int n = 0; n < 2; ++n) *(f32x4*)(out + off + bj * 128 + n * 16) = *(const f32x4*)(rbase + off + bj * 128 + n * 16) + gg[bj][n] * acc[ai][bj][m][n]; }
    }
};
template <bool F8> struct EpiSwiglu {
    static constexpr bool PERM = true, MIDHOOK = false;
    unsigned char* ACT; int ldc;
    __device__ __forceinline__ void operator()(const f32x4 (&acc)[2][2][4][2], const Unit& u, int wr, int wc, int fr, int fq) const {
        const int row0 = u.pm * 256 + wr * 64 + fr, col0 = u.pn * 128 + wc * 32 + 8 * fq;
#pragma unroll
        for (int ai = 0; ai < 2; ++ai)
#pragma unroll
            for (int m = 0; m < 4; ++m) { f32x4 r[2];
#pragma unroll
                for (int n = 0; n < 2; ++n) { const f32x4 g = acc[ai][0][m][n], up = acc[ai][1][m][n];
#pragma unroll
                    for (int q = 0; q < 4; ++q) r[n][q] = g[q] / (1.f + __expf(-g[q])) * up[q]; }
                if constexpr (F8) { u32x2 w; w.x = pk4_fp8(r[0][0], r[0][1], r[0][2], r[0][3]); w.y = pk4_fp8(r[1][0], r[1][1], r[1][2], r[1][3]);
                    *(u32x2*)(ACT + (size_t)(row0 + ai * 128 + m * 16) * ldc + col0) = w; }
                else { u32x4 w; w.x = pg8::cvt_pk_bf16(r[0][0], r[0][1]); w.y = pg8::cvt_pk_bf16(r[0][2], r[0][3]); w.z = pg8::cvt_pk_bf16(r[1][0], r[1][1]); w.w = pg8::cvt_pk_bf16(r[1][2], r[1][3]);
                    *(u32x4*)((bf16*)ACT + (size_t)(row0 + ai * 128 + m * 16) * ldc + col0) = w; } }
    }
};
struct EpiPlain {
    static constexpr bool PERM = true, MIDHOOK = false;
    bf16* O; int ldc;
    __device__ __forceinline__ void operator()(const f32x4 (&acc)[2][2][4][2], const Unit& u, int wr, int wc, int fr, int fq) const {
        const int row0 = u.pm * 256 + wr * 64 + fr, col0 = u.pn * 256 + wc * 32 + 8 * fq;
#pragma unroll
        for (int ai = 0; ai < 2; ++ai)
#pragma unroll
            for (int m = 0; m < 4; ++m)
#pragma unroll
                for (int bj = 0; bj < 2; ++bj) { const f32x4 v0 = acc[ai][bj][m][0], v1 = acc[ai][bj][m][1];
                    u32x4 w; w.x = pg8::cvt_pk_bf16(v0[0], v0[1]); w.y = pg8::cvt_pk_bf16(v0[2], v0[3]); w.z = pg8::cvt_pk_bf16(v1[0], v1[1]); w.w = pg8::cvt_pk_bf16(v1[2], v1[3]);
                    *(u32x4*)(O + (size_t)(row0 + ai * 128 + m * 16) * ldc + col0 + bj * 128) = w; }
    }
};

#ifndef PHASE_MASK
#define PHASE_MASK 0xFFFFFFFFu
#endif
#define IN(k) (((PHASE_MASK >> (k)) & 1u) && lo <= (k) && (k) < hi)
#define SEAM(k) do { if (IN(k) && IN((k) + 1)) xcd_barrier(bar); } while (0)
#ifndef DUP_MASK
#define DUP_MASK 0u
#endif
#define REP(k) for (int rep_ = 0; rep_ < (((DUP_MASK >> (k)) & 1u) ? 2 : 1); ++rep_, (((DUP_MASK >> (k)) & 1u) && rep_ == 1 ? xcd_barrier(bar) : (void)0))
#define SITE() do { F.ws = (unsigned char*)karg_p<(int)__builtin_offsetof(Args, ws)>(); int t_ = threadIdx.x; asm volatile("" : "+v"(t_)); F.tid = t_; F.lane = t_ & 63; } while (0)
template <int l> __device__ __forceinline__ void layer_common(Frame& F, const int lo, const int hi, const XcdBarrier& bar, LAS unsigned char* ring) {
    constexpr int pb = 1 + 8 * l;
        if (IN(pb + 0)) REP(pb + 0) { SITE(); const float* modl = (const float*)(F.ws + WS_MODV) + (size_t)l * 5 * MODW; const float* X2 = (const float*)(F.ws + WS_X2);
            const float* xl = l == 0 ? KP(x) : X2; const float* xc = l == 0 ? KP(ctx) : X2 + (size_t)ML * D;
            norm_mod_phase<false, 2>(F, xl, xc, KP(norm1_g) + l * D, modl, 0, 1, MT, nullptr); } SEAM(pb + 0);
        if (IN(pb + 1)) REP(pb + 1) { SITE();
            { SchedStd S{(const char*)(F.ws + WS_H), (const char*)(F.ws + WS_WIN) + (size_t)l * ZG * D * 2, (size_t)256 * D * 2, (size_t)256 * D * 2, l == 0 ? 68 : 64, 11, F.G, F.bx, l == 0 ? 0 : 4, 64, 2};
              EpiIn E{(bf16*)(F.ws + WS_Z), (const float*)(F.ws + WS_ROPE)};
              pg8::gemm_phase<EpiIn, SchedStd, true, true>(ring, D * 2, D * 2, D * 2, S, E); }
            { SITE(); SchedStd S{(const char*)(F.ws + WS_H8), (const char*)(F.ws + WS_WIN8) + (size_t)l * 3 * D * D, (size_t)256 * D, (size_t)256 * D, l == 0 ? 68 : 64, 12, F.G, (F.bx + 20) % F.G, 0, 0, 0};
              EpiGate E{(bf16*)(F.ws + WS_Z)};
              pg8::gemm_phase<EpiGate, SchedStd, true, true, true>(ring, D, D, D, S, E); }
        } SEAM(pb + 1);
        if (IN(pb + 2)) REP(pb + 2) { SITE(); const int nrows = l == 0 ? MT : ML; if (ATTN_NAIVE) attn_naive_phase(F, KP(sink) + l * 8, nrows); else attn_mfma_phase(F, KP(sink) + l * 8, l == 0); local_mix_phase(F, KP(conv_w) + (size_t)l * 3 * 512, nrows, l == 0 && !ATTN_NAIVE); } SEAM(pb + 2);
        if (IN(pb + 3)) REP(pb + 3) { SITE();
            SchedStd S{(const char*)(F.ws + WS_MIX), (const char*)(F.ws + WS_WBR) + (size_t)l * D * MIXW * 2, (size_t)256 * MIXW * 2, (size_t)256 * MIXW * 2, l == 0 ? 68 : 64, 4, F.G, F.bx, 0, 0, 0};
            EpiBrG E{(const bf16*)(F.ws + WS_Z), (bf16*)(F.ws + WS_Y)};
            pg8::gemm_phase<EpiBrG, SchedStd, true, true>(ring, MIXW * 2, MIXW * 2, MIXW * 2, S, E);
        } SEAM(pb + 3);
        if (IN(pb + 4)) REP(pb + 4) { SITE(); const float* modl = (const float*)(F.ws + WS_MODV) + (size_t)l * 5 * MODW; const float* X2 = (const float*)(F.ws + WS_X2);
            const float* xl = l == 0 ? KP(x) : X2; const float* xc = l == 0 ? KP(ctx) : X2 + (size_t)ML * D;
            SchedStd S{(const char*)(F.ws + WS_Y), (const char*)(F.ws + WS_WOUT) + (size_t)l * D * D * 2, (size_t)256 * D * 2, (size_t)256 * D * 2, l == 0 ? 68 : 64, 4, F.G, F.bx, 0, 0, 0};
            EpiRes E{xl, xc, (float*)(F.ws + WS_X1), modl + 2 * D};
            pg8::gemm_phase<EpiRes, SchedStd, true, true>(ring, D * 2, D * 2, D * 2, S, E);
        } SEAM(pb + 4);
}
constexpr int N_PHASES = 19;
__global__ void __launch_bounds__(NTHR, 2) mk_fwd(Args args_byval) {
    extern __shared__ __attribute__((aligned(16))) unsigned char lds_raw[];
    Frame F;
    F.lds = (LAS unsigned char*)lds_raw;
    F.tid = threadIdx.x; F.lane = F.tid & 63; F.wave = __builtin_amdgcn_readfirstlane(F.tid >> 6);
    F.G = gridDim.x; F.bx = blockIdx.x;
    SITE();
    volatile LAS unsigned* MISC = (volatile LAS unsigned*)(F.lds + MISC_OFF);
    for (int u = F.tid; u < (LDS_BYTES - LDSCTL_OFF) / 4; u += NTHR) ((LAS unsigned*)(F.lds + LDSCTL_OFF))[u] = 0u;
    __syncthreads();
    const int lo = karg_i<(int)__builtin_offsetof(Args, ph_lo)>(), hi = karg_i<(int)__builtin_offsetof(Args, ph_hi)>();
    const bool fused = (hi - lo) > 1;
    XcdBarrier bar; bar.bar = (unsigned*)(F.ws + WS_CTL) + CW_BAR; bar.x = 0; bar.st = nullptr;
    if (fused) bar = xcd_barrier_post((unsigned*)(F.ws + WS_CTL) + CW_BAR, MISC + 8);
    LAS unsigned char* ring = F.lds;

    if (IN(0)) REP(0) { SITE(); p0_prologue(F); } SEAM(0);

    layer_common<0>(F, lo, hi, bar, ring);
    {
            if (IN(6)) REP(6) { SITE(); const float* X1 = (const float*)(F.ws + WS_X1); norm_mod_phase<false, FFN0_FP8 ? 1 : 0>(F, X1, X1 + (size_t)ML * D, KP(norm2_g), (const float*)(F.ws + WS_MODV), 3, 4, MT, nullptr); } SEAM(6);
            if (IN(7)) REP(7) { SITE();
                constexpr int EB = FFN0_FP8 ? 1 : 2;
                SchedStd S{(const char*)(F.ws + WS_H), (const char*)(F.ws + WS_WGU0), (size_t)256 * D * EB, (size_t)256 * D * EB, 68, 22, F.G, F.bx, 0, 0, 0};
                EpiSwiglu<FFN0_FP8 != 0> E{(unsigned char*)(F.ws + WS_ACT), DFF};
                pg8::gemm_phase<EpiSwiglu<FFN0_FP8 != 0>, SchedStd, true, true, FFN0_FP8 != 0>(ring, D * EB, D * EB, D * EB, S, E);
            } SEAM(7);
            if (IN(8)) REP(8) { SITE(); const float* X1 = (const float*)(F.ws + WS_X1);
                constexpr int EB = FFN0_FP8 ? 1 : 2;
                SchedStd S{(const char*)(F.ws + WS_ACT), (const char*)(F.ws + WS_WDN0), (size_t)256 * DFF * EB, (size_t)256 * DFF * EB, 68, 4, F.G, F.bx, 0, 0, 0};
                EpiRes E{X1, X1 + (size_t)ML * D, (float*)(F.ws + WS_X2), (const float*)(F.ws + WS_MODV) + 5 * D};
                pg8::gemm_phase<EpiRes, SchedStd, true, true, FFN0_FP8 != 0>(ring, DFF * EB, DFF * EB, DFF * EB, S, E);
            } SEAM(8);
    }
    layer_common<1>(F, lo, hi, bar, ring);
    {
            if (IN(14)) REP(14) { SITE(); const float* X1 = (const float*)(F.ws + WS_X1); norm_mod_phase<true, 1>(F, X1, X1, KP(norm2_g) + D, (const float*)(F.ws + WS_MODV) + (size_t)5 * MODW, 3, 4, ML, KP(router_w)); } SEAM(14);
            if (IN(15)) REP(15) { SITE(); moe_scatter_phase(F); } SEAM(15);
            if (IN(16)) REP(16) { SITE();
                SchedMoe S{(const char*)(F.ws + WS_H2S), (const char*)(F.ws + WS_WMGU), (size_t)256 * D, (size_t)2 * DFE * D, (size_t)256 * D, 28, F.G, F.bx, (const int*)(F.ws + WS_TILE)};
                EpiSwiglu<true> E{(unsigned char*)(F.ws + WS_ACT), DFE};
                pg8::gemm_phase<EpiSwiglu<true>, SchedMoe, true, true, true>(ring, D, D, D, S, E);
            } SEAM(16);
            if (IN(17)) REP(17) { SITE();
                SchedMoe S{(const char*)(F.ws + WS_ACT), (const char*)(F.ws + WS_WMDN), (size_t)256 * DFE, (size_t)D * DFE, (size_t)256 * DFE, 4, F.G, F.bx, (const int*)(F.ws + WS_TILE)};
                EpiPlain E{(bf16*)(F.ws + WS_YS), D};
                pg8::gemm_phase<EpiPlain, SchedMoe, true, true, true>(ring, DFE, DFE, DFE, S, E);
            } SEAM(17);
            if (IN(18)) REP(18) { SITE(); final_phase(F, KP(final_g), (float*)karg_p<(int)__builtin_offsetof(Args, out)>(), (const float*)(F.ws + WS_MODV) + (size_t)5 * MODW); }
        }

#undef IN
#undef SEAM
}

extern "C" void kernel_launch(void* const* d_in, const int* in_sizes, int n_in, void* d_out, int out_size, void* d_ws, size_t ws_size, hipStream_t stream) {
    static int grid = 0;
    if (grid == 0) {
        if (n_in != 21 || out_size != ML * D || ws_size < WS_END) { fprintf(stderr, "kernel_launch: unexpected sizes (n_in %d, out %d, ws %zu < %zu)\n", n_in, out_size, ws_size, (size_t)WS_END); grid = -1; return; }
        int dev = 0, cus = 0, per_cu = 0;
        if (hipGetDevice(&dev) != hipSuccess || hipDeviceGetAttribute(&cus, hipDeviceAttributeMultiprocessorCount, dev) != hipSuccess) { grid = -1; return; }
        if (hipFuncSetAttribute((const void*)mk_fwd, hipFuncAttributeMaxDynamicSharedMemorySize, LDS_BYTES) != hipSuccess) { fprintf(stderr, "kernel_launch: hipFuncSetAttribute failed\n"); grid = -1; return; }
        if (hipOccupancyMaxActiveBlocksPerMultiprocessor(&per_cu, (const void*)mk_fwd, NTHR, LDS_BYTES) != hipSuccess || per_cu < 1) { fprintf(stderr, "kernel_launch: occupancy query says %d\n", per_cu); per_cu = 1; }
        (void)hipGetLastError();
        grid = cus;
    }
    if (grid < 0) return;
    (void)hipMemsetAsync((char*)d_ws + WS_CTL, 0, CTL_ZERO_BYTES, stream);
    Args a{};
    const float** pp = (const float**)&a;
    for (int i = 0; i < 21; ++i) pp[i] = (const float*)d_in[i];
    a.out = (float*)d_out; a.ws = (unsigned char*)d_ws;
#if MK_FUSED
    a.ph_lo = 0; a.ph_hi = N_PHASES;
    hipLaunchKernelGGL(mk_fwd, dim3(grid), dim3(NTHR), LDS_BYTES, stream, a);
#else
    for (int p = 0; p < N_PHASES; ++p) { a.ph_lo = p; a.ph_hi = p + 1; hipLaunchKernelGGL(mk_fwd, dim3(grid), dim3(NTHR), LDS_BYTES, stream, a); }
#endif
}
```

```cpp
#include <hip/hip_runtime.h>
#include <cstdio>
#include <cstdint>

#ifndef ATTN_NAIVE
#define ATTN_NAIVE 0
#endif
#ifndef DN0_FP8
#define DN0_FP8 1
#endif
#ifndef FFN0_FP8
#define FFN0_FP8 0
#endif
#ifndef PROBE_ATT
#define PROBE_ATT 0
#endif
#ifndef PROBE_MIXL
#define PROBE_MIXL 0
#endif
#ifndef MK_FUSED
#define MK_FUSED 1
#endif

#define LAS __attribute__((address_space(3)))
#define GAS __attribute__((address_space(1)))
typedef unsigned short bf16;
typedef short bf16x8 __attribute__((ext_vector_type(8)));
typedef float f32x4 __attribute__((ext_vector_type(4)));
typedef float f32x2 __attribute__((ext_vector_type(2)));
typedef unsigned u32x4 __attribute__((ext_vector_type(4)));
typedef unsigned u32x2 __attribute__((ext_vector_type(2)));
typedef GAS unsigned gu32;

constexpr int D = 1024, NB = 4, SEQ = 4096, ML = NB * SEQ, CTXL = 256, MC = NB * CTXL, MT = ML + MC;
constexpr int INW = 5888, DFF = 2816, DFE = 3584, NE = 8;
constexpr int ZQ = 0, ZK = 512, ZV = 640, ZCX = 768, ZCB = 1280, ZCC = 1792, ZPU = 2304, ZG = 2816;
constexpr int MIXW = 1536;
constexpr int MS = 2 * ML + NE * 256;
constexpr int MODW = 6 * D;
constexpr float EPS = 1e-6f;
constexpr float LOG2E = 1.4426950408889634f, QSCALE = 0.125f * LOG2E;
constexpr int NWAVES = 8, NTHR = 512;

__device__ __forceinline__ unsigned f2bf(float f) { unsigned u = __builtin_bit_cast(unsigned, f); return (u + 0x7fffu + ((u >> 16) & 1u)) >> 16; }
__device__ __forceinline__ unsigned pk2(float lo, float hi) { return f2bf(lo) | (f2bf(hi) << 16); }
__device__ __forceinline__ float bf2f(unsigned b) { return __builtin_bit_cast(float, b << 16); }
__device__ __forceinline__ unsigned pk4_fp8(float a, float b, float c, float d) { int w = 0; w = __builtin_amdgcn_cvt_pk_fp8_f32(a, b, w, false); w = __builtin_amdgcn_cvt_pk_fp8_f32(c, d, w, true); return (unsigned)w; }
constexpr float W8SCALE = 256.0f;
__device__ __forceinline__ float bflo(unsigned w) { return __builtin_bit_cast(float, w << 16); }
__device__ __forceinline__ float bfhi(unsigned w) { return __builtin_bit_cast(float, w & 0xffff0000u); }

namespace pg8 {
constexpr int BM = 256, BK = 64, HALF = 128, HTB = HALF * BK * 2, STAGE_BYTES = 8 * HTB, NXCD = 8, WGM = 8;
__host__ __device__ __forceinline__ int lds_byte(int r, int c) { const int st = (r >> 4) * 2 + (c >> 5), rr = r & 15, cc = c & 31, ob = rr * 64 + cc * 2; return st * 1024 + (ob ^ (((ob >> 9) & 1) << 5)); }
__host__ __device__ __forceinline__ void stage_rc(int b, int& R, int& C) { const int st = b / 1024, sb = b % 1024, swz = sb ^ (((sb >> 9) & 1) << 5); R = (st >> 1) * 16 + swz / 64; C = (st & 1) * 32 + (swz % 64) / 2; }
__host__ __device__ __forceinline__ int perm32(int rho) { const int n = rho >> 4, i = rho & 15; return 8 * (i >> 2) + 4 * n + (i & 3); }

struct Unit { int pm, pn, tag; const char* a; const char* b; };

__device__ __forceinline__ void tile_of(int L, int nM, int nN, int& pm, int& pn) {
    const int nwg = nM * nN; int wgid = L;
    { const int q = nwg / NXCD, r = nwg % NXCD, xcd = wgid % NXCD, off = wgid / NXCD; wgid = (xcd < r ? xcd * (q + 1) : r * (q + 1) + (xcd - r) * q) + off; }
    const int nig = WGM * nN, gid = wgid / nig, fm = gid * WGM, gsz = (nM - fm) < WGM ? (nM - fm) : WGM;
    pm = fm + ((wgid % nig) % gsz); pn = (wgid % nig) / gsz;
}

typedef __bf16 bf16x2_t __attribute__((ext_vector_type(2)));
__device__ __forceinline__ unsigned cvt_pk_bf16(float lo, float hi) { f32x2 v = {lo, hi}; bf16x2_t b = __builtin_convertvector(v, bf16x2_t); return __builtin_bit_cast(unsigned, b); }

typedef int i32x8 __attribute__((ext_vector_type(8)));
typedef int i32x4 __attribute__((ext_vector_type(4)));
template <class Epi, class Sched, bool ALIGN_EPI = false, bool SP2 = false, bool FP8 = false>
__device__ __forceinline__ void gemm_phase(LAS unsigned char* lds, const int lda, const int ldb, const int K, const Sched& S, const Epi& E) {
    int tid_ = threadIdx.x; asm volatile("" : "+v"(tid_));
    const int tid = tid_, wid = __builtin_amdgcn_readfirstlane(tid >> 6), lane = tid & 63, wr = wid >> 2, wc = wid & 3, fr = lane & 15, fq = lane >> 4;
    const int nt = K / 128;
    unsigned voffA[2], voffB[2];
#pragma unroll
    for (int i = 0; i < 2; ++i) { int R, C; stage_rc(tid * 16 + i * 8192, R, C); const int Rb = Epi::PERM ? ((R & ~31) + perm32(R & 31)) : R;
        voffA[i] = (unsigned)(R * lda + C * 2); voffB[i] = (unsigned)(Rb * ldb + C * 2); }
    const size_t kstep = (size_t)(BK * 2);
    const size_t hstepA = (size_t)HALF * lda, hstepB = (size_t)HALF * ldb;
    const unsigned ldsw = (unsigned)wid * 1024u;
    const int aoff = lds_byte(wr * 64 + fr, fq * 8), boff = lds_byte(wc * 32 + fr, fq * 8);
#define PG8_SA(b, h) (((b) * 2 + (h)) * HTB)
#define PG8_SB(b, h) ((4 + (b) * 2 + (h)) * HTB)
#define PG8_STAGE(bufoff, gbase, voff) do { _Pragma("unroll") for (int _i = 0; _i < 2; ++_i) \
        __builtin_amdgcn_global_load_lds((const unsigned*)((const char*)(gbase) + (voff)[_i]), (LAS unsigned*)(lds + (bufoff) + ldsw + _i * 8192), 16, 0, 0); } while (0)
#define PG8_RD(off) __builtin_bit_cast(i32x4, *(const LAS bf16x8*)(lds + (off)))
#define PG8_LDA(dst, b, h) do { _Pragma("unroll") for (int m = 0; m < 4; ++m) dst[m] = __builtin_shufflevector(PG8_RD(PG8_SA(b, h) + aoff + m * 2048), PG8_RD(PG8_SA(b, h) + aoff + m * 2048 + 1024), 0, 1, 2, 3, 4, 5, 6, 7); } while (0)
#define PG8_LDB(dst, b, h) do { _Pragma("unroll") for (int n = 0; n < 2; ++n) dst[n] = __builtin_shufflevector(PG8_RD(PG8_SB(b, h) + boff + n * 2048), PG8_RD(PG8_SB(b, h) + boff + n * 2048 + 1024), 0, 1, 2, 3, 4, 5, 6, 7); } while (0)
#define PG8_LO(x) __builtin_bit_cast(bf16x8, __builtin_shufflevector((x), (x), 0, 1, 2, 3))
#define PG8_HI(x) __builtin_bit_cast(bf16x8, __builtin_shufflevector((x), (x), 4, 5, 6, 7))
#define PG8_MMA(ai, bj, At, Bt) do { __builtin_amdgcn_s_setprio(1); _Pragma("unroll") for (int m = 0; m < 4; ++m) _Pragma("unroll") for (int n = 0; n < 2; ++n) { \
        if constexpr (FP8) asm volatile("s_nop 1\n\tv_mfma_scale_f32_16x16x128_f8f6f4 %0, %1, %2, %0, %3, %4 op_sel_hi:[0,0,0]" : "+v"(acc[ai][bj][m][n]) : "v"(Bt[n]), "v"(At[m]), "v"(sc_w), "v"(sc_a)); \
        else { acc[ai][bj][m][n] = __builtin_amdgcn_mfma_f32_16x16x32_bf16(PG8_LO(Bt[n]), PG8_LO(At[m]), acc[ai][bj][m][n], 0, 0, 0); \
               acc[ai][bj][m][n] = __builtin_amdgcn_mfma_f32_16x16x32_bf16(PG8_HI(Bt[n]), PG8_HI(At[m]), acc[ai][bj][m][n], 0, 0, 0); } } __builtin_amdgcn_s_setprio(0); } while (0)
#define PG8_WAIT_V(n) asm volatile("s_waitcnt vmcnt(" #n ")" ::: "memory")
#define PG8_WAIT_L(n) asm volatile("s_waitcnt lgkmcnt(" #n ")" ::: "memory")
#define PG8_BAR __builtin_amdgcn_s_barrier()
#define PG8_SCHED __builtin_amdgcn_sched_barrier(0)
    Unit cur, nxt; int ui = 0;
    if (!S.next(0, cur)) return;
    f32x4 acc[2][2][4][2];
#pragma unroll
    for (int a = 0; a < 2; ++a)
#pragma unroll
        for (int b = 0; b < 2; ++b)
#pragma unroll
            for (int m = 0; m < 4; ++m)
#pragma unroll
                for (int n = 0; n < 2; ++n) acc[a][b][m][n] = (f32x4){0.f, 0.f, 0.f, 0.f};
    i32x8 At[4], B0[2], B1[2];
    const int sc_w = 0x77777777, sc_a = 0x7f7f7f7f;
    const char* cA = cur.a; const char* cB = cur.b;
    if constexpr (SP2) {
        PG8_STAGE(PG8_SB(0, 0), cB, voffB); PG8_STAGE(PG8_SB(0, 1), cB + hstepB, voffB); PG8_STAGE(PG8_SA(0, 0), cA, voffA); PG8_STAGE(PG8_SA(0, 1), cA + hstepA, voffA);
        if (wr == 1) PG8_BAR;
        PG8_WAIT_V(2); PG8_BAR;
        PG8_STAGE(PG8_SB(1, 0), cB + kstep, voffB); PG8_STAGE(PG8_SA(1, 0), cA + kstep, voffA); PG8_STAGE(PG8_SB(1, 1), cB + hstepB + kstep, voffB);
        PG8_WAIT_V(6); PG8_BAR;
    } else {
        PG8_STAGE(PG8_SB(0, 0), cB, voffB); PG8_STAGE(PG8_SA(0, 0), cA, voffA); PG8_STAGE(PG8_SB(0, 1), cB + hstepB, voffB); PG8_STAGE(PG8_SA(0, 1), cA + hstepA, voffA);
        if (wr == 1) PG8_BAR;
        PG8_WAIT_V(4); PG8_BAR;
        PG8_STAGE(PG8_SB(1, 0), cB + kstep, voffB); PG8_STAGE(PG8_SA(1, 0), cA + kstep, voffA); PG8_STAGE(PG8_SB(1, 1), cB + hstepB + kstep, voffB);
        PG8_WAIT_V(6); PG8_BAR;
    }
    for (;;) {
        const bool has_next = S.next(ui + 1, nxt);
        const char* nA = has_next ? nxt.a : cA; const char* nB = has_next ? nxt.b : cB;
        for (int t = 0; t < nt; t += 2) {
            const bool last = (t == nt - 2);
            const char* a1 = cA + (size_t)(t + 1) * kstep;
            const char* a2 = last ? nA : cA + (size_t)(t + 2) * kstep; const char* b2 = last ? nB : cB + (size_t)(t + 2) * kstep;
            const char* a3 = a2 + kstep; const char* b3 = b2 + kstep;
            if constexpr (SP2) {
            PG8_LDB(B0, 0, 0); PG8_LDB(B1, 0, 1); PG8_SCHED; PG8_LDA(At, 0, 0); PG8_STAGE(PG8_SA(1, 1), a1 + hstepA, voffA);
            PG8_WAIT_V(8); PG8_WAIT_L(0); PG8_BAR; PG8_MMA(0, 0, At, B0); PG8_MMA(0, 1, At, B1); PG8_BAR; PG8_SCHED;
            PG8_LDA(At, 0, 1); PG8_STAGE(PG8_SB(0, 0), b2, voffB); PG8_STAGE(PG8_SB(0, 1), b2 + hstepB, voffB); PG8_STAGE(PG8_SA(0, 0), a2, voffA);
            PG8_WAIT_V(8); PG8_WAIT_L(0); PG8_BAR; PG8_MMA(1, 0, At, B0); PG8_MMA(1, 1, At, B1); PG8_BAR; PG8_SCHED;
            PG8_LDB(B0, 1, 0); PG8_LDB(B1, 1, 1); PG8_SCHED; PG8_LDA(At, 1, 0); PG8_STAGE(PG8_SA(0, 1), a2 + hstepA, voffA);
            PG8_WAIT_V(8); PG8_WAIT_L(0); PG8_BAR; PG8_MMA(0, 0, At, B0); PG8_MMA(0, 1, At, B1); PG8_BAR; PG8_SCHED;
            PG8_LDA(At, 1, 1); PG8_STAGE(PG8_SB(1, 0), b3, voffB); PG8_STAGE(PG8_SB(1, 1), b3 + hstepB, voffB); PG8_STAGE(PG8_SA(1, 0), a3, voffA);
            PG8_WAIT_V(8); PG8_WAIT_L(0); PG8_BAR; PG8_MMA(1, 0, At, B0); PG8_MMA(1, 1, At, B1); PG8_BAR; PG8_SCHED;
            } else {
            PG8_LDB(B0, 0, 0); PG8_SCHED; PG8_LDA(At, 0, 0); PG8_STAGE(PG8_SA(1, 1), a1 + hstepA, voffA);
            PG8_WAIT_L(8); PG8_BAR; PG8_WAIT_L(0); PG8_MMA(0, 0, At, B0); PG8_BAR; PG8_SCHED;
            PG8_LDB(B1, 0, 1); PG8_STAGE(PG8_SB(0, 0), b2, voffB);
            PG8_BAR; PG8_WAIT_L(0); PG8_MMA(0, 1, At, B1); PG8_BAR;
            PG8_LDA(At, 0, 1); PG8_STAGE(PG8_SA(0, 0), a2, voffA);
            PG8_BAR; PG8_WAIT_L(0); PG8_MMA(1, 0, At, B0); PG8_BAR; PG8_SCHED;
            PG8_STAGE(PG8_SB(0, 1), b2 + hstepB, voffB);
            PG8_WAIT_V(6); PG8_BAR; PG8_MMA(1, 1, At, B1); PG8_BAR;
            PG8_LDB(B0, 1, 0); PG8_SCHED; PG8_LDA(At, 1, 0); PG8_STAGE(PG8_SA(0, 1), a2 + hstepA, voffA);
            PG8_WAIT_L(8); PG8_BAR; PG8_WAIT_L(0); PG8_MMA(0, 0, At, B0); PG8_BAR; PG8_SCHED;
            PG8_LDB(B1, 1, 1); PG8_STAGE(PG8_SB(1, 0), b3, voffB);
            PG8_BAR; PG8_WAIT_L(0); PG8_MMA(0, 1, At, B1); PG8_BAR;
            PG8_LDA(At, 1, 1); PG8_STAGE(PG8_SA(1, 0), a3, voffA);
            PG8_BAR; PG8_WAIT_L(0); PG8_MMA(1, 0, At, B0); PG8_BAR; PG8_SCHED;
            PG8_STAGE(PG8_SB(1, 1), b3 + hstepB, voffB);
            PG8_WAIT_V(6); PG8_BAR; PG8_MMA(1, 1, At, B1); PG8_BAR;
            }
            if constexpr (Epi::MIDHOOK) { if (((t + 2) & 7) == 0 && !last) { int fr_ = fr, fq_ = fq; asm volatile("" : "+v"(fr_), "+v"(fq_)); E.mid(acc, cur, (t + 2) >> 3, wr, wc, fr_, fq_); } }
        }
        if constexpr (ALIGN_EPI) { if (wr == 0) PG8_BAR; }
        if constexpr (FP8) asm volatile("s_nop 15\n\ts_nop 15" ::: "memory");
        { int fr_ = fr, fq_ = fq; asm volatile("" : "+v"(fr_), "+v"(fq_));
          E(acc, cur, wr, wc, fr_, fq_); }
        if (!has_next) break;
#pragma unroll
        for (int a = 0; a < 2; ++a)
#pragma unroll
            for (int b = 0; b < 2; ++b)
#pragma unroll
                for (int m = 0; m < 4; ++m)
#pragma unroll
                    for (int n = 0; n < 2; ++n) acc[a][b][m][n] = (f32x4){0.f, 0.f, 0.f, 0.f};
        cur = nxt; cA = nA; cB = nB; ++ui;
        if constexpr (ALIGN_EPI) { if (wr == 1) PG8_BAR; }
    }
    PG8_WAIT_V(0);
    if constexpr (!ALIGN_EPI) { if (wr == 0) PG8_BAR; }
    PG8_BAR;
#undef PG8_SA
#undef PG8_SB
#undef PG8_STAGE
#undef PG8_LDA
#undef PG8_LDB
#undef PG8_MMA
#undef PG8_RD
#undef PG8_LO
#undef PG8_HI
#undef PG8_WAIT_V
#undef PG8_WAIT_L
#undef PG8_BAR
#undef PG8_SCHED
}
}

constexpr size_t MiB = 1u << 20;
constexpr size_t al256(size_t x) { return (x + 255) & ~(size_t)255; }
constexpr size_t WS_CTL = 0, CTL_ZERO_BYTES = 1 * MiB;
constexpr size_t WS_MODV = 1 * MiB;
constexpr size_t WS_ROPE = WS_MODV + al256((size_t)2 * 5 * MODW * 4);
constexpr size_t WS_CNTWG = WS_ROPE + al256(64 * 16 * 2 * 4);
constexpr size_t WS_TOKE = WS_CNTWG + al256(256 * 8 * 4);
constexpr size_t WS_TOKP = WS_TOKE + al256((size_t)ML * 2 * 4);
constexpr size_t WS_TOKW = WS_TOKP + al256((size_t)ML * 2 * 4);
constexpr size_t WS_TOKS = WS_TOKW + al256((size_t)ML * 2 * 4);
constexpr size_t WS_TILE = WS_TOKS + al256((size_t)ML * 2 * 4);
constexpr size_t WS_WIN = 4 * MiB;
constexpr size_t WS_WBR = WS_WIN + (size_t)2 * INW * D * 2;
constexpr size_t WS_WOUT = WS_WBR + (size_t)2 * 3 * D * 512 * 2;
constexpr size_t WS_WGU0 = WS_WOUT + (size_t)2 * D * D * 2;
constexpr size_t WS_WDN0 = WS_WGU0 + (size_t)2 * DFF * D * 2;
constexpr size_t WS_WMGU = WS_WDN0 + (size_t)D * DFF * 2;
constexpr size_t WS_WMDN = WS_WMGU + (size_t)NE * 2 * DFE * D * 2;
constexpr size_t WS_H = WS_WMDN + (size_t)NE * D * DFE * 2;
constexpr size_t WS_Z = WS_H + (size_t)MT * D * 2;
constexpr size_t WS_MIX = WS_Z + (size_t)MT * INW * 2;
constexpr size_t WS_ACT = WS_Z;
constexpr size_t WS_YACC = WS_MIX + (size_t)MT * MIXW * 2;
constexpr size_t WS_H2S = WS_YACC;
constexpr size_t WS_Y = WS_YACC + (size_t)MT * D * 4;
constexpr size_t WS_X1 = WS_Y + (size_t)MT * D * 2;
constexpr size_t WS_X2 = WS_X1 + (size_t)MT * D * 4;
constexpr size_t WS_YS = WS_X2;
constexpr size_t WS_H8 = WS_X2 + (size_t)MT * D * 4;
constexpr size_t WS_WIN8 = WS_H8 + (size_t)MT * D;
constexpr size_t WS_END = WS_WIN8 + (size_t)2 * 3 * D * D;
static_assert((size_t)MS * DFE * 2 <= (size_t)MT * INW * 2 + (size_t)MT * MIXW * 2, "ACT overlay");
static_assert((size_t)MS * D * 2 <= (size_t)MT * D * 4, "H2S / YS overlays");
static_assert(WS_TILE + 1024 <= WS_WIN, "small tables");
constexpr int CW_BAR = 4096;

constexpr int RING_BYTES = 131072;
constexpr int LDSCTL_OFF = 146944, MISC_OFF = LDSCTL_OFF + 320;
constexpr int LDS_BYTES = 147456;

#define XB_TMO      128
#define XB_XCNT(j)  (256  + 64 * (j))
#define XB_XSUB(j)  (1280 + 64 * (j))
#define XB_XGEN(j)  (2304 + 64 * (j))
#define XB_TOP      3328
#define XB_TOPGEN   3392
#define XCD_BAR_WORDS 3456
#define XB_SPIN_CAP (1u << 18)
__device__ __forceinline__ unsigned xb_ld(unsigned* p)              { return __hip_atomic_load(p, __ATOMIC_RELAXED, __HIP_MEMORY_SCOPE_AGENT); }
__device__ __forceinline__ unsigned xb_add(unsigned* p, unsigned v) { return __hip_atomic_fetch_add(p, v, __ATOMIC_RELAXED, __HIP_MEMORY_SCOPE_AGENT); }
__device__ __forceinline__ unsigned xb_xcc_id() { return (unsigned)__builtin_amdgcn_s_getreg((3 << 11) | 20) & 0xFu; }
#define XB_SPIN(cond, bar) do { unsigned _sp = 0; while (cond) { __builtin_amdgcn_s_sleep(1); \
    if ((++_sp & 255u) == 0u) { if (xb_ld(&(bar)[XB_TMO])) break; if (_sp > XB_SPIN_CAP) { atomicAdd(&(bar)[XB_TMO], 1u); break; } } } } while (0)
struct XcdBarrier { unsigned* bar; unsigned x; volatile LAS unsigned* st; };
__device__ __forceinline__ XcdBarrier xcd_barrier_post(unsigned* bar, volatile LAS unsigned* st) {
    XcdBarrier b; b.bar = bar; b.x = xb_xcc_id(); b.st = st;
    if (threadIdx.x == 0) (void)xb_add(&bar[XB_XCNT(b.x)], 1u);
    return b;
}
__device__ __forceinline__ void xcd_barrier_complete(unsigned* bar, unsigned x, unsigned& nloc, unsigned& nx) {
    const unsigned G = gridDim.x * gridDim.y * gridDim.z;
    unsigned sum, cnt, mine, sp = 0u;
    for (;;) {
        sum = 0u; cnt = 0u; mine = 0u;
#pragma unroll
        for (unsigned j = 0; j < 16; ++j) { const unsigned c = xb_ld(&bar[XB_XCNT(j)]); sum += c; cnt += (c > 0u) ? 1u : 0u; mine = (j == x) ? c : mine; }
        if (sum == G) break;
        __builtin_amdgcn_s_sleep(1);
        if ((++sp & 255u) == 0u) { if (xb_ld(&bar[XB_TMO])) break; if (sp > XB_SPIN_CAP) { atomicAdd(&bar[XB_TMO], 1u); break; } }
    }
    nloc = mine > 0u ? mine : 1u; nx = cnt > 0u ? cnt : 1u;
}
__device__ __attribute__((noinline)) void xcd_barrier_leader(unsigned* bar, unsigned bx_, volatile LAS unsigned* st) {
    {
        XcdBarrier b; b.bar = bar; b.x = bx_; b.st = st;
        __builtin_amdgcn_s_waitcnt(0);
        unsigned nloc = b.st[0], nx = b.st[1];
        if (nloc == 0u) { xcd_barrier_complete(bar, b.x, nloc, nx); b.st[0] = nloc; b.st[1] = nx; }
        const unsigned old = xb_add(&bar[XB_XSUB(b.x)], 1u);
        const unsigned gen = old / nloc;
        if (old + 1u == (gen + 1u) * nloc) {
            __builtin_amdgcn_fence(__ATOMIC_RELEASE, "agent");
            asm volatile("s_waitcnt vmcnt(0)" ::: "memory");
            const unsigned og = xb_add(&bar[XB_TOP], 1u);
            const unsigned tg = og / nx;
            if (og + 1u == (tg + 1u) * nx) xb_add(&bar[XB_TOPGEN], 1u);
            else XB_SPIN(xb_ld(&bar[XB_TOPGEN]) == tg, bar);
            __builtin_amdgcn_fence(__ATOMIC_ACQUIRE, "agent");
            xb_add(&bar[XB_XGEN(b.x)], 1u);
            asm volatile("s_waitcnt vmcnt(0)" ::: "memory");
        } else {
            XB_SPIN(xb_ld(&bar[XB_XGEN(b.x)]) == gen, bar);
            __builtin_amdgcn_fence(__ATOMIC_ACQUIRE, "agent");
            asm volatile("s_waitcnt vmcnt(0)" ::: "memory");
        }
    }
}
__device__ __forceinline__ void xcd_barrier(const XcdBarrier& b) {
    asm volatile("s_waitcnt vmcnt(0)" ::: "memory");
    __syncthreads();
    if (threadIdx.x == 0) xcd_barrier_leader(b.bar, b.x, b.st);
    __syncthreads();
}

struct Args {
    const float *x, *c, *ctx, *c_ctx, *norm1_g, *norm2_g, *final_g, *w_mod, *b_mod, *w_in, *conv_w, *sink, *pool_w, *pool_scale, *w_branch, *w_out,
                *ffn_w_gu, *ffn_w_down, *router_w, *moe_w_gu, *moe_w_down;
    float* out; unsigned char* ws; int ph_lo, ph_hi;
};
template <int OFF> __device__ __forceinline__ const void* karg_p() { const void* r; asm volatile("s_load_dwordx2 %0, %1, %2\n\ts_waitcnt lgkmcnt(0)" : "=s"(r) : "s"(__builtin_amdgcn_kernarg_segment_ptr()), "i"(OFF)); return r; }
template <int OFF> __device__ __forceinline__ int karg_i() { int r; asm volatile("s_load_dword %0, %1, %2\n\ts_waitcnt lgkmcnt(0)" : "=s"(r) : "s"(__builtin_amdgcn_kernarg_segment_ptr()), "i"(OFF)); return r; }
#define KP(field) ((const float*)karg_p<(int)__builtin_offsetof(Args, field)>())
struct Frame {
    LAS unsigned char* lds;
    int tid, lane, wave, G, bx;
    unsigned char* ws;
};
__device__ __forceinline__ float wave_sum(float v) {
#pragma unroll
    for (int o = 1; o < 64; o <<= 1) v += __shfl_xor(v, o);
    return v;
}
__device__ __forceinline__ float wave_max(float v) {
#pragma unroll
    for (int o = 1; o < 64; o <<= 1) v = fmaxf(v, __shfl_xor(v, o));
    return v;
}
#define LDS_WAIT() asm volatile("s_waitcnt lgkmcnt(0)" ::: "memory")

template <bool F8>
__device__ __forceinline__ void p0_transpose_item(const float* W, int ldw, bf16* WT, int ldt, int koff, int k0, int n0, int drow0, LAS float* scr, int lane) {
    f32x4 v[16];
    const int rl = lane >> 4, c4 = 4 * (lane & 15);
#pragma unroll
    for (int i = 0; i < 16; ++i) v[i] = __builtin_nontemporal_load((const f32x4*)(W + (size_t)(k0 + 4 * i + rl) * ldw + n0 + c4));
#pragma unroll
    for (int i = 0; i < 16; ++i) { LAS float* p = scr + (4 * i + rl) * 65 + c4; p[0] = v[i].x; p[1] = v[i].y; p[2] = v[i].z; p[3] = v[i].w; }
    LDS_WAIT(); asm volatile("" ::: "memory");
    const int c = lane & 7;
#pragma unroll
    for (int j = 0; j < 8; ++j) { const int n = (lane >> 3) + 8 * j; const LAS float* sp = scr + (8 * c) * 65 + n;
        if constexpr (F8) { u32x2 o; o.x = pk4_fp8(sp[0 * 65] * W8SCALE, sp[1 * 65] * W8SCALE, sp[2 * 65] * W8SCALE, sp[3 * 65] * W8SCALE); o.y = pk4_fp8(sp[4 * 65] * W8SCALE, sp[5 * 65] * W8SCALE, sp[6 * 65] * W8SCALE, sp[7 * 65] * W8SCALE);
            *(u32x2*)((unsigned char*)WT + (size_t)(drow0 + n) * ldt + koff + k0 + 8 * c) = o; }
        else { u32x4 o; o.x = pk2(sp[0 * 65], sp[1 * 65]); o.y = pk2(sp[2 * 65], sp[3 * 65]); o.z = pk2(sp[4 * 65], sp[5 * 65]); o.w = pk2(sp[6 * 65], sp[7 * 65]);
            *(u32x4*)(WT + (size_t)(drow0 + n) * ldt + koff + k0 + 8 * c) = o; } }
    LDS_WAIT(); asm volatile("" ::: "memory");
}
template <bool F8>
__device__ __forceinline__ void p0_job_item(const float* W, int ldw, int K, int N, bf16* WT, int ldt, int koff, int IL, int item, LAS float* scr, int lane) {
    const int nblk = N / 64, kb = item / nblk, nb = item % nblk, n0 = 64 * nb;
    int drow0 = n0;
    if (IL > 0) { const int half = n0 >= IL ? 1 : 0, f = n0 - half * IL; drow0 = 256 * (f / 128) + 128 * half + (f % 128); }
    p0_transpose_item<F8>(W, ldw, WT, ldt, koff, 64 * kb, n0, drow0, scr, lane);
}
__device__ __forceinline__ void p0_prologue(Frame& F) {
    LAS float* scr = (LAS float*)(F.lds + F.wave * 16640);
    const int gw = F.bx * NWAVES + F.wave, NGW = F.G * NWAVES;
    constexpr int I_IN = (D / 64) * (ZG / 64), I_IN8 = (D / 64) * (3 * D / 64), I_BR = (512 / 64) * (D / 64), I_OUT = (D / 64) * (D / 64), I_GU0 = (D / 64) * (2 * DFF / 64), I_DN0 = (DFF / 64) * (D / 64),
                  I_MGU = (D / 64) * (2 * DFE / 64), I_MDN = (DFE / 64) * (D / 64);
    constexpr int NITEMS = 2 * I_IN + 2 * I_IN8 + 4 * I_BR + 2 * I_OUT + I_GU0 + I_DN0 + NE * I_MGU + NE * I_MDN;
    bf16* const wsb = (bf16*)F.ws;
    for (int it = gw; it < NITEMS; it += NGW) {
        int r = it;
        if (r < NE * I_MGU) { const int e = r / I_MGU; p0_job_item<true>(KP(moe_w_gu) + (size_t)e * D * 2 * DFE, 2 * DFE, D, 2 * DFE, (bf16*)(F.ws + WS_WMGU + (size_t)e * 2 * DFE * D), D, 0, DFE, r % I_MGU, scr, F.lane); continue; } r -= NE * I_MGU;
        if (r < NE * I_MDN) { const int e = r / I_MDN; p0_job_item<true>(KP(moe_w_down) + (size_t)e * DFE * D, D, DFE, D, (bf16*)(F.ws + WS_WMDN + (size_t)e * D * DFE), DFE, 0, 0, r % I_MDN, scr, F.lane); continue; } r -= NE * I_MDN;
        if (r < 2 * I_IN) { const int l = r / I_IN; p0_job_item<false>(KP(w_in) + (size_t)l * D * INW, INW, D, ZG, (bf16*)(F.ws + WS_WIN) + (size_t)l * ZG * D, D, 0, 0, r % I_IN, scr, F.lane); continue; } r -= 2 * I_IN;
        if (r < 2 * I_IN8) { const int l = r / I_IN8; p0_job_item<true>(KP(w_in) + (size_t)l * D * INW + ZG, INW, D, 3 * D, (bf16*)(F.ws + WS_WIN8 + (size_t)l * 3 * D * D), D, 0, 0, r % I_IN8, scr, F.lane); continue; } r -= 2 * I_IN8;
        if (r < 4 * I_BR) { const int j = r / I_BR, l = j >> 1, b = j & 1; p0_job_item<false>(KP(w_branch) + (size_t)(l * 3 + b) * 512 * D, D, 512, D, (bf16*)(F.ws + WS_WBR) + (size_t)l * D * MIXW, MIXW, 512 * b, 0, r % I_BR, scr, F.lane); continue; } r -= 4 * I_BR;
        if (r < 2 * I_OUT) { const int l = r / I_OUT; p0_job_item<false>(KP(w_out) + (size_t)l * D * D, D, D, D, (bf16*)(F.ws + WS_WOUT) + (size_t)l * D * D, D, 0, 0, r % I_OUT, scr, F.lane); continue; } r -= 2 * I_OUT;
        if (r < I_GU0) { p0_job_item<FFN0_FP8 != 0>(KP(ffn_w_gu), 2 * DFF, D, 2 * DFF, (bf16*)(F.ws + WS_WGU0), D, 0, DFF, r, scr, F.lane); continue; } r -= I_GU0;
        p0_job_item<(FFN0_FP8 || DN0_FP8)>(KP(ffn_w_down), D, DFF, D, (bf16*)(F.ws + WS_WDN0), DFF, 0, 0, r, scr, F.lane);
    }
    (void)wsb;
    __syncthreads();
    constexpr int I_MOD = 2 * (MODW / 64), I_FOLD = 2 * 4 * (D / 64);
    for (int it = F.bx; it < I_MOD + I_FOLD + 1; it += F.G) {
        if (it < I_MOD) {
            const int l = it / (MODW / 64), cb = it % (MODW / 64);
            LAS float* sv = (LAS float*)F.lds;
            LAS float* red = (LAS float*)(F.lds + 32768);
            for (int i = F.tid; i < 5 * D; i += NTHR) { const int r = i / D, k = i % D; const float v = r < 4 ? KP(c)[r * D + k] : KP(c_ctx)[k]; sv[i] = v / (1.f + __expf(-v)); }
            __syncthreads();
            const int col = cb * 64 + F.lane; const float* wp = KP(w_mod) + (size_t)l * D * MODW + col;
            float a0 = 0.f, a1 = 0.f, a2 = 0.f, a3 = 0.f, a4 = 0.f;
#pragma unroll 8
            for (int kk = 0; kk < 128; ++kk) { const int k = F.wave * 128 + kk; const float w = wp[(size_t)k * MODW];
                a0 += sv[k] * w; a1 += sv[D + k] * w; a2 += sv[2 * D + k] * w; a3 += sv[3 * D + k] * w; a4 += sv[4 * D + k] * w; }
            red[(F.wave * 5 + 0) * 64 + F.lane] = a0; red[(F.wave * 5 + 1) * 64 + F.lane] = a1; red[(F.wave * 5 + 2) * 64 + F.lane] = a2;
            red[(F.wave * 5 + 3) * 64 + F.lane] = a3; red[(F.wave * 5 + 4) * 64 + F.lane] = a4;
            __syncthreads();
            if (F.tid < 320) { const int r = F.tid / 64, ln = F.tid % 64; float s = 0.f;
#pragma unroll
                for (int w = 0; w < 8; ++w) s += red[(w * 5 + r) * 64 + ln];
                const int cc = cb * 64 + ln;
                ((float*)(F.ws + WS_MODV))[(size_t)(l * 5 + r) * MODW + cc] = s + KP(b_mod)[l * MODW + cc]; }
            __syncthreads();
        } else if (it < I_MOD + I_FOLD) {
            const int r = it - I_MOD, l = r / 64, g = (r % 64) / 16, nb = r % 16;
            LAS float* pw = (LAS float*)F.lds;
            const float* pws = KP(pool_w) + (size_t)(l * 4 + g) * 128 * 128;
            for (int i = F.tid; i < 128 * 128; i += NTHR) pw[i] = pws[i];
            __syncthreads();
            const int n = nb * 64 + F.lane; const float* w2 = KP(w_branch) + (size_t)(l * 3 + 2) * 512 * D + (size_t)(128 * g) * D + n;
            const float* ps = KP(pool_scale) + l * 512 + 128 * g;
            float acc[16];
#pragma unroll
            for (int q = 0; q < 16; ++q) acc[q] = 0.f;
            for (int j = 0; j < 128; ++j) { const float wv = w2[(size_t)j * D] * ps[j];
#pragma unroll
                for (int q = 0; q < 16; ++q) acc[q] += pw[(F.wave * 16 + q) * 128 + j] * wv; }
            bf16* dst = (bf16*)(F.ws + WS_WBR) + (size_t)l * D * MIXW + (size_t)n * MIXW + 1024 + 128 * g + F.wave * 16;
            u32x4 o0, o1; o0.x = pk2(acc[0], acc[1]); o0.y = pk2(acc[2], acc[3]); o0.z = pk2(acc[4], acc[5]); o0.w = pk2(acc[6], acc[7]);
            o1.x = pk2(acc[8], acc[9]); o1.y = pk2(acc[10], acc[11]); o1.z = pk2(acc[12], acc[13]); o1.w = pk2(acc[14], acc[15]);
            *(u32x4*)dst = o0; *(u32x4*)(dst + 8) = o1;
            __syncthreads();
        } else {
            for (int i = F.tid; i < 64 * 16; i += NTHR) { const int pos = i / 16, fi = i % 16;
                const float inv = powf(10000.0f, -(float)fi / 16.0f); const float ang = (float)pos * inv;
                ((float*)(F.ws + WS_ROPE))[2 * i] = cosf(ang); ((float*)(F.ws + WS_ROPE))[2 * i + 1] = sinf(ang); }
        }
    }
}

template <bool ROUTER, int OUTM = 0>
__device__ __forceinline__ void norm_mod_phase(Frame& F, const float* xl, const float* xc, const float* gvec, const float* modl, int shi, int sci, int nrows, const float* router_w) {
    bf16* H = (bf16*)(F.ws + WS_H);
    LAS int* lcnt = (LAS int*)F.lds;
    if (ROUTER) { if (F.tid < 8) lcnt[F.tid] = 0; __syncthreads(); }
    if constexpr (!ROUTER) {
        const int nwv = F.G * NWAVES, gw = F.bx * NWAVES + F.wave;
        for (int r0 = gw; r0 < nrows; r0 += 2 * nwv) {
            const bool has1 = r0 + nwv < nrows; const int r1 = has1 ? r0 + nwv : r0;
            const int b0 = r0 < ML ? r0 / SEQ : 4, b1 = r1 < ML ? r1 / SEQ : 4;
            const float* x0 = r0 < ML ? xl + (size_t)r0 * D : xc + (size_t)(r0 - ML) * D; const float* x1 = r1 < ML ? xl + (size_t)r1 * D : xc + (size_t)(r1 - ML) * D;
            const float* m0 = modl + (size_t)b0 * MODW; const float* m1 = modl + (size_t)b1 * MODW;
            f32x4 va[4], vb[4], g[4], sh0[4], sc0[4], sh1[4], sc1[4];
#pragma unroll
            for (int j = 0; j < 4; ++j) { const int c = 4 * F.lane + 256 * j; va[j] = *(const f32x4*)(x0 + c); vb[j] = *(const f32x4*)(x1 + c); }
#pragma unroll
            for (int j = 0; j < 4; ++j) { const int c = 4 * F.lane + 256 * j; g[j] = *(const f32x4*)(gvec + c); sh0[j] = *(const f32x4*)(m0 + shi * D + c); sc0[j] = *(const f32x4*)(m0 + sci * D + c);
                sh1[j] = *(const f32x4*)(m1 + shi * D + c); sc1[j] = *(const f32x4*)(m1 + sci * D + c); }
            float sa = 0.f, sb = 0.f;
#pragma unroll
            for (int j = 0; j < 4; ++j) { sa += (va[j].x * va[j].x + va[j].y * va[j].y) + (va[j].z * va[j].z + va[j].w * va[j].w); sb += (vb[j].x * vb[j].x + vb[j].y * vb[j].y) + (vb[j].z * vb[j].z + vb[j].w * vb[j].w); }
            const float ra = 1.0f / sqrtf(wave_sum(sa) * (1.f / D) + EPS), rb = 1.0f / sqrtf(wave_sum(sb) * (1.f / D) + EPS);
#pragma unroll
            for (int j = 0; j < 4; ++j) { const int c = 4 * F.lane + 256 * j;
                const f32x4 oa = (va[j] * ra * g[j]) * (sc0[j] + 1.0f) + sh0[j], ob = (vb[j] * rb * g[j]) * (sc1[j] + 1.0f) + sh1[j];
                if constexpr (OUTM == 1) { *(unsigned*)((unsigned char*)H + (size_t)r0 * D + c) = pk4_fp8(oa.x, oa.y, oa.z, oa.w); if (has1) *(unsigned*)((unsigned char*)H + (size_t)r1 * D + c) = pk4_fp8(ob.x, ob.y, ob.z, ob.w); }
                else { u32x2 o; o.x = pk2(oa.x, oa.y); o.y = pk2(oa.z, oa.w); *(u32x2*)(H + (size_t)r0 * D + c) = o; if (has1) { o.x = pk2(ob.x, ob.y); o.y = pk2(ob.z, ob.w); *(u32x2*)(H + (size_t)r1 * D + c) = o; } }
                if constexpr (OUTM == 2) { *(unsigned*)(F.ws + WS_H8 + (size_t)r0 * D + c) = pk4_fp8(oa.x, oa.y, oa.z, oa.w); if (has1) *(unsigned*)(F.ws + WS_H8 + (size_t)r1 * D + c) = pk4_fp8(ob.x, ob.y, ob.z, ob.w); } }
        }
        return;
    }
    const int nloop = ROUTER ? 8 : (nrows + F.G * NWAVES - 1) / (F.G * NWAVES);
    for (int i = 0; i < nloop; ++i) {
        const int r = ROUTER ? (F.bx * 64 + F.wave + 8 * i) : ((i * F.G + F.bx) * NWAVES + F.wave);
        if (r >= nrows) continue;
        const int bidx = r < ML ? r / SEQ : 4;
        const float* xr = r < ML ? xl + (size_t)r * D : xc + (size_t)(r - ML) * D;
        const float* mv = modl + (size_t)bidx * MODW;
        f32x4 v[4]; float ss = 0.f;
#pragma unroll
        for (int j = 0; j < 4; ++j) { v[j] = *(const f32x4*)(xr + 4 * F.lane + 256 * j); ss += (v[j].x * v[j].x + v[j].y * v[j].y) + (v[j].z * v[j].z + v[j].w * v[j].w); }
        const float rstd = 1.0f / sqrtf(wave_sum(ss) * (1.f / D) + EPS);
#pragma unroll
        for (int j = 0; j < 4; ++j) { const int c = 4 * F.lane + 256 * j;
            const f32x4 g = *(const f32x4*)(gvec + c), sh = *(const f32x4*)(mv + shi * D + c), sc = *(const f32x4*)(mv + sci * D + c);
            v[j] = (v[j] * rstd * g) * (sc + 1.0f) + sh;
            if constexpr (OUTM == 1) *(unsigned*)((unsigned char*)H + (size_t)r * D + c) = pk4_fp8(v[j].x, v[j].y, v[j].z, v[j].w);
            else { u32x2 o; o.x = pk2(v[j].x, v[j].y); o.y = pk2(v[j].z, v[j].w); *(u32x2*)(H + (size_t)r * D + c) = o; }
            if constexpr (OUTM == 2) *(unsigned*)(F.ws + WS_H8 + (size_t)r * D + c) = pk4_fp8(v[j].x, v[j].y, v[j].z, v[j].w); }
        if (ROUTER) {
            float lg[8];
#pragma unroll
            for (int e = 0; e < 8; ++e) lg[e] = 0.f;
#pragma unroll
            for (int j = 0; j < 4; ++j)
#pragma unroll
                for (int q = 0; q < 4; ++q) { const int c = 4 * F.lane + 256 * j + q; const f32x4 w0 = *(const f32x4*)(router_w + (size_t)c * 8), w1 = *(const f32x4*)(router_w + (size_t)c * 8 + 4); const float hv = v[j][q];
                    lg[0] += hv * w0.x; lg[1] += hv * w0.y; lg[2] += hv * w0.z; lg[3] += hv * w0.w; lg[4] += hv * w1.x; lg[5] += hv * w1.y; lg[6] += hv * w1.z; lg[7] += hv * w1.w; }
#pragma unroll
            for (int e = 0; e < 8; ++e) lg[e] = wave_sum(lg[e]);
            int e1 = 0; float v1 = lg[0];
#pragma unroll
            for (int e = 1; e < 8; ++e) if (lg[e] > v1) { v1 = lg[e]; e1 = e; }
            int e2 = -1; float v2 = -3.0e38f;
#pragma unroll
            for (int e = 0; e < 8; ++e) if (e != e1 && lg[e] > v2) { v2 = lg[e]; e2 = e; }
            const float ex = __expf(v2 - v1), w1 = 1.f / (1.f + ex), w2 = ex * w1;
            if (F.lane == 0) {
                const int p1 = atomicAdd((int*)&lcnt[e1], 1), p2 = atomicAdd((int*)&lcnt[e2], 1);
                int* te = (int*)(F.ws + WS_TOKE) + 2 * r; te[0] = e1; te[1] = e2;
                int* tp = (int*)(F.ws + WS_TOKP) + 2 * r; tp[0] = p1; tp[1] = p2;
                float* tw = (float*)(F.ws + WS_TOKW) + 2 * r; tw[0] = w1; tw[1] = w2;
            }
        }
    }
    if (ROUTER) { __syncthreads(); if (F.tid < 8) ((int*)(F.ws + WS_CNTWG))[F.bx * 8 + F.tid] = lcnt[F.tid]; __syncthreads(); }
}

__device__ __forceinline__ void moe_scatter_phase(Frame& F) {
    LAS int* tab = (LAS int*)F.lds;
    const int* cw = (const int*)(F.ws + WS_CNTWG);
    if (F.tid < 32) tab[F.tid] = 0;
    __syncthreads();
    for (int idx = F.tid; idx < F.G * 8; idx += NTHR) {
        const int c = __hip_atomic_load(cw + idx, __ATOMIC_RELAXED, __HIP_MEMORY_SCOPE_AGENT); const int w = idx >> 3, e = idx & 7;
        atomicAdd((int*)&tab[16 + e], c); if (w < F.bx) atomicAdd((int*)&tab[8 + e], c);
    }
    __syncthreads();
    if (F.tid == 0) { int off = 0; for (int e = 0; e < 8; ++e) { tab[e] = off; off += ((tab[16 + e] + 255) / 256) * 256; } tab[24] = off / 256;
        if (F.bx == 0) { int* tl = (int*)(F.ws + WS_TILE); int t = 0; for (int e = 0; e < 8; ++e) { const int n = (tab[16 + e] + 255) / 256; for (int q = 0; q < n; ++q) tl[t++] = e; } tl[200] = t; } }
    __syncthreads();
    const bf16* H = (const bf16*)(F.ws + WS_H); bf16* HS = (bf16*)(F.ws + WS_H2S);
    for (int i = 0; i < 8; ++i) {
        const int r = F.bx * 64 + F.wave + 8 * i; if (r >= ML) continue;
        const int* te = (const int*)(F.ws + WS_TOKE) + 2 * r; const int* tp = (const int*)(F.ws + WS_TOKP) + 2 * r;
        const int e1 = te[0], e2 = te[1];
        const int s1 = tab[e1] + tab[8 + e1] + tp[0], s2 = tab[e2] + tab[8 + e2] + tp[1];
        if (F.lane == 0) { int* ts = (int*)(F.ws + WS_TOKS) + 2 * r; ts[0] = s1; ts[1] = s2; }
        const u32x4 a = ((const u32x4*)((const unsigned char*)H + (size_t)r * D))[F.lane];
        ((u32x4*)((unsigned char*)HS + (size_t)s1 * D))[F.lane] = a; ((u32x4*)((unsigned char*)HS + (size_t)s2 * D))[F.lane] = a;
    }
}

__device__ __forceinline__ void final_phase(Frame& F, const float* final_g, float* out, const float* modl) {
    const float* X1 = (const float*)(F.ws + WS_X1); const bf16* YS = (const bf16*)(F.ws + WS_YS);
    const int nwv = F.G * NWAVES, gw = F.bx * NWAVES + F.wave;
    for (int r0 = gw; r0 < ML; r0 += 2 * nwv) {
        const bool has1 = r0 + nwv < ML; const int r1 = has1 ? r0 + nwv : r0;
        const float* ga = modl + (size_t)(r0 / SEQ) * MODW + 5 * D; const float* gb = modl + (size_t)(r1 / SEQ) * MODW + 5 * D;
        const int* tsa = (const int*)(F.ws + WS_TOKS) + 2 * r0; const int* tsb = (const int*)(F.ws + WS_TOKS) + 2 * r1;
        const float* twa = (const float*)(F.ws + WS_TOKW) + 2 * r0; const float* twb = (const float*)(F.ws + WS_TOKW) + 2 * r1;
        const int a1 = tsa[0], a2 = tsa[1], b1 = tsb[0], b2 = tsb[1]; const float wa1 = twa[0], wa2 = twa[1], wb1 = twb[0], wb2 = twb[1];
        f32x4 xa[4], xb[4], gva[4], gvb[4], fg[4]; u32x2 ya1[4], ya2[4], yb1[4], yb2[4];
#pragma unroll
        for (int j = 0; j < 4; ++j) { const int c = 4 * F.lane + 256 * j;
            xa[j] = *(const f32x4*)(X1 + (size_t)r0 * D + c); xb[j] = *(const f32x4*)(X1 + (size_t)r1 * D + c);
            ya1[j] = *(const u32x2*)(YS + (size_t)a1 * D + c); ya2[j] = *(const u32x2*)(YS + (size_t)a2 * D + c); yb1[j] = *(const u32x2*)(YS + (size_t)b1 * D + c); yb2[j] = *(const u32x2*)(YS + (size_t)b2 * D + c);
            gva[j] = *(const f32x4*)(ga + c); gvb[j] = *(const f32x4*)(gb + c); fg[j] = *(const f32x4*)(final_g + c); }
        float sa = 0.f, sb = 0.f;
#pragma unroll
        for (int j = 0; j < 4; ++j) {
            f32x4 f; f.x = wa1 * bflo(ya1[j].x) + wa2 * bflo(ya2[j].x); f.y = wa1 * bfhi(ya1[j].x) + wa2 * bfhi(ya2[j].x); f.z = wa1 * bflo(ya1[j].y) + wa2 * bflo(ya2[j].y); f.w = wa1 * bfhi(ya1[j].y) + wa2 * bfhi(ya2[j].y);
            xa[j] = xa[j] + gva[j] * f; sa += (xa[j].x * xa[j].x + xa[j].y * xa[j].y) + (xa[j].z * xa[j].z + xa[j].w * xa[j].w);
            f.x = wb1 * bflo(yb1[j].x) + wb2 * bflo(yb2[j].x); f.y = wb1 * bfhi(yb1[j].x) + wb2 * bfhi(yb2[j].x); f.z = wb1 * bflo(yb1[j].y) + wb2 * bflo(yb2[j].y); f.w = wb1 * bfhi(yb1[j].y) + wb2 * bfhi(yb2[j].y);
            xb[j] = xb[j] + gvb[j] * f; sb += (xb[j].x * xb[j].x + xb[j].y * xb[j].y) + (xb[j].z * xb[j].z + xb[j].w * xb[j].w); }
        const float ra = 1.0f / sqrtf(wave_sum(sa) * (1.f / D) + EPS), rb = 1.0f / sqrtf(wave_sum(sb) * (1.f / D) + EPS);
#pragma unroll
        for (int j = 0; j < 4; ++j) { const int c = 4 * F.lane + 256 * j;
            __builtin_nontemporal_store(xa[j] * ra * fg[j], (f32x4*)(out + (size_t)r0 * D + c)); if (has1) __builtin_nontemporal_store(xb[j] * rb * fg[j], (f32x4*)(out + (size_t)r1 * D + c)); }
    }
}

__device__ __forceinline__ void unpack8(const u32x4 w, float (&f)[8]) { f[0] = bflo(w.x); f[1] = bfhi(w.x); f[2] = bflo(w.y); f[3] = bfhi(w.y); f[4] = bflo(w.z); f[5] = bfhi(w.z); f[6] = bflo(w.w); f[7] = bfhi(w.w); }
__device__ __forceinline__ void local_mix_phase(Frame& F, const float* cw, int nrows, const bool skip16) {
    const bf16* Z = (const bf16*)(F.ws + WS_Z); bf16* MIX = (bf16*)(F.ws + WS_MIX);
    const int vcu = (F.G % 8 == 0) ? (F.bx % 8) * (F.G / 8) + F.bx / 8 : F.bx;
    const int nwk = (skip16 && F.G > 32) ? F.G - 16 : F.G, wk = (skip16 && F.G > 32) ? vcu - 16 : vcu;
    const int total = (nrows / 8) * 64, stride = nwk * NTHR;
    for (int idx = (wk < 0 ? total : wk * NTHR + F.tid); idx < total; idx += stride) {
        const int r0 = (idx >> 6) * 8, cg = idx & 63, c0 = cg * 8;
        int t0, L;
        if (r0 < ML) { t0 = r0 % SEQ; L = SEQ; } else { t0 = (r0 - ML) % CTXL; L = CTXL; }
        const bf16* zb = Z + (size_t)(r0 - t0) * INW;
        { float wa[8], wb[8], wc_[8];
          { const f32x4 a0 = *(const f32x4*)(cw + c0), a1 = *(const f32x4*)(cw + c0 + 4), b0 = *(const f32x4*)(cw + 512 + c0), b1 = *(const f32x4*)(cw + 512 + c0 + 4), d0 = *(const f32x4*)(cw + 1024 + c0), d1 = *(const f32x4*)(cw + 1024 + c0 + 4);
            wa[0] = a0.x; wa[1] = a0.y; wa[2] = a0.z; wa[3] = a0.w; wa[4] = a1.x; wa[5] = a1.y; wa[6] = a1.z; wa[7] = a1.w;
            wb[0] = b0.x; wb[1] = b0.y; wb[2] = b0.z; wb[3] = b0.w; wb[4] = b1.x; wb[5] = b1.y; wb[6] = b1.z; wb[7] = b1.w;
            wc_[0] = d0.x; wc_[1] = d0.y; wc_[2] = d0.z; wc_[3] = d0.w; wc_[4] = d1.x; wc_[5] = d1.y; wc_[6] = d1.z; wc_[7] = d1.w; }
          float pp[8], pc[8], pn[8];
#pragma unroll
          for (int q = 0; q < 8; ++q) pp[q] = 0.f;
          if (t0 > 0) { float cx[8], cc[8]; const bf16* zr = zb + (size_t)(t0 - 1) * INW; unpack8(*(const u32x4*)(zr + ZCX + c0), cx); unpack8(*(const u32x4*)(zr + ZCC + c0), cc);
#pragma unroll
              for (int q = 0; q < 8; ++q) pp[q] = cc[q] * cx[q]; }
          { float cx[8], cc[8]; const bf16* zr = zb + (size_t)t0 * INW; unpack8(*(const u32x4*)(zr + ZCX + c0), cx); unpack8(*(const u32x4*)(zr + ZCC + c0), cc);
#pragma unroll
              for (int q = 0; q < 8; ++q) pc[q] = cc[q] * cx[q]; }
#pragma unroll
          for (int i = 0; i < 8; ++i) { const int t = t0 + i;
#pragma unroll
              for (int q = 0; q < 8; ++q) pn[q] = 0.f;
              if (t + 1 < L) { float cx[8], cc[8]; const bf16* zr = zb + (size_t)(t + 1) * INW; unpack8(*(const u32x4*)(zr + ZCX + c0), cx); unpack8(*(const u32x4*)(zr + ZCC + c0), cc);
#pragma unroll
                  for (int q = 0; q < 8; ++q) pn[q] = cc[q] * cx[q]; }
              float cb[8], o[8]; unpack8(*(const u32x4*)(zb + (size_t)t * INW + ZCB + c0), cb);
#pragma unroll
              for (int q = 0; q < 8; ++q) { o[q] = cb[q] * (wa[q] * pp[q] + wb[q] * pc[q] + wc_[q] * pn[q]); pp[q] = pc[q]; pc[q] = pn[q]; }
              u32x4 w; w.x = pk2(o[0], o[1]); w.y = pk2(o[2], o[3]); w.z = pk2(o[4], o[5]); w.w = pk2(o[6], o[7]);
              *(u32x4*)(MIX + (size_t)(r0 + i) * MIXW + 512 + c0) = w; } }
        { const int hw = 1 << (c0 >> 7);
          float s[8];
#pragma unroll
          for (int q = 0; q < 8; ++q) s[q] = 0.f;
#pragma unroll
          for (int j = -8; j < 8; ++j) { const int tt = t0 + j; if (j >= -hw && j < hw && tt >= 0 && tt < L) { float u[8]; unpack8(*(const u32x4*)(zb + (size_t)tt * INW + ZPU + c0), u);
#pragma unroll
                  for (int q = 0; q < 8; ++q) s[q] += u[q]; } }
#pragma unroll
          for (int i = 0; i < 8; ++i) { const int t = t0 + i; const int lo = t - hw < 0 ? 0 : t - hw, hi = t + hw > L ? L : t + hw;
              float u0[8]; unpack8(*(const u32x4*)(zb + (size_t)t * INW + ZPU + c0), u0);
              const float inv = 1.0f / (float)(hi - lo);
              u32x4 w; w.x = pk2(s[0] * inv - u0[0], s[1] * inv - u0[1]); w.y = pk2(s[2] * inv - u0[2], s[3] * inv - u0[3]);
              w.z = pk2(s[4] * inv - u0[4], s[5] * inv - u0[5]); w.w = pk2(s[6] * inv - u0[6], s[7] * inv - u0[7]);
              *(u32x4*)(MIX + (size_t)(r0 + i) * MIXW + 1024 + c0) = w;
              if (i < 7) {
                  if (t + hw < L) { float u[8]; unpack8(*(const u32x4*)(zb + (size_t)(t + hw) * INW + ZPU + c0), u);
#pragma unroll
                      for (int q = 0; q < 8; ++q) s[q] += u[q]; }
                  if (t - hw >= 0) { float u[8]; unpack8(*(const u32x4*)(zb + (size_t)(t - hw) * INW + ZPU + c0), u);
#pragma unroll
                      for (int q = 0; q < 8; ++q) s[q] -= u[q]; } } } }
    }
}

__device__ __forceinline__ void attn_naive_phase(Frame& F, const float* sinkl, int nrows) {
    const bf16* Z = (const bf16*)(F.ws + WS_Z); bf16* MIX = (bf16*)(F.ws + WS_MIX);
    LAS float* qs = (LAS float*)(F.lds + F.wave * 10240);
    LAS float* sc = qs + 256;
    const int nunits = nrows * 2, NGW = F.G * NWAVES;
    for (int uidx = F.bx * NWAVES + F.wave; uidx < nunits; uidx += NGW) {
        const int r = uidx >> 1, kh = uidx & 1;
        int b, nloc, krow0;
        if (r < ML) { b = r / SEQ; const int t = r % SEQ; const int lo = t - 128 < 0 ? 0 : t - 128, hi = t + 128 > SEQ - 1 ? SEQ - 1 : t + 128; nloc = hi - lo + 1; krow0 = b * SEQ + lo; }
        else { b = (r - ML) / CTXL; nloc = 0; krow0 = 0; }
        const int crow0 = ML + b * CTXL, nk = nloc + CTXL;
        { const u32x2 qw = *(const u32x2*)(Z + (size_t)r * INW + ZQ + kh * 256 + 4 * F.lane); const int g = F.lane >> 4, d = (4 * F.lane) & 63;
          qs[(d + 0) * 4 + g] = bflo(qw.x); qs[(d + 1) * 4 + g] = bfhi(qw.x); qs[(d + 2) * 4 + g] = bflo(qw.y); qs[(d + 3) * 4 + g] = bfhi(qw.y); }
        LDS_WAIT(); asm volatile("" ::: "memory");
        for (int c0 = 0; c0 < nk; c0 += 64) {
            const int kk = c0 + F.lane;
            if (kk < nk) {
                const int krow = kk < nloc ? krow0 + kk : crow0 + (kk - nloc);
                const u32x4* kp = (const u32x4*)(Z + (size_t)krow * INW + ZK + kh * 64);
                f32x4 s = (f32x4){0.f, 0.f, 0.f, 0.f};
#pragma unroll
                for (int d8 = 0; d8 < 8; ++d8) { float kf[8]; unpack8(kp[d8], kf);
#pragma unroll
                    for (int q = 0; q < 8; ++q) { const f32x4 qv = *(const LAS f32x4*)(qs + (d8 * 8 + q) * 4); s += qv * kf[q]; } }
                *(LAS f32x4*)(sc + kk * 4) = s;
            }
        }
        LDS_WAIT(); asm volatile("" ::: "memory");
        f32x4 mx; { const float* sk = sinkl + kh * 4; mx = (f32x4){sk[0] * LOG2E, sk[1] * LOG2E, sk[2] * LOG2E, sk[3] * LOG2E}; }
        const f32x4 snk = mx;
        for (int kk = F.lane; kk < nk; kk += 64) { const f32x4 s = *(const LAS f32x4*)(sc + kk * 4); mx.x = fmaxf(mx.x, s.x); mx.y = fmaxf(mx.y, s.y); mx.z = fmaxf(mx.z, s.z); mx.w = fmaxf(mx.w, s.w); }
        mx.x = wave_max(mx.x); mx.y = wave_max(mx.y); mx.z = wave_max(mx.z); mx.w = wave_max(mx.w);
        f32x4 sm = (f32x4){0.f, 0.f, 0.f, 0.f};
        for (int kk = F.lane; kk < nk; kk += 64) { f32x4 s = *(const LAS f32x4*)(sc + kk * 4);
            s.x = exp2f(s.x - mx.x); s.y = exp2f(s.y - mx.y); s.z = exp2f(s.z - mx.z); s.w = exp2f(s.w - mx.w); sm += s; *(LAS f32x4*)(sc + kk * 4) = s; }
        sm.x = wave_sum(sm.x) + exp2f(snk.x - mx.x); sm.y = wave_sum(sm.y) + exp2f(snk.y - mx.y); sm.z = wave_sum(sm.z) + exp2f(snk.z - mx.z); sm.w = wave_sum(sm.w) + exp2f(snk.w - mx.w);
        LDS_WAIT(); asm volatile("" ::: "memory");
        f32x4 o = (f32x4){0.f, 0.f, 0.f, 0.f};
        const bf16* vb = Z + ZV + kh * 64 + F.lane;
#pragma unroll 4
        for (int kk = 0; kk < nk; ++kk) { const int krow = kk < nloc ? krow0 + kk : crow0 + (kk - nloc);
            const float v = bf2f((unsigned)vb[(size_t)krow * INW]); const f32x4 p = *(const LAS f32x4*)(sc + kk * 4); o += p * v; }
        bf16* op = MIX + (size_t)r * MIXW + kh * 256 + F.lane;
        op[0] = (bf16)f2bf(o.x / sm.x); op[64] = (bf16)f2bf(o.y / sm.y); op[128] = (bf16)f2bf(o.z / sm.z); op[192] = (bf16)f2bf(o.w / sm.w);
        LDS_WAIT(); asm volatile("" ::: "memory");
    }
}

typedef float f32x16 __attribute__((ext_vector_type(16)));
typedef short s16x4 __attribute__((ext_vector_type(4)));
__device__ __forceinline__ unsigned cvtpk(float lo, float hi) { f32x2 v = {lo, hi}; pg8::bf16x2_t b = __builtin_convertvector(v, pg8::bf16x2_t); return __builtin_bit_cast(unsigned, b); }
__device__ __forceinline__ s16x4 vtr(const LAS unsigned char* p) { return __builtin_bit_cast(s16x4, __builtin_amdgcn_ds_read_tr16_b64_v4i16((LAS s16x4*)p)); }
constexpr int AKP = 144, ATT_V_OFF = 128 * AKP;
__device__ __forceinline__ void attn_unit(Frame& F, const bf16* Z, bf16* MIX, const float* sinkl, const bool isctx, const int b, const int kh, const int qblk) {
    const int qrow0 = isctx ? ML + b * CTXL + qblk * 128 : b * SEQ + qblk * 128;
    const int cbase = ML + b * CTXL;
    const bool has_prev = !isctx && qblk > 0, has_next = !isctx && qblk < 31;
    const int nch = isctx ? 2 : 3 + (has_prev ? 1 : 0) + (has_next ? 1 : 0);
    const int lane = F.lane, r = lane & 31, h = lane >> 5, g = F.wave >> 1, qh = F.wave & 1, head = kh * 4 + g;
    LAS unsigned char* Ks = F.lds; LAS unsigned char* Vs = F.lds + ATT_V_OFF;
    bf16x8 qf[2][4];
#pragma unroll
    for (int sub = 0; sub < 2; ++sub)
#pragma unroll
        for (int ks = 0; ks < 4; ++ks) qf[sub][ks] = *(const bf16x8*)(Z + (size_t)(qrow0 + 64 * qh + 32 * sub + r) * INW + ZQ + head * 64 + 16 * ks + 8 * h);
    const float sk = sinkl[head] * LOG2E;
    float m[2], l[2]; f32x16 O[2][2];
#pragma unroll
    for (int sub = 0; sub < 2; ++sub) { m[sub] = sk; l[sub] = h == 0 ? 1.f : 0.f;
#pragma unroll
        for (int db = 0; db < 2; ++db)
#pragma unroll
            for (int i = 0; i < 16; ++i) O[sub][db][i] = 0.f; }
#define ATT_CHUNK(ci, row0, kind) do { if (isctx) { row0 = cbase + 128 * (ci); kind = 0; } else if ((ci) == 0) { row0 = qrow0; kind = 0; } else if ((ci) <= 2) { row0 = cbase + 128 * ((ci) - 1); kind = 0; } \
        else if ((ci) == 3 && has_prev) { row0 = qrow0 - 128; kind = 1; } else { row0 = qrow0 + 128; kind = 2; } } while (0)
    const int skey = F.tid >> 3, spart = F.tid & 7;
    u32x4 pk0, pk1, pv0, pv1;
#define ATT_LOAD(ci) do { int row0_, kind_; ATT_CHUNK(ci, row0_, kind_); (void)kind_; const bf16* kp_ = Z + (size_t)(row0_ + skey) * INW + ZK + kh * 64 + spart * 8; \
        pk0 = *(const u32x4*)kp_; pk1 = *(const u32x4*)(kp_ + (size_t)64 * INW); pv0 = *(const u32x4*)(kp_ + (ZV - ZK)); pv1 = *(const u32x4*)(kp_ + (size_t)64 * INW + (ZV - ZK)); } while (0)
    ATT_LOAD(0);
    const int grp = (lane >> 4) & 1, q4 = (lane & 15) >> 2, p4 = lane & 3;
    for (int ci = 0; ci < nch; ++ci) {
        __syncthreads();
        *(LAS u32x4*)(Ks + skey * AKP + spart * 16) = pk0; *(LAS u32x4*)(Ks + (skey + 64) * AKP + spart * 16) = pk1;
        *(LAS u32x4*)(Vs + skey * AKP + spart * 16) = pv0; *(LAS u32x4*)(Vs + (skey + 64) * AKP + spart * 16) = pv1;
        if (ci + 1 < nch) ATT_LOAD(ci + 1);
        __syncthreads();
        int row0, kind; ATT_CHUNK(ci, row0, kind); (void)row0;
        int dl = 4 * h - r - 64 * qh; asm volatile("" : "+v"(dl));
        for (int t = 0; t < 4; ++t) {
            if (kind == 1 && 32 * t + 31 < 64 * qh) continue;
            if (kind == 2 && 32 * t > 64 * qh + 63) continue;
            bf16x8 kf[4], vf[2][2];
#pragma unroll
            for (int ks = 0; ks < 4; ++ks) kf[ks] = *(const LAS bf16x8*)(Ks + (32 * t + r) * AKP + 32 * ks + 16 * h);
#pragma unroll
            for (int s = 0; s < 2; ++s)
#pragma unroll
                for (int db = 0; db < 2; ++db) { const LAS unsigned char* vp = Vs + (32 * t + 16 * s + 4 * h + q4) * AKP + (32 * db + 16 * grp + 4 * p4) * 2;
                    const s16x4 lo = vtr(vp), hi = vtr(vp + 8 * AKP); vf[s][db] = __builtin_shufflevector(lo, hi, 0, 1, 2, 3, 4, 5, 6, 7); }
#pragma unroll
            for (int sub = 0; sub < 2; ++sub) {
                if (kind == 1 && 32 * t + 31 < 64 * qh + 32 * sub) continue;
                if (kind == 2 && 32 * t > 64 * qh + 32 * sub + 31) continue;
                f32x16 S;
#pragma unroll
                for (int i = 0; i < 16; ++i) S[i] = 0.f;
#pragma unroll
                for (int ks = 0; ks < 4; ++ks) S = __builtin_amdgcn_mfma_f32_32x32x16_bf16(kf[ks], qf[sub][ks], S, 0, 0, 0);
                if (kind != 0) { const int d0 = dl + 32 * t - 32 * sub;
#pragma unroll
                    for (int i = 0; i < 16; ++i) { const int dd = d0 + (i & 3) + 8 * (i >> 2); const bool ok = kind == 1 ? (dd >= 0) : (dd <= 0); S[i] = ok ? S[i] : -1.0e30f; } }
                float tmax = S[0];
#pragma unroll
                for (int i = 1; i < 16; ++i) tmax = fmaxf(tmax, S[i]);
                tmax = fmaxf(tmax, __shfl_xor(tmax, 32));
                const float mnew = fmaxf(m[sub], tmax);
                if (__any(mnew > m[sub])) { const float alpha = __builtin_amdgcn_exp2f(m[sub] - mnew); l[sub] *= alpha; m[sub] = mnew;
#pragma unroll
                    for (int db = 0; db < 2; ++db)
#pragma unroll
                        for (int i = 0; i < 16; ++i) O[sub][db][i] *= alpha; }
                float ps = 0.f;
#pragma unroll
                for (int i = 0; i < 16; ++i) { S[i] = __builtin_amdgcn_exp2f(S[i] - m[sub]); ps += S[i]; }
                l[sub] += ps;
                u32x4 w0, w1; w0.x = cvtpk(S[0], S[1]); w0.y = cvtpk(S[2], S[3]); w0.z = cvtpk(S[4], S[5]); w0.w = cvtpk(S[6], S[7]);
                w1.x = cvtpk(S[8], S[9]); w1.y = cvtpk(S[10], S[11]); w1.z = cvtpk(S[12], S[13]); w1.w = cvtpk(S[14], S[15]);
                const bf16x8 P0 = __builtin_bit_cast(bf16x8, w0), P1 = __builtin_bit_cast(bf16x8, w1);
#pragma unroll
                for (int db = 0; db < 2; ++db) { O[sub][db] = __builtin_amdgcn_mfma_f32_32x32x16_bf16(vf[0][db], P0, O[sub][db], 0, 0, 0); O[sub][db] = __builtin_amdgcn_mfma_f32_32x32x16_bf16(vf[1][db], P1, O[sub][db], 0, 0, 0); }
            }
        }
    }
#undef ATT_CHUNK
#undef ATT_LOAD
#pragma unroll
    for (int sub = 0; sub < 2; ++sub) { const float lt = l[sub] + __shfl_xor(l[sub], 32), inv = 1.f / lt;
        bf16* op = MIX + (size_t)(qrow0 + 64 * qh + 32 * sub + r) * MIXW + head * 64 + 4 * h;
#pragma unroll
        for (int db = 0; db < 2; ++db)
#pragma unroll
            for (int gq = 0; gq < 4; ++gq) { u32x2 w; w.x = cvtpk(O[sub][db][4 * gq] * inv, O[sub][db][4 * gq + 1] * inv); w.y = cvtpk(O[sub][db][4 * gq + 2] * inv, O[sub][db][4 * gq + 3] * inv);
                *(u32x2*)(op + 32 * db + 8 * gq) = w; } }
}
__device__ __forceinline__ void attn_mfma_phase(Frame& F, const float* sinkl, const bool with_ctx) {
    const bf16* Z = (const bf16*)(F.ws + WS_Z); bf16* MIX = (bf16*)(F.ws + WS_MIX);
    const int vcu = (F.G % 8 == 0) ? (F.bx % 8) * (F.G / 8) + F.bx / 8 : F.bx;
    const int nun = with_ctx ? 272 : 256;
    for (int u = vcu; u < nun; u += F.G) { const bool isctx = u >= 256; const int uu = isctx ? (u - 256) : u;
        attn_unit(F, Z, MIX, sinkl, isctx, isctx ? (uu >> 2) : (uu >> 6), isctx ? ((uu >> 1) & 1) : ((uu >> 5) & 1), isctx ? (uu & 1) : (uu & 31)); }
    __syncthreads();
}

using pg8::Unit;
struct SchedStd {
    const char* A; const char* B; size_t astep, bstep; int nM, nN, G, c, nx, xpm0, xpn;
    __device__ __forceinline__ bool next(int i, Unit& u) const {
        const int L = i * G + c, nwg = nM * nN; if (L >= nwg + nx) return false;
        if (L < nwg) pg8::tile_of(L, nM, nN, u.pm, u.pn); else { u.pm = xpm0 + (L - nwg); u.pn = xpn; }
        u.tag = 0; u.a = A + (size_t)u.pm * astep; u.b = B + (size_t)u.pn * bstep; return true;
    }
};
struct SchedMoe {
    const char* A; const char* B; size_t astep, bstep_e, bstep_n; int NJ, G, c; const int* tile;
    __device__ __forceinline__ bool next(int i, Unit& u) const {
        const int nt = __builtin_amdgcn_readfirstlane(__hip_atomic_load(tile + 200, __ATOMIC_RELAXED, __HIP_MEMORY_SCOPE_AGENT));
        const int L = i * G + c; if (L >= nt * NJ) return false;
        u.pm = L % nt; u.pn = L / nt; u.tag = __builtin_amdgcn_readfirstlane(__hip_atomic_load(tile + u.pm, __ATOMIC_RELAXED, __HIP_MEMORY_SCOPE_AGENT));
        u.a = A + (size_t)u.pm * astep; u.b = B + (size_t)u.tag * bstep_e + (size_t)u.pn * bstep_n; return true;
    }
};

struct EpiGate {
    static constexpr bool PERM = true, MIDHOOK = false;
    bf16* Z;
    __device__ __forceinline__ void operator()(const f32x4 (&acc)[2][2][4][2], const Unit& u, int wr, int wc, int fr, int fq) const {
        const int row0 = u.pm * 256 + wr * 64 + fr, col0 = ZG + u.pn * 256 + wc * 32 + 8 * fq;
#pragma unroll
        for (int ai = 0; ai < 2; ++ai)
#pragma unroll
            for (int m = 0; m < 4; ++m)
#pragma unroll
                for (int bj = 0; bj < 2; ++bj) { f32x4 v0 = acc[ai][bj][m][0], v1 = acc[ai][bj][m][1];
#pragma unroll
                    for (int q = 0; q < 4; ++q) { v0[q] = __builtin_amdgcn_rcpf(1.f + __expf(-v0[q])); v1[q] = __builtin_amdgcn_rcpf(1.f + __expf(-v1[q])); }
                    u32x4 w; w.x = pg8::cvt_pk_bf16(v0[0], v0[1]); w.y = pg8::cvt_pk_bf16(v0[2], v0[3]); w.z = pg8::cvt_pk_bf16(v1[0], v1[1]); w.w = pg8::cvt_pk_bf16(v1[2], v1[3]);
                    *(u32x4*)(Z + (size_t)(row0 + ai * 128 + m * 16) * INW + col0 + bj * 128) = w; }
    }
};
struct EpiIn {
    static constexpr bool PERM = true, MIDHOOK = false;
    bf16* Z; const float* rope;
    __device__ __forceinline__ void operator()(const f32x4 (&acc)[2][2][4][2], const Unit& u, int wr, int wc, int fr, int fq) const {
        const int row0 = u.pm * 256 + wr * 64 + fr, col0 = u.pn * 256 + wc * 32 + 8 * fq;
        const bool latent = u.pm < 64, gate = u.pn >= 11;
        const float sgn = fq < 2 ? -1.f : 1.f;
#pragma unroll
        for (int ai = 0; ai < 2; ++ai)
#pragma unroll
            for (int m = 0; m < 4; ++m) { const int row = row0 + ai * 128 + m * 16; bf16* rowp = Z + (size_t)row * INW + col0;
                const int pos = (wc & 1) ? (16 * m + fr) : (4 * (u.pm & 15) + 2 * ai + wr);
#pragma unroll
                for (int bj = 0; bj < 2; ++bj) { f32x4 v0 = acc[ai][bj][m][0], v1 = acc[ai][bj][m][1];
                    const bool isq = u.pn < 2, isk = (u.pn == 2 && bj == 0);
                    if (isq || isk) {
                        if (latent) {
                            const f32x4* cs = (const f32x4*)(rope + (size_t)(pos * 16 + 8 * (fq & 1)) * 2);
                            const f32x4 t0 = cs[0], t1 = cs[1], t2 = cs[2], t3 = cs[3];
                            f32x4 p0, p1;
                            p0.x = __shfl_xor(v0.x, 32); p0.y = __shfl_xor(v0.y, 32); p0.z = __shfl_xor(v0.z, 32); p0.w = __shfl_xor(v0.w, 32);
                            p1.x = __shfl_xor(v1.x, 32); p1.y = __shfl_xor(v1.y, 32); p1.z = __shfl_xor(v1.z, 32); p1.w = __shfl_xor(v1.w, 32);
                            v0.x = v0.x * t0.x + p0.x * (sgn * t0.y); v0.y = v0.y * t0.z + p0.y * (sgn * t0.w); v0.z = v0.z * t1.x + p0.z * (sgn * t1.y); v0.w = v0.w * t1.z + p0.w * (sgn * t1.w);
                            v1.x = v1.x * t2.x + p1.x * (sgn * t2.y); v1.y = v1.y * t2.z + p1.y * (sgn * t2.w); v1.z = v1.z * t3.x + p1.z * (sgn * t3.y); v1.w = v1.w * t3.z + p1.w * (sgn * t3.w);
                        }
                        if (isq) { v0 = v0 * QSCALE; v1 = v1 * QSCALE; }
                    }
                    if (gate) {
#pragma unroll
                        for (int q = 0; q < 4; ++q) { v0[q] = 1.f / (1.f + __expf(-v0[q])); v1[q] = 1.f / (1.f + __expf(-v1[q])); } }
                    u32x4 w; w.x = pg8::cvt_pk_bf16(v0[0], v0[1]); w.y = pg8::cvt_pk_bf16(v0[2], v0[3]); w.z = pg8::cvt_pk_bf16(v1[0], v1[1]); w.w = pg8::cvt_pk_bf16(v1[2], v1[3]);
                    *(u32x4*)(rowp + bj * 128) = w; } }
    }
};
struct EpiBrG {
    static constexpr bool PERM = true, MIDHOOK = true;
    const bf16* Z; bf16* Y;
    __device__ __forceinline__ void mid(f32x4 (&acc)[2][2][4][2], const Unit& u, int seg, int wr, int wc, int fr, int fq) const {
        const int row0 = u.pm * 256 + wr * 64 + fr, col0 = u.pn * 256 + wc * 32 + 8 * fq;
#pragma unroll
        for (int ai = 0; ai < 2; ++ai)
#pragma unroll
            for (int m = 0; m < 4; ++m) { const bf16* gp = Z + (size_t)(row0 + ai * 128 + m * 16) * INW + ZG + (seg - 1) * D + col0;
#pragma unroll
                for (int bj = 0; bj < 2; ++bj) { const u32x4 ga = *(const u32x4*)(gp + bj * 128), gb = *(const u32x4*)(gp + D + bj * 128);
                    f32x4 r0, r1;
                    r0.x = bflo(ga.x) * __builtin_amdgcn_rcpf(bflo(gb.x)); r0.y = bfhi(ga.x) * __builtin_amdgcn_rcpf(bfhi(gb.x)); r0.z = bflo(ga.y) * __builtin_amdgcn_rcpf(bflo(gb.y)); r0.w = bfhi(ga.y) * __builtin_amdgcn_rcpf(bfhi(gb.y));
                    r1.x = bflo(ga.z) * __builtin_amdgcn_rcpf(bflo(gb.z)); r1.y = bfhi(ga.z) * __builtin_amdgcn_rcpf(bfhi(gb.z)); r1.z = bflo(ga.w) * __builtin_amdgcn_rcpf(bflo(gb.w)); r1.w = bfhi(ga.w) * __builtin_amdgcn_rcpf(bfhi(gb.w));
                    acc[ai][bj][m][0] *= r0; acc[ai][bj][m][1] *= r1; }
                asm volatile("" ::: "memory"); }
    }
    __device__ __forceinline__ void operator()(const f32x4 (&acc)[2][2][4][2], const Unit& u, int wr, int wc, int fr, int fq) const {
        const int row0 = u.pm * 256 + wr * 64 + fr, col0 = u.pn * 256 + wc * 32 + 8 * fq;
#pragma unroll
        for (int ai = 0; ai < 2; ++ai)
#pragma unroll
            for (int m = 0; m < 4; ++m) { const size_t row = (size_t)(row0 + ai * 128 + m * 16); const bf16* gp = Z + row * INW + ZG + 2 * D + col0;
#pragma unroll
                for (int bj = 0; bj < 2; ++bj) { const u32x4 g = *(const u32x4*)(gp + bj * 128); const f32x4 v0 = acc[ai][bj][m][0], v1 = acc[ai][bj][m][1];
                    u32x4 w; w.x = pg8::cvt_pk_bf16(v0[0] * bflo(g.x), v0[1] * bfhi(g.x)); w.y = pg8::cvt_pk_bf16(v0[2] * bflo(g.y), v0[3] * bfhi(g.y));
                    w.z = pg8::cvt_pk_bf16(v1[0] * bflo(g.z), v1[1] * bfhi(g.z)); w.w = pg8::cvt_pk_bf16(v1[2] * bflo(g.w), v1[3] * bfhi(g.w));
                    *(u32x4*)(Y + row * D + col0 + bj * 128) = w; } }
    }
};
struct EpiRes {
    static constexpr bool PERM = false, MIDHOOK = false;
    const float* rl; const float* rc; float* out; const float* gv;
    __device__ __forceinline__ void operator()(const f32x4 (&acc)[2][2][4][2], const Unit& u, int wr, int wc, int fr, int fq) const {
        const int row0 = u.pm * 256 + wr * 64 + fr, col0 = u.pn * 256 + wc * 32 + 4 * fq;
        const int bidx = u.pm < 64 ? (u.pm >> 4) : 4; const float* g = gv + (size_t)bidx * MODW;
        const float* rbase = u.pm < 64 ? rl : rc - (size_t)ML * D;
        f32x4 gg[2][2];
#pragma unroll
        for (int bj = 0; bj < 2; ++bj)
#pragma unroll
            for (int n = 0; n < 2; ++n) gg[bj][n] = *(const f32x4*)(g + col0 + bj * 128 + n * 16);
#pragma unroll
        for (int ai = 0; ai < 2; ++ai)
#pragma unroll
            for (int m = 0; m < 4; ++m) { const size_t off = (size_t)(row0 + ai * 128 + m * 16) * D + col0;
#pragma unroll
                for (int bj = 0; bj < 2; ++bj)
#pragma unroll
                    for (int n = 0; n < 2; ++n) *(f32x4*)(out + off + bj * 128 + n * 16) = *(const f32x4*)(rbase + off + bj * 128 + n * 16) + gg[bj][n] * acc[ai][bj][m][n]; }
    }
};
template <bool F8> struct EpiSwiglu {
    static constexpr bool PERM = true, MIDHOOK = false;
    unsigned char* ACT; int ldc;
    __device__ __forceinline__ void operator()(const f32x4 (&acc)[2][2][4][2], const Unit& u, int wr, int wc, int fr, int fq) const {
        const int row0 = u.pm * 256 + wr * 64 + fr, col0 = u.pn * 128 + wc * 32 + 8 * fq;
#pragma unroll
        for (int ai = 0; ai < 2; ++ai)
#pragma unroll
            for (int m = 0; m < 4; ++m) { f32x4 r[2];
#pragma unroll
                for (int n = 0; n < 2; ++n) { const f32x4 g = acc[ai][0][m][n], up = acc[ai][1][m][n];
#pragma unroll
                    for (int q = 0; q < 4; ++q) r[n][q] = g[q] / (1.f + __expf(-g[q])) * up[q]; }
                if constexpr (F8) { u32x2 w; w.x = pk4_fp8(r[0][0], r[0][1], r[0][2], r[0][3]); w.y = pk4_fp8(r[1][0], r[1][1], r[1][2], r[1][3]);
                    *(u32x2*)(ACT + (size_t)(row0 + ai * 128 + m * 16) * ldc + col0) = w; }
                else { u32x4 w; w.x = pg8::cvt_pk_bf16(r[0][0], r[0][1]); w.y = pg8::cvt_pk_bf16(r[0][2], r[0][3]); w.z = pg8::cvt_pk_bf16(r[1][0], r[1][1]); w.w = pg8::cvt_pk_bf16(r[1][2], r[1][3]);
                    *(u32x4*)((bf16*)ACT + (size_t)(row0 + ai * 128 + m * 16) * ldc + col0) = w; } }
    }
};
struct EpiPlain {
    static constexpr bool PERM = true, MIDHOOK = false;
    bf16* O; int ldc;
    __device__ __forceinline__ void operator()(const f32x4 (&acc)[2][2][4][2], const Unit& u, int wr, int wc, int fr, int fq) const {
        const int row0 = u.pm * 256 + wr * 64 + fr, col0 = u.pn * 256 + wc * 32 + 8 * fq;
#pragma unroll
        for (int ai = 0; ai < 2; ++ai)
#pragma unroll
            for (int m = 0; m < 4; ++m)
#pragma unroll
                for (int bj = 0; bj < 2; ++bj) { const f32x4 v0 = acc[ai][bj][m][0], v1 = acc[ai][bj][m][1];
                    u32x4 w; w.x = pg8::cvt_pk_bf16(v0[0], v0[1]); w.y = pg8::cvt_pk_bf16(v0[2], v0[3]); w.z = pg8::cvt_pk_bf16(v1[0], v1[1]); w.w = pg8::cvt_pk_bf16(v1[2], v1[3]);
                    *(u32x4*)(O + (size_t)(row0 + ai * 128 + m * 16) * ldc + col0 + bj * 128) = w; }
    }
};

#ifndef PHASE_MASK
#define PHASE_MASK 0xFFFFFFFFu
#endif
#define IN(k) (((PHASE_MASK >> (k)) & 1u) && lo <= (k) && (k) < hi)
#define SEAM(k) do { if (IN(k) && IN((k) + 1)) xcd_barrier(bar); } while (0)
#ifndef DUP_MASK
#define DUP_MASK 0u
#endif
#define REP(k) for (int rep_ = 0; rep_ < (((DUP_MASK >> (k)) & 1u) ? 2 : 1); ++rep_, (((DUP_MASK >> (k)) & 1u) && rep_ == 1 ? xcd_barrier(bar) : (void)0))
#define SITE() do { F.ws = (unsigned char*)karg_p<(int)__builtin_offsetof(Args, ws)>(); int t_ = threadIdx.x; asm volatile("" : "+v"(t_)); F.tid = t_; F.lane = t_ & 63; } while (0)
template <int l> __device__ __forceinline__ void layer_common(Frame& F, const int lo, const int hi, const XcdBarrier& bar, LAS unsigned char* ring) {
    constexpr int pb = 1 + 8 * l;
        if (IN(pb + 0)) REP(pb + 0) { SITE(); const float* modl = (const float*)(F.ws + WS_MODV) + (size_t)l * 5 * MODW; const float* X2 = (const float*)(F.ws + WS_X2);
            const float* xl = l == 0 ? KP(x) : X2; const float* xc = l == 0 ? KP(ctx) : X2 + (size_t)ML * D;
            norm_mod_phase<false, 2>(F, xl, xc, KP(norm1_g) + l * D, modl, 0, 1, MT, nullptr); } SEAM(pb + 0);
        if (IN(pb + 1)) REP(pb + 1) { SITE();
            { SchedStd S{(const char*)(F.ws + WS_H), (const char*)(F.ws + WS_WIN) + (size_t)l * ZG * D * 2, (size_t)256 * D * 2, (size_t)256 * D * 2, l == 0 ? 68 : 64, 11, F.G, F.bx, l == 0 ? 0 : 4, 64, 2};
              EpiIn E{(bf16*)(F.ws + WS_Z), (const float*)(F.ws + WS_ROPE)};
              pg8::gemm_phase<EpiIn, SchedStd, true, true>(ring, D * 2, D * 2, D * 2, S, E); }
            { SITE(); SchedStd S{(const char*)(F.ws + WS_H8), (const char*)(F.ws + WS_WIN8) + (size_t)l * 3 * D * D, (size_t)256 * D, (size_t)256 * D, l == 0 ? 68 : 64, 12, F.G, (F.bx + 20) % F.G, 0, 0, 0};
              EpiGate E{(bf16*)(F.ws + WS_Z)};
              pg8::gemm_phase<EpiGate, SchedStd, true, true, true>(ring, D, D, D, S, E); }
        } SEAM(pb + 1);
        if (IN(pb + 2)) REP(pb + 2) { SITE(); const int nrows = l == 0 ? MT : ML; if (ATTN_NAIVE) attn_naive_phase(F, KP(sink) + l * 8, nrows); else { for (int rp_ = 0; rp_ < 1 + PROBE_ATT; ++rp_) attn_mfma_phase(F, KP(sink) + l * 8, l == 0); } for (int rp_ = 0; rp_ < 1 + PROBE_MIXL; ++rp_) local_mix_phase(F, KP(conv_w) + (size_t)l * 3 * 512, nrows, l == 0 && !ATTN_NAIVE); } SEAM(pb + 2);
        if (IN(pb + 3)) REP(pb + 3) { SITE();
            SchedStd S{(const char*)(F.ws + WS_MIX), (const char*)(F.ws + WS_WBR) + (size_t)l * D * MIXW * 2, (size_t)256 * MIXW * 2, (size_t)256 * MIXW * 2, l == 0 ? 68 : 64, 4, F.G, F.bx, 0, 0, 0};
            EpiBrG E{(const bf16*)(F.ws + WS_Z), (bf16*)(F.ws + WS_Y)};
            pg8::gemm_phase<EpiBrG, SchedStd, true, true>(ring, MIXW * 2, MIXW * 2, MIXW * 2, S, E);
        } SEAM(pb + 3);
        if (IN(pb + 4)) REP(pb + 4) { SITE(); const float* modl = (const float*)(F.ws + WS_MODV) + (size_t)l * 5 * MODW; const float* X2 = (const float*)(F.ws + WS_X2);
            const float* xl = l == 0 ? KP(x) : X2; const float* xc = l == 0 ? KP(ctx) : X2 + (size_t)ML * D;
            SchedStd S{(const char*)(F.ws + WS_Y), (const char*)(F.ws + WS_WOUT) + (size_t)l * D * D * 2, (size_t)256 * D * 2, (size_t)256 * D * 2, l == 0 ? 68 : 64, 4, F.G, F.bx, 0, 0, 0};
            EpiRes E{xl, xc, (float*)(F.ws + WS_X1), modl + 2 * D};
            pg8::gemm_phase<EpiRes, SchedStd, true, true>(ring, D * 2, D * 2, D * 2, S, E);
        } SEAM(pb + 4);
}
constexpr int N_PHASES = 19;
__global__ void __launch_bounds__(NTHR, 2) mk_fwd(Args args_byval) {
    extern __shared__ __attribute__((aligned(16))) unsigned char lds_raw[];
    Frame F;
    F.lds = (LAS unsigned char*)lds_raw;
    F.tid = threadIdx.x; F.lane = F.tid & 63; F.wave = __builtin_amdgcn_readfirstlane(F.tid >> 6);
    F.G = gridDim.x; F.bx = blockIdx.x;
    SITE();
    volatile LAS unsigned* MISC = (volatile LAS unsigned*)(F.lds + MISC_OFF);
    for (int u = F.tid; u < (LDS_BYTES - LDSCTL_OFF) / 4; u += NTHR) ((LAS unsigned*)(F.lds + LDSCTL_OFF))[u] = 0u;
    __syncthreads();
    const int lo = karg_i<(int)__builtin_offsetof(Args, ph_lo)>(), hi = karg_i<(int)__builtin_offsetof(Args, ph_hi)>();
    const bool fused = (hi - lo) > 1;
    XcdBarrier bar; bar.bar = (unsigned*)(F.ws + WS_CTL) + CW_BAR; bar.x = 0; bar.st = nullptr;
    if (fused) bar = xcd_barrier_post((unsigned*)(F.ws + WS_CTL) + CW_BAR, MISC + 8);
    LAS unsigned char* ring = F.lds;

    if (IN(0)) REP(0) { SITE(); p0_prologue(F); } SEAM(0);

    layer_common<0>(F, lo, hi, bar, ring);
    {
            if (IN(6)) REP(6) { SITE(); const float* X1 = (const float*)(F.ws + WS_X1); norm_mod_phase<false, FFN0_FP8 ? 1 : 0>(F, X1, X1 + (size_t)ML * D, KP(norm2_g), (const float*)(F.ws + WS_MODV), 3, 4, MT, nullptr); } SEAM(6);
            if (IN(7)) REP(7) { SITE();
                constexpr int EB = FFN0_FP8 ? 1 : 2;
                SchedStd S{(const char*)(F.ws + WS_H), (const char*)(F.ws + WS_WGU0), (size_t)256 * D * EB, (size_t)256 * D * EB, 68, 22, F.G, F.bx, 0, 0, 0};
                EpiSwiglu<(FFN0_FP8 || DN0_FP8)> E{(unsigned char*)(F.ws + WS_ACT), DFF};
                pg8::gemm_phase<EpiSwiglu<(FFN0_FP8 || DN0_FP8)>, SchedStd, true, true, FFN0_FP8 != 0>(ring, D * EB, D * EB, D * EB, S, E);
            } SEAM(7);
            if (IN(8)) REP(8) { SITE(); const float* X1 = (const float*)(F.ws + WS_X1);
                constexpr int EB = (FFN0_FP8 || DN0_FP8) ? 1 : 2;
                SchedStd S{(const char*)(F.ws + WS_ACT), (const char*)(F.ws + WS_WDN0), (size_t)256 * DFF * EB, (size_t)256 * DFF * EB, 68, 4, F.G, F.bx, 0, 0, 0};
                EpiRes E{X1, X1 + (size_t)ML * D, (float*)(F.ws + WS_X2), (const float*)(F.ws + WS_MODV) + 5 * D};
                pg8::gemm_phase<EpiRes, SchedStd, true, true, (FFN0_FP8 || DN0_FP8)>(ring, DFF * EB, DFF * EB, DFF * EB, S, E);
            } SEAM(8);
    }
    layer_common<1>(F, lo, hi, bar, ring);
    {
            if (IN(14)) REP(14) { SITE(); const float* X1 = (const float*)(F.ws + WS_X1); norm_mod_phase<true, 1>(F, X1, X1, KP(norm2_g) + D, (const float*)(F.ws + WS_MODV) + (size_t)5 * MODW, 3, 4, ML, KP(router_w)); } SEAM(14);
            if (IN(15)) REP(15) { SITE(); moe_scatter_phase(F); } SEAM(15);
            if (IN(16)) REP(16) { SITE();
                SchedMoe S{(const char*)(F.ws + WS_H2S), (const char*)(F.ws + WS_WMGU), (size_t)256 * D, (size_t)2 * DFE * D, (size_t)256 * D, 28, F.G, F.bx, (const int*)(F.ws + WS_TILE)};
                EpiSwiglu<true> E{(unsigned char*)(F.ws + WS_ACT), DFE};
                pg8::gemm_phase<EpiSwiglu<true>, SchedMoe, true, true, true>(ring, D, D, D, S, E);
            } SEAM(16);
            if (IN(17)) REP(17) { SITE();
                SchedMoe S{(const char*)(F.ws + WS_ACT), (const char*)(F.ws + WS_WMDN), (size_t)256 * DFE, (size_t)D * DFE, (size_t)256 * DFE, 4, F.G, F.bx, (const int*)(F.ws + WS_TILE)};
                EpiPlain E{(bf16*)(F.ws + WS_YS), D};
                pg8::gemm_phase<EpiPlain, SchedMoe, true, true, true>(ring, DFE, DFE, DFE, S, E);
            } SEAM(17);
            if (IN(18)) REP(18) { SITE(); final_phase(F, KP(final_g), (float*)karg_p<(int)__builtin_offsetof(Args, out)>(), (const float*)(F.ws + WS_MODV) + (size_t)5 * MODW); }
        }

#undef IN
#undef SEAM
}

extern "C" void kernel_launch(void* const* d_in, const int* in_sizes, int n_in, void* d_out, int out_size, void* d_ws, size_t ws_size, hipStream_t stream) {
    static int grid = 0;
    if (grid == 0) {
        if (n_in != 21 || out_size != ML * D || ws_size < WS_END) { fprintf(stderr, "kernel_launch: unexpected sizes (n_in %d, out %d, ws %zu < %zu)\n", n_in, out_size, ws_size, (size_t)WS_END); grid = -1; return; }
        int dev = 0, cus = 0, per_cu = 0;
        if (hipGetDevice(&dev) != hipSuccess || hipDeviceGetAttribute(&cus, hipDeviceAttributeMultiprocessorCount, dev) != hipSuccess) { grid = -1; return; }
        if (hipFuncSetAttribute((const void*)mk_fwd, hipFuncAttributeMaxDynamicSharedMemorySize, LDS_BYTES) != hipSuccess) { fprintf(stderr, "kernel_launch: hipFuncSetAttribute failed\n"); grid = -1; return; }
        if (hipOccupancyMaxActiveBlocksPerMultiprocessor(&per_cu, (const void*)mk_fwd, NTHR, LDS_BYTES) != hipSuccess || per_cu < 1) { fprintf(stderr, "kernel_launch: occupancy query says %d\n", per_cu); per_cu = 1; }
        (void)hipGetLastError();
        grid = cus;
    }
    if (grid < 0) return;
    (void)hipMemsetAsync((char*)d_ws + WS_CTL, 0, CTL_ZERO_BYTES, stream);
    Args a{};
    const float** pp = (const float**)&a;
    for (int i = 0; i < 21; ++i) pp[i] = (const float*)d_in[i];
    a.out = (float*)d_out; a.ws = (unsigned char*)d_ws;
#if MK_FUSED
    a.ph_lo = 0; a.ph_hi = N_PHASES;
    hipLaunchKernelGGL(mk_fwd, dim3(grid), dim3(NTHR), LDS_BYTES, stream, a);
#else
    for (int p = 0; p < N_PHASES; ++p) { a.ph_lo = p; a.ph_hi = p + 1; hipLaunchKernelGGL(mk_fwd, dim3(grid), dim3(NTHR), LDS_BYTES, stream, a); }
#endif
}
```

```cpp
#include <hip/hip_runtime.h>
#include <cstdio>
#include <cstdint>

#ifndef ATTN_NAIVE
#define ATTN_NAIVE 0
#endif
#ifndef DN0_FP8
#define DN0_FP8 1
#endif
#ifndef FFN0_FP8
#define FFN0_FP8 0
#endif
#ifndef PROBE_ATT
#define PROBE_ATT 0
#endif
#ifndef PROBE_MIXL
#define PROBE_MIXL 0
#endif
#ifndef MK_FUSED
#define MK_FUSED 1
#endif

#define LAS __attribute__((address_space(3)))
#define GAS __attribute__((address_space(1)))
typedef unsigned short bf16;
typedef short bf16x8 __attribute__((ext_vector_type(8)));
typedef float f32x4 __attribute__((ext_vector_type(4)));
typedef float f32x2 __attribute__((ext_vector_type(2)));
typedef unsigned u32x4 __attribute__((ext_vector_type(4)));
typedef unsigned u32x2 __attribute__((ext_vector_type(2)));
typedef GAS unsigned gu32;

constexpr int D = 1024, NB = 4, SEQ = 4096, ML = NB * SEQ, CTXL = 256, MC = NB * CTXL, MT = ML + MC;
constexpr int INW = 5888, DFF = 2816, DFE = 3584, NE = 8;
constexpr int ZQ = 0, ZK = 512, ZV = 640, ZCX = 768, ZCB = 1280, ZCC = 1792, ZPU = 2304, ZG = 2816;
constexpr int MIXW = 1536;
constexpr int MS = 2 * ML + NE * 256;
constexpr int MODW = 6 * D;
constexpr float EPS = 1e-6f;
constexpr float LOG2E = 1.4426950408889634f, QSCALE = 0.125f * LOG2E;
constexpr int NWAVES = 8, NTHR = 512;

__device__ __forceinline__ unsigned f2bf(float f) { unsigned u = __builtin_bit_cast(unsigned, f); return (u + 0x7fffu + ((u >> 16) & 1u)) >> 16; }
__device__ __forceinline__ unsigned pk2(float lo, float hi) { return f2bf(lo) | (f2bf(hi) << 16); }
__device__ __forceinline__ float bf2f(unsigned b) { return __builtin_bit_cast(float, b << 16); }
__device__ __forceinline__ float clamp8(float x) { return __builtin_amdgcn_fmed3f(x, -448.f, 448.f); }
__device__ __forceinline__ unsigned pk4_fp8(float a, float b, float c, float d) { int w = 0; w = __builtin_amdgcn_cvt_pk_fp8_f32(clamp8(a), clamp8(b), w, false); w = __builtin_amdgcn_cvt_pk_fp8_f32(clamp8(c), clamp8(d), w, true); return (unsigned)w; }
constexpr float W8SCALE = 256.0f;
__device__ __forceinline__ float bflo(unsigned w) { return __builtin_bit_cast(float, w << 16); }
__device__ __forceinline__ float bfhi(unsigned w) { return __builtin_bit_cast(float, w & 0xffff0000u); }

namespace pg8 {
constexpr int BM = 256, BK = 64, HALF = 128, HTB = HALF * BK * 2, STAGE_BYTES = 8 * HTB, NXCD = 8, WGM = 8;
__host__ __device__ __forceinline__ int lds_byte(int r, int c) { const int st = (r >> 4) * 2 + (c >> 5), rr = r & 15, cc = c & 31, ob = rr * 64 + cc * 2; return st * 1024 + (ob ^ (((ob >> 9) & 1) << 5)); }
__host__ __device__ __forceinline__ void stage_rc(int b, int& R, int& C) { const int st = b / 1024, sb = b % 1024, swz = sb ^ (((sb >> 9) & 1) << 5); R = (st >> 1) * 16 + swz / 64; C = (st & 1) * 32 + (swz % 64) / 2; }
__host__ __device__ __forceinline__ int perm32(int rho) { const int n = rho >> 4, i = rho & 15; return 8 * (i >> 2) + 4 * n + (i & 3); }

struct Unit { int pm, pn, tag; const char* a; const char* b; };

__device__ __forceinline__ void tile_of(int L, int nM, int nN, int& pm, int& pn) {
    const int nwg = nM * nN; int wgid = L;
    { const int q = nwg / NXCD, r = nwg % NXCD, xcd = wgid % NXCD, off = wgid / NXCD; wgid = (xcd < r ? xcd * (q + 1) : r * (q + 1) + (xcd - r) * q) + off; }
    const int nig = WGM * nN, gid = wgid / nig, fm = gid * WGM, gsz = (nM - fm) < WGM ? (nM - fm) : WGM;
    pm = fm + ((wgid % nig) % gsz); pn = (wgid % nig) / gsz;
}

typedef __bf16 bf16x2_t __attribute__((ext_vector_type(2)));
__device__ __forceinline__ unsigned cvt_pk_bf16(float lo, float hi) { f32x2 v = {lo, hi}; bf16x2_t b = __builtin_convertvector(v, bf16x2_t); return __builtin_bit_cast(unsigned, b); }

typedef int i32x8 __attribute__((ext_vector_type(8)));
typedef int i32x4 __attribute__((ext_vector_type(4)));
template <class Epi, class Sched, bool ALIGN_EPI = false, bool SP2 = false, bool FP8 = false>
__device__ __forceinline__ void gemm_phase(LAS unsigned char* lds, const int lda, const int ldb, const int K, const Sched& S, const Epi& E) {
    int tid_ = threadIdx.x; asm volatile("" : "+v"(tid_));
    const int tid = tid_, wid = __builtin_amdgcn_readfirstlane(tid >> 6), lane = tid & 63, wr = wid >> 2, wc = wid & 3, fr = lane & 15, fq = lane >> 4;
    const int nt = K / 128;
    unsigned voffA[2], voffB[2];
#pragma unroll
    for (int i = 0; i < 2; ++i) { int R, C; stage_rc(tid * 16 + i * 8192, R, C); const int Rb = Epi::PERM ? ((R & ~31) + perm32(R & 31)) : R;
        voffA[i] = (unsigned)(R * lda + C * 2); voffB[i] = (unsigned)(Rb * ldb + C * 2); }
    const size_t kstep = (size_t)(BK * 2);
    const size_t hstepA = (size_t)HALF * lda, hstepB = (size_t)HALF * ldb;
    const unsigned ldsw = (unsigned)wid * 1024u;
    const int aoff = lds_byte(wr * 64 + fr, fq * 8), boff = lds_byte(wc * 32 + fr, fq * 8);
#define PG8_SA(b, h) (((b) * 2 + (h)) * HTB)
#define PG8_SB(b, h) ((4 + (b) * 2 + (h)) * HTB)
#define PG8_STAGE(bufoff, gbase, voff) do { _Pragma("unroll") for (int _i = 0; _i < 2; ++_i) \
        __builtin_amdgcn_global_load_lds((const unsigned*)((const char*)(gbase) + (voff)[_i]), (LAS unsigned*)(lds + (bufoff) + ldsw + _i * 8192), 16, 0, 0); } while (0)
#define PG8_RD(off) __builtin_bit_cast(i32x4, *(const LAS bf16x8*)(lds + (off)))
#define PG8_LDA(dst, b, h) do { _Pragma("unroll") for (int m = 0; m < 4; ++m) dst[m] = __builtin_shufflevector(PG8_RD(PG8_SA(b, h) + aoff + m * 2048), PG8_RD(PG8_SA(b, h) + aoff + m * 2048 + 1024), 0, 1, 2, 3, 4, 5, 6, 7); } while (0)
#define PG8_LDB(dst, b, h) do { _Pragma("unroll") for (int n = 0; n < 2; ++n) dst[n] = __builtin_shufflevector(PG8_RD(PG8_SB(b, h) + boff + n * 2048), PG8_RD(PG8_SB(b, h) + boff + n * 2048 + 1024), 0, 1, 2, 3, 4, 5, 6, 7); } while (0)
#define PG8_LO(x) __builtin_bit_cast(bf16x8, __builtin_shufflevector((x), (x), 0, 1, 2, 3))
#define PG8_HI(x) __builtin_bit_cast(bf16x8, __builtin_shufflevector((x), (x), 4, 5, 6, 7))
#define PG8_MMA(ai, bj, At, Bt) do { __builtin_amdgcn_s_setprio(1); _Pragma("unroll") for (int m = 0; m < 4; ++m) _Pragma("unroll") for (int n = 0; n < 2; ++n) { \
        if constexpr (FP8) asm volatile("s_nop 1\n\tv_mfma_scale_f32_16x16x128_f8f6f4 %0, %1, %2, %0, %3, %4 op_sel_hi:[0,0,0]" : "+v"(acc[ai][bj][m][n]) : "v"(Bt[n]), "v"(At[m]), "v"(sc_w), "v"(sc_a)); \
        else { acc[ai][bj][m][n] = __builtin_amdgcn_mfma_f32_16x16x32_bf16(PG8_LO(Bt[n]), PG8_LO(At[m]), acc[ai][bj][m][n], 0, 0, 0); \
               acc[ai][bj][m][n] = __builtin_amdgcn_mfma_f32_16x16x32_bf16(PG8_HI(Bt[n]), PG8_HI(At[m]), acc[ai][bj][m][n], 0, 0, 0); } } __builtin_amdgcn_s_setprio(0); } while (0)
#define PG8_WAIT_V(n) asm volatile("s_waitcnt vmcnt(" #n ")" ::: "memory")
#define PG8_WAIT_L(n) asm volatile("s_waitcnt lgkmcnt(" #n ")" ::: "memory")
#define PG8_BAR __builtin_amdgcn_s_barrier()
#define PG8_SCHED __builtin_amdgcn_sched_barrier(0)
    Unit cur, nxt; int ui = 0;
    if (!S.next(0, cur)) return;
    f32x4 acc[2][2][4][2];
#pragma unroll
    for (int a = 0; a < 2; ++a)
#pragma unroll
        for (int b = 0; b < 2; ++b)
#pragma unroll
            for (int m = 0; m < 4; ++m)
#pragma unroll
                for (int n = 0; n < 2; ++n) acc[a][b][m][n] = (f32x4){0.f, 0.f, 0.f, 0.f};
    i32x8 At[4], B0[2], B1[2];
    const int sc_w = 0x77777777, sc_a = 0x7f7f7f7f;
    const char* cA = cur.a; const char* cB = cur.b;
    if constexpr (SP2) {
        PG8_STAGE(PG8_SB(0, 0), cB, voffB); PG8_STAGE(PG8_SB(0, 1), cB + hstepB, voffB); PG8_STAGE(PG8_SA(0, 0), cA, voffA); PG8_STAGE(PG8_SA(0, 1), cA + hstepA, voffA);
        if (wr == 1) PG8_BAR;
        PG8_WAIT_V(2); PG8_BAR;
        PG8_STAGE(PG8_SB(1, 0), cB + kstep, voffB); PG8_STAGE(PG8_SA(1, 0), cA + kstep, voffA); PG8_STAGE(PG8_SB(1, 1), cB + hstepB + kstep, voffB);
        PG8_WAIT_V(6); PG8_BAR;
    } else {
        PG8_STAGE(PG8_SB(0, 0), cB, voffB); PG8_STAGE(PG8_SA(0, 0), cA, voffA); PG8_STAGE(PG8_SB(0, 1), cB + hstepB, voffB); PG8_STAGE(PG8_SA(0, 1), cA + hstepA, voffA);
        if (wr == 1) PG8_BAR;
        PG8_WAIT_V(4); PG8_BAR;
        PG8_STAGE(PG8_SB(1, 0), cB + kstep, voffB); PG8_STAGE(PG8_SA(1, 0), cA + kstep, voffA); PG8_STAGE(PG8_SB(1, 1), cB + hstepB + kstep, voffB);
        PG8_WAIT_V(6); PG8_BAR;
    }
    for (;;) {
        const bool has_next = S.next(ui + 1, nxt);
        const char* nA = has_next ? nxt.a : cA; const char* nB = has_next ? nxt.b : cB;
        for (int t = 0; t < nt; t += 2) {
            const bool last = (t == nt - 2);
            const char* a1 = cA + (size_t)(t + 1) * kstep;
            const char* a2 = last ? nA : cA + (size_t)(t + 2) * kstep; const char* b2 = last ? nB : cB + (size_t)(t + 2) * kstep;
            const char* a3 = a2 + kstep; const char* b3 = b2 + kstep;
            if constexpr (SP2) {
            PG8_LDB(B0, 0, 0); PG8_LDB(B1, 0, 1); PG8_SCHED; PG8_LDA(At, 0, 0); PG8_STAGE(PG8_SA(1, 1), a1 + hstepA, voffA);
            PG8_WAIT_V(8); PG8_WAIT_L(0); PG8_BAR; PG8_MMA(0, 0, At, B0); PG8_MMA(0, 1, At, B1); PG8_BAR; PG8_SCHED;
            PG8_LDA(At, 0, 1); PG8_STAGE(PG8_SB(0, 0), b2, voffB); PG8_STAGE(PG8_SB(0, 1), b2 + hstepB, voffB); PG8_STAGE(PG8_SA(0, 0), a2, voffA);
            PG8_WAIT_V(8); PG8_WAIT_L(0); PG8_BAR; PG8_MMA(1, 0, At, B0); PG8_MMA(1, 1, At, B1); PG8_BAR; PG8_SCHED;
            PG8_LDB(B0, 1, 0); PG8_LDB(B1, 1, 1); PG8_SCHED; PG8_LDA(At, 1, 0); PG8_STAGE(PG8_SA(0, 1), a2 + hstepA, voffA);
            PG8_WAIT_V(8); PG8_WAIT_L(0); PG8_BAR; PG8_MMA(0, 0, At, B0); PG8_MMA(0, 1, At, B1); PG8_BAR; PG8_SCHED;
            PG8_LDA(At, 1, 1); PG8_STAGE(PG8_SB(1, 0), b3, voffB); PG8_STAGE(PG8_SB(1, 1), b3 + hstepB, voffB); PG8_STAGE(PG8_SA(1, 0), a3, voffA);
            PG8_WAIT_V(8); PG8_WAIT_L(0); PG8_BAR; PG8_MMA(1, 0, At, B0); PG8_MMA(1, 1, At, B1); PG8_BAR; PG8_SCHED;
            } else {
            PG8_LDB(B0, 0, 0); PG8_SCHED; PG8_LDA(At, 0, 0); PG8_STAGE(PG8_SA(1, 1), a1 + hstepA, voffA);
            PG8_WAIT_L(8); PG8_BAR; PG8_WAIT_L(0); PG8_MMA(0, 0, At, B0); PG8_BAR; PG8_SCHED;
            PG8_LDB(B1, 0, 1); PG8_STAGE(PG8_SB(0, 0), b2, voffB);
            PG8_BAR; PG8_WAIT_L(0); PG8_MMA(0, 1, At, B1); PG8_BAR;
            PG8_LDA(At, 0, 1); PG8_STAGE(PG8_SA(0, 0), a2, voffA);
            PG8_BAR; PG8_WAIT_L(0); PG8_MMA(1, 0, At, B0); PG8_BAR; PG8_SCHED;
            PG8_STAGE(PG8_SB(0, 1), b2 + hstepB, voffB);
            PG8_WAIT_V(6); PG8_BAR; PG8_MMA(1, 1, At, B1); PG8_BAR;
            PG8_LDB(B0, 1, 0); PG8_SCHED; PG8_LDA(At, 1, 0); PG8_STAGE(PG8_SA(0, 1), a2 + hstepA, voffA);
            PG8_WAIT_L(8); PG8_BAR; PG8_WAIT_L(0); PG8_MMA(0, 0, At, B0); PG8_BAR; PG8_SCHED;
            PG8_LDB(B1, 1, 1); PG8_STAGE(PG8_SB(1, 0), b3, voffB);
            PG8_BAR; PG8_WAIT_L(0); PG8_MMA(0, 1, At, B1); PG8_BAR;
            PG8_LDA(At, 1, 1); PG8_STAGE(PG8_SA(1, 0), a3, voffA);
            PG8_BAR; PG8_WAIT_L(0); PG8_MMA(1, 0, At, B0); PG8_BAR; PG8_SCHED;
            PG8_STAGE(PG8_SB(1, 1), b3 + hstepB, voffB);
            PG8_WAIT_V(6); PG8_BAR; PG8_MMA(1, 1, At, B1); PG8_BAR;
            }
            if constexpr (Epi::MIDHOOK) { if (((t + 2) & 7) == 0 && !last) { int fr_ = fr, fq_ = fq; asm volatile("" : "+v"(fr_), "+v"(fq_)); E.mid(acc, cur, (t + 2) >> 3, wr, wc, fr_, fq_); } }
        }
        if constexpr (ALIGN_EPI) { if (wr == 0) PG8_BAR; }
        if constexpr (FP8) asm volatile("s_nop 15\n\ts_nop 15" ::: "memory");
        { int fr_ = fr, fq_ = fq; asm volatile("" : "+v"(fr_), "+v"(fq_));
          E(acc, cur, wr, wc, fr_, fq_); }
        if (!has_next) break;
#pragma unroll
        for (int a = 0; a < 2; ++a)
#pragma unroll
            for (int b = 0; b < 2; ++b)
#pragma unroll
                for (int m = 0; m < 4; ++m)
#pragma unroll
                    for (int n = 0; n < 2; ++n) acc[a][b][m][n] = (f32x4){0.f, 0.f, 0.f, 0.f};
        cur = nxt; cA = nA; cB = nB; ++ui;
        if constexpr (ALIGN_EPI) { if (wr == 1) PG8_BAR; }
    }
    PG8_WAIT_V(0);
    if constexpr (!ALIGN_EPI) { if (wr == 0) PG8_BAR; }
    PG8_BAR;
#undef PG8_SA
#undef PG8_SB
#undef PG8_STAGE
#undef PG8_LDA
#undef PG8_LDB
#undef PG8_MMA
#undef PG8_RD
#undef PG8_LO
#undef PG8_HI
#undef PG8_WAIT_V
#undef PG8_WAIT_L
#undef PG8_BAR
#undef PG8_SCHED
}
}

constexpr size_t MiB = 1u << 20;
constexpr size_t al256(size_t x) { return (x + 255) & ~(size_t)255; }
constexpr size_t WS_CTL = 0, CTL_ZERO_BYTES = 1 * MiB;
constexpr size_t WS_MODV = 1 * MiB;
constexpr size_t WS_ROPE = WS_MODV + al256((size_t)2 * 5 * MODW * 4);
constexpr size_t WS_CNTWG = WS_ROPE + al256(64 * 16 * 2 * 4);
constexpr size_t WS_TOKE = WS_CNTWG + al256(256 * 8 * 4);
constexpr size_t WS_TOKP = WS_TOKE + al256((size_t)ML * 2 * 4);
constexpr size_t WS_TOKW = WS_TOKP + al256((size_t)ML * 2 * 4);
constexpr size_t WS_TOKS = WS_TOKW + al256((size_t)ML * 2 * 4);
constexpr size_t WS_TILE = WS_TOKS + al256((size_t)ML * 2 * 4);
constexpr size_t WS_WIN = 4 * MiB;
constexpr size_t WS_WBR = WS_WIN + (size_t)2 * INW * D * 2;
constexpr size_t WS_WOUT = WS_WBR + (size_t)2 * 3 * D * 512 * 2;
constexpr size_t WS_WGU0 = WS_WOUT + (size_t)2 * D * D * 2;
constexpr size_t WS_WDN0 = WS_WGU0 + (size_t)2 * DFF * D * 2;
constexpr size_t WS_WMGU = WS_WDN0 + (size_t)D * DFF * 2;
constexpr size_t WS_WMDN = WS_WMGU + (size_t)NE * 2 * DFE * D * 2;
constexpr size_t WS_H = WS_WMDN + (size_t)NE * D * DFE * 2;
constexpr size_t WS_Z = WS_H + (size_t)MT * D * 2;
constexpr size_t WS_MIX = WS_Z + (size_t)MT * INW * 2;
constexpr size_t WS_ACT = WS_Z;
constexpr size_t WS_YACC = WS_MIX + (size_t)MT * MIXW * 2;
constexpr size_t WS_H2S = WS_YACC;
constexpr size_t WS_Y = WS_YACC + (size_t)MT * D * 4;
constexpr size_t WS_X1 = WS_Y + (size_t)MT * D * 2;
constexpr size_t WS_X2 = WS_X1 + (size_t)MT * D * 4;
constexpr size_t WS_YS = WS_X2;
constexpr size_t WS_H8 = WS_X2 + (size_t)MT * D * 4;
constexpr size_t WS_WIN8 = WS_H8 + (size_t)MT * D;
constexpr size_t WS_END = WS_WIN8 + (size_t)2 * 3 * D * D;
static_assert((size_t)MS * DFE * 2 <= (size_t)MT * INW * 2 + (size_t)MT * MIXW * 2, "ACT overlay");
static_assert((size_t)MS * D * 2 <= (size_t)MT * D * 4, "H2S / YS overlays");
static_assert(WS_TILE + 1024 <= WS_WIN, "small tables");
constexpr int CW_BAR = 4096;

constexpr int RING_BYTES = 131072;
constexpr int LDSCTL_OFF = 146944, MISC_OFF = LDSCTL_OFF + 320;
constexpr int LDS_BYTES = 147456;

#define XB_TMO      128
#define XB_XCNT(j)  (256  + 64 * (j))
#define XB_XSUB(j)  (1280 + 64 * (j))
#define XB_XGEN(j)  (2304 + 64 * (j))
#define XB_TOP      3328
#define XB_TOPGEN   3392
#define XCD_BAR_WORDS 3456
#define XB_SPIN_CAP (1u << 18)
__device__ __forceinline__ unsigned xb_ld(unsigned* p)              { return __hip_atomic_load(p, __ATOMIC_RELAXED, __HIP_MEMORY_SCOPE_AGENT); }
__device__ __forceinline__ unsigned xb_add(unsigned* p, unsigned v) { return __hip_atomic_fetch_add(p, v, __ATOMIC_RELAXED, __HIP_MEMORY_SCOPE_AGENT); }
__device__ __forceinline__ unsigned xb_xcc_id() { return (unsigned)__builtin_amdgcn_s_getreg((3 << 11) | 20) & 0xFu; }
#define XB_SPIN(cond, bar) do { unsigned _sp = 0; while (cond) { __builtin_amdgcn_s_sleep(1); \
    if ((++_sp & 255u) == 0u) { if (xb_ld(&(bar)[XB_TMO])) break; if (_sp > XB_SPIN_CAP) { atomicAdd(&(bar)[XB_TMO], 1u); break; } } } } while (0)
struct XcdBarrier { unsigned* bar; unsigned x; volatile LAS unsigned* st; };
__device__ __forceinline__ XcdBarrier xcd_barrier_post(unsigned* bar, volatile LAS unsigned* st) {
    XcdBarrier b; b.bar = bar; b.x = xb_xcc_id(); b.st = st;
    if (threadIdx.x == 0) (void)xb_add(&bar[XB_XCNT(b.x)], 1u);
    return b;
}
__device__ __forceinline__ void xcd_barrier_complete(unsigned* bar, unsigned x, unsigned& nloc, unsigned& nx) {
    const unsigned G = gridDim.x * gridDim.y * gridDim.z;
    unsigned sum, cnt, mine, sp = 0u;
    for (;;) {
        sum = 0u; cnt = 0u; mine = 0u;
#pragma unroll
        for (unsigned j = 0; j < 16; ++j) { const unsigned c = xb_ld(&bar[XB_XCNT(j)]); sum += c; cnt += (c > 0u) ? 1u : 0u; mine = (j == x) ? c : mine; }
        if (sum == G) break;
        __builtin_amdgcn_s_sleep(1);
        if ((++sp & 255u) == 0u) { if (xb_ld(&bar[XB_TMO])) break; if (sp > XB_SPIN_CAP) { atomicAdd(&bar[XB_TMO], 1u); break; } }
    }
    nloc = mine > 0u ? mine : 1u; nx = cnt > 0u ? cnt : 1u;
}
__device__ __attribute__((noinline)) void xcd_barrier_leader(unsigned* bar, unsigned bx_, volatile LAS unsigned* st) {
    {
        XcdBarrier b; b.bar = bar; b.x = bx_; b.st = st;
        __builtin_amdgcn_s_waitcnt(0);
        unsigned nloc = b.st[0], nx = b.st[1];
        if (nloc == 0u) { xcd_barrier_complete(bar, b.x, nloc, nx); b.st[0] = nloc; b.st[1] = nx; }
        const unsigned old = xb_add(&bar[XB_XSUB(b.x)], 1u);
        const unsigned gen = old / nloc;
        if (old + 1u == (gen + 1u) * nloc) {
            __builtin_amdgcn_fence(__ATOMIC_RELEASE, "agent");
            asm volatile("s_waitcnt vmcnt(0)" ::: "memory");
            const unsigned og = xb_add(&bar[XB_TOP], 1u);
            const unsigned tg = og / nx;
            if (og + 1u == (tg + 1u) * nx) xb_add(&bar[XB_TOPGEN], 1u);
            else XB_SPIN(xb_ld(&bar[XB_TOPGEN]) == tg, bar);
            __builtin_amdgcn_fence(__ATOMIC_ACQUIRE, "agent");
            xb_add(&bar[XB_XGEN(b.x)], 1u);
            asm volatile("s_waitcnt vmcnt(0)" ::: "memory");
        } else {
            XB_SPIN(xb_ld(&bar[XB_XGEN(b.x)]) == gen, bar);
            __builtin_amdgcn_fence(__ATOMIC_ACQUIRE, "agent");
            asm volatile("s_waitcnt vmcnt(0)" ::: "memory");
        }
    }
}
__device__ __forceinline__ void xcd_barrier(const XcdBarrier& b) {
    asm volatile("s_waitcnt vmcnt(0)" ::: "memory");
    __syncthreads();
    if (threadIdx.x == 0) xcd_barrier_leader(b.bar, b.x, b.st);
    __syncthreads();
}

struct Args {
    const float *x, *c, *ctx, *c_ctx, *norm1_g, *norm2_g, *final_g, *w_mod, *b_mod, *w_in, *conv_w, *sink, *pool_w, *pool_scale, *w_branch, *w_out,
                *ffn_w_gu, *ffn_w_down, *router_w, *moe_w_gu, *moe_w_down;
    float* out; unsigned char* ws; int ph_lo, ph_hi;
};
template <int OFF> __device__ __forceinline__ const void* karg_p() { const void* r; asm volatile("s_load_dwordx2 %0, %1, %2\n\ts_waitcnt lgkmcnt(0)" : "=s"(r) : "s"(__builtin_amdgcn_kernarg_segment_ptr()), "i"(OFF)); return r; }
template <int OFF> __device__ __forceinline__ int karg_i() { int r; asm volatile("s_load_dword %0, %1, %2\n\ts_waitcnt lgkmcnt(0)" : "=s"(r) : "s"(__builtin_amdgcn_kernarg_segment_ptr()), "i"(OFF)); return r; }
#define KP(field) ((const float*)karg_p<(int)__builtin_offsetof(Args, field)>())
struct Frame {
    LAS unsigned char* lds;
    int tid, lane, wave, G, bx;
    unsigned char* ws;
};
__device__ __forceinline__ float wave_sum(float v) {
#pragma unroll
    for (int o = 1; o < 64; o <<= 1) v += __shfl_xor(v, o);
    return v;
}
__device__ __forceinline__ float wave_max(float v) {
#pragma unroll
    for (int o = 1; o < 64; o <<= 1) v = fmaxf(v, __shfl_xor(v, o));
    return v;
}
#define LDS_WAIT() asm volatile("s_waitcnt lgkmcnt(0)" ::: "memory")

template <bool F8>
__device__ __forceinline__ void p0_transpose_item(const float* W, int ldw, bf16* WT, int ldt, int koff, int k0, int n0, int drow0, LAS float* scr, int lane) {
    f32x4 v[16];
    const int rl = lane >> 4, c4 = 4 * (lane & 15);
#pragma unroll
    for (int i = 0; i < 16; ++i) v[i] = __builtin_nontemporal_load((const f32x4*)(W + (size_t)(k0 + 4 * i + rl) * ldw + n0 + c4));
#pragma unroll
    for (int i = 0; i < 16; ++i) { LAS float* p = scr + (4 * i + rl) * 65 + c4; p[0] = v[i].x; p[1] = v[i].y; p[2] = v[i].z; p[3] = v[i].w; }
    LDS_WAIT(); asm volatile("" ::: "memory");
    const int c = lane & 7;
#pragma unroll
    for (int j = 0; j < 8; ++j) { const int n = (lane >> 3) + 8 * j; const LAS float* sp = scr + (8 * c) * 65 + n;
        if constexpr (F8) { u32x2 o; o.x = pk4_fp8(sp[0 * 65] * W8SCALE, sp[1 * 65] * W8SCALE, sp[2 * 65] * W8SCALE, sp[3 * 65] * W8SCALE); o.y = pk4_fp8(sp[4 * 65] * W8SCALE, sp[5 * 65] * W8SCALE, sp[6 * 65] * W8SCALE, sp[7 * 65] * W8SCALE);
            *(u32x2*)((unsigned char*)WT + (size_t)(drow0 + n) * ldt + koff + k0 + 8 * c) = o; }
        else { u32x4 o; o.x = pk2(sp[0 * 65], sp[1 * 65]); o.y = pk2(sp[2 * 65], sp[3 * 65]); o.z = pk2(sp[4 * 65], sp[5 * 65]); o.w = pk2(sp[6 * 65], sp[7 * 65]);
            *(u32x4*)(WT + (size_t)(drow0 + n) * ldt + koff + k0 + 8 * c) = o; } }
    LDS_WAIT(); asm volatile("" ::: "memory");
}
template <bool F8>
__device__ __forceinline__ void p0_job_item(const float* W, int ldw, int K, int N, bf16* WT, int ldt, int koff, int IL, int item, LAS float* scr, int lane) {
    const int nblk = N / 64, kb = item / nblk, nb = item % nblk, n0 = 64 * nb;
    int drow0 = n0;
    if (IL > 0) { const int half = n0 >= IL ? 1 : 0, f = n0 - half * IL; drow0 = 256 * (f / 128) + 128 * half + (f % 128); }
    p0_transpose_item<F8>(W, ldw, WT, ldt, koff, 64 * kb, n0, drow0, scr, lane);
}
__device__ __forceinline__ void p0_prologue(Frame& F) {
    LAS float* scr = (LAS float*)(F.lds + F.wave * 16640);
    const int gw = F.bx * NWAVES + F.wave, NGW = F.G * NWAVES;
    constexpr int I_IN = (D / 64) * (ZG / 64), I_IN8 = (D / 64) * (3 * D / 64), I_BR = (512 / 64) * (D / 64), I_OUT = (D / 64) * (D / 64), I_GU0 = (D / 64) * (2 * DFF / 64), I_DN0 = (DFF / 64) * (D / 64),
                  I_MGU = (D / 64) * (2 * DFE / 64), I_MDN = (DFE / 64) * (D / 64);
    constexpr int NITEMS = 2 * I_IN + 2 * I_IN8 + 4 * I_BR + 2 * I_OUT + I_GU0 + I_DN0 + NE * I_MGU + NE * I_MDN;
    bf16* const wsb = (bf16*)F.ws;
    for (int it = gw; it < NITEMS; it += NGW) {
        int r = it;
        if (r < NE * I_MGU) { const int e = r / I_MGU; p0_job_item<true>(KP(moe_w_gu) + (size_t)e * D * 2 * DFE, 2 * DFE, D, 2 * DFE, (bf16*)(F.ws + WS_WMGU + (size_t)e * 2 * DFE * D), D, 0, DFE, r % I_MGU, scr, F.lane); continue; } r -= NE * I_MGU;
        if (r < NE * I_MDN) { const int e = r / I_MDN; p0_job_item<true>(KP(moe_w_down) + (size_t)e * DFE * D, D, DFE, D, (bf16*)(F.ws + WS_WMDN + (size_t)e * D * DFE), DFE, 0, 0, r % I_MDN, scr, F.lane); continue; } r -= NE * I_MDN;
        if (r < 2 * I_IN) { const int l = r / I_IN; p0_job_item<false>(KP(w_in) + (size_t)l * D * INW, INW, D, ZG, (bf16*)(F.ws + WS_WIN) + (size_t)l * ZG * D, D, 0, 0, r % I_IN, scr, F.lane); continue; } r -= 2 * I_IN;
        if (r < 2 * I_IN8) { const int l = r / I_IN8; p0_job_item<true>(KP(w_in) + (size_t)l * D * INW + ZG, INW, D, 3 * D, (bf16*)(F.ws + WS_WIN8 + (size_t)l * 3 * D * D), D, 0, 0, r % I_IN8, scr, F.lane); continue; } r -= 2 * I_IN8;
        if (r < 4 * I_BR) { const int j = r / I_BR, l = j >> 1, b = j & 1; p0_job_item<false>(KP(w_branch) + (size_t)(l * 3 + b) * 512 * D, D, 512, D, (bf16*)(F.ws + WS_WBR) + (size_t)l * D * MIXW, MIXW, 512 * b, 0, r % I_BR, scr, F.lane); continue; } r -= 4 * I_BR;
        if (r < 2 * I_OUT) { const int l = r / I_OUT; p0_job_item<false>(KP(w_out) + (size_t)l * D * D, D, D, D, (bf16*)(F.ws + WS_WOUT) + (size_t)l * D * D, D, 0, 0, r % I_OUT, scr, F.lane); continue; } r -= 2 * I_OUT;
        if (r < I_GU0) { p0_job_item<FFN0_FP8 != 0>(KP(ffn_w_gu), 2 * DFF, D, 2 * DFF, (bf16*)(F.ws + WS_WGU0), D, 0, DFF, r, scr, F.lane); continue; } r -= I_GU0;
        p0_job_item<(FFN0_FP8 || DN0_FP8)>(KP(ffn_w_down), D, DFF, D, (bf16*)(F.ws + WS_WDN0), DFF, 0, 0, r, scr, F.lane);
    }
    (void)wsb;
    __syncthreads();
    constexpr int I_MOD = 2 * (MODW / 64), I_FOLD = 2 * 4 * (D / 64);
    for (int it = F.bx; it < I_MOD + I_FOLD + 1; it += F.G) {
        if (it < I_MOD) {
            const int l = it / (MODW / 64), cb = it % (MODW / 64);
            LAS float* sv = (LAS float*)F.lds;
            LAS float* red = (LAS float*)(F.lds + 32768);
            for (int i = F.tid; i < 5 * D; i += NTHR) { const int r = i / D, k = i % D; const float v = r < 4 ? KP(c)[r * D + k] : KP(c_ctx)[k]; sv[i] = v / (1.f + __expf(-v)); }
            __syncthreads();
            const int col = cb * 64 + F.lane; const float* wp = KP(w_mod) + (size_t)l * D * MODW + col;
            float a0 = 0.f, a1 = 0.f, a2 = 0.f, a3 = 0.f, a4 = 0.f;
#pragma unroll 8
            for (int kk = 0; kk < 128; ++kk) { const int k = F.wave * 128 + kk; const float w = wp[(size_t)k * MODW];
                a0 += sv[k] * w; a1 += sv[D + k] * w; a2 += sv[2 * D + k] * w; a3 += sv[3 * D + k] * w; a4 += sv[4 * D + k] * w; }
            red[(F.wave * 5 + 0) * 64 + F.lane] = a0; red[(F.wave * 5 + 1) * 64 + F.lane] = a1; red[(F.wave * 5 + 2) * 64 + F.lane] = a2;
            red[(F.wave * 5 + 3) * 64 + F.lane] = a3; red[(F.wave * 5 + 4) * 64 + F.lane] = a4;
            __syncthreads();
            if (F.tid < 320) { const int r = F.tid / 64, ln = F.tid % 64; float s = 0.f;
#pragma unroll
                for (int w = 0; w < 8; ++w) s += red[(w * 5 + r) * 64 + ln];
                const int cc = cb * 64 + ln;
                ((float*)(F.ws + WS_MODV))[(size_t)(l * 5 + r) * MODW + cc] = s + KP(b_mod)[l * MODW + cc]; }
            __syncthreads();
        } else if (it < I_MOD + I_FOLD) {
            const int r = it - I_MOD, l = r / 64, g = (r % 64) / 16, nb = r % 16;
            LAS float* pw = (LAS float*)F.lds;
            const float* pws = KP(pool_w) + (size_t)(l * 4 + g) * 128 * 128;
            for (int i = F.tid; i < 128 * 128; i += NTHR) pw[i] = pws[i];
            __syncthreads();
            const int n = nb * 64 + F.lane; const float* w2 = KP(w_branch) + (size_t)(l * 3 + 2) * 512 * D + (size_t)(128 * g) * D + n;
            const float* ps = KP(pool_scale) + l * 512 + 128 * g;
            float acc[16];
#pragma unroll
            for (int q = 0; q < 16; ++q) acc[q] = 0.f;
            for (int j = 0; j < 128; ++j) { const float wv = w2[(size_t)j * D] * ps[j];
#pragma unroll
                for (int q = 0; q < 16; ++q) acc[q] += pw[(F.wave * 16 + q) * 128 + j] * wv; }
            bf16* dst = (bf16*)(F.ws + WS_WBR) + (size_t)l * D * MIXW + (size_t)n * MIXW + 1024 + 128 * g + F.wave * 16;
            u32x4 o0, o1; o0.x = pk2(acc[0], acc[1]); o0.y = pk2(acc[2], acc[3]); o0.z = pk2(acc[4], acc[5]); o0.w = pk2(acc[6], acc[7]);
            o1.x = pk2(acc[8], acc[9]); o1.y = pk2(acc[10], acc[11]); o1.z = pk2(acc[12], acc[13]); o1.w = pk2(acc[14], acc[15]);
            *(u32x4*)dst = o0; *(u32x4*)(dst + 8) = o1;
            __syncthreads();
        } else {
            for (int i = F.tid; i < 64 * 16; i += NTHR) { const int pos = i / 16, fi = i % 16;
                const float inv = powf(10000.0f, -(float)fi / 16.0f); const float ang = (float)pos * inv;
                ((float*)(F.ws + WS_ROPE))[2 * i] = cosf(ang); ((float*)(F.ws + WS_ROPE))[2 * i + 1] = sinf(ang); }
        }
    }
}

template <bool ROUTER, int OUTM = 0>
__device__ __forceinline__ void norm_mod_phase(Frame& F, const float* xl, const float* xc, const float* gvec, const float* modl, int shi, int sci, int nrows, const float* router_w) {
    bf16* H = (bf16*)(F.ws + WS_H);
    LAS int* lcnt = (LAS int*)F.lds;
    if (ROUTER) { if (F.tid < 8) lcnt[F.tid] = 0; __syncthreads(); }
    if constexpr (!ROUTER) {
        const int nwv = F.G * NWAVES, gw = F.bx * NWAVES + F.wave;
        for (int r0 = gw; r0 < nrows; r0 += 2 * nwv) {
            const bool has1 = r0 + nwv < nrows; const int r1 = has1 ? r0 + nwv : r0;
            const int b0 = r0 < ML ? r0 / SEQ : 4, b1 = r1 < ML ? r1 / SEQ : 4;
            const float* x0 = r0 < ML ? xl + (size_t)r0 * D : xc + (size_t)(r0 - ML) * D; const float* x1 = r1 < ML ? xl + (size_t)r1 * D : xc + (size_t)(r1 - ML) * D;
            const float* m0 = modl + (size_t)b0 * MODW; const float* m1 = modl + (size_t)b1 * MODW;
            f32x4 va[4], vb[4], g[4], sh0[4], sc0[4], sh1[4], sc1[4];
#pragma unroll
            for (int j = 0; j < 4; ++j) { const int c = 4 * F.lane + 256 * j; va[j] = *(const f32x4*)(x0 + c); vb[j] = *(const f32x4*)(x1 + c); }
#pragma unroll
            for (int j = 0; j < 4; ++j) { const int c = 4 * F.lane + 256 * j; g[j] = *(const f32x4*)(gvec + c); sh0[j] = *(const f32x4*)(m0 + shi * D + c); sc0[j] = *(const f32x4*)(m0 + sci * D + c);
                sh1[j] = *(const f32x4*)(m1 + shi * D + c); sc1[j] = *(const f32x4*)(m1 + sci * D + c); }
            float sa = 0.f, sb = 0.f;
#pragma unroll
            for (int j = 0; j < 4; ++j) { sa += (va[j].x * va[j].x + va[j].y * va[j].y) + (va[j].z * va[j].z + va[j].w * va[j].w); sb += (vb[j].x * vb[j].x + vb[j].y * vb[j].y) + (vb[j].z * vb[j].z + vb[j].w * vb[j].w); }
            const float ra = 1.0f / sqrtf(wave_sum(sa) * (1.f / D) + EPS), rb = 1.0f / sqrtf(wave_sum(sb) * (1.f / D) + EPS);
#pragma unroll
            for (int j = 0; j < 4; ++j) { const int c = 4 * F.lane + 256 * j;
                const f32x4 oa = (va[j] * ra * g[j]) * (sc0[j] + 1.0f) + sh0[j], ob = (vb[j] * rb * g[j]) * (sc1[j] + 1.0f) + sh1[j];
                if constexpr (OUTM == 1) { *(unsigned*)((unsigned char*)H + (size_t)r0 * D + c) = pk4_fp8(oa.x, oa.y, oa.z, oa.w); if (has1) *(unsigned*)((unsigned char*)H + (size_t)r1 * D + c) = pk4_fp8(ob.x, ob.y, ob.z, ob.w); }
                else { u32x2 o; o.x = pk2(oa.x, oa.y); o.y = pk2(oa.z, oa.w); *(u32x2*)(H + (size_t)r0 * D + c) = o; if (has1) { o.x = pk2(ob.x, ob.y); o.y = pk2(ob.z, ob.w); *(u32x2*)(H + (size_t)r1 * D + c) = o; } }
                if constexpr (OUTM == 2) { *(unsigned*)(F.ws + WS_H8 + (size_t)r0 * D + c) = pk4_fp8(oa.x, oa.y, oa.z, oa.w); if (has1) *(unsigned*)(F.ws + WS_H8 + (size_t)r1 * D + c) = pk4_fp8(ob.x, ob.y, ob.z, ob.w); } }
        }
        return;
    }
    const int nloop = ROUTER ? 8 : (nrows + F.G * NWAVES - 1) / (F.G * NWAVES);
    for (int i = 0; i < nloop; ++i) {
        const int r = ROUTER ? (F.bx * 64 + F.wave + 8 * i) : ((i * F.G + F.bx) * NWAVES + F.wave);
        if (r >= nrows) continue;
        const int bidx = r < ML ? r / SEQ : 4;
        const float* xr = r < ML ? xl + (size_t)r * D : xc + (size_t)(r - ML) * D;
        const float* mv = modl + (size_t)bidx * MODW;
        f32x4 v[4]; float ss = 0.f;
#pragma unroll
        for (int j = 0; j < 4; ++j) { v[j] = *(const f32x4*)(xr + 4 * F.lane + 256 * j); ss += (v[j].x * v[j].x + v[j].y * v[j].y) + (v[j].z * v[j].z + v[j].w * v[j].w); }
        const float rstd = 1.0f / sqrtf(wave_sum(ss) * (1.f / D) + EPS);
#pragma unroll
        for (int j = 0; j < 4; ++j) { const int c = 4 * F.lane + 256 * j;
            const f32x4 g = *(const f32x4*)(gvec + c), sh = *(const f32x4*)(mv + shi * D + c), sc = *(const f32x4*)(mv + sci * D + c);
            v[j] = (v[j] * rstd * g) * (sc + 1.0f) + sh;
            if constexpr (OUTM == 1) *(unsigned*)((unsigned char*)H + (size_t)r * D + c) = pk4_fp8(v[j].x, v[j].y, v[j].z, v[j].w);
            else { u32x2 o; o.x = pk2(v[j].x, v[j].y); o.y = pk2(v[j].z, v[j].w); *(u32x2*)(H + (size_t)r * D + c) = o; }
            if constexpr (OUTM == 2) *(unsigned*)(F.ws + WS_H8 + (size_t)r * D + c) = pk4_fp8(v[j].x, v[j].y, v[j].z, v[j].w); }
        if (ROUTER) {
            float lg[8];
#pragma unroll
            for (int e = 0; e < 8; ++e) lg[e] = 0.f;
#pragma unroll
            for (int j = 0; j < 4; ++j)
#pragma unroll
                for (int q = 0; q < 4; ++q) { const int c = 4 * F.lane + 256 * j + q; const f32x4 w0 = *(const f32x4*)(router_w + (size_t)c * 8), w1 = *(const f32x4*)(router_w + (size_t)c * 8 + 4); const float hv = v[j][q];
                    lg[0] += hv * w0.x; lg[1] += hv * w0.y; lg[2] += hv * w0.z; lg[3] += hv * w0.w; lg[4] += hv * w1.x; lg[5] += hv * w1.y; lg[6] += hv * w1.z; lg[7] += hv * w1.w; }
#pragma unroll
            for (int e = 0; e < 8; ++e) lg[e] = wave_sum(lg[e]);
            int e1 = 0; float v1 = lg[0];
#pragma unroll
            for (int e = 1; e < 8; ++e) if (lg[e] > v1) { v1 = lg[e]; e1 = e; }
            int e2 = -1; float v2 = -3.0e38f;
#pragma unroll
            for (int e = 0; e < 8; ++e) if (e != e1 && lg[e] > v2) { v2 = lg[e]; e2 = e; }
            const float ex = __expf(v2 - v1), w1 = 1.f / (1.f + ex), w2 = ex * w1;
            if (F.lane == 0) {
                const int p1 = atomicAdd((int*)&lcnt[e1], 1), p2 = atomicAdd((int*)&lcnt[e2], 1);
                int* te = (int*)(F.ws + WS_TOKE) + 2 * r; te[0] = e1; te[1] = e2;
                int* tp = (int*)(F.ws + WS_TOKP) + 2 * r; tp[0] = p1; tp[1] = p2;
                float* tw = (float*)(F.ws + WS_TOKW) + 2 * r; tw[0] = w1; tw[1] = w2;
            }
        }
    }
    if (ROUTER) { __syncthreads(); if (F.tid < 8) ((int*)(F.ws + WS_CNTWG))[F.bx * 8 + F.tid] = lcnt[F.tid]; __syncthreads(); }
}

__device__ __forceinline__ void moe_scatter_phase(Frame& F) {
    LAS int* tab = (LAS int*)F.lds;
    const int* cw = (const int*)(F.ws + WS_CNTWG);
    if (F.tid < 32) tab[F.tid] = 0;
    __syncthreads();
    for (int idx = F.tid; idx < F.G * 8; idx += NTHR) {
        const int c = __hip_atomic_load(cw + idx, __ATOMIC_RELAXED, __HIP_MEMORY_SCOPE_AGENT); const int w = idx >> 3, e = idx & 7;
        atomicAdd((int*)&tab[16 + e], c); if (w < F.bx) atomicAdd((int*)&tab[8 + e], c);
    }
    __syncthreads();
    if (F.tid == 0) { int off = 0; for (int e = 0; e < 8; ++e) { tab[e] = off; off += ((tab[16 + e] + 255) / 256) * 256; } tab[24] = off / 256;
        if (F.bx == 0) { int* tl = (int*)(F.ws + WS_TILE); int t = 0; for (int e = 0; e < 8; ++e) { const int n = (tab[16 + e] + 255) / 256; for (int q = 0; q < n; ++q) tl[t++] = e; } tl[200] = t; } }
    __syncthreads();
    const bf16* H = (const bf16*)(F.ws + WS_H); bf16* HS = (bf16*)(F.ws + WS_H2S);
    for (int i = 0; i < 8; ++i) {
        const int r = F.bx * 64 + F.wave + 8 * i; if (r >= ML) continue;
        const int* te = (const int*)(F.ws + WS_TOKE) + 2 * r; const int* tp = (const int*)(F.ws + WS_TOKP) + 2 * r;
        const int e1 = te[0], e2 = te[1];
        const int s1 = tab[e1] + tab[8 + e1] + tp[0], s2 = tab[e2] + tab[8 + e2] + tp[1];
        if (F.lane == 0) { int* ts = (int*)(F.ws + WS_TOKS) + 2 * r; ts[0] = s1; ts[1] = s2; }
        const u32x4 a = ((const u32x4*)((const unsigned char*)H + (size_t)r * D))[F.lane];
        ((u32x4*)((unsigned char*)HS + (size_t)s1 * D))[F.lane] = a; ((u32x4*)((unsigned char*)HS + (size_t)s2 * D))[F.lane] = a;
    }
}

__device__ __forceinline__ void final_phase(Frame& F, const float* final_g, float* out, const float* modl) {
    const float* X1 = (const float*)(F.ws + WS_X1); const bf16* YS = (const bf16*)(F.ws + WS_YS);
    const int nwv = F.G * NWAVES, gw = F.bx * NWAVES + F.wave;
    for (int r0 = gw; r0 < ML; r0 += 2 * nwv) {
        const bool has1 = r0 + nwv < ML; const int r1 = has1 ? r0 + nwv : r0;
        const float* ga = modl + (size_t)(r0 / SEQ) * MODW + 5 * D; const float* gb = modl + (size_t)(r1 / SEQ) * MODW + 5 * D;
        const int* tsa = (const int*)(F.ws + WS_TOKS) + 2 * r0; const int* tsb = (const int*)(F.ws + WS_TOKS) + 2 * r1;
        const float* twa = (const float*)(F.ws + WS_TOKW) + 2 * r0; const float* twb = (const float*)(F.ws + WS_TOKW) + 2 * r1;
        const int a1 = tsa[0], a2 = tsa[1], b1 = tsb[0], b2 = tsb[1]; const float wa1 = twa[0], wa2 = twa[1], wb1 = twb[0], wb2 = twb[1];
        f32x4 xa[4], xb[4], gva[4], gvb[4], fg[4]; u32x2 ya1[4], ya2[4], yb1[4], yb2[4];
#pragma unroll
        for (int j = 0; j < 4; ++j) { const int c = 4 * F.lane + 256 * j;
            xa[j] = *(const f32x4*)(X1 + (size_t)r0 * D + c); xb[j] = *(const f32x4*)(X1 + (size_t)r1 * D + c);
            ya1[j] = *(const u32x2*)(YS + (size_t)a1 * D + c); ya2[j] = *(const u32x2*)(YS + (size_t)a2 * D + c); yb1[j] = *(const u32x2*)(YS + (size_t)b1 * D + c); yb2[j] = *(const u32x2*)(YS + (size_t)b2 * D + c);
            gva[j] = *(const f32x4*)(ga + c); gvb[j] = *(const f32x4*)(gb + c); fg[j] = *(const f32x4*)(final_g + c); }
        float sa = 0.f, sb = 0.f;
#pragma unroll
        for (int j = 0; j < 4; ++j) {
            f32x4 f; f.x = wa1 * bflo(ya1[j].x) + wa2 * bflo(ya2[j].x); f.y = wa1 * bfhi(ya1[j].x) + wa2 * bfhi(ya2[j].x); f.z = wa1 * bflo(ya1[j].y) + wa2 * bflo(ya2[j].y); f.w = wa1 * bfhi(ya1[j].y) + wa2 * bfhi(ya2[j].y);
            xa[j] = xa[j] + gva[j] * f; sa += (xa[j].x * xa[j].x + xa[j].y * xa[j].y) + (xa[j].z * xa[j].z + xa[j].w * xa[j].w);
            f.x = wb1 * bflo(yb1[j].x) + wb2 * bflo(yb2[j].x); f.y = wb1 * bfhi(yb1[j].x) + wb2 * bfhi(yb2[j].x); f.z = wb1 * bflo(yb1[j].y) + wb2 * bflo(yb2[j].y); f.w = wb1 * bfhi(yb1[j].y) + wb2 * bfhi(yb2[j].y);
            xb[j] = xb[j] + gvb[j] * f; sb += (xb[j].x * xb[j].x + xb[j].y * xb[j].y) + (xb[j].z * xb[j].z + xb[j].w * xb[j].w); }
        const float ra = 1.0f / sqrtf(wave_sum(sa) * (1.f / D) + EPS), rb = 1.0f / sqrtf(wave_sum(sb) * (1.f / D) + EPS);
#pragma unroll
        for (int j = 0; j < 4; ++j) { const int c = 4 * F.lane + 256 * j;
            __builtin_nontemporal_store(xa[j] * ra * fg[j], (f32x4*)(out + (size_t)r0 * D + c)); if (has1) __builtin_nontemporal_store(xb[j] * rb * fg[j], (f32x4*)(out + (size_t)r1 * D + c)); }
    }
}

__device__ __forceinline__ void unpack8(const u32x4 w, float (&f)[8]) { f[0] = bflo(w.x); f[1] = bfhi(w.x); f[2] = bflo(w.y); f[3] = bfhi(w.y); f[4] = bflo(w.z); f[5] = bfhi(w.z); f[6] = bflo(w.w); f[7] = bfhi(w.w); }
__device__ __forceinline__ void local_mix_phase(Frame& F, const float* cw, int nrows, const bool skip16) {
    const bf16* Z = (const bf16*)(F.ws + WS_Z); bf16* MIX = (bf16*)(F.ws + WS_MIX);
    const int vcu = (F.G % 8 == 0) ? (F.bx % 8) * (F.G / 8) + F.bx / 8 : F.bx;
    const int nwk = (skip16 && F.G > 32) ? F.G - 16 : F.G, wk = (skip16 && F.G > 32) ? vcu - 16 : vcu;
    const int total = (nrows / 8) * 64, stride = nwk * NTHR;
    for (int idx = (wk < 0 ? total : wk * NTHR + F.tid); idx < total; idx += stride) {
        const int r0 = (idx >> 6) * 8, cg = idx & 63, c0 = cg * 8;
        int t0, L;
        if (r0 < ML) { t0 = r0 % SEQ; L = SEQ; } else { t0 = (r0 - ML) % CTXL; L = CTXL; }
        const bf16* zb = Z + (size_t)(r0 - t0) * INW;
        { float wa[8], wb[8], wc_[8];
          { const f32x4 a0 = *(const f32x4*)(cw + c0), a1 = *(const f32x4*)(cw + c0 + 4), b0 = *(const f32x4*)(cw + 512 + c0), b1 = *(const f32x4*)(cw + 512 + c0 + 4), d0 = *(const f32x4*)(cw + 1024 + c0), d1 = *(const f32x4*)(cw + 1024 + c0 + 4);
            wa[0] = a0.x; wa[1] = a0.y; wa[2] = a0.z; wa[3] = a0.w; wa[4] = a1.x; wa[5] = a1.y; wa[6] = a1.z; wa[7] = a1.w;
            wb[0] = b0.x; wb[1] = b0.y; wb[2] = b0.z; wb[3] = b0.w; wb[4] = b1.x; wb[5] = b1.y; wb[6] = b1.z; wb[7] = b1.w;
            wc_[0] = d0.x; wc_[1] = d0.y; wc_[2] = d0.z; wc_[3] = d0.w; wc_[4] = d1.x; wc_[5] = d1.y; wc_[6] = d1.z; wc_[7] = d1.w; }
          float pp[8], pc[8], pn[8];
#pragma unroll
          for (int q = 0; q < 8; ++q) pp[q] = 0.f;
          if (t0 > 0) { float cx[8], cc[8]; const bf16* zr = zb + (size_t)(t0 - 1) * INW; unpack8(*(const u32x4*)(zr + ZCX + c0), cx); unpack8(*(const u32x4*)(zr + ZCC + c0), cc);
#pragma unroll
              for (int q = 0; q < 8; ++q) pp[q] = cc[q] * cx[q]; }
          { float cx[8], cc[8]; const bf16* zr = zb + (size_t)t0 * INW; unpack8(*(const u32x4*)(zr + ZCX + c0), cx); unpack8(*(const u32x4*)(zr + ZCC + c0), cc);
#pragma unroll
              for (int q = 0; q < 8; ++q) pc[q] = cc[q] * cx[q]; }
#pragma unroll
          for (int i = 0; i < 8; ++i) { const int t = t0 + i;
#pragma unroll
              for (int q = 0; q < 8; ++q) pn[q] = 0.f;
              if (t + 1 < L) { float cx[8], cc[8]; const bf16* zr = zb + (size_t)(t + 1) * INW; unpack8(*(const u32x4*)(zr + ZCX + c0), cx); unpack8(*(const u32x4*)(zr + ZCC + c0), cc);
#pragma unroll
                  for (int q = 0; q < 8; ++q) pn[q] = cc[q] * cx[q]; }
              float cb[8], o[8]; unpack8(*(const u32x4*)(zb + (size_t)t * INW + ZCB + c0), cb);
#pragma unroll
              for (int q = 0; q < 8; ++q) { o[q] = cb[q] * (wa[q] * pp[q] + wb[q] * pc[q] + wc_[q] * pn[q]); pp[q] = pc[q]; pc[q] = pn[q]; }
              u32x4 w; w.x = pk2(o[0], o[1]); w.y = pk2(o[2], o[3]); w.z = pk2(o[4], o[5]); w.w = pk2(o[6], o[7]);
              *(u32x4*)(MIX + (size_t)(r0 + i) * MIXW + 512 + c0) = w; } }
        { const int hw = 1 << (c0 >> 7);
          float s[8];
#pragma unroll
          for (int q = 0; q < 8; ++q) s[q] = 0.f;
#pragma unroll
          for (int j = -8; j < 8; ++j) { const int tt = t0 + j; if (j >= -hw && j < hw && tt >= 0 && tt < L) { float u[8]; unpack8(*(const u32x4*)(zb + (size_t)tt * INW + ZPU + c0), u);
#pragma unroll
                  for (int q = 0; q < 8; ++q) s[q] += u[q]; } }
#pragma unroll
          for (int i = 0; i < 8; ++i) { const int t = t0 + i; const int lo = t - hw < 0 ? 0 : t - hw, hi = t + hw > L ? L : t + hw;
              float u0[8]; unpack8(*(const u32x4*)(zb + (size_t)t * INW + ZPU + c0), u0);
              const float inv = 1.0f / (float)(hi - lo);
              u32x4 w; w.x = pk2(s[0] * inv - u0[0], s[1] * inv - u0[1]); w.y = pk2(s[2] * inv - u0[2], s[3] * inv - u0[3]);
              w.z = pk2(s[4] * inv - u0[4], s[5] * inv - u0[5]); w.w = pk2(s[6] * inv - u0[6], s[7] * inv - u0[7]);
              *(u32x4*)(MIX + (size_t)(r0 + i) * MIXW + 1024 + c0) = w;
              if (i < 7) {
                  if (t + hw < L) { float u[8]; unpack8(*(const u32x4*)(zb + (size_t)(t + hw) * INW + ZPU + c0), u);
#pragma unroll
                      for (int q = 0; q < 8; ++q) s[q] += u[q]; }
                  if (t - hw >= 0) { float u[8]; unpack8(*(const u32x4*)(zb + (size_t)(t - hw) * INW + ZPU + c0), u);
#pragma unroll
                      for (int q = 0; q < 8; ++q) s[q] -= u[q]; } } } }
    }
}

__device__ __forceinline__ void attn_naive_phase(Frame& F, const float* sinkl, int nrows) {
    const bf16* Z = (const bf16*)(F.ws + WS_Z); bf16* MIX = (bf16*)(F.ws + WS_MIX);
    LAS float* qs = (LAS float*)(F.lds + F.wave * 10240);
    LAS float* sc = qs + 256;
    const int nunits = nrows * 2, NGW = F.G * NWAVES;
    for (int uidx = F.bx * NWAVES + F.wave; uidx < nunits; uidx += NGW) {
        const int r = uidx >> 1, kh = uidx & 1;
        int b, nloc, krow0;
        if (r < ML) { b = r / SEQ; const int t = r % SEQ; const int lo = t - 128 < 0 ? 0 : t - 128, hi = t + 128 > SEQ - 1 ? SEQ - 1 : t + 128; nloc = hi - lo + 1; krow0 = b * SEQ + lo; }
        else { b = (r - ML) / CTXL; nloc = 0; krow0 = 0; }
        const int crow0 = ML + b * CTXL, nk = nloc + CTXL;
        { const u32x2 qw = *(const u32x2*)(Z + (size_t)r * INW + ZQ + kh * 256 + 4 * F.lane); const int g = F.lane >> 4, d = (4 * F.lane) & 63;
          qs[(d + 0) * 4 + g] = bflo(qw.x); qs[(d + 1) * 4 + g] = bfhi(qw.x); qs[(d + 2) * 4 + g] = bflo(qw.y); qs[(d + 3) * 4 + g] = bfhi(qw.y); }
        LDS_WAIT(); asm volatile("" ::: "memory");
        for (int c0 = 0; c0 < nk; c0 += 64) {
            const int kk = c0 + F.lane;
            if (kk < nk) {
                const int krow = kk < nloc ? krow0 + kk : crow0 + (kk - nloc);
                const u32x4* kp = (const u32x4*)(Z + (size_t)krow * INW + ZK + kh * 64);
                f32x4 s = (f32x4){0.f, 0.f, 0.f, 0.f};
#pragma unroll
                for (int d8 = 0; d8 < 8; ++d8) { float kf[8]; unpack8(kp[d8], kf);
#pragma unroll
                    for (int q = 0; q < 8; ++q) { const f32x4 qv = *(const LAS f32x4*)(qs + (d8 * 8 + q) * 4); s += qv * kf[q]; } }
                *(LAS f32x4*)(sc + kk * 4) = s;
            }
        }
        LDS_WAIT(); asm volatile("" ::: "memory");
        f32x4 mx; { const float* sk = sinkl + kh * 4; mx = (f32x4){sk[0] * LOG2E, sk[1] * LOG2E, sk[2] * LOG2E, sk[3] * LOG2E}; }
        const f32x4 snk = mx;
        for (int kk = F.lane; kk < nk; kk += 64) { const f32x4 s = *(const LAS f32x4*)(sc + kk * 4); mx.x = fmaxf(mx.x, s.x); mx.y = fmaxf(mx.y, s.y); mx.z = fmaxf(mx.z, s.z); mx.w = fmaxf(mx.w, s.w); }
        mx.x = wave_max(mx.x); mx.y = wave_max(mx.y); mx.z = wave_max(mx.z); mx.w = wave_max(mx.w);
        f32x4 sm = (f32x4){0.f, 0.f, 0.f, 0.f};
        for (int kk = F.lane; kk < nk; kk += 64) { f32x4 s = *(const LAS f32x4*)(sc + kk * 4);
            s.x = exp2f(s.x - mx.x); s.y = exp2f(s.y - mx.y); s.z = exp2f(s.z - mx.z); s.w = exp2f(s.w - mx.w); sm += s; *(LAS f32x4*)(sc + kk * 4) = s; }
        sm.x = wave_sum(sm.x) + exp2f(snk.x - mx.x); sm.y = wave_sum(sm.y) + exp2f(snk.y - mx.y); sm.z = wave_sum(sm.z) + exp2f(snk.z - mx.z); sm.w = wave_sum(sm.w) + exp2f(snk.w - mx.w);
        LDS_WAIT(); asm volatile("" ::: "memory");
        f32x4 o = (f32x4){0.f, 0.f, 0.f, 0.f};
        const bf16* vb = Z + ZV + kh * 64 + F.lane;
#pragma unroll 4
        for (int kk = 0; kk < nk; ++kk) { const int krow = kk < nloc ? krow0 + kk : crow0 + (kk - nloc);
            const float v = bf2f((unsigned)vb[(size_t)krow * INW]); const f32x4 p = *(const LAS f32x4*)(sc + kk * 4); o += p * v; }
        bf16* op = MIX + (size_t)r * MIXW + kh * 256 + F.lane;
        op[0] = (bf16)f2bf(o.x / sm.x); op[64] = (bf16)f2bf(o.y / sm.y); op[128] = (bf16)f2bf(o.z / sm.z); op[192] = (bf16)f2bf(o.w / sm.w);
        LDS_WAIT(); asm volatile("" ::: "memory");
    }
}

typedef float f32x16 __attribute__((ext_vector_type(16)));
typedef short s16x4 __attribute__((ext_vector_type(4)));
__device__ __forceinline__ unsigned cvtpk(float lo, float hi) { f32x2 v = {lo, hi}; pg8::bf16x2_t b = __builtin_convertvector(v, pg8::bf16x2_t); return __builtin_bit_cast(unsigned, b); }
__device__ __forceinline__ s16x4 vtr(const LAS unsigned char* p) { return __builtin_bit_cast(s16x4, __builtin_amdgcn_ds_read_tr16_b64_v4i16((LAS s16x4*)p)); }
constexpr int AKP = 144, ATT_V_OFF = 128 * AKP;
__device__ __forceinline__ void attn_unit(Frame& F, const bf16* Z, bf16* MIX, const float* sinkl, const bool isctx, const int b, const int kh, const int qblk) {
    const int qrow0 = isctx ? ML + b * CTXL + qblk * 128 : b * SEQ + qblk * 128;
    const int cbase = ML + b * CTXL;
    const bool has_prev = !isctx && qblk > 0, has_next = !isctx && qblk < 31;
    const int nch = isctx ? 2 : 3 + (has_prev ? 1 : 0) + (has_next ? 1 : 0);
    const int lane = F.lane, r = lane & 31, h = lane >> 5, g = F.wave >> 1, qh = F.wave & 1, head = kh * 4 + g;
    LAS unsigned char* Ks = F.lds; LAS unsigned char* Vs = F.lds + ATT_V_OFF;
    bf16x8 qf[2][4];
#pragma unroll
    for (int sub = 0; sub < 2; ++sub)
#pragma unroll
        for (int ks = 0; ks < 4; ++ks) qf[sub][ks] = *(const bf16x8*)(Z + (size_t)(qrow0 + 64 * qh + 32 * sub + r) * INW + ZQ + head * 64 + 16 * ks + 8 * h);
    const float sk = sinkl[head] * LOG2E;
    float m[2], l[2]; f32x16 O[2][2];
#pragma unroll
    for (int sub = 0; sub < 2; ++sub) { m[sub] = sk; l[sub] = h == 0 ? 1.f : 0.f;
#pragma unroll
        for (int db = 0; db < 2; ++db)
#pragma unroll
            for (int i = 0; i < 16; ++i) O[sub][db][i] = 0.f; }
#define ATT_CHUNK(ci, row0, kind) do { if (isctx) { row0 = cbase + 128 * (ci); kind = 0; } else if ((ci) == 0) { row0 = qrow0; kind = 0; } else if ((ci) <= 2) { row0 = cbase + 128 * ((ci) - 1); kind = 0; } \
        else if ((ci) == 3 && has_prev) { row0 = qrow0 - 128; kind = 1; } else { row0 = qrow0 + 128; kind = 2; } } while (0)
    const int skey = F.tid >> 3, spart = F.tid & 7;
    u32x4 pk0, pk1, pv0, pv1;
#define ATT_LOAD(ci) do { int row0_, kind_; ATT_CHUNK(ci, row0_, kind_); (void)kind_; const bf16* kp_ = Z + (size_t)(row0_ + skey) * INW + ZK + kh * 64 + spart * 8; \
        pk0 = *(const u32x4*)kp_; pk1 = *(const u32x4*)(kp_ + (size_t)64 * INW); pv0 = *(const u32x4*)(kp_ + (ZV - ZK)); pv1 = *(const u32x4*)(kp_ + (size_t)64 * INW + (ZV - ZK)); } while (0)
    ATT_LOAD(0);
    const int grp = (lane >> 4) & 1, q4 = (lane & 15) >> 2, p4 = lane & 3;
    for (int ci = 0; ci < nch; ++ci) {
        __syncthreads();
        *(LAS u32x4*)(Ks + skey * AKP + spart * 16) = pk0; *(LAS u32x4*)(Ks + (skey + 64) * AKP + spart * 16) = pk1;
        *(LAS u32x4*)(Vs + skey * AKP + spart * 16) = pv0; *(LAS u32x4*)(Vs + (skey + 64) * AKP + spart * 16) = pv1;
        if (ci + 1 < nch) ATT_LOAD(ci + 1);
        __syncthreads();
        int row0, kind; ATT_CHUNK(ci, row0, kind); (void)row0;
        int dl = 4 * h - r - 64 * qh; asm volatile("" : "+v"(dl));
        for (int t = 0; t < 4; ++t) {
            if (kind == 1 && 32 * t + 31 < 64 * qh) continue;
            if (kind == 2 && 32 * t > 64 * qh + 63) continue;
            bf16x8 kf[4], vf[2][2];
#pragma unroll
            for (int ks = 0; ks < 4; ++ks) kf[ks] = *(const LAS bf16x8*)(Ks + (32 * t + r) * AKP + 32 * ks + 16 * h);
#pragma unroll
            for (int s = 0; s < 2; ++s)
#pragma unroll
                for (int db = 0; db < 2; ++db) { const LAS unsigned char* vp = Vs + (32 * t + 16 * s + 4 * h + q4) * AKP + (32 * db + 16 * grp + 4 * p4) * 2;
                    const s16x4 lo = vtr(vp), hi = vtr(vp + 8 * AKP); vf[s][db] = __builtin_shufflevector(lo, hi, 0, 1, 2, 3, 4, 5, 6, 7); }
#pragma unroll
            for (int sub = 0; sub < 2; ++sub) {
                if (kind == 1 && 32 * t + 31 < 64 * qh + 32 * sub) continue;
                if (kind == 2 && 32 * t > 64 * qh + 32 * sub + 31) continue;
                f32x16 S;
#pragma unroll
                for (int i = 0; i < 16; ++i) S[i] = 0.f;
#pragma unroll
                for (int ks = 0; ks < 4; ++ks) S = __builtin_amdgcn_mfma_f32_32x32x16_bf16(kf[ks], qf[sub][ks], S, 0, 0, 0);
                if (kind != 0) { const int d0 = dl + 32 * t - 32 * sub;
#pragma unroll
                    for (int i = 0; i < 16; ++i) { const int dd = d0 + (i & 3) + 8 * (i >> 2); const bool ok = kind == 1 ? (dd >= 0) : (dd <= 0); S[i] = ok ? S[i] : -1.0e30f; } }
                float tmax = S[0];
#pragma unroll
                for (int i = 1; i < 16; ++i) tmax = fmaxf(tmax, S[i]);
                tmax = fmaxf(tmax, __shfl_xor(tmax, 32));
                const float mnew = fmaxf(m[sub], tmax);
                if (__any(mnew > m[sub])) { const float alpha = __builtin_amdgcn_exp2f(m[sub] - mnew); l[sub] *= alpha; m[sub] = mnew;
#pragma unroll
                    for (int db = 0; db < 2; ++db)
#pragma unroll
                        for (int i = 0; i < 16; ++i) O[sub][db][i] *= alpha; }
                float ps = 0.f;
#pragma unroll
                for (int i = 0; i < 16; ++i) { S[i] = __builtin_amdgcn_exp2f(S[i] - m[sub]); ps += S[i]; }
                l[sub] += ps;
                u32x4 w0, w1; w0.x = cvtpk(S[0], S[1]); w0.y = cvtpk(S[2], S[3]); w0.z = cvtpk(S[4], S[5]); w0.w = cvtpk(S[6], S[7]);
                w1.x = cvtpk(S[8], S[9]); w1.y = cvtpk(S[10], S[11]); w1.z = cvtpk(S[12], S[13]); w1.w = cvtpk(S[14], S[15]);
                const bf16x8 P0 = __builtin_bit_cast(bf16x8, w0), P1 = __builtin_bit_cast(bf16x8, w1);
#pragma unroll
                for (int db = 0; db < 2; ++db) { O[sub][db] = __builtin_amdgcn_mfma_f32_32x32x16_bf16(vf[0][db], P0, O[sub][db], 0, 0, 0); O[sub][db] = __builtin_amdgcn_mfma_f32_32x32x16_bf16(vf[1][db], P1, O[sub][db], 0, 0, 0); }
            }
        }
    }
#undef ATT_CHUNK
#undef ATT_LOAD
#pragma unroll
    for (int sub = 0; sub < 2; ++sub) { const float lt = l[sub] + __shfl_xor(l[sub], 32), inv = 1.f / lt;
        bf16* op = MIX + (size_t)(qrow0 + 64 * qh + 32 * sub + r) * MIXW + head * 64 + 4 * h;
#pragma unroll
        for (int db = 0; db < 2; ++db)
#pragma unroll
            for (int gq = 0; gq < 4; ++gq) { u32x2 w; w.x = cvtpk(O[sub][db][4 * gq] * inv, O[sub][db][4 * gq + 1] * inv); w.y = cvtpk(O[sub][db][4 * gq + 2] * inv, O[sub][db][4 * gq + 3] * inv);
                *(u32x2*)(op + 32 * db + 8 * gq) = w; } }
}
__device__ __forceinline__ void attn_mfma_phase(Frame& F, const float* sinkl, const bool with_ctx) {
    const bf16* Z = (const bf16*)(F.ws + WS_Z); bf16* MIX = (bf16*)(F.ws + WS_MIX);
    const int vcu = (F.G % 8 == 0) ? (F.bx % 8) * (F.G / 8) + F.bx / 8 : F.bx;
    const int nun = with_ctx ? 272 : 256;
    for (int u = vcu; u < nun; u += F.G) { const bool isctx = u >= 256; const int uu = isctx ? (u - 256) : u;
        attn_unit(F, Z, MIX, sinkl, isctx, isctx ? (uu >> 2) : (uu >> 6), isctx ? ((uu >> 1) & 1) : ((uu >> 5) & 1), isctx ? (uu & 1) : (uu & 31)); }
    __syncthreads();
}

using pg8::Unit;
struct SchedStd {
    const char* A; const char* B; size_t astep, bstep; int nM, nN, G, c, nx, xpm0, xpn;
    __device__ __forceinline__ bool next(int i, Unit& u) const {
        const int L = i * G + c, nwg = nM * nN; if (L >= nwg + nx) return false;
        if (L < nwg) pg8::tile_of(L, nM, nN, u.pm, u.pn); else { u.pm = xpm0 + (L - nwg); u.pn = xpn; }
        u.tag = 0; u.a = A + (size_t)u.pm * astep; u.b = B + (size_t)u.pn * bstep; return true;
    }
};
struct SchedMoe {
    const char* A; const char* B; size_t astep, bstep_e, bstep_n; int NJ, G, c; const int* tile;
    __device__ __forceinline__ bool next(int i, Unit& u) const {
        const int nt = __builtin_amdgcn_readfirstlane(__hip_atomic_load(tile + 200, __ATOMIC_RELAXED, __HIP_MEMORY_SCOPE_AGENT));
        const int L = i * G + c; if (L >= nt * NJ) return false;
        u.pm = L % nt; u.pn = L / nt; u.tag = __builtin_amdgcn_readfirstlane(__hip_atomic_load(tile + u.pm, __ATOMIC_RELAXED, __HIP_MEMORY_SCOPE_AGENT));
        u.a = A + (size_t)u.pm * astep; u.b = B + (size_t)u.tag * bstep_e + (size_t)u.pn * bstep_n; return true;
    }
};

struct EpiGate {
    static constexpr bool PERM = true, MIDHOOK = false;
    bf16* Z;
    __device__ __forceinline__ void operator()(const f32x4 (&acc)[2][2][4][2], const Unit& u, int wr, int wc, int fr, int fq) const {
        const int row0 = u.pm * 256 + wr * 64 + fr, col0 = ZG + u.pn * 256 + wc * 32 + 8 * fq;
#pragma unroll
        for (int ai = 0; ai < 2; ++ai)
#pragma unroll
            for (int m = 0; m < 4; ++m)
#pragma unroll
                for (int bj = 0; bj < 2; ++bj) { f32x4 v0 = acc[ai][bj][m][0], v1 = acc[ai][bj][m][1];
#pragma unroll
                    for (int q = 0; q < 4; ++q) { v0[q] = __builtin_amdgcn_rcpf(1.f + __expf(-v0[q])); v1[q] = __builtin_amdgcn_rcpf(1.f + __expf(-v1[q])); }
                    u32x4 w; w.x = pg8::cvt_pk_bf16(v0[0], v0[1]); w.y = pg8::cvt_pk_bf16(v0[2], v0[3]); w.z = pg8::cvt_pk_bf16(v1[0], v1[1]); w.w = pg8::cvt_pk_bf16(v1[2], v1[3]);
                    *(u32x4*)(Z + (size_t)(row0 + ai * 128 + m * 16) * INW + col0 + bj * 128) = w; }
    }
};
struct EpiIn {
    static constexpr bool PERM = true, MIDHOOK = false;
    bf16* Z; const float* rope;
    __device__ __forceinline__ void operator()(const f32x4 (&acc)[2][2][4][2], const Unit& u, int wr, int wc, int fr, int fq) const {
        const int row0 = u.pm * 256 + wr * 64 + fr, col0 = u.pn * 256 + wc * 32 + 8 * fq;
        const bool latent = u.pm < 64, gate = u.pn >= 11;
        const float sgn = fq < 2 ? -1.f : 1.f;
#pragma unroll
        for (int ai = 0; ai < 2; ++ai)
#pragma unroll
            for (int m = 0; m < 4; ++m) { const int row = row0 + ai * 128 + m * 16; bf16* rowp = Z + (size_t)row * INW + col0;
                const int pos = (wc & 1) ? (16 * m + fr) : (4 * (u.pm & 15) + 2 * ai + wr);
#pragma unroll
                for (int bj = 0; bj < 2; ++bj) { f32x4 v0 = acc[ai][bj][m][0], v1 = acc[ai][bj][m][1];
                    const bool isq = u.pn < 2, isk = (u.pn == 2 && bj == 0);
                    if (isq || isk) {
                        if (latent) {
                            const f32x4* cs = (const f32x4*)(rope + (size_t)(pos * 16 + 8 * (fq & 1)) * 2);
                            const f32x4 t0 = cs[0], t1 = cs[1], t2 = cs[2], t3 = cs[3];
                            f32x4 p0, p1;
                            p0.x = __shfl_xor(v0.x, 32); p0.y = __shfl_xor(v0.y, 32); p0.z = __shfl_xor(v0.z, 32); p0.w = __shfl_xor(v0.w, 32);
                            p1.x = __shfl_xor(v1.x, 32); p1.y = __shfl_xor(v1.y, 32); p1.z = __shfl_xor(v1.z, 32); p1.w = __shfl_xor(v1.w, 32);
                            v0.x = v0.x * t0.x + p0.x * (sgn * t0.y); v0.y = v0.y * t0.z + p0.y * (sgn * t0.w); v0.z = v0.z * t1.x + p0.z * (sgn * t1.y); v0.w = v0.w * t1.z + p0.w * (sgn * t1.w);
                            v1.x = v1.x * t2.x + p1.x * (sgn * t2.y); v1.y = v1.y * t2.z + p1.y * (sgn * t2.w); v1.z = v1.z * t3.x + p1.z * (sgn * t3.y); v1.w = v1.w * t3.z + p1.w * (sgn * t3.w);
                        }
                        if (isq) { v0 = v0 * QSCALE; v1 = v1 * QSCALE; }
                    }
                    if (gate) {
#pragma unroll
                        for (int q = 0; q < 4; ++q) { v0[q] = 1.f / (1.f + __expf(-v0[q])); v1[q] = 1.f / (1.f + __expf(-v1[q])); } }
                    u32x4 w; w.x = pg8::cvt_pk_bf16(v0[0], v0[1]); w.y = pg8::cvt_pk_bf16(v0[2], v0[3]); w.z = pg8::cvt_pk_bf16(v1[0], v1[1]); w.w = pg8::cvt_pk_bf16(v1[2], v1[3]);
                    *(u32x4*)(rowp + bj * 128) = w; } }
    }
};
struct EpiBrG {
    static constexpr bool PERM = true, MIDHOOK = true;
    const bf16* Z; bf16* Y;
    __device__ __forceinline__ void mid(f32x4 (&acc)[2][2][4][2], const Unit& u, int seg, int wr, int wc, int fr, int fq) const {
        const int row0 = u.pm * 256 + wr * 64 + fr, col0 = u.pn * 256 + wc * 32 + 8 * fq;
#pragma unroll
        for (int ai = 0; ai < 2; ++ai)
#pragma unroll
            for (int m = 0; m < 4; ++m) { const bf16* gp = Z + (size_t)(row0 + ai * 128 + m * 16) * INW + ZG + (seg - 1) * D + col0;
#pragma unroll
                for (int bj = 0; bj < 2; ++bj) { const u32x4 ga = *(const u32x4*)(gp + bj * 128), gb = *(const u32x4*)(gp + D + bj * 128);
                    f32x4 r0, r1;
                    r0.x = bflo(ga.x) * __builtin_amdgcn_rcpf(bflo(gb.x)); r0.y = bfhi(ga.x) * __builtin_amdgcn_rcpf(bfhi(gb.x)); r0.z = bflo(ga.y) * __builtin_amdgcn_rcpf(bflo(gb.y)); r0.w = bfhi(ga.y) * __builtin_amdgcn_rcpf(bfhi(gb.y));
                    r1.x = bflo(ga.z) * __builtin_amdgcn_rcpf(bflo(gb.z)); r1.y = bfhi(ga.z) * __builtin_amdgcn_rcpf(bfhi(gb.z)); r1.z = bflo(ga.w) * __builtin_amdgcn_rcpf(bflo(gb.w)); r1.w = bfhi(ga.w) * __builtin_amdgcn_rcpf(bfhi(gb.w));
                    acc[ai][bj][m][0] *= r0; acc[ai][bj][m][1] *= r1; }
                asm volatile("" ::: "memory"); }
    }
    __device__ __forceinline__ void operator()(const f32x4 (&acc)[2][2][4][2], const Unit& u, int wr, int wc, int fr, int fq) const {
        const int row0 = u.pm * 256 + wr * 64 + fr, col0 = u.pn * 256 + wc * 32 + 8 * fq;
#pragma unroll
        for (int ai = 0; ai < 2; ++ai)
#pragma unroll
            for (int m = 0; m < 4; ++m) { const size_t row = (size_t)(row0 + ai * 128 + m * 16); const bf16* gp = Z + row * INW + ZG + 2 * D + col0;
#pragma unroll
                for (int bj = 0; bj < 2; ++bj) { const u32x4 g = *(const u32x4*)(gp + bj * 128); const f32x4 v0 = acc[ai][bj][m][0], v1 = acc[ai][bj][m][1];
                    u32x4 w; w.x = pg8::cvt_pk_bf16(v0[0] * bflo(g.x), v0[1] * bfhi(g.x)); w.y = pg8::cvt_pk_bf16(v0[2] * bflo(g.y), v0[3] * bfhi(g.y));
                    w.z = pg8::cvt_pk_bf16(v1[0] * bflo(g.z), v1[1] * bfhi(g.z)); w.w = pg8::cvt_pk_bf16(v1[2] * bflo(g.w), v1[3] * bfhi(g.w));
                    *(u32x4*)(Y + row * D + col0 + bj * 128) = w; } }
    }
};
struct EpiRes {
    static constexpr bool PERM = false, MIDHOOK = false;
    const float* rl; const float* rc; float* out; const float* gv;
    __device__ __forceinline__ void operator()(const f32x4 (&acc)[2][2][4][2], const Unit& u, int wr, int wc, int fr, int fq) const {
        const int row0 = u.pm * 256 + wr * 64 + fr, col0 = u.pn * 256 + wc * 32 + 4 * fq;
        const int bidx = u.pm < 64 ? (u.pm >> 4) : 4; const float* g = gv + (size_t)bidx * MODW;
        const float* rbase = u.pm < 64 ? rl : rc - (size_t)ML * D;
        f32x4 gg[2][2];
#pragma unroll
        for (int bj = 0; bj < 2; ++bj)
#pragma unroll
            for (int n = 0; n < 2; ++n) gg[bj][n] = *(const f32x4*)(g + col0 + bj * 128 + n * 16);
#pragma unroll
        for (int ai = 0; ai < 2; ++ai)
#pragma unroll
            for (int m = 0; m < 4; ++m) { const size_t off = (size_t)(row0 + ai * 128 + m * 16) * D + col0;
#pragma unroll
                for (int bj = 0; bj < 2; ++bj)
#pragma unroll
                    for (int n = 0; n < 2; ++n) *(f32x4*)(out + off + bj * 128 + n * 16) = *(const f32x4*)(rbase + off + bj * 128 + n * 16) + gg[bj][n] * acc[ai][bj][m][n]; }
    }
};
template <bool F8> struct EpiSwiglu {
    static constexpr bool PERM = true, MIDHOOK = false;
    unsigned char* ACT; int ldc;
    __device__ __forceinline__ void operator()(const f32x4 (&acc)[2][2][4][2], const Unit& u, int wr, int wc, int fr, int fq) const {
        const int row0 = u.pm * 256 + wr * 64 + fr, col0 = u.pn * 128 + wc * 32 + 8 * fq;
#pragma unroll
        for (int ai = 0; ai < 2; ++ai)
#pragma unroll
            for (int m = 0; m < 4; ++m) { f32x4 r[2];
#pragma unroll
                for (int n = 0; n < 2; ++n) { const f32x4 g = acc[ai][0][m][n], up = acc[ai][1][m][n];
#pragma unroll
                    for (int q = 0; q < 4; ++q) r[n][q] = g[q] * __builtin_amdgcn_rcpf(1.f + __expf(-g[q])) * up[q]; }
                if constexpr (F8) { u32x2 w; w.x = pk4_fp8(r[0][0], r[0][1], r[0][2], r[0][3]); w.y = pk4_fp8(r[1][0], r[1][1], r[1][2], r[1][3]);
                    *(u32x2*)(ACT + (size_t)(row0 + ai * 128 + m * 16) * ldc + col0) = w; }
                else { u32x4 w; w.x = pg8::cvt_pk_bf16(r[0][0], r[0][1]); w.y = pg8::cvt_pk_bf16(r[0][2], r[0][3]); w.z = pg8::cvt_pk_bf16(r[1][0], r[1][1]); w.w = pg8::cvt_pk_bf16(r[1][2], r[1][3]);
                    *(u32x4*)((bf16*)ACT + (size_t)(row0 + ai * 128 + m * 16) * ldc + col0) = w; } }
    }
};
struct EpiPlain {
    static constexpr bool PERM = true, MIDHOOK = false;
    bf16* O; int ldc;
    __device__ __forceinline__ void operator()(const f32x4 (&acc)[2][2][4][2], const Unit& u, int wr, int wc, int fr, int fq) const {
        const int row0 = u.pm * 256 + wr * 64 + fr, col0 = u.pn * 256 + wc * 32 + 8 * fq;
#pragma unroll
        for (int ai = 0; ai < 2; ++ai)
#pragma unroll
            for (int m = 0; m < 4; ++m)
#pragma unroll
                for (int bj = 0; bj < 2; ++bj) { const f32x4 v0 = acc[ai][bj][m][0], v1 = acc[ai][bj][m][1];
                    u32x4 w; w.x = pg8::cvt_pk_bf16(v0[0], v0[1]); w.y = pg8::cvt_pk_bf16(v0[2], v0[3]); w.z = pg8::cvt_pk_bf16(v1[0], v1[1]); w.w = pg8::cvt_pk_bf16(v1[2], v1[3]);
                    *(u32x4*)(O + (size_t)(row0 + ai * 128 + m * 16) * ldc + col0 + bj * 128) = w; }
    }
};

#ifndef PHASE_MASK
#define PHASE_MASK 0xFFFFFFFFu
#endif
#define IN(k) (((PHASE_MASK >> (k)) & 1u) && lo <= (k) && (k) < hi)
#define SEAM(k) do { if (IN(k) && IN((k) + 1)) xcd_barrier(bar); } while (0)
#ifndef DUP_MASK
#define DUP_MASK 0u
#endif
#define REP(k) for (int rep_ = 0; rep_ < (((DUP_MASK >> (k)) & 1u) ? 2 : 1); ++rep_, (((DUP_MASK >> (k)) & 1u) && rep_ == 1 ? xcd_barrier(bar) : (void)0))
#define SITE() do { F.ws = (unsigned char*)karg_p<(int)__builtin_offsetof(Args, ws)>(); int t_ = threadIdx.x; asm volatile("" : "+v"(t_)); F.tid = t_; F.lane = t_ & 63; } while (0)
template <int l> __device__ __forceinline__ void layer_common(Frame& F, const int lo, const int hi, const XcdBarrier& bar, LAS unsigned char* ring) {
    constexpr int pb = 1 + 8 * l;
        if (IN(pb + 0)) REP(pb + 0) { SITE(); const float* modl = (const float*)(F.ws + WS_MODV) + (size_t)l * 5 * MODW; const float* X2 = (const float*)(F.ws + WS_X2);
            const float* xl = l == 0 ? KP(x) : X2; const float* xc = l == 0 ? KP(ctx) : X2 + (size_t)ML * D;
            norm_mod_phase<false, 2>(F, xl, xc, KP(norm1_g) + l * D, modl, 0, 1, MT, nullptr); } SEAM(pb + 0);
        if (IN(pb + 1)) REP(pb + 1) { SITE();
            { SchedStd S{(const char*)(F.ws + WS_H), (const char*)(F.ws + WS_WIN) + (size_t)l * ZG * D * 2, (size_t)256 * D * 2, (size_t)256 * D * 2, l == 0 ? 68 : 64, 11, F.G, F.bx, l == 0 ? 0 : 4, 64, 2};
              EpiIn E{(bf16*)(F.ws + WS_Z), (const float*)(F.ws + WS_ROPE)};
              pg8::gemm_phase<EpiIn, SchedStd, true, true>(ring, D * 2, D * 2, D * 2, S, E); }
            { SITE(); SchedStd S{(const char*)(F.ws + WS_H8), (const char*)(F.ws + WS_WIN8) + (size_t)l * 3 * D * D, (size_t)256 * D, (size_t)256 * D, l == 0 ? 68 : 64, 12, F.G, (F.bx + 20) % F.G, 0, 0, 0};
              EpiGate E{(bf16*)(F.ws + WS_Z)};
              pg8::gemm_phase<EpiGate, SchedStd, true, true, true>(ring, D, D, D, S, E); }
        } SEAM(pb + 1);
        if (IN(pb + 2)) REP(pb + 2) { SITE(); const int nrows = l == 0 ? MT : ML; if (ATTN_NAIVE) attn_naive_phase(F, KP(sink) + l * 8, nrows); else { for (int rp_ = 0; rp_ < 1 + PROBE_ATT; ++rp_) attn_mfma_phase(F, KP(sink) + l * 8, l == 0); } for (int rp_ = 0; rp_ < 1 + PROBE_MIXL; ++rp_) local_mix_phase(F, KP(conv_w) + (size_t)l * 3 * 512, nrows, l == 0 && !ATTN_NAIVE); } SEAM(pb + 2);
        if (IN(pb + 3)) REP(pb + 3) { SITE();
            SchedStd S{(const char*)(F.ws + WS_MIX), (const char*)(F.ws + WS_WBR) + (size_t)l * D * MIXW * 2, (size_t)256 * MIXW * 2, (size_t)256 * MIXW * 2, l == 0 ? 68 : 64, 4, F.G, F.bx, 0, 0, 0};
            EpiBrG E{(const bf16*)(F.ws + WS_Z), (bf16*)(F.ws + WS_Y)};
            pg8::gemm_phase<EpiBrG, SchedStd, true, true>(ring, MIXW * 2, MIXW * 2, MIXW * 2, S, E);
        } SEAM(pb + 3);
        if (IN(pb + 4)) REP(pb + 4) { SITE(); const float* modl = (const float*)(F.ws + WS_MODV) + (size_t)l * 5 * MODW; const float* X2 = (const float*)(F.ws + WS_X2);
            const float* xl = l == 0 ? KP(x) : X2; const float* xc = l == 0 ? KP(ctx) : X2 + (size_t)ML * D;
            SchedStd S{(const char*)(F.ws + WS_Y), (const char*)(F.ws + WS_WOUT) + (size_t)l * D * D * 2, (size_t)256 * D * 2, (size_t)256 * D * 2, l == 0 ? 68 : 64, 4, F.G, F.bx, 0, 0, 0};
            EpiRes E{xl, xc, (float*)(F.ws + WS_X1), modl + 2 * D};
            pg8::gemm_phase<EpiRes, SchedStd, true, true>(ring, D * 2, D * 2, D * 2, S, E);
        } SEAM(pb + 4);
}
constexpr int N_PHASES = 19;
__global__ void __launch_bounds__(NTHR, 2) mk_fwd(Args args_byval) {
    extern __shared__ __attribute__((aligned(16))) unsigned char lds_raw[];
    Frame F;
    F.lds = (LAS unsigned char*)lds_raw;
    F.tid = threadIdx.x; F.lane = F.tid & 63; F.wave = __builtin_amdgcn_readfirstlane(F.tid >> 6);
    F.G = gridDim.x; F.bx = blockIdx.x;
    SITE();
    volatile LAS unsigned* MISC = (volatile LAS unsigned*)(F.lds + MISC_OFF);
    for (int u = F.tid; u < (LDS_BYTES - LDSCTL_OFF) / 4; u += NTHR) ((LAS unsigned*)(F.lds + LDSCTL_OFF))[u] = 0u;
    __syncthreads();
    const int lo = karg_i<(int)__builtin_offsetof(Args, ph_lo)>(), hi = karg_i<(int)__builtin_offsetof(Args, ph_hi)>();
    const bool fused = (hi - lo) > 1;
    XcdBarrier bar; bar.bar = (unsigned*)(F.ws + WS_CTL) + CW_BAR; bar.x = 0; bar.st = nullptr;
    if (fused) bar = xcd_barrier_post((unsigned*)(F.ws + WS_CTL) + CW_BAR, MISC + 8);
    LAS unsigned char* ring = F.lds;

    if (IN(0)) REP(0) { SITE(); p0_prologue(F); } SEAM(0);

    layer_common<0>(F, lo, hi, bar, ring);
    {
            if (IN(6)) REP(6) { SITE(); const float* X1 = (const float*)(F.ws + WS_X1); norm_mod_phase<false, FFN0_FP8 ? 1 : 0>(F, X1, X1 + (size_t)ML * D, KP(norm2_g), (const float*)(F.ws + WS_MODV), 3, 4, MT, nullptr); } SEAM(6);
            if (IN(7)) REP(7) { SITE();
                constexpr int EB = FFN0_FP8 ? 1 : 2;
                SchedStd S{(const char*)(F.ws + WS_H), (const char*)(F.ws + WS_WGU0), (size_t)256 * D * EB, (size_t)256 * D * EB, 68, 22, F.G, F.bx, 0, 0, 0};
                EpiSwiglu<(FFN0_FP8 || DN0_FP8)> E{(unsigned char*)(F.ws + WS_ACT), DFF};
                pg8::gemm_phase<EpiSwiglu<(FFN0_FP8 || DN0_FP8)>, SchedStd, true, true, FFN0_FP8 != 0>(ring, D * EB, D * EB, D * EB, S, E);
            } SEAM(7);
            if (IN(8)) REP(8) { SITE(); const float* X1 = (const float*)(F.ws + WS_X1);
                constexpr int EB = (FFN0_FP8 || DN0_FP8) ? 1 : 2;
                SchedStd S{(const char*)(F.ws + WS_ACT), (const char*)(F.ws + WS_WDN0), (size_t)256 * DFF * EB, (size_t)256 * DFF * EB, 68, 4, F.G, F.bx, 0, 0, 0};
                EpiRes E{X1, X1 + (size_t)ML * D, (float*)(F.ws + WS_X2), (const float*)(F.ws + WS_MODV) + 5 * D};
                pg8::gemm_phase<EpiRes, SchedStd, true, true, (FFN0_FP8 || DN0_FP8)>(ring, DFF * EB, DFF * EB, DFF * EB, S, E);
            } SEAM(8);
    }
    layer_common<1>(F, lo, hi, bar, ring);
    {
            if (IN(14)) REP(14) { SITE(); const float* X1 = (const float*)(F.ws + WS_X1); norm_mod_phase<true, 1>(F, X1, X1, KP(norm2_g) + D, (const float*)(F.ws + WS_MODV) + (size_t)5 * MODW, 3, 4, ML, KP(router_w)); } SEAM(14);
            if (IN(15)) REP(15) { SITE(); moe_scatter_phase(F); } SEAM(15);
            if (IN(16)) REP(16) { SITE();
                SchedMoe S{(const char*)(F.ws + WS_H2S), (const char*)(F.ws + WS_WMGU), (size_t)256 * D, (size_t)2 * DFE * D, (size_t)256 * D, 28, F.G, F.bx, (const int*)(F.ws + WS_TILE)};
                EpiSwiglu<true> E{(unsigned char*)(F.ws + WS_ACT), DFE};
                pg8::gemm_phase<EpiSwiglu<true>, SchedMoe, true, true, true>(ring, D, D, D, S, E);
            } SEAM(16);
            if (IN(17)) REP(17) { SITE();
                SchedMoe S{(const char*)(F.ws + WS_ACT), (const char*)(F.ws + WS_WMDN), (size_t)256 * DFE, (size_t)D * DFE, (size_t)256 * DFE, 4, F.G, F.bx, (const int*)(F.ws + WS_TILE)};
                EpiPlain E{(bf16*)(F.ws + WS_YS), D};
                pg8::gemm_phase<EpiPlain, SchedMoe, true, true, true>(ring, DFE, DFE, DFE, S, E);
            } SEAM(17);
            if (IN(18)) REP(18) { SITE(); final_phase(F, KP(final_g), (float*)karg_p<(int)__builtin_offsetof(Args, out)>(), (const float*)(F.ws + WS_MODV) + (size_t)5 * MODW); }
        }

#undef IN
#undef SEAM
}

extern "C" void kernel_launch(void* const* d_in, const int* in_sizes, int n_in, void* d_out, int out_size, void* d_ws, size_t ws_size, hipStream_t stream) {
    static int grid = 0;
    if (grid == 0) {
        if (n_in != 21 || out_size != ML * D || ws_size < WS_END) { fprintf(stderr, "kernel_launch: unexpected sizes (n_in %d, out %d, ws %zu < %zu)\n", n_in, out_size, ws_size, (size_t)WS_END); grid = -1; return; }
        int dev = 0, cus = 0, per_cu = 0;
        if (hipGetDevice(&dev) != hipSuccess || hipDeviceGetAttribute(&cus, hipDeviceAttributeMultiprocessorCount, dev) != hipSuccess) { grid = -1; return; }
        if (hipFuncSetAttribute((const void*)mk_fwd, hipFuncAttributeMaxDynamicSharedMemorySize, LDS_BYTES) != hipSuccess) { fprintf(stderr, "kernel_launch: hipFuncSetAttribute failed\n"); grid = -1; return; }
        if (hipOccupancyMaxActiveBlocksPerMultiprocessor(&per_cu, (const void*)mk_fwd, NTHR, LDS_BYTES) != hipSuccess || per_cu < 1) { fprintf(stderr, "kernel_launch: occupancy query says %d\n", per_cu); per_cu = 1; }
        (void)hipGetLastError();
        grid = cus;
    }
    if (grid < 0) return;
    (void)hipMemsetAsync((char*)d_ws + WS_CTL, 0, CTL_ZERO_BYTES, stream);
    Args a{};
    const float** pp = (const float**)&a;
    for (int i = 0; i < 21; ++i) pp[i] = (const float*)d_in[i];
    a.out = (float*)d_out; a.ws = (unsigned char*)d_ws;
#if MK_FUSED
    a.ph_lo = 0; a.ph_hi = N_PHASES;
    hipLaunchKernelGGL(mk_fwd, dim3(grid), dim3(NTHR), LDS_BYTES, stream, a);
#else
    for (int p = 0; p < N_PHASES; ++p) { a.ph_lo = p; a.ph_hi = p + 1; hipLaunchKernelGGL(mk_fwd, dim3(grid), dim3(NTHR), LDS_BYTES, stream, a); }
#endif
}
```

```cpp
#include <hip/hip_runtime.h>
#include <cstdio>
#include <cstdint>

#ifndef ATTN_NAIVE
#define ATTN_NAIVE 0
#endif
#ifndef DN0_FP8
#define DN0_FP8 1
#endif
#ifndef FFN0_FP8
#define FFN0_FP8 0
#endif
#ifndef PROBE_ATT
#define PROBE_ATT 0
#endif
#ifndef PROBE_MIXL
#define PROBE_MIXL 0
#endif
#ifndef MK_FUSED
#define MK_FUSED 1
#endif

#define LAS __attribute__((address_space(3)))
#define GAS __attribute__((address_space(1)))
typedef unsigned short bf16;
typedef short bf16x8 __attribute__((ext_vector_type(8)));
typedef float f32x4 __attribute__((ext_vector_type(4)));
typedef float f32x2 __attribute__((ext_vector_type(2)));
typedef unsigned u32x4 __attribute__((ext_vector_type(4)));
typedef unsigned u32x2 __attribute__((ext_vector_type(2)));
typedef GAS unsigned gu32;

constexpr int D = 1024, NB = 4, SEQ = 4096, ML = NB * SEQ, CTXL = 256, MC = NB * CTXL, MT = ML + MC;
constexpr int INW = 5888, DFF = 2816, DFE = 3584, NE = 8;
constexpr int ZQ = 0, ZK = 512, ZV = 640, ZCX = 768, ZCB = 1280, ZCC = 1792, ZPU = 2304, ZG = 2816;
constexpr int MIXW = 1536;
constexpr int MS = 2 * ML + NE * 256;
constexpr int MODW = 6 * D;
constexpr float EPS = 1e-6f;
constexpr float LOG2E = 1.4426950408889634f, QSCALE = 0.125f * LOG2E;
constexpr int NWAVES = 8, NTHR = 512;

__device__ __forceinline__ unsigned f2bf(float f) { unsigned u = __builtin_bit_cast(unsigned, f); return (u + 0x7fffu + ((u >> 16) & 1u)) >> 16; }
typedef __bf16 bf16x2v __attribute__((ext_vector_type(2)));
__device__ __forceinline__ unsigned pk2(float lo, float hi) { f32x2 v = {lo, hi}; bf16x2v b = __builtin_convertvector(v, bf16x2v); return __builtin_bit_cast(unsigned, b); }
__device__ __forceinline__ float bf2f(unsigned b) { return __builtin_bit_cast(float, b << 16); }
__device__ __forceinline__ float clamp8(float x) { return __builtin_amdgcn_fmed3f(x, -448.f, 448.f); }
__device__ __forceinline__ unsigned pk4_fp8(float a, float b, float c, float d) { int w = 0; w = __builtin_amdgcn_cvt_pk_fp8_f32(clamp8(a), clamp8(b), w, false); w = __builtin_amdgcn_cvt_pk_fp8_f32(clamp8(c), clamp8(d), w, true); return (unsigned)w; }
constexpr float W8SCALE = 256.0f;
__device__ __forceinline__ float bflo(unsigned w) { return __builtin_bit_cast(float, w << 16); }
__device__ __forceinline__ float bfhi(unsigned w) { return __builtin_bit_cast(float, w & 0xffff0000u); }

namespace pg8 {
constexpr int BM = 256, BK = 64, HALF = 128, HTB = HALF * BK * 2, STAGE_BYTES = 8 * HTB, NXCD = 8, WGM = 8;
__host__ __device__ __forceinline__ int lds_byte(int r, int c) { const int st = (r >> 4) * 2 + (c >> 5), rr = r & 15, cc = c & 31, ob = rr * 64 + cc * 2; return st * 1024 + (ob ^ (((ob >> 9) & 1) << 5)); }
__host__ __device__ __forceinline__ void stage_rc(int b, int& R, int& C) { const int st = b / 1024, sb = b % 1024, swz = sb ^ (((sb >> 9) & 1) << 5); R = (st >> 1) * 16 + swz / 64; C = (st & 1) * 32 + (swz % 64) / 2; }
__host__ __device__ __forceinline__ int perm32(int rho) { const int n = rho >> 4, i = rho & 15; return 8 * (i >> 2) + 4 * n + (i & 3); }

struct Unit { int pm, pn, tag; const char* a; const char* b; };

__device__ __forceinline__ void tile_of(int L, int nM, int nN, int& pm, int& pn) {
    const int nwg = nM * nN; int wgid = L;
    { const int q = nwg / NXCD, r = nwg % NXCD, xcd = wgid % NXCD, off = wgid / NXCD; wgid = (xcd < r ? xcd * (q + 1) : r * (q + 1) + (xcd - r) * q) + off; }
    const int nig = WGM * nN, gid = wgid / nig, fm = gid * WGM, gsz = (nM - fm) < WGM ? (nM - fm) : WGM;
    pm = fm + ((wgid % nig) % gsz); pn = (wgid % nig) / gsz;
}

typedef __bf16 bf16x2_t __attribute__((ext_vector_type(2)));
__device__ __forceinline__ unsigned cvt_pk_bf16(float lo, float hi) { f32x2 v = {lo, hi}; bf16x2_t b = __builtin_convertvector(v, bf16x2_t); return __builtin_bit_cast(unsigned, b); }

typedef int i32x8 __attribute__((ext_vector_type(8)));
typedef int i32x4 __attribute__((ext_vector_type(4)));
template <class Epi, class Sched, bool ALIGN_EPI = false, bool SP2 = false, bool FP8 = false>
__device__ __forceinline__ void gemm_phase(LAS unsigned char* lds, const int lda, const int ldb, const int K, const Sched& S, const Epi& E) {
    int tid_ = threadIdx.x; asm volatile("" : "+v"(tid_));
    const int tid = tid_, wid = __builtin_amdgcn_readfirstlane(tid >> 6), lane = tid & 63, wr = wid >> 2, wc = wid & 3, fr = lane & 15, fq = lane >> 4;
    const int nt = K / 128;
    unsigned voffA[2], voffB[2];
#pragma unroll
    for (int i = 0; i < 2; ++i) { int R, C; stage_rc(tid * 16 + i * 8192, R, C); const int Rb = Epi::PERM ? ((R & ~31) + perm32(R & 31)) : R;
        voffA[i] = (unsigned)(R * lda + C * 2); voffB[i] = (unsigned)(Rb * ldb + C * 2); }
    const size_t kstep = (size_t)(BK * 2);
    const size_t hstepA = (size_t)HALF * lda, hstepB = (size_t)HALF * ldb;
    const unsigned ldsw = (unsigned)wid * 1024u;
    const int aoff = lds_byte(wr * 64 + fr, fq * 8), boff = lds_byte(wc * 32 + fr, fq * 8);
#define PG8_SA(b, h) (((b) * 2 + (h)) * HTB)
#define PG8_SB(b, h) ((4 + (b) * 2 + (h)) * HTB)
#define PG8_STAGE(bufoff, gbase, voff) do { _Pragma("unroll") for (int _i = 0; _i < 2; ++_i) \
        __builtin_amdgcn_global_load_lds((const unsigned*)((const char*)(gbase) + (voff)[_i]), (LAS unsigned*)(lds + (bufoff) + ldsw + _i * 8192), 16, 0, 0); } while (0)
#define PG8_RD(off) __builtin_bit_cast(i32x4, *(const LAS bf16x8*)(lds + (off)))
#define PG8_LDA(dst, b, h) do { _Pragma("unroll") for (int m = 0; m < 4; ++m) dst[m] = __builtin_shufflevector(PG8_RD(PG8_SA(b, h) + aoff + m * 2048), PG8_RD(PG8_SA(b, h) + aoff + m * 2048 + 1024), 0, 1, 2, 3, 4, 5, 6, 7); } while (0)
#define PG8_LDB(dst, b, h) do { _Pragma("unroll") for (int n = 0; n < 2; ++n) dst[n] = __builtin_shufflevector(PG8_RD(PG8_SB(b, h) + boff + n * 2048), PG8_RD(PG8_SB(b, h) + boff + n * 2048 + 1024), 0, 1, 2, 3, 4, 5, 6, 7); } while (0)
#define PG8_LO(x) __builtin_bit_cast(bf16x8, __builtin_shufflevector((x), (x), 0, 1, 2, 3))
#define PG8_HI(x) __builtin_bit_cast(bf16x8, __builtin_shufflevector((x), (x), 4, 5, 6, 7))
#define PG8_MMA(ai, bj, At, Bt) do { __builtin_amdgcn_s_setprio(1); _Pragma("unroll") for (int m = 0; m < 4; ++m) _Pragma("unroll") for (int n = 0; n < 2; ++n) { \
        if constexpr (FP8) asm volatile("s_nop 1\n\tv_mfma_scale_f32_16x16x128_f8f6f4 %0, %1, %2, %0, %3, %4 op_sel_hi:[0,0,0]" : "+v"(acc[ai][bj][m][n]) : "v"(Bt[n]), "v"(At[m]), "v"(sc_w), "v"(sc_a)); \
        else { acc[ai][bj][m][n] = __builtin_amdgcn_mfma_f32_16x16x32_bf16(PG8_LO(Bt[n]), PG8_LO(At[m]), acc[ai][bj][m][n], 0, 0, 0); \
               acc[ai][bj][m][n] = __builtin_amdgcn_mfma_f32_16x16x32_bf16(PG8_HI(Bt[n]), PG8_HI(At[m]), acc[ai][bj][m][n], 0, 0, 0); } } __builtin_amdgcn_s_setprio(0); } while (0)
#define PG8_WAIT_V(n) asm volatile("s_waitcnt vmcnt(" #n ")" ::: "memory")
#define PG8_WAIT_L(n) asm volatile("s_waitcnt lgkmcnt(" #n ")" ::: "memory")
#define PG8_BAR __builtin_amdgcn_s_barrier()
#define PG8_SCHED __builtin_amdgcn_sched_barrier(0)
    Unit cur, nxt; int ui = 0;
    if (!S.next(0, cur)) return;
    f32x4 acc[2][2][4][2];
#pragma unroll
    for (int a = 0; a < 2; ++a)
#pragma unroll
        for (int b = 0; b < 2; ++b)
#pragma unroll
            for (int m = 0; m < 4; ++m)
#pragma unroll
                for (int n = 0; n < 2; ++n) acc[a][b][m][n] = (f32x4){0.f, 0.f, 0.f, 0.f};
    i32x8 At[4], B0[2], B1[2];
    const int sc_w = 0x77777777, sc_a = 0x7f7f7f7f;
    const char* cA = cur.a; const char* cB = cur.b;
    if constexpr (SP2) {
        PG8_STAGE(PG8_SB(0, 0), cB, voffB); PG8_STAGE(PG8_SB(0, 1), cB + hstepB, voffB); PG8_STAGE(PG8_SA(0, 0), cA, voffA); PG8_STAGE(PG8_SA(0, 1), cA + hstepA, voffA);
        if (wr == 1) PG8_BAR;
        PG8_WAIT_V(2); PG8_BAR;
        PG8_STAGE(PG8_SB(1, 0), cB + kstep, voffB); PG8_STAGE(PG8_SA(1, 0), cA + kstep, voffA); PG8_STAGE(PG8_SB(1, 1), cB + hstepB + kstep, voffB);
        PG8_WAIT_V(6); PG8_BAR;
    } else {
        PG8_STAGE(PG8_SB(0, 0), cB, voffB); PG8_STAGE(PG8_SA(0, 0), cA, voffA); PG8_STAGE(PG8_SB(0, 1), cB + hstepB, voffB); PG8_STAGE(PG8_SA(0, 1), cA + hstepA, voffA);
        if (wr == 1) PG8_BAR;
        PG8_WAIT_V(4); PG8_BAR;
        PG8_STAGE(PG8_SB(1, 0), cB + kstep, voffB); PG8_STAGE(PG8_SA(1, 0), cA + kstep, voffA); PG8_STAGE(PG8_SB(1, 1), cB + hstepB + kstep, voffB);
        PG8_WAIT_V(6); PG8_BAR;
    }
    for (;;) {
        const bool has_next = S.next(ui + 1, nxt);
        const char* nA = has_next ? nxt.a : cA; const char* nB = has_next ? nxt.b : cB;
        for (int t = 0; t < nt; t += 2) {
            const bool last = (t == nt - 2);
            const char* a1 = cA + (size_t)(t + 1) * kstep;
            const char* a2 = last ? nA : cA + (size_t)(t + 2) * kstep; const char* b2 = last ? nB : cB + (size_t)(t + 2) * kstep;
            const char* a3 = a2 + kstep; const char* b3 = b2 + kstep;
            if constexpr (SP2) {
            PG8_LDB(B0, 0, 0); PG8_LDB(B1, 0, 1); PG8_SCHED; PG8_LDA(At, 0, 0); PG8_STAGE(PG8_SA(1, 1), a1 + hstepA, voffA);
            PG8_WAIT_V(8); PG8_WAIT_L(0); PG8_BAR; PG8_MMA(0, 0, At, B0); PG8_MMA(0, 1, At, B1); PG8_BAR; PG8_SCHED;
            PG8_LDA(At, 0, 1); PG8_STAGE(PG8_SB(0, 0), b2, voffB); PG8_STAGE(PG8_SB(0, 1), b2 + hstepB, voffB); PG8_STAGE(PG8_SA(0, 0), a2, voffA);
            PG8_WAIT_V(8); PG8_WAIT_L(0); PG8_BAR; PG8_MMA(1, 0, At, B0); PG8_MMA(1, 1, At, B1); PG8_BAR; PG8_SCHED;
            PG8_LDB(B0, 1, 0); PG8_LDB(B1, 1, 1); PG8_SCHED; PG8_LDA(At, 1, 0); PG8_STAGE(PG8_SA(0, 1), a2 + hstepA, voffA);
            PG8_WAIT_V(8); PG8_WAIT_L(0); PG8_BAR; PG8_MMA(0, 0, At, B0); PG8_MMA(0, 1, At, B1); PG8_BAR; PG8_SCHED;
            PG8_LDA(At, 1, 1); PG8_STAGE(PG8_SB(1, 0), b3, voffB); PG8_STAGE(PG8_SB(1, 1), b3 + hstepB, voffB); PG8_STAGE(PG8_SA(1, 0), a3, voffA);
            PG8_WAIT_V(8); PG8_WAIT_L(0); PG8_BAR; PG8_MMA(1, 0, At, B0); PG8_MMA(1, 1, At, B1); PG8_BAR; PG8_SCHED;
            } else {
            PG8_LDB(B0, 0, 0); PG8_SCHED; PG8_LDA(At, 0, 0); PG8_STAGE(PG8_SA(1, 1), a1 + hstepA, voffA);
            PG8_WAIT_L(8); PG8_BAR; PG8_WAIT_L(0); PG8_MMA(0, 0, At, B0); PG8_BAR; PG8_SCHED;
            PG8_LDB(B1, 0, 1); PG8_STAGE(PG8_SB(0, 0), b2, voffB);
            PG8_BAR; PG8_WAIT_L(0); PG8_MMA(0, 1, At, B1); PG8_BAR;
            PG8_LDA(At, 0, 1); PG8_STAGE(PG8_SA(0, 0), a2, voffA);
            PG8_BAR; PG8_WAIT_L(0); PG8_MMA(1, 0, At, B0); PG8_BAR; PG8_SCHED;
            PG8_STAGE(PG8_SB(0, 1), b2 + hstepB, voffB);
            PG8_WAIT_V(6); PG8_BAR; PG8_MMA(1, 1, At, B1); PG8_BAR;
            PG8_LDB(B0, 1, 0); PG8_SCHED; PG8_LDA(At, 1, 0); PG8_STAGE(PG8_SA(0, 1), a2 + hstepA, voffA);
            PG8_WAIT_L(8); PG8_BAR; PG8_WAIT_L(0); PG8_MMA(0, 0, At, B0); PG8_BAR; PG8_SCHED;
            PG8_LDB(B1, 1, 1); PG8_STAGE(PG8_SB(1, 0), b3, voffB);
            PG8_BAR; PG8_WAIT_L(0); PG8_MMA(0, 1, At, B1); PG8_BAR;
            PG8_LDA(At, 1, 1); PG8_STAGE(PG8_SA(1, 0), a3, voffA);
            PG8_BAR; PG8_WAIT_L(0); PG8_MMA(1, 0, At, B0); PG8_BAR; PG8_SCHED;
            PG8_STAGE(PG8_SB(1, 1), b3 + hstepB, voffB);
            PG8_WAIT_V(6); PG8_BAR; PG8_MMA(1, 1, At, B1); PG8_BAR;
            }
            if constexpr (Epi::MIDHOOK) { if (((t + 2) & 7) == 0 && !last) { int fr_ = fr, fq_ = fq; asm volatile("" : "+v"(fr_), "+v"(fq_)); E.mid(acc, cur, (t + 2) >> 3, wr, wc, fr_, fq_); } }
        }
        if constexpr (ALIGN_EPI) { if (wr == 0) PG8_BAR; }
        if constexpr (FP8) asm volatile("s_nop 15\n\ts_nop 15" ::: "memory");
        { int fr_ = fr, fq_ = fq; asm volatile("" : "+v"(fr_), "+v"(fq_));
          E(acc, cur, wr, wc, fr_, fq_); }
        if (!has_next) break;
#pragma unroll
        for (int a = 0; a < 2; ++a)
#pragma unroll
            for (int b = 0; b < 2; ++b)
#pragma unroll
                for (int m = 0; m < 4; ++m)
#pragma unroll
                    for (int n = 0; n < 2; ++n) acc[a][b][m][n] = (f32x4){0.f, 0.f, 0.f, 0.f};
        cur = nxt; cA = nA; cB = nB; ++ui;
        if constexpr (ALIGN_EPI) { if (wr == 1) PG8_BAR; }
    }
    PG8_WAIT_V(0);
    if constexpr (!ALIGN_EPI) { if (wr == 0) PG8_BAR; }
    PG8_BAR;
#undef PG8_SA
#undef PG8_SB
#undef PG8_STAGE
#undef PG8_LDA
#undef PG8_LDB
#undef PG8_MMA
#undef PG8_RD
#undef PG8_LO
#undef PG8_HI
#undef PG8_WAIT_V
#undef PG8_WAIT_L
#undef PG8_BAR
#undef PG8_SCHED
}
}

constexpr size_t MiB = 1u << 20;
constexpr size_t al256(size_t x) { return (x + 255) & ~(size_t)255; }
constexpr size_t WS_CTL = 0, CTL_ZERO_BYTES = 1 * MiB;
constexpr size_t WS_MODV = 1 * MiB;
constexpr size_t WS_ROPE = WS_MODV + al256((size_t)2 * 5 * MODW * 4);
constexpr size_t WS_CNTWG = WS_ROPE + al256(64 * 16 * 2 * 4);
constexpr size_t WS_TOKE = WS_CNTWG + al256(256 * 8 * 4);
constexpr size_t WS_TOKP = WS_TOKE + al256((size_t)ML * 2 * 4);
constexpr size_t WS_TOKW = WS_TOKP + al256((size_t)ML * 2 * 4);
constexpr size_t WS_TOKS = WS_TOKW + al256((size_t)ML * 2 * 4);
constexpr size_t WS_TILE = WS_TOKS + al256((size_t)ML * 2 * 4);
constexpr size_t WS_WIN = 4 * MiB;
constexpr size_t WS_WBR = WS_WIN + (size_t)2 * INW * D * 2;
constexpr size_t WS_WOUT = WS_WBR + (size_t)2 * 3 * D * 512 * 2;
constexpr size_t WS_WGU0 = WS_WOUT + (size_t)2 * D * D * 2;
constexpr size_t WS_WDN0 = WS_WGU0 + (size_t)2 * DFF * D * 2;
constexpr size_t WS_WMGU = WS_WDN0 + (size_t)D * DFF * 2;
constexpr size_t WS_WMDN = WS_WMGU + (size_t)NE * 2 * DFE * D * 2;
constexpr size_t WS_H = WS_WMDN + (size_t)NE * D * DFE * 2;
constexpr size_t WS_Z = WS_H + (size_t)MT * D * 2;
constexpr size_t WS_MIX = WS_Z + (size_t)MT * INW * 2;
constexpr size_t WS_ACT = WS_Z;
constexpr size_t WS_YACC = WS_MIX + (size_t)MT * MIXW * 2;
constexpr size_t WS_H2S = WS_YACC;
constexpr size_t WS_Y = WS_YACC + (size_t)MT * D * 4;
constexpr size_t WS_X1 = WS_Y + (size_t)MT * D * 2;
constexpr size_t WS_X2 = WS_X1 + (size_t)MT * D * 4;
constexpr size_t WS_YS = WS_X2;
constexpr size_t WS_H8 = WS_X2 + (size_t)MT * D * 4;
constexpr size_t WS_WIN8 = WS_H8 + (size_t)MT * D;
constexpr size_t WS_END = WS_WIN8 + (size_t)2 * 3 * D * D;
static_assert((size_t)MS * DFE * 2 <= (size_t)MT * INW * 2 + (size_t)MT * MIXW * 2, "ACT overlay");
static_assert((size_t)MS * D * 2 <= (size_t)MT * D * 4, "H2S / YS overlays");
static_assert(WS_TILE + 1024 <= WS_WIN, "small tables");
constexpr int CW_BAR = 4096;

constexpr int RING_BYTES = 131072;
constexpr int LDSCTL_OFF = 146944, MISC_OFF = LDSCTL_OFF + 320;
constexpr int LDS_BYTES = 147456;

#define XB_TMO      128
#define XB_XCNT(j)  (256  + 64 * (j))
#define XB_XSUB(j)  (1280 + 64 * (j))
#define XB_XGEN(j)  (2304 + 64 * (j))
#define XB_TOP      3328
#define XB_TOPGEN   3392
#define XCD_BAR_WORDS 3456
#define XB_SPIN_CAP (1u << 18)
__device__ __forceinline__ unsigned xb_ld(unsigned* p)              { return __hip_atomic_load(p, __ATOMIC_RELAXED, __HIP_MEMORY_SCOPE_AGENT); }
__device__ __forceinline__ unsigned xb_add(unsigned* p, unsigned v) { return __hip_atomic_fetch_add(p, v, __ATOMIC_RELAXED, __HIP_MEMORY_SCOPE_AGENT); }
__device__ __forceinline__ unsigned xb_xcc_id() { return (unsigned)__builtin_amdgcn_s_getreg((3 << 11) | 20) & 0xFu; }
#define XB_SPIN(cond, bar) do { unsigned _sp = 0; while (cond) { __builtin_amdgcn_s_sleep(1); \
    if ((++_sp & 255u) == 0u) { if (xb_ld(&(bar)[XB_TMO])) break; if (_sp > XB_SPIN_CAP) { atomicAdd(&(bar)[XB_TMO], 1u); break; } } } } while (0)
struct XcdBarrier { unsigned* bar; unsigned x; volatile LAS unsigned* st; };
__device__ __forceinline__ XcdBarrier xcd_barrier_post(unsigned* bar, volatile LAS unsigned* st) {
    XcdBarrier b; b.bar = bar; b.x = xb_xcc_id(); b.st = st;
    if (threadIdx.x == 0) (void)xb_add(&bar[XB_XCNT(b.x)], 1u);
    return b;
}
__device__ __forceinline__ void xcd_barrier_complete(unsigned* bar, unsigned x, unsigned& nloc, unsigned& nx) {
    const unsigned G = gridDim.x * gridDim.y * gridDim.z;
    unsigned sum, cnt, mine, sp = 0u;
    for (;;) {
        sum = 0u; cnt = 0u; mine = 0u;
#pragma unroll
        for (unsigned j = 0; j < 16; ++j) { const unsigned c = xb_ld(&bar[XB_XCNT(j)]); sum += c; cnt += (c > 0u) ? 1u : 0u; mine = (j == x) ? c : mine; }
        if (sum == G) break;
        __builtin_amdgcn_s_sleep(1);
        if ((++sp & 255u) == 0u) { if (xb_ld(&bar[XB_TMO])) break; if (sp > XB_SPIN_CAP) { atomicAdd(&bar[XB_TMO], 1u); break; } }
    }
    nloc = mine > 0u ? mine : 1u; nx = cnt > 0u ? cnt : 1u;
}
__device__ __attribute__((noinline)) void xcd_barrier_leader(unsigned* bar, unsigned bx_, volatile LAS unsigned* st) {
    {
        XcdBarrier b; b.bar = bar; b.x = bx_; b.st = st;
        __builtin_amdgcn_s_waitcnt(0);
        unsigned nloc = b.st[0], nx = b.st[1];
        if (nloc == 0u) { xcd_barrier_complete(bar, b.x, nloc, nx); b.st[0] = nloc; b.st[1] = nx; }
        const unsigned old = xb_add(&bar[XB_XSUB(b.x)], 1u);
        const unsigned gen = old / nloc;
        if (old + 1u == (gen + 1u) * nloc) {
            __builtin_amdgcn_fence(__ATOMIC_RELEASE, "agent");
            asm volatile("s_waitcnt vmcnt(0)" ::: "memory");
            const unsigned og = xb_add(&bar[XB_TOP], 1u);
            const unsigned tg = og / nx;
            if (og + 1u == (tg + 1u) * nx) xb_add(&bar[XB_TOPGEN], 1u);
            else XB_SPIN(xb_ld(&bar[XB_TOPGEN]) == tg, bar);
            __builtin_amdgcn_fence(__ATOMIC_ACQUIRE, "agent");
            xb_add(&bar[XB_XGEN(b.x)], 1u);
            asm volatile("s_waitcnt vmcnt(0)" ::: "memory");
        } else {
            XB_SPIN(xb_ld(&bar[XB_XGEN(b.x)]) == gen, bar);
            __builtin_amdgcn_fence(__ATOMIC_ACQUIRE, "agent");
            asm volatile("s_waitcnt vmcnt(0)" ::: "memory");
        }
    }
}
__device__ __forceinline__ void xcd_barrier(const XcdBarrier& b) {
    asm volatile("s_waitcnt vmcnt(0)" ::: "memory");
    __syncthreads();
    if (threadIdx.x == 0) xcd_barrier_leader(b.bar, b.x, b.st);
    __syncthreads();
}

struct Args {
    const float *x, *c, *ctx, *c_ctx, *norm1_g, *norm2_g, *final_g, *w_mod, *b_mod, *w_in, *conv_w, *sink, *pool_w, *pool_scale, *w_branch, *w_out,
                *ffn_w_gu, *ffn_w_down, *router_w, *moe_w_gu, *moe_w_down;
    float* out; unsigned char* ws; int ph_lo, ph_hi;
};
template <int OFF> __device__ __forceinline__ const void* karg_p() { const void* r; asm volatile("s_load_dwordx2 %0, %1, %2\n\ts_waitcnt lgkmcnt(0)" : "=s"(r) : "s"(__builtin_amdgcn_kernarg_segment_ptr()), "i"(OFF)); return r; }
template <int OFF> __device__ __forceinline__ int karg_i() { int r; asm volatile("s_load_dword %0, %1, %2\n\ts_waitcnt lgkmcnt(0)" : "=s"(r) : "s"(__builtin_amdgcn_kernarg_segment_ptr()), "i"(OFF)); return r; }
#define KP(field) ((const float*)karg_p<(int)__builtin_offsetof(Args, field)>())
struct Frame {
    LAS unsigned char* lds;
    int tid, lane, wave, G, bx;
    unsigned char* ws;
};
__device__ __forceinline__ float wave_sum(float v) {
#pragma unroll
    for (int o = 1; o < 64; o <<= 1) v += __shfl_xor(v, o);
    return v;
}
__device__ __forceinline__ float wave_max(float v) {
#pragma unroll
    for (int o = 1; o < 64; o <<= 1) v = fmaxf(v, __shfl_xor(v, o));
    return v;
}
#define LDS_WAIT() asm volatile("s_waitcnt lgkmcnt(0)" ::: "memory")

template <bool F8>
__device__ __forceinline__ void p0_transpose_item(const float* W, int ldw, bf16* WT, int ldt, int koff, int k0, int n0, int drow0, LAS float* scr, int lane) {
    f32x4 v[16];
    const int rl = lane >> 4, c4 = 4 * (lane & 15);
#pragma unroll
    for (int i = 0; i < 16; ++i) v[i] = __builtin_nontemporal_load((const f32x4*)(W + (size_t)(k0 + 4 * i + rl) * ldw + n0 + c4));
#pragma unroll
    for (int i = 0; i < 16; ++i) { LAS float* p = scr + (4 * i + rl) * 65 + c4; p[0] = v[i].x; p[1] = v[i].y; p[2] = v[i].z; p[3] = v[i].w; }
    LDS_WAIT(); asm volatile("" ::: "memory");
    const int c = lane & 7;
#pragma unroll
    for (int j = 0; j < 8; ++j) { const int n = (lane >> 3) + 8 * j; const LAS float* sp = scr + (8 * c) * 65 + n;
        if constexpr (F8) { u32x2 o; o.x = pk4_fp8(sp[0 * 65] * W8SCALE, sp[1 * 65] * W8SCALE, sp[2 * 65] * W8SCALE, sp[3 * 65] * W8SCALE); o.y = pk4_fp8(sp[4 * 65] * W8SCALE, sp[5 * 65] * W8SCALE, sp[6 * 65] * W8SCALE, sp[7 * 65] * W8SCALE);
            *(u32x2*)((unsigned char*)WT + (size_t)(drow0 + n) * ldt + koff + k0 + 8 * c) = o; }
        else { u32x4 o; o.x = pk2(sp[0 * 65], sp[1 * 65]); o.y = pk2(sp[2 * 65], sp[3 * 65]); o.z = pk2(sp[4 * 65], sp[5 * 65]); o.w = pk2(sp[6 * 65], sp[7 * 65]);
            *(u32x4*)(WT + (size_t)(drow0 + n) * ldt + koff + k0 + 8 * c) = o; } }
    LDS_WAIT(); asm volatile("" ::: "memory");
}
template <bool F8>
__device__ __forceinline__ void p0_job_item(const float* W, int ldw, int K, int N, bf16* WT, int ldt, int koff, int IL, int item, LAS float* scr, int lane) {
    const int nblk = N / 64, kb = item / nblk, nb = item % nblk, n0 = 64 * nb;
    int drow0 = n0;
    if (IL > 0) { const int half = n0 >= IL ? 1 : 0, f = n0 - half * IL; drow0 = 256 * (f / 128) + 128 * half + (f % 128); }
    p0_transpose_item<F8>(W, ldw, WT, ldt, koff, 64 * kb, n0, drow0, scr, lane);
}
__device__ __forceinline__ void p0_prologue(Frame& F) {
    LAS float* scr = (LAS float*)(F.lds + F.wave * 16640);
    const int gw = F.bx * NWAVES + F.wave, NGW = F.G * NWAVES;
    constexpr int I_IN = (D / 64) * (ZG / 64), I_IN8 = (D / 64) * (3 * D / 64), I_BR = (512 / 64) * (D / 64), I_OUT = (D / 64) * (D / 64), I_GU0 = (D / 64) * (2 * DFF / 64), I_DN0 = (DFF / 64) * (D / 64),
                  I_MGU = (D / 64) * (2 * DFE / 64), I_MDN = (DFE / 64) * (D / 64);
    constexpr int NITEMS = 2 * I_IN + 2 * I_IN8 + 4 * I_BR + 2 * I_OUT + I_GU0 + I_DN0 + NE * I_MGU + NE * I_MDN;
    bf16* const wsb = (bf16*)F.ws;
    for (int it = gw; it < NITEMS; it += NGW) {
        int r = it;
        if (r < NE * I_MGU) { const int e = r / I_MGU; p0_job_item<true>(KP(moe_w_gu) + (size_t)e * D * 2 * DFE, 2 * DFE, D, 2 * DFE, (bf16*)(F.ws + WS_WMGU + (size_t)e * 2 * DFE * D), D, 0, DFE, r % I_MGU, scr, F.lane); continue; } r -= NE * I_MGU;
        if (r < NE * I_MDN) { const int e = r / I_MDN; p0_job_item<true>(KP(moe_w_down) + (size_t)e * DFE * D, D, DFE, D, (bf16*)(F.ws + WS_WMDN + (size_t)e * D * DFE), DFE, 0, 0, r % I_MDN, scr, F.lane); continue; } r -= NE * I_MDN;
        if (r < 2 * I_IN) { const int l = r / I_IN; p0_job_item<false>(KP(w_in) + (size_t)l * D * INW, INW, D, ZG, (bf16*)(F.ws + WS_WIN) + (size_t)l * ZG * D, D, 0, 0, r % I_IN, scr, F.lane); continue; } r -= 2 * I_IN;
        if (r < 2 * I_IN8) { const int l = r / I_IN8; p0_job_item<true>(KP(w_in) + (size_t)l * D * INW + ZG, INW, D, 3 * D, (bf16*)(F.ws + WS_WIN8 + (size_t)l * 3 * D * D), D, 0, 0, r % I_IN8, scr, F.lane); continue; } r -= 2 * I_IN8;
        if (r < 4 * I_BR) { const int j = r / I_BR, l = j >> 1, b = j & 1; p0_job_item<false>(KP(w_branch) + (size_t)(l * 3 + b) * 512 * D, D, 512, D, (bf16*)(F.ws + WS_WBR) + (size_t)l * D * MIXW, MIXW, 512 * b, 0, r % I_BR, scr, F.lane); continue; } r -= 4 * I_BR;
        if (r < 2 * I_OUT) { const int l = r / I_OUT; p0_job_item<false>(KP(w_out) + (size_t)l * D * D, D, D, D, (bf16*)(F.ws + WS_WOUT) + (size_t)l * D * D, D, 0, 0, r % I_OUT, scr, F.lane); continue; } r -= 2 * I_OUT;
        if (r < I_GU0) { p0_job_item<FFN0_FP8 != 0>(KP(ffn_w_gu), 2 * DFF, D, 2 * DFF, (bf16*)(F.ws + WS_WGU0), D, 0, DFF, r, scr, F.lane); continue; } r -= I_GU0;
        p0_job_item<(FFN0_FP8 || DN0_FP8)>(KP(ffn_w_down), D, DFF, D, (bf16*)(F.ws + WS_WDN0), DFF, 0, 0, r, scr, F.lane);
    }
    (void)wsb;
    __syncthreads();
    constexpr int I_MOD = 2 * (MODW / 64), I_FOLD = 2 * 4 * (D / 64);
    for (int it = F.bx; it < I_MOD + I_FOLD + 1; it += F.G) {
        if (it < I_MOD) {
            const int l = it / (MODW / 64), cb = it % (MODW / 64);
            LAS float* sv = (LAS float*)F.lds;
            LAS float* red = (LAS float*)(F.lds + 32768);
            for (int i = F.tid; i < 5 * D; i += NTHR) { const int r = i / D, k = i % D; const float v = r < 4 ? KP(c)[r * D + k] : KP(c_ctx)[k]; sv[i] = v / (1.f + __expf(-v)); }
            __syncthreads();
            const int col = cb * 64 + F.lane; const float* wp = KP(w_mod) + (size_t)l * D * MODW + col;
            float a0 = 0.f, a1 = 0.f, a2 = 0.f, a3 = 0.f, a4 = 0.f;
#pragma unroll 8
            for (int kk = 0; kk < 128; ++kk) { const int k = F.wave * 128 + kk; const float w = wp[(size_t)k * MODW];
                a0 += sv[k] * w; a1 += sv[D + k] * w; a2 += sv[2 * D + k] * w; a3 += sv[3 * D + k] * w; a4 += sv[4 * D + k] * w; }
            red[(F.wave * 5 + 0) * 64 + F.lane] = a0; red[(F.wave * 5 + 1) * 64 + F.lane] = a1; red[(F.wave * 5 + 2) * 64 + F.lane] = a2;
            red[(F.wave * 5 + 3) * 64 + F.lane] = a3; red[(F.wave * 5 + 4) * 64 + F.lane] = a4;
            __syncthreads();
            if (F.tid < 320) { const int r = F.tid / 64, ln = F.tid % 64; float s = 0.f;
#pragma unroll
                for (int w = 0; w < 8; ++w) s += red[(w * 5 + r) * 64 + ln];
                const int cc = cb * 64 + ln;
                ((float*)(F.ws + WS_MODV))[(size_t)(l * 5 + r) * MODW + cc] = s + KP(b_mod)[l * MODW + cc]; }
            __syncthreads();
        } else if (it < I_MOD + I_FOLD) {
            const int r = it - I_MOD, l = r / 64, g = (r % 64) / 16, nb = r % 16;
            LAS float* pw = (LAS float*)F.lds;
            const float* pws = KP(pool_w) + (size_t)(l * 4 + g) * 128 * 128;
            for (int i = F.tid; i < 128 * 128; i += NTHR) pw[i] = pws[i];
            __syncthreads();
            const int n = nb * 64 + F.lane; const float* w2 = KP(w_branch) + (size_t)(l * 3 + 2) * 512 * D + (size_t)(128 * g) * D + n;
            const float* ps = KP(pool_scale) + l * 512 + 128 * g;
            float acc[16];
#pragma unroll
            for (int q = 0; q < 16; ++q) acc[q] = 0.f;
            for (int j = 0; j < 128; ++j) { const float wv = w2[(size_t)j * D] * ps[j];
#pragma unroll
                for (int q = 0; q < 16; ++q) acc[q] += pw[(F.wave * 16 + q) * 128 + j] * wv; }
            bf16* dst = (bf16*)(F.ws + WS_WBR) + (size_t)l * D * MIXW + (size_t)n * MIXW + 1024 + 128 * g + F.wave * 16;
            u32x4 o0, o1; o0.x = pk2(acc[0], acc[1]); o0.y = pk2(acc[2], acc[3]); o0.z = pk2(acc[4], acc[5]); o0.w = pk2(acc[6], acc[7]);
            o1.x = pk2(acc[8], acc[9]); o1.y = pk2(acc[10], acc[11]); o1.z = pk2(acc[12], acc[13]); o1.w = pk2(acc[14], acc[15]);
            *(u32x4*)dst = o0; *(u32x4*)(dst + 8) = o1;
            __syncthreads();
        } else {
            for (int i = F.tid; i < 64 * 16; i += NTHR) { const int pos = i / 16, fi = i % 16;
                const float inv = powf(10000.0f, -(float)fi / 16.0f); const float ang = (float)pos * inv;
                ((float*)(F.ws + WS_ROPE))[2 * i] = cosf(ang); ((float*)(F.ws + WS_ROPE))[2 * i + 1] = sinf(ang); }
        }
    }
}

template <bool ROUTER, int OUTM = 0>
__device__ __forceinline__ void norm_mod_phase(Frame& F, const float* xl, const float* xc, const float* gvec, const float* modl, int shi, int sci, int nrows, const float* router_w) {
    bf16* H = (bf16*)(F.ws + WS_H);
    LAS int* lcnt = (LAS int*)F.lds;
    if (ROUTER) { if (F.tid < 8) lcnt[F.tid] = 0; __syncthreads(); }
    if constexpr (!ROUTER) {
        const int nwv = F.G * NWAVES, gw = F.bx * NWAVES + F.wave;
        for (int r0 = gw; r0 < nrows; r0 += 2 * nwv) {
            const bool has1 = r0 + nwv < nrows; const int r1 = has1 ? r0 + nwv : r0;
            const int b0 = r0 < ML ? r0 / SEQ : 4, b1 = r1 < ML ? r1 / SEQ : 4;
            const float* x0 = r0 < ML ? xl + (size_t)r0 * D : xc + (size_t)(r0 - ML) * D; const float* x1 = r1 < ML ? xl + (size_t)r1 * D : xc + (size_t)(r1 - ML) * D;
            const float* m0 = modl + (size_t)b0 * MODW; const float* m1 = modl + (size_t)b1 * MODW;
            f32x4 va[4], vb[4], g[4], sh0[4], sc0[4], sh1[4], sc1[4];
#pragma unroll
            for (int j = 0; j < 4; ++j) { const int c = 4 * F.lane + 256 * j; va[j] = *(const f32x4*)(x0 + c); vb[j] = *(const f32x4*)(x1 + c); }
#pragma unroll
            for (int j = 0; j < 4; ++j) { const int c = 4 * F.lane + 256 * j; g[j] = *(const f32x4*)(gvec + c); sh0[j] = *(const f32x4*)(m0 + shi * D + c); sc0[j] = *(const f32x4*)(m0 + sci * D + c);
                sh1[j] = *(const f32x4*)(m1 + shi * D + c); sc1[j] = *(const f32x4*)(m1 + sci * D + c); }
            float sa = 0.f, sb = 0.f;
#pragma unroll
            for (int j = 0; j < 4; ++j) { sa += (va[j].x * va[j].x + va[j].y * va[j].y) + (va[j].z * va[j].z + va[j].w * va[j].w); sb += (vb[j].x * vb[j].x + vb[j].y * vb[j].y) + (vb[j].z * vb[j].z + vb[j].w * vb[j].w); }
            const float ra = 1.0f / sqrtf(wave_sum(sa) * (1.f / D) + EPS), rb = 1.0f / sqrtf(wave_sum(sb) * (1.f / D) + EPS);
#pragma unroll
            for (int j = 0; j < 4; ++j) { const int c = 4 * F.lane + 256 * j;
                const f32x4 oa = (va[j] * ra * g[j]) * (sc0[j] + 1.0f) + sh0[j], ob = (vb[j] * rb * g[j]) * (sc1[j] + 1.0f) + sh1[j];
                if constexpr (OUTM == 1) { *(unsigned*)((unsigned char*)H + (size_t)r0 * D + c) = pk4_fp8(oa.x, oa.y, oa.z, oa.w); if (has1) *(unsigned*)((unsigned char*)H + (size_t)r1 * D + c) = pk4_fp8(ob.x, ob.y, ob.z, ob.w); }
                else { u32x2 o; o.x = pk2(oa.x, oa.y); o.y = pk2(oa.z, oa.w); *(u32x2*)(H + (size_t)r0 * D + c) = o; if (has1) { o.x = pk2(ob.x, ob.y); o.y = pk2(ob.z, ob.w); *(u32x2*)(H + (size_t)r1 * D + c) = o; } }
                if constexpr (OUTM == 2) { *(unsigned*)(F.ws + WS_H8 + (size_t)r0 * D + c) = pk4_fp8(oa.x, oa.y, oa.z, oa.w); if (has1) *(unsigned*)(F.ws + WS_H8 + (size_t)r1 * D + c) = pk4_fp8(ob.x, ob.y, ob.z, ob.w); } }
        }
        return;
    }
    const int nloop = ROUTER ? 8 : (nrows + F.G * NWAVES - 1) / (F.G * NWAVES);
    for (int i = 0; i < nloop; ++i) {
        const int r = ROUTER ? (F.bx * 64 + F.wave + 8 * i) : ((i * F.G + F.bx) * NWAVES + F.wave);
        if (r >= nrows) continue;
        const int bidx = r < ML ? r / SEQ : 4;
        const float* xr = r < ML ? xl + (size_t)r * D : xc + (size_t)(r - ML) * D;
        const float* mv = modl + (size_t)bidx * MODW;
        f32x4 v[4]; float ss = 0.f;
#pragma unroll
        for (int j = 0; j < 4; ++j) { v[j] = *(const f32x4*)(xr + 4 * F.lane + 256 * j); ss += (v[j].x * v[j].x + v[j].y * v[j].y) + (v[j].z * v[j].z + v[j].w * v[j].w); }
        const float rstd = 1.0f / sqrtf(wave_sum(ss) * (1.f / D) + EPS);
#pragma unroll
        for (int j = 0; j < 4; ++j) { const int c = 4 * F.lane + 256 * j;
            const f32x4 g = *(const f32x4*)(gvec + c), sh = *(const f32x4*)(mv + shi * D + c), sc = *(const f32x4*)(mv + sci * D + c);
            v[j] = (v[j] * rstd * g) * (sc + 1.0f) + sh;
            if constexpr (OUTM == 1) *(unsigned*)((unsigned char*)H + (size_t)r * D + c) = pk4_fp8(v[j].x, v[j].y, v[j].z, v[j].w);
            else { u32x2 o; o.x = pk2(v[j].x, v[j].y); o.y = pk2(v[j].z, v[j].w); *(u32x2*)(H + (size_t)r * D + c) = o; }
            if constexpr (OUTM == 2) *(unsigned*)(F.ws + WS_H8 + (size_t)r * D + c) = pk4_fp8(v[j].x, v[j].y, v[j].z, v[j].w); }
        if (ROUTER) {
            float lg[8];
#pragma unroll
            for (int e = 0; e < 8; ++e) lg[e] = 0.f;
#pragma unroll
            for (int j = 0; j < 4; ++j)
#pragma unroll
                for (int q = 0; q < 4; ++q) { const int c = 4 * F.lane + 256 * j + q; const f32x4 w0 = *(const f32x4*)(router_w + (size_t)c * 8), w1 = *(const f32x4*)(router_w + (size_t)c * 8 + 4); const float hv = v[j][q];
                    lg[0] += hv * w0.x; lg[1] += hv * w0.y; lg[2] += hv * w0.z; lg[3] += hv * w0.w; lg[4] += hv * w1.x; lg[5] += hv * w1.y; lg[6] += hv * w1.z; lg[7] += hv * w1.w; }
#pragma unroll
            for (int e = 0; e < 8; ++e) lg[e] = wave_sum(lg[e]);
            int e1 = 0; float v1 = lg[0];
#pragma unroll
            for (int e = 1; e < 8; ++e) if (lg[e] > v1) { v1 = lg[e]; e1 = e; }
            int e2 = -1; float v2 = -3.0e38f;
#pragma unroll
            for (int e = 0; e < 8; ++e) if (e != e1 && lg[e] > v2) { v2 = lg[e]; e2 = e; }
            const float ex = __expf(v2 - v1), w1 = 1.f / (1.f + ex), w2 = ex * w1;
            if (F.lane == 0) {
                const int p1 = atomicAdd((int*)&lcnt[e1], 1), p2 = atomicAdd((int*)&lcnt[e2], 1);
                int* te = (int*)(F.ws + WS_TOKE) + 2 * r; te[0] = e1; te[1] = e2;
                int* tp = (int*)(F.ws + WS_TOKP) + 2 * r; tp[0] = p1; tp[1] = p2;
                float* tw = (float*)(F.ws + WS_TOKW) + 2 * r; tw[0] = w1; tw[1] = w2;
            }
        }
    }
    if (ROUTER) { __syncthreads(); if (F.tid < 8) ((int*)(F.ws + WS_CNTWG))[F.bx * 8 + F.tid] = lcnt[F.tid]; __syncthreads(); }
}

__device__ __forceinline__ void moe_scatter_phase(Frame& F) {
    LAS int* tab = (LAS int*)F.lds;
    const int* cw = (const int*)(F.ws + WS_CNTWG);
    if (F.tid < 32) tab[F.tid] = 0;
    __syncthreads();
    for (int idx = F.tid; idx < F.G * 8; idx += NTHR) {
        const int c = __hip_atomic_load(cw + idx, __ATOMIC_RELAXED, __HIP_MEMORY_SCOPE_AGENT); const int w = idx >> 3, e = idx & 7;
        atomicAdd((int*)&tab[16 + e], c); if (w < F.bx) atomicAdd((int*)&tab[8 + e], c);
    }
    __syncthreads();
    if (F.tid == 0) { int off = 0; for (int e = 0; e < 8; ++e) { tab[e] = off; off += ((tab[16 + e] + 255) / 256) * 256; } tab[24] = off / 256;
        if (F.bx == 0) { int* tl = (int*)(F.ws + WS_TILE); int t = 0; for (int e = 0; e < 8; ++e) { const int n = (tab[16 + e] + 255) / 256; for (int q = 0; q < n; ++q) tl[t++] = e; } tl[200] = t; } }
    __syncthreads();
    const bf16* H = (const bf16*)(F.ws + WS_H); bf16* HS = (bf16*)(F.ws + WS_H2S);
    for (int i = 0; i < 8; ++i) {
        const int r = F.bx * 64 + F.wave + 8 * i; if (r >= ML) continue;
        const int* te = (const int*)(F.ws + WS_TOKE) + 2 * r; const int* tp = (const int*)(F.ws + WS_TOKP) + 2 * r;
        const int e1 = te[0], e2 = te[1];
        const int s1 = tab[e1] + tab[8 + e1] + tp[0], s2 = tab[e2] + tab[8 + e2] + tp[1];
        if (F.lane == 0) { int* ts = (int*)(F.ws + WS_TOKS) + 2 * r; ts[0] = s1; ts[1] = s2; }
        const u32x4 a = ((const u32x4*)((const unsigned char*)H + (size_t)r * D))[F.lane];
        ((u32x4*)((unsigned char*)HS + (size_t)s1 * D))[F.lane] = a; ((u32x4*)((unsigned char*)HS + (size_t)s2 * D))[F.lane] = a;
    }
}

__device__ __forceinline__ void final_phase(Frame& F, const float* final_g, float* out, const float* modl) {
    const float* X1 = (const float*)(F.ws + WS_X1); const bf16* YS = (const bf16*)(F.ws + WS_YS);
    const int nwv = F.G * NWAVES, gw = F.bx * NWAVES + F.wave;
    for (int r0 = gw; r0 < ML; r0 += 2 * nwv) {
        const bool has1 = r0 + nwv < ML; const int r1 = has1 ? r0 + nwv : r0;
        const float* ga = modl + (size_t)(r0 / SEQ) * MODW + 5 * D; const float* gb = modl + (size_t)(r1 / SEQ) * MODW + 5 * D;
        const int* tsa = (const int*)(F.ws + WS_TOKS) + 2 * r0; const int* tsb = (const int*)(F.ws + WS_TOKS) + 2 * r1;
        const float* twa = (const float*)(F.ws + WS_TOKW) + 2 * r0; const float* twb = (const float*)(F.ws + WS_TOKW) + 2 * r1;
        const int a1 = tsa[0], a2 = tsa[1], b1 = tsb[0], b2 = tsb[1]; const float wa1 = twa[0], wa2 = twa[1], wb1 = twb[0], wb2 = twb[1];
        f32x4 xa[4], xb[4], gva[4], gvb[4], fg[4]; u32x2 ya1[4], ya2[4], yb1[4], yb2[4];
#pragma unroll
        for (int j = 0; j < 4; ++j) { const int c = 4 * F.lane + 256 * j;
            xa[j] = *(const f32x4*)(X1 + (size_t)r0 * D + c); xb[j] = *(const f32x4*)(X1 + (size_t)r1 * D + c);
            ya1[j] = *(const u32x2*)(YS + (size_t)a1 * D + c); ya2[j] = *(const u32x2*)(YS + (size_t)a2 * D + c); yb1[j] = *(const u32x2*)(YS + (size_t)b1 * D + c); yb2[j] = *(const u32x2*)(YS + (size_t)b2 * D + c);
            gva[j] = *(const f32x4*)(ga + c); gvb[j] = *(const f32x4*)(gb + c); fg[j] = *(const f32x4*)(final_g + c); }
        float sa = 0.f, sb = 0.f;
#pragma unroll
        for (int j = 0; j < 4; ++j) {
            f32x4 f; f.x = wa1 * bflo(ya1[j].x) + wa2 * bflo(ya2[j].x); f.y = wa1 * bfhi(ya1[j].x) + wa2 * bfhi(ya2[j].x); f.z = wa1 * bflo(ya1[j].y) + wa2 * bflo(ya2[j].y); f.w = wa1 * bfhi(ya1[j].y) + wa2 * bfhi(ya2[j].y);
            xa[j] = xa[j] + gva[j] * f; sa += (xa[j].x * xa[j].x + xa[j].y * xa[j].y) + (xa[j].z * xa[j].z + xa[j].w * xa[j].w);
            f.x = wb1 * bflo(yb1[j].x) + wb2 * bflo(yb2[j].x); f.y = wb1 * bfhi(yb1[j].x) + wb2 * bfhi(yb2[j].x); f.z = wb1 * bflo(yb1[j].y) + wb2 * bflo(yb2[j].y); f.w = wb1 * bfhi(yb1[j].y) + wb2 * bfhi(yb2[j].y);
            xb[j] = xb[j] + gvb[j] * f; sb += (xb[j].x * xb[j].x + xb[j].y * xb[j].y) + (xb[j].z * xb[j].z + xb[j].w * xb[j].w); }
        const float ra = 1.0f / sqrtf(wave_sum(sa) * (1.f / D) + EPS), rb = 1.0f / sqrtf(wave_sum(sb) * (1.f / D) + EPS);
#pragma unroll
        for (int j = 0; j < 4; ++j) { const int c = 4 * F.lane + 256 * j;
            __builtin_nontemporal_store(xa[j] * ra * fg[j], (f32x4*)(out + (size_t)r0 * D + c)); if (has1) __builtin_nontemporal_store(xb[j] * rb * fg[j], (f32x4*)(out + (size_t)r1 * D + c)); }
    }
}

__device__ __forceinline__ void unpack8(const u32x4 w, float (&f)[8]) { f[0] = bflo(w.x); f[1] = bfhi(w.x); f[2] = bflo(w.y); f[3] = bfhi(w.y); f[4] = bflo(w.z); f[5] = bfhi(w.z); f[6] = bflo(w.w); f[7] = bfhi(w.w); }
__device__ __forceinline__ void local_mix_phase(Frame& F, const float* cw, int nrows, const bool skip16) {
    const bf16* Z = (const bf16*)(F.ws + WS_Z); bf16* MIX = (bf16*)(F.ws + WS_MIX);
    const int vcu = (F.G % 8 == 0) ? (F.bx % 8) * (F.G / 8) + F.bx / 8 : F.bx;
    const int nwk = (skip16 && F.G > 32) ? F.G - 16 : F.G, wk = (skip16 && F.G > 32) ? vcu - 16 : vcu;
    const int total = (nrows / 8) * 64, stride = nwk * NTHR;
    for (int idx = (wk < 0 ? total : wk * NTHR + F.tid); idx < total; idx += stride) {
        const int r0 = (idx >> 6) * 8, cg = idx & 63, c0 = cg * 8;
        int t0, L;
        if (r0 < ML) { t0 = r0 % SEQ; L = SEQ; } else { t0 = (r0 - ML) % CTXL; L = CTXL; }
        const bf16* zb = Z + (size_t)(r0 - t0) * INW;
        { float wa[8], wb[8], wc_[8];
          { const f32x4 a0 = *(const f32x4*)(cw + c0), a1 = *(const f32x4*)(cw + c0 + 4), b0 = *(const f32x4*)(cw + 512 + c0), b1 = *(const f32x4*)(cw + 512 + c0 + 4), d0 = *(const f32x4*)(cw + 1024 + c0), d1 = *(const f32x4*)(cw + 1024 + c0 + 4);
            wa[0] = a0.x; wa[1] = a0.y; wa[2] = a0.z; wa[3] = a0.w; wa[4] = a1.x; wa[5] = a1.y; wa[6] = a1.z; wa[7] = a1.w;
            wb[0] = b0.x; wb[1] = b0.y; wb[2] = b0.z; wb[3] = b0.w; wb[4] = b1.x; wb[5] = b1.y; wb[6] = b1.z; wb[7] = b1.w;
            wc_[0] = d0.x; wc_[1] = d0.y; wc_[2] = d0.z; wc_[3] = d0.w; wc_[4] = d1.x; wc_[5] = d1.y; wc_[6] = d1.z; wc_[7] = d1.w; }
          float pp[8], pc[8], pn[8];
#pragma unroll
          for (int q = 0; q < 8; ++q) pp[q] = 0.f;
          if (t0 > 0) { float cx[8], cc[8]; const bf16* zr = zb + (size_t)(t0 - 1) * INW; unpack8(*(const u32x4*)(zr + ZCX + c0), cx); unpack8(*(const u32x4*)(zr + ZCC + c0), cc);
#pragma unroll
              for (int q = 0; q < 8; ++q) pp[q] = cc[q] * cx[q]; }
          { float cx[8], cc[8]; const bf16* zr = zb + (size_t)t0 * INW; unpack8(*(const u32x4*)(zr + ZCX + c0), cx); unpack8(*(const u32x4*)(zr + ZCC + c0), cc);
#pragma unroll
              for (int q = 0; q < 8; ++q) pc[q] = cc[q] * cx[q]; }
#pragma unroll
          for (int i = 0; i < 8; ++i) { const int t = t0 + i;
#pragma unroll
              for (int q = 0; q < 8; ++q) pn[q] = 0.f;
              if (t + 1 < L) { float cx[8], cc[8]; const bf16* zr = zb + (size_t)(t + 1) * INW; unpack8(*(const u32x4*)(zr + ZCX + c0), cx); unpack8(*(const u32x4*)(zr + ZCC + c0), cc);
#pragma unroll
                  for (int q = 0; q < 8; ++q) pn[q] = cc[q] * cx[q]; }
              float cb[8], o[8]; unpack8(*(const u32x4*)(zb + (size_t)t * INW + ZCB + c0), cb);
#pragma unroll
              for (int q = 0; q < 8; ++q) { o[q] = cb[q] * (wa[q] * pp[q] + wb[q] * pc[q] + wc_[q] * pn[q]); pp[q] = pc[q]; pc[q] = pn[q]; }
              u32x4 w; w.x = pk2(o[0], o[1]); w.y = pk2(o[2], o[3]); w.z = pk2(o[4], o[5]); w.w = pk2(o[6], o[7]);
              *(u32x4*)(MIX + (size_t)(r0 + i) * MIXW + 512 + c0) = w; } }
        { const int hw = 1 << (c0 >> 7);
          float s[8];
#pragma unroll
          for (int q = 0; q < 8; ++q) s[q] = 0.f;
#pragma unroll
          for (int j = -8; j < 8; ++j) { const int tt = t0 + j; if (j >= -hw && j < hw && tt >= 0 && tt < L) { float u[8]; unpack8(*(const u32x4*)(zb + (size_t)tt * INW + ZPU + c0), u);
#pragma unroll
                  for (int q = 0; q < 8; ++q) s[q] += u[q]; } }
#pragma unroll
          for (int i = 0; i < 8; ++i) { const int t = t0 + i; const int lo = t - hw < 0 ? 0 : t - hw, hi = t + hw > L ? L : t + hw;
              float u0[8]; unpack8(*(const u32x4*)(zb + (size_t)t * INW + ZPU + c0), u0);
              const float inv = 1.0f / (float)(hi - lo);
              u32x4 w; w.x = pk2(s[0] * inv - u0[0], s[1] * inv - u0[1]); w.y = pk2(s[2] * inv - u0[2], s[3] * inv - u0[3]);
              w.z = pk2(s[4] * inv - u0[4], s[5] * inv - u0[5]); w.w = pk2(s[6] * inv - u0[6], s[7] * inv - u0[7]);
              *(u32x4*)(MIX + (size_t)(r0 + i) * MIXW + 1024 + c0) = w;
              if (i < 7) {
                  if (t + hw < L) { float u[8]; unpack8(*(const u32x4*)(zb + (size_t)(t + hw) * INW + ZPU + c0), u);
#pragma unroll
                      for (int q = 0; q < 8; ++q) s[q] += u[q]; }
                  if (t - hw >= 0) { float u[8]; unpack8(*(const u32x4*)(zb + (size_t)(t - hw) * INW + ZPU + c0), u);
#pragma unroll
                      for (int q = 0; q < 8; ++q) s[q] -= u[q]; } } } }
    }
}

__device__ __forceinline__ void attn_naive_phase(Frame& F, const float* sinkl, int nrows) {
    const bf16* Z = (const bf16*)(F.ws + WS_Z); bf16* MIX = (bf16*)(F.ws + WS_MIX);
    LAS float* qs = (LAS float*)(F.lds + F.wave * 10240);
    LAS float* sc = qs + 256;
    const int nunits = nrows * 2, NGW = F.G * NWAVES;
    for (int uidx = F.bx * NWAVES + F.wave; uidx < nunits; uidx += NGW) {
        const int r = uidx >> 1, kh = uidx & 1;
        int b, nloc, krow0;
        if (r < ML) { b = r / SEQ; const int t = r % SEQ; const int lo = t - 128 < 0 ? 0 : t - 128, hi = t + 128 > SEQ - 1 ? SEQ - 1 : t + 128; nloc = hi - lo + 1; krow0 = b * SEQ + lo; }
        else { b = (r - ML) / CTXL; nloc = 0; krow0 = 0; }
        const int crow0 = ML + b * CTXL, nk = nloc + CTXL;
        { const u32x2 qw = *(const u32x2*)(Z + (size_t)r * INW + ZQ + kh * 256 + 4 * F.lane); const int g = F.lane >> 4, d = (4 * F.lane) & 63;
          qs[(d + 0) * 4 + g] = bflo(qw.x); qs[(d + 1) * 4 + g] = bfhi(qw.x); qs[(d + 2) * 4 + g] = bflo(qw.y); qs[(d + 3) * 4 + g] = bfhi(qw.y); }
        LDS_WAIT(); asm volatile("" ::: "memory");
        for (int c0 = 0; c0 < nk; c0 += 64) {
            const int kk = c0 + F.lane;
            if (kk < nk) {
                const int krow = kk < nloc ? krow0 + kk : crow0 + (kk - nloc);
                const u32x4* kp = (const u32x4*)(Z + (size_t)krow * INW + ZK + kh * 64);
                f32x4 s = (f32x4){0.f, 0.f, 0.f, 0.f};
#pragma unroll
                for (int d8 = 0; d8 < 8; ++d8) { float kf[8]; unpack8(kp[d8], kf);
#pragma unroll
                    for (int q = 0; q < 8; ++q) { const f32x4 qv = *(const LAS f32x4*)(qs + (d8 * 8 + q) * 4); s += qv * kf[q]; } }
                *(LAS f32x4*)(sc + kk * 4) = s;
            }
        }
        LDS_WAIT(); asm volatile("" ::: "memory");
        f32x4 mx; { const float* sk = sinkl + kh * 4; mx = (f32x4){sk[0] * LOG2E, sk[1] * LOG2E, sk[2] * LOG2E, sk[3] * LOG2E}; }
        const f32x4 snk = mx;
        for (int kk = F.lane; kk < nk; kk += 64) { const f32x4 s = *(const LAS f32x4*)(sc + kk * 4); mx.x = fmaxf(mx.x, s.x); mx.y = fmaxf(mx.y, s.y); mx.z = fmaxf(mx.z, s.z); mx.w = fmaxf(mx.w, s.w); }
        mx.x = wave_max(mx.x); mx.y = wave_max(mx.y); mx.z = wave_max(mx.z); mx.w = wave_max(mx.w);
        f32x4 sm = (f32x4){0.f, 0.f, 0.f, 0.f};
        for (int kk = F.lane; kk < nk; kk += 64) { f32x4 s = *(const LAS f32x4*)(sc + kk * 4);
            s.x = exp2f(s.x - mx.x); s.y = exp2f(s.y - mx.y); s.z = exp2f(s.z - mx.z); s.w = exp2f(s.w - mx.w); sm += s; *(LAS f32x4*)(sc + kk * 4) = s; }
        sm.x = wave_sum(sm.x) + exp2f(snk.x - mx.x); sm.y = wave_sum(sm.y) + exp2f(snk.y - mx.y); sm.z = wave_sum(sm.z) + exp2f(snk.z - mx.z); sm.w = wave_sum(sm.w) + exp2f(snk.w - mx.w);
        LDS_WAIT(); asm volatile("" ::: "memory");
        f32x4 o = (f32x4){0.f, 0.f, 0.f, 0.f};
        const bf16* vb = Z + ZV + kh * 64 + F.lane;
#pragma unroll 4
        for (int kk = 0; kk < nk; ++kk) { const int krow = kk < nloc ? krow0 + kk : crow0 + (kk - nloc);
            const float v = bf2f((unsigned)vb[(size_t)krow * INW]); const f32x4 p = *(const LAS f32x4*)(sc + kk * 4); o += p * v; }
        bf16* op = MIX + (size_t)r * MIXW + kh * 256 + F.lane;
        op[0] = (bf16)f2bf(o.x / sm.x); op[64] = (bf16)f2bf(o.y / sm.y); op[128] = (bf16)f2bf(o.z / sm.z); op[192] = (bf16)f2bf(o.w / sm.w);
        LDS_WAIT(); asm volatile("" ::: "memory");
    }
}

typedef float f32x16 __attribute__((ext_vector_type(16)));
typedef short s16x4 __attribute__((ext_vector_type(4)));
__device__ __forceinline__ unsigned cvtpk(float lo, float hi) { f32x2 v = {lo, hi}; pg8::bf16x2_t b = __builtin_convertvector(v, pg8::bf16x2_t); return __builtin_bit_cast(unsigned, b); }
__device__ __forceinline__ s16x4 vtr(const LAS unsigned char* p) { return __builtin_bit_cast(s16x4, __builtin_amdgcn_ds_read_tr16_b64_v4i16((LAS s16x4*)p)); }
constexpr int AKP = 144, ATT_V_OFF = 128 * AKP;
__device__ __forceinline__ void attn_unit(Frame& F, const bf16* Z, bf16* MIX, const float* sinkl, const bool isctx, const int b, const int kh, const int qblk) {
    const int qrow0 = isctx ? ML + b * CTXL + qblk * 128 : b * SEQ + qblk * 128;
    const int cbase = ML + b * CTXL;
    const bool has_prev = !isctx && qblk > 0, has_next = !isctx && qblk < 31;
    const int nch = isctx ? 2 : 3 + (has_prev ? 1 : 0) + (has_next ? 1 : 0);
    const int lane = F.lane, r = lane & 31, h = lane >> 5, g = F.wave >> 1, qh = F.wave & 1, head = kh * 4 + g;
    LAS unsigned char* Ks = F.lds; LAS unsigned char* Vs = F.lds + ATT_V_OFF;
    bf16x8 qf[2][4];
#pragma unroll
    for (int sub = 0; sub < 2; ++sub)
#pragma unroll
        for (int ks = 0; ks < 4; ++ks) qf[sub][ks] = *(const bf16x8*)(Z + (size_t)(qrow0 + 64 * qh + 32 * sub + r) * INW + ZQ + head * 64 + 16 * ks + 8 * h);
    const float sk = sinkl[head] * LOG2E;
    float m[2], l[2]; f32x16 O[2][2];
#pragma unroll
    for (int sub = 0; sub < 2; ++sub) { m[sub] = sk; l[sub] = h == 0 ? 1.f : 0.f;
#pragma unroll
        for (int db = 0; db < 2; ++db)
#pragma unroll
            for (int i = 0; i < 16; ++i) O[sub][db][i] = 0.f; }
#define ATT_CHUNK(ci, row0, kind) do { if (isctx) { row0 = cbase + 128 * (ci); kind = 0; } else if ((ci) == 0) { row0 = qrow0; kind = 0; } else if ((ci) <= 2) { row0 = cbase + 128 * ((ci) - 1); kind = 0; } \
        else if ((ci) == 3 && has_prev) { row0 = qrow0 - 128; kind = 1; } else { row0 = qrow0 + 128; kind = 2; } } while (0)
    const int skey = F.tid >> 3, spart = F.tid & 7;
    u32x4 pk0, pk1, pv0, pv1;
#define ATT_LOAD(ci) do { int row0_, kind_; ATT_CHUNK(ci, row0_, kind_); (void)kind_; const bf16* kp_ = Z + (size_t)(row0_ + skey) * INW + ZK + kh * 64 + spart * 8; \
        pk0 = *(const u32x4*)kp_; pk1 = *(const u32x4*)(kp_ + (size_t)64 * INW); pv0 = *(const u32x4*)(kp_ + (ZV - ZK)); pv1 = *(const u32x4*)(kp_ + (size_t)64 * INW + (ZV - ZK)); } while (0)
    ATT_LOAD(0);
    const int grp = (lane >> 4) & 1, q4 = (lane & 15) >> 2, p4 = lane & 3;
    for (int ci = 0; ci < nch; ++ci) {
        __syncthreads();
        *(LAS u32x4*)(Ks + skey * AKP + spart * 16) = pk0; *(LAS u32x4*)(Ks + (skey + 64) * AKP + spart * 16) = pk1;
        *(LAS u32x4*)(Vs + skey * AKP + spart * 16) = pv0; *(LAS u32x4*)(Vs + (skey + 64) * AKP + spart * 16) = pv1;
        if (ci + 1 < nch) ATT_LOAD(ci + 1);
        __syncthreads();
        int row0, kind; ATT_CHUNK(ci, row0, kind); (void)row0;
        int dl = 4 * h - r - 64 * qh; asm volatile("" : "+v"(dl));
        for (int t = 0; t < 4; ++t) {
            if (kind == 1 && 32 * t + 31 < 64 * qh) continue;
            if (kind == 2 && 32 * t > 64 * qh + 63) continue;
            bf16x8 kf[4], vf[2][2];
#pragma unroll
            for (int ks = 0; ks < 4; ++ks) kf[ks] = *(const LAS bf16x8*)(Ks + (32 * t + r) * AKP + 32 * ks + 16 * h);
#pragma unroll
            for (int s = 0; s < 2; ++s)
#pragma unroll
                for (int db = 0; db < 2; ++db) { const LAS unsigned char* vp = Vs + (32 * t + 16 * s + 4 * h + q4) * AKP + (32 * db + 16 * grp + 4 * p4) * 2;
                    const s16x4 lo = vtr(vp), hi = vtr(vp + 8 * AKP); vf[s][db] = __builtin_shufflevector(lo, hi, 0, 1, 2, 3, 4, 5, 6, 7); }
#pragma unroll
            for (int sub = 0; sub < 2; ++sub) {
                if (kind == 1 && 32 * t + 31 < 64 * qh + 32 * sub) continue;
                if (kind == 2 && 32 * t > 64 * qh + 32 * sub + 31) continue;
                f32x16 S;
#pragma unroll
                for (int i = 0; i < 16; ++i) S[i] = 0.f;
#pragma unroll
                for (int ks = 0; ks < 4; ++ks) S = __builtin_amdgcn_mfma_f32_32x32x16_bf16(kf[ks], qf[sub][ks], S, 0, 0, 0);
                if (kind != 0) { const int d0 = dl + 32 * t - 32 * sub;
#pragma unroll
                    for (int i = 0; i < 16; ++i) { const int dd = d0 + (i & 3) + 8 * (i >> 2); const bool ok = kind == 1 ? (dd >= 0) : (dd <= 0); S[i] = ok ? S[i] : -1.0e30f; } }
                float tmax = S[0];
#pragma unroll
                for (int i = 1; i < 16; ++i) tmax = fmaxf(tmax, S[i]);
                tmax = fmaxf(tmax, __shfl_xor(tmax, 32));
                const float mnew = fmaxf(m[sub], tmax);
                if (__any(mnew > m[sub])) { const float alpha = __builtin_amdgcn_exp2f(m[sub] - mnew); l[sub] *= alpha; m[sub] = mnew;
#pragma unroll
                    for (int db = 0; db < 2; ++db)
#pragma unroll
                        for (int i = 0; i < 16; ++i) O[sub][db][i] *= alpha; }
                float ps = 0.f;
#pragma unroll
                for (int i = 0; i < 16; ++i) { S[i] = __builtin_amdgcn_exp2f(S[i] - m[sub]); ps += S[i]; }
                l[sub] += ps;
                u32x4 w0, w1; w0.x = cvtpk(S[0], S[1]); w0.y = cvtpk(S[2], S[3]); w0.z = cvtpk(S[4], S[5]); w0.w = cvtpk(S[6], S[7]);
                w1.x = cvtpk(S[8], S[9]); w1.y = cvtpk(S[10], S[11]); w1.z = cvtpk(S[12], S[13]); w1.w = cvtpk(S[14], S[15]);
                const bf16x8 P0 = __builtin_bit_cast(bf16x8, w0), P1 = __builtin_bit_cast(bf16x8, w1);
#pragma unroll
                for (int db = 0; db < 2; ++db) { O[sub][db] = __builtin_amdgcn_mfma_f32_32x32x16_bf16(vf[0][db], P0, O[sub][db], 0, 0, 0); O[sub][db] = __builtin_amdgcn_mfma_f32_32x32x16_bf16(vf[1][db], P1, O[sub][db], 0, 0, 0); }
            }
        }
    }
#undef ATT_CHUNK
#undef ATT_LOAD
#pragma unroll
    for (int sub = 0; sub < 2; ++sub) { const float lt = l[sub] + __shfl_xor(l[sub], 32), inv = 1.f / lt;
        bf16* op = MIX + (size_t)(qrow0 + 64 * qh + 32 * sub + r) * MIXW + head * 64 + 4 * h;
#pragma unroll
        for (int db = 0; db < 2; ++db)
#pragma unroll
            for (int gq = 0; gq < 4; ++gq) { u32x2 w; w.x = cvtpk(O[sub][db][4 * gq] * inv, O[sub][db][4 * gq + 1] * inv); w.y = cvtpk(O[sub][db][4 * gq + 2] * inv, O[sub][db][4 * gq + 3] * inv);
                *(u32x2*)(op + 32 * db + 8 * gq) = w; } }
}
__device__ __forceinline__ void attn_mfma_phase(Frame& F, const float* sinkl, const bool with_ctx) {
    const bf16* Z = (const bf16*)(F.ws + WS_Z); bf16* MIX = (bf16*)(F.ws + WS_MIX);
    const int vcu = (F.G % 8 == 0) ? (F.bx % 8) * (F.G / 8) + F.bx / 8 : F.bx;
    const int nun = with_ctx ? 272 : 256;
    for (int u = vcu; u < nun; u += F.G) { const bool isctx = u >= 256; const int uu = isctx ? (u - 256) : u;
        attn_unit(F, Z, MIX, sinkl, isctx, isctx ? (uu >> 2) : (uu >> 6), isctx ? ((uu >> 1) & 1) : ((uu >> 5) & 1), isctx ? (uu & 1) : (uu & 31)); }
    __syncthreads();
}

using pg8::Unit;
struct SchedStd {
    const char* A; const char* B; size_t astep, bstep; int nM, nN, G, c, nx, xpm0, xpn;
    __device__ __forceinline__ bool next(int i, Unit& u) const {
        const int L = i * G + c, nwg = nM * nN; if (L >= nwg + nx) return false;
        if (L < nwg) pg8::tile_of(L, nM, nN, u.pm, u.pn); else { u.pm = xpm0 + (L - nwg); u.pn = xpn; }
        u.tag = 0; u.a = A + (size_t)u.pm * astep; u.b = B + (size_t)u.pn * bstep; return true;
    }
};
struct SchedMoe {
    const char* A; const char* B; size_t astep, bstep_e, bstep_n; int NJ, G, c; const int* tile;
    __device__ __forceinline__ bool next(int i, Unit& u) const {
        const int nt = __builtin_amdgcn_readfirstlane(__hip_atomic_load(tile + 200, __ATOMIC_RELAXED, __HIP_MEMORY_SCOPE_AGENT));
        const int L = i * G + c; if (L >= nt * NJ) return false;
        u.pm = L % nt; u.pn = L / nt; u.tag = __builtin_amdgcn_readfirstlane(__hip_atomic_load(tile + u.pm, __ATOMIC_RELAXED, __HIP_MEMORY_SCOPE_AGENT));
        u.a = A + (size_t)u.pm * astep; u.b = B + (size_t)u.tag * bstep_e + (size_t)u.pn * bstep_n; return true;
    }
};

struct EpiGate {
    static constexpr bool PERM = true, MIDHOOK = false;
    bf16* Z;
    __device__ __forceinline__ void operator()(const f32x4 (&acc)[2][2][4][2], const Unit& u, int wr, int wc, int fr, int fq) const {
        const int row0 = u.pm * 256 + wr * 64 + fr, col0 = ZG + u.pn * 256 + wc * 32 + 8 * fq;
#pragma unroll
        for (int ai = 0; ai < 2; ++ai)
#pragma unroll
            for (int m = 0; m < 4; ++m)
#pragma unroll
                for (int bj = 0; bj < 2; ++bj) { f32x4 v0 = acc[ai][bj][m][0], v1 = acc[ai][bj][m][1];
#pragma unroll
                    for (int q = 0; q < 4; ++q) { v0[q] = __builtin_amdgcn_rcpf(1.f + __expf(-v0[q])); v1[q] = __builtin_amdgcn_rcpf(1.f + __expf(-v1[q])); }
                    u32x4 w; w.x = pg8::cvt_pk_bf16(v0[0], v0[1]); w.y = pg8::cvt_pk_bf16(v0[2], v0[3]); w.z = pg8::cvt_pk_bf16(v1[0], v1[1]); w.w = pg8::cvt_pk_bf16(v1[2], v1[3]);
                    *(u32x4*)(Z + (size_t)(row0 + ai * 128 + m * 16) * INW + col0 + bj * 128) = w; }
    }
};
struct EpiIn {
    static constexpr bool PERM = true, MIDHOOK = false;
    bf16* Z; const float* rope;
    __device__ __forceinline__ void operator()(const f32x4 (&acc)[2][2][4][2], const Unit& u, int wr, int wc, int fr, int fq) const {
        const int row0 = u.pm * 256 + wr * 64 + fr, col0 = u.pn * 256 + wc * 32 + 8 * fq;
        const bool latent = u.pm < 64, gate = u.pn >= 11;
        const float sgn = fq < 2 ? -1.f : 1.f;
#pragma unroll
        for (int ai = 0; ai < 2; ++ai)
#pragma unroll
            for (int m = 0; m < 4; ++m) { const int row = row0 + ai * 128 + m * 16; bf16* rowp = Z + (size_t)row * INW + col0;
                const int pos = (wc & 1) ? (16 * m + fr) : (4 * (u.pm & 15) + 2 * ai + wr);
#pragma unroll
                for (int bj = 0; bj < 2; ++bj) { f32x4 v0 = acc[ai][bj][m][0], v1 = acc[ai][bj][m][1];
                    const bool isq = u.pn < 2, isk = (u.pn == 2 && bj == 0);
                    if (isq || isk) {
                        if (latent) {
                            const f32x4* cs = (const f32x4*)(rope + (size_t)(pos * 16 + 8 * (fq & 1)) * 2);
                            const f32x4 t0 = cs[0], t1 = cs[1], t2 = cs[2], t3 = cs[3];
                            f32x4 p0, p1;
                            p0.x = __shfl_xor(v0.x, 32); p0.y = __shfl_xor(v0.y, 32); p0.z = __shfl_xor(v0.z, 32); p0.w = __shfl_xor(v0.w, 32);
                            p1.x = __shfl_xor(v1.x, 32); p1.y = __shfl_xor(v1.y, 32); p1.z = __shfl_xor(v1.z, 32); p1.w = __shfl_xor(v1.w, 32);
                            v0.x = v0.x * t0.x + p0.x * (sgn * t0.y); v0.y = v0.y * t0.z + p0.y * (sgn * t0.w); v0.z = v0.z * t1.x + p0.z * (sgn * t1.y); v0.w = v0.w * t1.z + p0.w * (sgn * t1.w);
                            v1.x = v1.x * t2.x + p1.x * (sgn * t2.y); v1.y = v1.y * t2.z + p1.y * (sgn * t2.w); v1.z = v1.z * t3.x + p1.z * (sgn * t3.y); v1.w = v1.w * t3.z + p1.w * (sgn * t3.w);
                        }
                        if (isq) { v0 = v0 * QSCALE; v1 = v1 * QSCALE; }
                    }
                    if (gate) {
#pragma unroll
                        for (int q = 0; q < 4; ++q) { v0[q] = 1.f / (1.f + __expf(-v0[q])); v1[q] = 1.f / (1.f + __expf(-v1[q])); } }
                    u32x4 w; w.x = pg8::cvt_pk_bf16(v0[0], v0[1]); w.y = pg8::cvt_pk_bf16(v0[2], v0[3]); w.z = pg8::cvt_pk_bf16(v1[0], v1[1]); w.w = pg8::cvt_pk_bf16(v1[2], v1[3]);
                    *(u32x4*)(rowp + bj * 128) = w; } }
    }
};
struct EpiBrG {
    static constexpr bool PERM = true, MIDHOOK = true;
    const bf16* Z; bf16* Y;
    __device__ __forceinline__ void mid(f32x4 (&acc)[2][2][4][2], const Unit& u, int seg, int wr, int wc, int fr, int fq) const {
        const int row0 = u.pm * 256 + wr * 64 + fr, col0 = u.pn * 256 + wc * 32 + 8 * fq;
#pragma unroll
        for (int ai = 0; ai < 2; ++ai)
#pragma unroll
            for (int m = 0; m < 4; ++m) { const bf16* gp = Z + (size_t)(row0 + ai * 128 + m * 16) * INW + ZG + (seg - 1) * D + col0;
#pragma unroll
                for (int bj = 0; bj < 2; ++bj) { const u32x4 ga = *(const u32x4*)(gp + bj * 128), gb = *(const u32x4*)(gp + D + bj * 128);
                    f32x4 r0, r1;
                    r0.x = bflo(ga.x) * __builtin_amdgcn_rcpf(bflo(gb.x)); r0.y = bfhi(ga.x) * __builtin_amdgcn_rcpf(bfhi(gb.x)); r0.z = bflo(ga.y) * __builtin_amdgcn_rcpf(bflo(gb.y)); r0.w = bfhi(ga.y) * __builtin_amdgcn_rcpf(bfhi(gb.y));
                    r1.x = bflo(ga.z) * __builtin_amdgcn_rcpf(bflo(gb.z)); r1.y = bfhi(ga.z) * __builtin_amdgcn_rcpf(bfhi(gb.z)); r1.z = bflo(ga.w) * __builtin_amdgcn_rcpf(bflo(gb.w)); r1.w = bfhi(ga.w) * __builtin_amdgcn_rcpf(bfhi(gb.w));
                    acc[ai][bj][m][0] *= r0; acc[ai][bj][m][1] *= r1; }
                asm volatile("" ::: "memory"); }
    }
    __device__ __forceinline__ void operator()(const f32x4 (&acc)[2][2][4][2], const Unit& u, int wr, int wc, int fr, int fq) const {
        const int row0 = u.pm * 256 + wr * 64 + fr, col0 = u.pn * 256 + wc * 32 + 8 * fq;
#pragma unroll
        for (int ai = 0; ai < 2; ++ai)
#pragma unroll
            for (int m = 0; m < 4; ++m) { const size_t row = (size_t)(row0 + ai * 128 + m * 16); const bf16* gp = Z + row * INW + ZG + 2 * D + col0;
#pragma unroll
                for (int bj = 0; bj < 2; ++bj) { const u32x4 g = *(const u32x4*)(gp + bj * 128); const f32x4 v0 = acc[ai][bj][m][0], v1 = acc[ai][bj][m][1];
                    u32x4 w; w.x = pg8::cvt_pk_bf16(v0[0] * bflo(g.x), v0[1] * bfhi(g.x)); w.y = pg8::cvt_pk_bf16(v0[2] * bflo(g.y), v0[3] * bfhi(g.y));
                    w.z = pg8::cvt_pk_bf16(v1[0] * bflo(g.z), v1[1] * bfhi(g.z)); w.w = pg8::cvt_pk_bf16(v1[2] * bflo(g.w), v1[3] * bfhi(g.w));
                    *(u32x4*)(Y + row * D + col0 + bj * 128) = w; } }
    }
};
struct EpiRes {
    static constexpr bool PERM = true, MIDHOOK = false;
    const float* rl; const float* rc; float* out; const float* gv;
    __device__ __forceinline__ void operator()(const f32x4 (&acc)[2][2][4][2], const Unit& u, int wr, int wc, int fr, int fq) const {
        const int row0 = u.pm * 256 + wr * 64 + fr, col0 = u.pn * 256 + wc * 32 + 8 * fq;
        const int bidx = u.pm < 64 ? (u.pm >> 4) : 4; const float* g = gv + (size_t)bidx * MODW;
        const float* rbase = u.pm < 64 ? rl : rc - (size_t)ML * D;
        f32x4 gg[2][2];
#pragma unroll
        for (int bj = 0; bj < 2; ++bj)
#pragma unroll
            for (int n = 0; n < 2; ++n) gg[bj][n] = *(const f32x4*)(g + col0 + bj * 128 + n * 4);
#pragma unroll
        for (int ai = 0; ai < 2; ++ai)
#pragma unroll
            for (int m = 0; m < 4; ++m) { const size_t off = (size_t)(row0 + ai * 128 + m * 16) * D + col0;
#pragma unroll
                for (int bj = 0; bj < 2; ++bj)
#pragma unroll
                    for (int n = 0; n < 2; ++n) *(f32x4*)(out + off + bj * 128 + n * 4) = *(const f32x4*)(rbase + off + bj * 128 + n * 4) + gg[bj][n] * acc[ai][bj][m][n]; }
    }
};
template <bool F8> struct EpiSwiglu {
    static constexpr bool PERM = true, MIDHOOK = false;
    unsigned char* ACT; int ldc;
    __device__ __forceinline__ void operator()(const f32x4 (&acc)[2][2][4][2], const Unit& u, int wr, int wc, int fr, int fq) const {
        const int row0 = u.pm * 256 + wr * 64 + fr, col0 = u.pn * 128 + wc * 32 + 8 * fq;
#pragma unroll
        for (int ai = 0; ai < 2; ++ai)
#pragma unroll
            for (int m = 0; m < 4; ++m) { f32x4 r[2];
#pragma unroll
                for (int n = 0; n < 2; ++n) { const f32x4 g = acc[ai][0][m][n], up = acc[ai][1][m][n];
#pragma unroll
                    for (int q = 0; q < 4; ++q) r[n][q] = g[q] * __builtin_amdgcn_rcpf(1.f + __expf(-g[q])) * up[q]; }
                if constexpr (F8) { u32x2 w; w.x = pk4_fp8(r[0][0], r[0][1], r[0][2], r[0][3]); w.y = pk4_fp8(r[1][0], r[1][1], r[1][2], r[1][3]);
                    *(u32x2*)(ACT + (size_t)(row0 + ai * 128 + m * 16) * ldc + col0) = w; }
                else { u32x4 w; w.x = pg8::cvt_pk_bf16(r[0][0], r[0][1]); w.y = pg8::cvt_pk_bf16(r[0][2], r[0][3]); w.z = pg8::cvt_pk_bf16(r[1][0], r[1][1]); w.w = pg8::cvt_pk_bf16(r[1][2], r[1][3]);
                    *(u32x4*)((bf16*)ACT + (size_t)(row0 + ai * 128 + m * 16) * ldc + col0) = w; } }
    }
};
struct EpiPlain {
    static constexpr bool PERM = true, MIDHOOK = false;
    bf16* O; int ldc;
    __device__ __forceinline__ void operator()(const f32x4 (&acc)[2][2][4][2], const Unit& u, int wr, int wc, int fr, int fq) const {
        const int row0 = u.pm * 256 + wr * 64 + fr, col0 = u.pn * 256 + wc * 32 + 8 * fq;
#pragma unroll
        for (int ai = 0; ai < 2; ++ai)
#pragma unroll
            for (int m = 0; m < 4; ++m)
#pragma unroll
                for (int bj = 0; bj < 2; ++bj) { const f32x4 v0 = acc[ai][bj][m][0], v1 = acc[ai][bj][m][1];
                    u32x4 w; w.x = pg8::cvt_pk_bf16(v0[0], v0[1]); w.y = pg8::cvt_pk_bf16(v0[2], v0[3]); w.z = pg8::cvt_pk_bf16(v1[0], v1[1]); w.w = pg8::cvt_pk_bf16(v1[2], v1[3]);
                    *(u32x4*)(O + (size_t)(row0 + ai * 128 + m * 16) * ldc + col0 + bj * 128) = w; }
    }
};

#ifndef PHASE_MASK
#define PHASE_MASK 0xFFFFFFFFu
#endif
#define IN(k) (((PHASE_MASK >> (k)) & 1u) && lo <= (k) && (k) < hi)
#define SEAM(k) do { if (IN(k) && IN((k) + 1)) xcd_barrier(bar); } while (0)
#ifndef DUP_MASK
#define DUP_MASK 0u
#endif
#define REP(k) for (int rep_ = 0; rep_ < (((DUP_MASK >> (k)) & 1u) ? 2 : 1); ++rep_, (((DUP_MASK >> (k)) & 1u) && rep_ == 1 ? xcd_barrier(bar) : (void)0))
#define SITE() do { F.ws = (unsigned char*)karg_p<(int)__builtin_offsetof(Args, ws)>(); int t_ = threadIdx.x; asm volatile("" : "+v"(t_)); F.tid = t_; F.lane = t_ & 63; } while (0)
template <int l> __device__ __forceinline__ void layer_common(Frame& F, const int lo, const int hi, const XcdBarrier& bar, LAS unsigned char* ring) {
    constexpr int pb = 1 + 8 * l;
        if (IN(pb + 0)) REP(pb + 0) { SITE(); const float* modl = (const float*)(F.ws + WS_MODV) + (size_t)l * 5 * MODW; const float* X2 = (const float*)(F.ws + WS_X2);
            const float* xl = l == 0 ? KP(x) : X2; const float* xc = l == 0 ? KP(ctx) : X2 + (size_t)ML * D;
            norm_mod_phase<false, 2>(F, xl, xc, KP(norm1_g) + l * D, modl, 0, 1, MT, nullptr); } SEAM(pb + 0);
        if (IN(pb + 1)) REP(pb + 1) { SITE();
            { SchedStd S{(const char*)(F.ws + WS_H), (const char*)(F.ws + WS_WIN) + (size_t)l * ZG * D * 2, (size_t)256 * D * 2, (size_t)256 * D * 2, l == 0 ? 68 : 64, 11, F.G, F.bx, l == 0 ? 0 : 4, 64, 2};
              EpiIn E{(bf16*)(F.ws + WS_Z), (const float*)(F.ws + WS_ROPE)};
              pg8::gemm_phase<EpiIn, SchedStd, true, true>(ring, D * 2, D * 2, D * 2, S, E); }
            { SITE(); SchedStd S{(const char*)(F.ws + WS_H8), (const char*)(F.ws + WS_WIN8) + (size_t)l * 3 * D * D, (size_t)256 * D, (size_t)256 * D, l == 0 ? 68 : 64, 12, F.G, (F.bx + 20) % F.G, 0, 0, 0};
              EpiGate E{(bf16*)(F.ws + WS_Z)};
              pg8::gemm_phase<EpiGate, SchedStd, true, true, true>(ring, D, D, D, S, E); }
        } SEAM(pb + 1);
        if (IN(pb + 2)) REP(pb + 2) { SITE(); const int nrows = l == 0 ? MT : ML; if (ATTN_NAIVE) attn_naive_phase(F, KP(sink) + l * 8, nrows); else { for (int rp_ = 0; rp_ < 1 + PROBE_ATT; ++rp_) attn_mfma_phase(F, KP(sink) + l * 8, l == 0); } for (int rp_ = 0; rp_ < 1 + PROBE_MIXL; ++rp_) local_mix_phase(F, KP(conv_w) + (size_t)l * 3 * 512, nrows, l == 0 && !ATTN_NAIVE); } SEAM(pb + 2);
        if (IN(pb + 3)) REP(pb + 3) { SITE();
            SchedStd S{(const char*)(F.ws + WS_MIX), (const char*)(F.ws + WS_WBR) + (size_t)l * D * MIXW * 2, (size_t)256 * MIXW * 2, (size_t)256 * MIXW * 2, l == 0 ? 68 : 64, 4, F.G, F.bx, 0, 0, 0};
            EpiBrG E{(const bf16*)(F.ws + WS_Z), (bf16*)(F.ws + WS_Y)};
            pg8::gemm_phase<EpiBrG, SchedStd, true, true>(ring, MIXW * 2, MIXW * 2, MIXW * 2, S, E);
        } SEAM(pb + 3);
        if (IN(pb + 4)) REP(pb + 4) { SITE(); const float* modl = (const float*)(F.ws + WS_MODV) + (size_t)l * 5 * MODW; const float* X2 = (const float*)(F.ws + WS_X2);
            const float* xl = l == 0 ? KP(x) : X2; const float* xc = l == 0 ? KP(ctx) : X2 + (size_t)ML * D;
            SchedStd S{(const char*)(F.ws + WS_Y), (const char*)(F.ws + WS_WOUT) + (size_t)l * D * D * 2, (size_t)256 * D * 2, (size_t)256 * D * 2, l == 0 ? 68 : 64, 4, F.G, F.bx, 0, 0, 0};
            EpiRes E{xl, xc, (float*)(F.ws + WS_X1), modl + 2 * D};
            pg8::gemm_phase<EpiRes, SchedStd, true, true>(ring, D * 2, D * 2, D * 2, S, E);
        } SEAM(pb + 4);
}
constexpr int N_PHASES = 19;
__global__ void __launch_bounds__(NTHR, 2) mk_fwd(Args args_byval) {
    extern __shared__ __attribute__((aligned(16))) unsigned char lds_raw[];
    Frame F;
    F.lds = (LAS unsigned char*)lds_raw;
    F.tid = threadIdx.x; F.lane = F.tid & 63; F.wave = __builtin_amdgcn_readfirstlane(F.tid >> 6);
    F.G = gridDim.x; F.bx = blockIdx.x;
    SITE();
    volatile LAS unsigned* MISC = (volatile LAS unsigned*)(F.lds + MISC_OFF);
    for (int u = F.tid; u < (LDS_BYTES - LDSCTL_OFF) / 4; u += NTHR) ((LAS unsigned*)(F.lds + LDSCTL_OFF))[u] = 0u;
    __syncthreads();
    const int lo = karg_i<(int)__builtin_offsetof(Args, ph_lo)>(), hi = karg_i<(int)__builtin_offsetof(Args, ph_hi)>();
    const bool fused = (hi - lo) > 1;
    XcdBarrier bar; bar.bar = (unsigned*)(F.ws + WS_CTL) + CW_BAR; bar.x = 0; bar.st = nullptr;
    if (fused) bar = xcd_barrier_post((unsigned*)(F.ws + WS_CTL) + CW_BAR, MISC + 8);
    LAS unsigned char* ring = F.lds;

    if (IN(0)) REP(0) { SITE(); p0_prologue(F); } SEAM(0);

    layer_common<0>(F, lo, hi, bar, ring);
    {
            if (IN(6)) REP(6) { SITE(); const float* X1 = (const float*)(F.ws + WS_X1); norm_mod_phase<false, FFN0_FP8 ? 1 : 0>(F, X1, X1 + (size_t)ML * D, KP(norm2_g), (const float*)(F.ws + WS_MODV), 3, 4, MT, nullptr); } SEAM(6);
            if (IN(7)) REP(7) { SITE();
                constexpr int EB = FFN0_FP8 ? 1 : 2;
                SchedStd S{(const char*)(F.ws + WS_H), (const char*)(F.ws + WS_WGU0), (size_t)256 * D * EB, (size_t)256 * D * EB, 68, 22, F.G, F.bx, 0, 0, 0};
                EpiSwiglu<(FFN0_FP8 || DN0_FP8)> E{(unsigned char*)(F.ws + WS_ACT), DFF};
                pg8::gemm_phase<EpiSwiglu<(FFN0_FP8 || DN0_FP8)>, SchedStd, true, true, FFN0_FP8 != 0>(ring, D * EB, D * EB, D * EB, S, E);
            } SEAM(7);
            if (IN(8)) REP(8) { SITE(); const float* X1 = (const float*)(F.ws + WS_X1);
                constexpr int EB = (FFN0_FP8 || DN0_FP8) ? 1 : 2;
                SchedStd S{(const char*)(F.ws + WS_ACT), (const char*)(F.ws + WS_WDN0), (size_t)256 * DFF * EB, (size_t)256 * DFF * EB, 68, 4, F.G, F.bx, 0, 0, 0};
                EpiRes E{X1, X1 + (size_t)ML * D, (float*)(F.ws + WS_X2), (const float*)(F.ws + WS_MODV) + 5 * D};
                pg8::gemm_phase<EpiRes, SchedStd, true, true, (FFN0_FP8 || DN0_FP8)>(ring, DFF * EB, DFF * EB, DFF * EB, S, E);
            } SEAM(8);
    }
    layer_common<1>(F, lo, hi, bar, ring);
    {
            if (IN(14)) REP(14) { SITE(); const float* X1 = (const float*)(F.ws + WS_X1); norm_mod_phase<true, 1>(F, X1, X1, KP(norm2_g) + D, (const float*)(F.ws + WS_MODV) + (size_t)5 * MODW, 3, 4, ML, KP(router_w)); } SEAM(14);
            if (IN(15)) REP(15) { SITE(); moe_scatter_phase(F); } SEAM(15);
            if (IN(16)) REP(16) { SITE();
                SchedMoe S{(const char*)(F.ws + WS_H2S), (const char*)(F.ws + WS_WMGU), (size_t)256 * D, (size_t)2 * DFE * D, (size_t)256 * D, 28, F.G, F.bx, (const int*)(F.ws + WS_TILE)};
                EpiSwiglu<true> E{(unsigned char*)(F.ws + WS_ACT), DFE};
                pg8::gemm_phase<EpiSwiglu<true>, SchedMoe, true, true, true>(ring, D, D, D, S, E);
            } SEAM(16);
            if (IN(17)) REP(17) { SITE();
                SchedMoe S{(const char*)(F.ws + WS_ACT), (const char*)(F.ws + WS_WMDN), (size_t)256 * DFE, (size_t)D * DFE, (size_t)256 * DFE, 4, F.G, F.bx, (const int*)(F.ws + WS_TILE)};
                EpiPlain E{(bf16*)(F.ws + WS_YS), D};
                pg8::gemm_phase<EpiPlain, SchedMoe, true, true, true>(ring, DFE, DFE, DFE, S, E);
            } SEAM(17);
            if (IN(18)) REP(18) { SITE(); final_phase(F, KP(final_g), (float*)karg_p<(int)__builtin_offsetof(Args, out)>(), (const float*)(F.ws + WS_MODV) + (size_t)5 * MODW); }
        }

#undef IN
#undef SEAM
}

extern "C" void kernel_launch(void* const* d_in, const int* in_sizes, int n_in, void* d_out, int out_size, void* d_ws, size_t ws_size, hipStream_t stream) {
    static int grid = 0;
    if (grid == 0) {
        if (n_in != 21 || out_size != ML * D || ws_size < WS_END) { fprintf(stderr, "kernel_launch: unexpected sizes (n_in %d, out %d, ws %zu < %zu)\n", n_in, out_size, ws_size, (size_t)WS_END); grid = -1; return; }
        int dev = 0, cus = 0, per_cu = 0;
        if (hipGetDevice(&dev) != hipSuccess || hipDeviceGetAttribute(&cus, hipDeviceAttributeMultiprocessorCount, dev) != hipSuccess) { grid = -1; return; }
        if (hipFuncSetAttribute((const void*)mk_fwd, hipFuncAttributeMaxDynamicSharedMemorySize, LDS_BYTES) != hipSuccess) { fprintf(stderr, "kernel_launch: hipFuncSetAttribute failed\n"); grid = -1; return; }
        if (hipOccupancyMaxActiveBlocksPerMultiprocessor(&per_cu, (const void*)mk_fwd, NTHR, LDS_BYTES) != hipSuccess || per_cu < 1) { fprintf(stderr, "kernel_launch: occupancy query says %d\n", per_cu); per_cu = 1; }
        (void)hipGetLastError();
        grid = cus;
    }
    if (grid < 0) return;
    (void)hipMemsetAsync((char*)d_ws + WS_CTL, 0, CTL_ZERO_BYTES, stream);
    Args a{};
    const float** pp = (const float**)&a;
    for (int i = 0; i < 21; ++i) pp[i] = (const float*)d_in[i];
    a.out = (float*)d_out; a.ws = (unsigned char*)d_ws;
#if MK_FUSED
    a.ph_lo = 0; a.ph_hi = N_PHASES;
    hipLaunchKernelGGL(mk_fwd, dim3(grid), dim3(NTHR), LDS_BYTES, stream, a);
#else
    for (int p = 0; p < N_PHASES; ++p) { a.ph_lo = p; a.ph_hi = p + 1; hipLaunchKernelGGL(mk_fwd, dim3(grid), dim3(NTHR), LDS_BYTES, stream, a); }
#endif
}
```

```cpp
#include <hip/hip_runtime.h>
#include <cstdio>
#include <cstdint>

#ifndef ATTN_NAIVE
#define ATTN_NAIVE 0
#endif
#ifndef DN0_FP8
#define DN0_FP8 1
#endif
#ifndef FFN0_FP8
#define FFN0_FP8 0
#endif
#ifndef PROBE_ATT
#define PROBE_ATT 0
#endif
#ifndef PROBE_MIXL
#define PROBE_MIXL 0
#endif
#ifndef MK_FUSED
#define MK_FUSED 1
#endif

#define LAS __attribute__((address_space(3)))
#define GAS __attribute__((address_space(1)))
typedef unsigned short bf16;
typedef short bf16x8 __attribute__((ext_vector_type(8)));
typedef float f32x4 __attribute__((ext_vector_type(4)));
typedef float f32x2 __attribute__((ext_vector_type(2)));
typedef unsigned u32x4 __attribute__((ext_vector_type(4)));
typedef unsigned u32x2 __attribute__((ext_vector_type(2)));
typedef GAS unsigned gu32;

constexpr int D = 1024, NB = 4, SEQ = 4096, ML = NB * SEQ, CTXL = 256, MC = NB * CTXL, MT = ML + MC;
constexpr int INW = 5888, DFF = 2816, DFE = 3584, NE = 8;
constexpr int ZQ = 0, ZK = 512, ZV = 640, ZCX = 768, ZCB = 1280, ZCC = 1792, ZPU = 2304, ZG = 2816;
constexpr int MIXW = 1536;
constexpr int MS = 2 * ML + NE * 256;
constexpr int MODW = 6 * D;
constexpr float EPS = 1e-6f;
constexpr float LOG2E = 1.4426950408889634f, QSCALE = 0.125f * LOG2E;
constexpr int NWAVES = 8, NTHR = 512;

__device__ __forceinline__ unsigned f2bf(float f) { unsigned u = __builtin_bit_cast(unsigned, f); return (u + 0x7fffu + ((u >> 16) & 1u)) >> 16; }
typedef __bf16 bf16x2v __attribute__((ext_vector_type(2)));
__device__ __forceinline__ unsigned pk2(float lo, float hi) { f32x2 v = {lo, hi}; bf16x2v b = __builtin_convertvector(v, bf16x2v); return __builtin_bit_cast(unsigned, b); }
__device__ __forceinline__ float bf2f(unsigned b) { return __builtin_bit_cast(float, b << 16); }
__device__ __forceinline__ float clamp8(float x) { return __builtin_amdgcn_fmed3f(x, -448.f, 448.f); }
__device__ __forceinline__ unsigned pk4_fp8(float a, float b, float c, float d) { int w = 0; w = __builtin_amdgcn_cvt_pk_fp8_f32(clamp8(a), clamp8(b), w, false); w = __builtin_amdgcn_cvt_pk_fp8_f32(clamp8(c), clamp8(d), w, true); return (unsigned)w; }
constexpr float W8SCALE = 256.0f;
__device__ __forceinline__ float bflo(unsigned w) { return __builtin_bit_cast(float, w << 16); }
__device__ __forceinline__ float bfhi(unsigned w) { return __builtin_bit_cast(float, w & 0xffff0000u); }

namespace pg8 {
constexpr int BM = 256, BK = 64, HALF = 128, HTB = HALF * BK * 2, STAGE_BYTES = 8 * HTB, NXCD = 8, WGM = 8;
__host__ __device__ __forceinline__ int lds_byte(int r, int c) { const int st = (r >> 4) * 2 + (c >> 5), rr = r & 15, cc = c & 31, ob = rr * 64 + cc * 2; return st * 1024 + (ob ^ (((ob >> 9) & 1) << 5)); }
__host__ __device__ __forceinline__ void stage_rc(int b, int& R, int& C) { const int st = b / 1024, sb = b % 1024, swz = sb ^ (((sb >> 9) & 1) << 5); R = (st >> 1) * 16 + swz / 64; C = (st & 1) * 32 + (swz % 64) / 2; }
__host__ __device__ __forceinline__ int perm32(int rho) { const int n = rho >> 4, i = rho & 15; return 8 * (i >> 2) + 4 * n + (i & 3); }

struct Unit { int pm, pn, tag; const char* a; const char* b; };

__device__ __forceinline__ void tile_of(int L, int nM, int nN, int& pm, int& pn) {
    const int nwg = nM * nN; int wgid = L;
    { const int q = nwg / NXCD, r = nwg % NXCD, xcd = wgid % NXCD, off = wgid / NXCD; wgid = (xcd < r ? xcd * (q + 1) : r * (q + 1) + (xcd - r) * q) + off; }
    const int nig = WGM * nN, gid = wgid / nig, fm = gid * WGM, gsz = (nM - fm) < WGM ? (nM - fm) : WGM;
    pm = fm + ((wgid % nig) % gsz); pn = (wgid % nig) / gsz;
}

typedef __bf16 bf16x2_t __attribute__((ext_vector_type(2)));
__device__ __forceinline__ unsigned cvt_pk_bf16(float lo, float hi) { f32x2 v = {lo, hi}; bf16x2_t b = __builtin_convertvector(v, bf16x2_t); return __builtin_bit_cast(unsigned, b); }

typedef int i32x8 __attribute__((ext_vector_type(8)));
typedef int i32x4 __attribute__((ext_vector_type(4)));
template <class Epi, class Sched, bool ALIGN_EPI = false, bool SP2 = false, bool FP8 = false>
__device__ __forceinline__ void gemm_phase(LAS unsigned char* lds, const int lda, const int ldb, const int K, const Sched& S, const Epi& E) {
    int tid_ = threadIdx.x; asm volatile("" : "+v"(tid_));
    const int tid = tid_, wid = __builtin_amdgcn_readfirstlane(tid >> 6), lane = tid & 63, wr = wid >> 2, wc = wid & 3, fr = lane & 15, fq = lane >> 4;
    const int nt = K / 128;
    unsigned voffA[2], voffB[2];
#pragma unroll
    for (int i = 0; i < 2; ++i) { int R, C; stage_rc(tid * 16 + i * 8192, R, C); const int Rb = Epi::PERM ? ((R & ~31) + perm32(R & 31)) : R;
        voffA[i] = (unsigned)(R * lda + C * 2); voffB[i] = (unsigned)(Rb * ldb + C * 2); }
    const size_t kstep = (size_t)(BK * 2);
    const size_t hstepA = (size_t)HALF * lda, hstepB = (size_t)HALF * ldb;
    const unsigned ldsw = (unsigned)wid * 1024u;
    const int aoff = lds_byte(wr * 64 + fr, fq * 8), boff = lds_byte(wc * 32 + fr, fq * 8);
#define PG8_SA(b, h) (((b) * 2 + (h)) * HTB)
#define PG8_SB(b, h) ((4 + (b) * 2 + (h)) * HTB)
#define PG8_STAGE(bufoff, gbase, voff) do { _Pragma("unroll") for (int _i = 0; _i < 2; ++_i) \
        __builtin_amdgcn_global_load_lds((const unsigned*)((const char*)(gbase) + (voff)[_i]), (LAS unsigned*)(lds + (bufoff) + ldsw + _i * 8192), 16, 0, 0); } while (0)
#define PG8_RD(off) __builtin_bit_cast(i32x4, *(const LAS bf16x8*)(lds + (off)))
#define PG8_LDA(dst, b, h) do { _Pragma("unroll") for (int m = 0; m < 4; ++m) dst[m] = __builtin_shufflevector(PG8_RD(PG8_SA(b, h) + aoff + m * 2048), PG8_RD(PG8_SA(b, h) + aoff + m * 2048 + 1024), 0, 1, 2, 3, 4, 5, 6, 7); } while (0)
#define PG8_LDB(dst, b, h) do { _Pragma("unroll") for (int n = 0; n < 2; ++n) dst[n] = __builtin_shufflevector(PG8_RD(PG8_SB(b, h) + boff + n * 2048), PG8_RD(PG8_SB(b, h) + boff + n * 2048 + 1024), 0, 1, 2, 3, 4, 5, 6, 7); } while (0)
#define PG8_LO(x) __builtin_bit_cast(bf16x8, __builtin_shufflevector((x), (x), 0, 1, 2, 3))
#define PG8_HI(x) __builtin_bit_cast(bf16x8, __builtin_shufflevector((x), (x), 4, 5, 6, 7))
#define PG8_MMA(ai, bj, At, Bt) do { __builtin_amdgcn_s_setprio(1); _Pragma("unroll") for (int m = 0; m < 4; ++m) _Pragma("unroll") for (int n = 0; n < 2; ++n) { \
        if constexpr (FP8) asm volatile("s_nop 1\n\tv_mfma_scale_f32_16x16x128_f8f6f4 %0, %1, %2, %0, %3, %4 op_sel_hi:[0,0,0]" : "+v"(acc[ai][bj][m][n]) : "v"(Bt[n]), "v"(At[m]), "v"(sc_w), "v"(sc_a)); \
        else { acc[ai][bj][m][n] = __builtin_amdgcn_mfma_f32_16x16x32_bf16(PG8_LO(Bt[n]), PG8_LO(At[m]), acc[ai][bj][m][n], 0, 0, 0); \
               acc[ai][bj][m][n] = __builtin_amdgcn_mfma_f32_16x16x32_bf16(PG8_HI(Bt[n]), PG8_HI(At[m]), acc[ai][bj][m][n], 0, 0, 0); } } __builtin_amdgcn_s_setprio(0); } while (0)
#define PG8_WAIT_V(n) asm volatile("s_waitcnt vmcnt(" #n ")" ::: "memory")
#define PG8_WAIT_L(n) asm volatile("s_waitcnt lgkmcnt(" #n ")" ::: "memory")
#define PG8_BAR __builtin_amdgcn_s_barrier()
#define PG8_SCHED __builtin_amdgcn_sched_barrier(0)
    Unit cur, nxt; int ui = 0;
    if (!S.next(0, cur)) return;
    f32x4 acc[2][2][4][2];
#pragma unroll
    for (int a = 0; a < 2; ++a)
#pragma unroll
        for (int b = 0; b < 2; ++b)
#pragma unroll
            for (int m = 0; m < 4; ++m)
#pragma unroll
                for (int n = 0; n < 2; ++n) acc[a][b][m][n] = (f32x4){0.f, 0.f, 0.f, 0.f};
    i32x8 At[4], B0[2], B1[2];
    const int sc_w = 0x77777777, sc_a = 0x7f7f7f7f;
    const char* cA = cur.a; const char* cB = cur.b;
    if constexpr (SP2) {
        PG8_STAGE(PG8_SB(0, 0), cB, voffB); PG8_STAGE(PG8_SB(0, 1), cB + hstepB, voffB); PG8_STAGE(PG8_SA(0, 0), cA, voffA); PG8_STAGE(PG8_SA(0, 1), cA + hstepA, voffA);
        if (wr == 1) PG8_BAR;
        PG8_WAIT_V(2); PG8_BAR;
        PG8_STAGE(PG8_SB(1, 0), cB + kstep, voffB); PG8_STAGE(PG8_SA(1, 0), cA + kstep, voffA); PG8_STAGE(PG8_SB(1, 1), cB + hstepB + kstep, voffB);
        PG8_WAIT_V(6); PG8_BAR;
    } else {
        PG8_STAGE(PG8_SB(0, 0), cB, voffB); PG8_STAGE(PG8_SA(0, 0), cA, voffA); PG8_STAGE(PG8_SB(0, 1), cB + hstepB, voffB); PG8_STAGE(PG8_SA(0, 1), cA + hstepA, voffA);
        if (wr == 1) PG8_BAR;
        PG8_WAIT_V(4); PG8_BAR;
        PG8_STAGE(PG8_SB(1, 0), cB + kstep, voffB); PG8_STAGE(PG8_SA(1, 0), cA + kstep, voffA); PG8_STAGE(PG8_SB(1, 1), cB + hstepB + kstep, voffB);
        PG8_WAIT_V(6); PG8_BAR;
    }
    for (;;) {
        const bool has_next = S.next(ui + 1, nxt);
        const char* nA = has_next ? nxt.a : cA; const char* nB = has_next ? nxt.b : cB;
        for (int t = 0; t < nt; t += 2) {
            const bool last = (t == nt - 2);
            const char* a1 = cA + (size_t)(t + 1) * kstep;
            const char* a2 = last ? nA : cA + (size_t)(t + 2) * kstep; const char* b2 = last ? nB : cB + (size_t)(t + 2) * kstep;
            const char* a3 = a2 + kstep; const char* b3 = b2 + kstep;
            if constexpr (SP2) {
            PG8_LDB(B0, 0, 0); PG8_LDB(B1, 0, 1); PG8_SCHED; PG8_LDA(At, 0, 0); PG8_STAGE(PG8_SA(1, 1), a1 + hstepA, voffA);
            PG8_WAIT_V(8); PG8_WAIT_L(0); PG8_BAR; PG8_MMA(0, 0, At, B0); PG8_MMA(0, 1, At, B1); PG8_BAR; PG8_SCHED;
            PG8_LDA(At, 0, 1); PG8_STAGE(PG8_SB(0, 0), b2, voffB); PG8_STAGE(PG8_SB(0, 1), b2 + hstepB, voffB); PG8_STAGE(PG8_SA(0, 0), a2, voffA);
            PG8_WAIT_V(8); PG8_WAIT_L(0); PG8_BAR; PG8_MMA(1, 0, At, B0); PG8_MMA(1, 1, At, B1); PG8_BAR; PG8_SCHED;
            PG8_LDB(B0, 1, 0); PG8_LDB(B1, 1, 1); PG8_SCHED; PG8_LDA(At, 1, 0); PG8_STAGE(PG8_SA(0, 1), a2 + hstepA, voffA);
            PG8_WAIT_V(8); PG8_WAIT_L(0); PG8_BAR; PG8_MMA(0, 0, At, B0); PG8_MMA(0, 1, At, B1); PG8_BAR; PG8_SCHED;
            PG8_LDA(At, 1, 1); PG8_STAGE(PG8_SB(1, 0), b3, voffB); PG8_STAGE(PG8_SB(1, 1), b3 + hstepB, voffB); PG8_STAGE(PG8_SA(1, 0), a3, voffA);
            PG8_WAIT_V(8); PG8_WAIT_L(0); PG8_BAR; PG8_MMA(1, 0, At, B0); PG8_MMA(1, 1, At, B1); PG8_BAR; PG8_SCHED;
            } else {
            PG8_LDB(B0, 0, 0); PG8_SCHED; PG8_LDA(At, 0, 0); PG8_STAGE(PG8_SA(1, 1), a1 + hstepA, voffA);
            PG8_WAIT_L(8); PG8_BAR; PG8_WAIT_L(0); PG8_MMA(0, 0, At, B0); PG8_BAR; PG8_SCHED;
            PG8_LDB(B1, 0, 1); PG8_STAGE(PG8_SB(0, 0), b2, voffB);
            PG8_BAR; PG8_WAIT_L(0); PG8_MMA(0, 1, At, B1); PG8_BAR;
            PG8_LDA(At, 0, 1); PG8_STAGE(PG8_SA(0, 0), a2, voffA);
            PG8_BAR; PG8_WAIT_L(0); PG8_MMA(1, 0, At, B0); PG8_BAR; PG8_SCHED;
            PG8_STAGE(PG8_SB(0, 1), b2 + hstepB, voffB);
            PG8_WAIT_V(6); PG8_BAR; PG8_MMA(1, 1, At, B1); PG8_BAR;
            PG8_LDB(B0, 1, 0); PG8_SCHED; PG8_LDA(At, 1, 0); PG8_STAGE(PG8_SA(0, 1), a2 + hstepA, voffA);
            PG8_WAIT_L(8); PG8_BAR; PG8_WAIT_L(0); PG8_MMA(0, 0, At, B0); PG8_BAR; PG8_SCHED;
            PG8_LDB(B1, 1, 1); PG8_STAGE(PG8_SB(1, 0), b3, voffB);
            PG8_BAR; PG8_WAIT_L(0); PG8_MMA(0, 1, At, B1); PG8_BAR;
            PG8_LDA(At, 1, 1); PG8_STAGE(PG8_SA(1, 0), a3, voffA);
            PG8_BAR; PG8_WAIT_L(0); PG8_MMA(1, 0, At, B0); PG8_BAR; PG8_SCHED;
            PG8_STAGE(PG8_SB(1, 1), b3 + hstepB, voffB);
            PG8_WAIT_V(6); PG8_BAR; PG8_MMA(1, 1, At, B1); PG8_BAR;
            }
            if constexpr (Epi::MIDHOOK) { if (((t + 2) & 7) == 0 && !last) { int fr_ = fr, fq_ = fq; asm volatile("" : "+v"(fr_), "+v"(fq_)); E.mid(acc, cur, (t + 2) >> 3, wr, wc, fr_, fq_); } }
        }
        if constexpr (ALIGN_EPI) { if (wr == 0) PG8_BAR; }
        if constexpr (FP8) asm volatile("s_nop 15\n\ts_nop 15" ::: "memory");
        { int fr_ = fr, fq_ = fq; asm volatile("" : "+v"(fr_), "+v"(fq_));
          E(acc, cur, wr, wc, fr_, fq_); }
        if (!has_next) break;
#pragma unroll
        for (int a = 0; a < 2; ++a)
#pragma unroll
            for (int b = 0; b < 2; ++b)
#pragma unroll
                for (int m = 0; m < 4; ++m)
#pragma unroll
                    for (int n = 0; n < 2; ++n) acc[a][b][m][n] = (f32x4){0.f, 0.f, 0.f, 0.f};
        cur = nxt; cA = nA; cB = nB; ++ui;
        if constexpr (ALIGN_EPI) { if (wr == 1) PG8_BAR; }
    }
    PG8_WAIT_V(0);
    if constexpr (!ALIGN_EPI) { if (wr == 0) PG8_BAR; }
    PG8_BAR;
#undef PG8_SA
#undef PG8_SB
#undef PG8_STAGE
#undef PG8_LDA
#undef PG8_LDB
#undef PG8_MMA
#undef PG8_RD
#undef PG8_LO
#undef PG8_HI
#undef PG8_WAIT_V
#undef PG8_WAIT_L
#undef PG8_BAR
#undef PG8_SCHED
}
}

constexpr size_t MiB = 1u << 20;
constexpr size_t al256(size_t x) { return (x + 255) & ~(size_t)255; }
constexpr size_t WS_CTL = 0, CTL_ZERO_BYTES = 1 * MiB;
constexpr size_t WS_MODV = 1 * MiB;
constexpr size_t WS_ROPE = WS_MODV + al256((size_t)2 * 5 * MODW * 4);
constexpr size_t WS_CNTWG = WS_ROPE + al256(64 * 16 * 2 * 4);
constexpr size_t WS_TOKE = WS_CNTWG + al256(256 * 8 * 4);
constexpr size_t WS_TOKP = WS_TOKE + al256((size_t)ML * 2 * 4);
constexpr size_t WS_TOKW = WS_TOKP + al256((size_t)ML * 2 * 4);
constexpr size_t WS_TOKS = WS_TOKW + al256((size_t)ML * 2 * 4);
constexpr size_t WS_TILE = WS_TOKS + al256((size_t)ML * 2 * 4);
constexpr size_t WS_WIN = 4 * MiB;
constexpr size_t WS_WBR = WS_WIN + (size_t)2 * INW * D * 2;
constexpr size_t WS_WOUT = WS_WBR + (size_t)2 * 3 * D * 512 * 2;
constexpr size_t WS_WGU0 = WS_WOUT + (size_t)2 * D * D * 2;
constexpr size_t WS_WDN0 = WS_WGU0 + (size_t)2 * DFF * D * 2;
constexpr size_t WS_WMGU = WS_WDN0 + (size_t)D * DFF * 2;
constexpr size_t WS_WMDN = WS_WMGU + (size_t)NE * 2 * DFE * D * 2;
constexpr size_t WS_H = WS_WMDN + (size_t)NE * D * DFE * 2;
constexpr size_t WS_Z = WS_H + (size_t)MT * D * 2;
constexpr size_t WS_MIX = WS_Z + (size_t)MT * INW * 2;
constexpr size_t WS_ACT = WS_Z;
constexpr size_t WS_YACC = WS_MIX + (size_t)MT * MIXW * 2;
constexpr size_t WS_H2S = WS_YACC;
constexpr size_t WS_Y = WS_YACC + (size_t)MT * D * 4;
constexpr size_t WS_X1 = WS_Y + (size_t)MT * D * 2;
constexpr size_t WS_X2 = WS_X1 + (size_t)MT * D * 4;
constexpr size_t WS_YS = WS_X2;
constexpr size_t WS_H8 = WS_X2 + (size_t)MT * D * 4;
constexpr size_t WS_WIN8 = WS_H8 + (size_t)MT * D;
constexpr size_t WS_END = WS_WIN8 + (size_t)2 * 3 * D * D;
static_assert((size_t)MS * DFE * 2 <= (size_t)MT * INW * 2 + (size_t)MT * MIXW * 2, "ACT overlay");
static_assert((size_t)MS * D * 2 <= (size_t)MT * D * 4, "H2S / YS overlays");
static_assert(WS_TILE + 1024 <= WS_WIN, "small tables");
constexpr int CW_BAR = 4096;

constexpr int RING_BYTES = 131072;
constexpr int LDSCTL_OFF = 146944, MISC_OFF = LDSCTL_OFF + 320;
constexpr int LDS_BYTES = 147456;

#define XB_TMO      128
#define XB_XCNT(j)  (256  + 64 * (j))
#define XB_XSUB(j)  (1280 + 64 * (j))
#define XB_XGEN(j)  (2304 + 64 * (j))
#define XB_TOP      3328
#define XB_TOPGEN   3392
#define XCD_BAR_WORDS 3456
#define XB_SPIN_CAP (1u << 18)
__device__ __forceinline__ unsigned xb_ld(unsigned* p)              { return __hip_atomic_load(p, __ATOMIC_RELAXED, __HIP_MEMORY_SCOPE_AGENT); }
__device__ __forceinline__ unsigned xb_add(unsigned* p, unsigned v) { return __hip_atomic_fetch_add(p, v, __ATOMIC_RELAXED, __HIP_MEMORY_SCOPE_AGENT); }
__device__ __forceinline__ unsigned xb_xcc_id() { return (unsigned)__builtin_amdgcn_s_getreg((3 << 11) | 20) & 0xFu; }
#define XB_SPIN(cond, bar) do { unsigned _sp = 0; while (cond) { __builtin_amdgcn_s_sleep(1); \
    if ((++_sp & 255u) == 0u) { if (xb_ld(&(bar)[XB_TMO])) break; if (_sp > XB_SPIN_CAP) { atomicAdd(&(bar)[XB_TMO], 1u); break; } } } } while (0)
struct XcdBarrier { unsigned* bar; unsigned x; volatile LAS unsigned* st; };
__device__ __forceinline__ XcdBarrier xcd_barrier_post(unsigned* bar, volatile LAS unsigned* st) {
    XcdBarrier b; b.bar = bar; b.x = xb_xcc_id(); b.st = st;
    if (threadIdx.x == 0) (void)xb_add(&bar[XB_XCNT(b.x)], 1u);
    return b;
}
__device__ __forceinline__ void xcd_barrier_complete(unsigned* bar, unsigned x, unsigned& nloc, unsigned& nx) {
    const unsigned G = gridDim.x * gridDim.y * gridDim.z;
    unsigned sum, cnt, mine, sp = 0u;
    for (;;) {
        sum = 0u; cnt = 0u; mine = 0u;
#pragma unroll
        for (unsigned j = 0; j < 16; ++j) { const unsigned c = xb_ld(&bar[XB_XCNT(j)]); sum += c; cnt += (c > 0u) ? 1u : 0u; mine = (j == x) ? c : mine; }
        if (sum == G) break;
        __builtin_amdgcn_s_sleep(1);
        if ((++sp & 255u) == 0u) { if (xb_ld(&bar[XB_TMO])) break; if (sp > XB_SPIN_CAP) { atomicAdd(&bar[XB_TMO], 1u); break; } }
    }
    nloc = mine > 0u ? mine : 1u; nx = cnt > 0u ? cnt : 1u;
}
__device__ __attribute__((noinline)) void xcd_barrier_leader(unsigned* bar, unsigned bx_, volatile LAS unsigned* st) {
    {
        XcdBarrier b; b.bar = bar; b.x = bx_; b.st = st;
        __builtin_amdgcn_s_waitcnt(0);
        unsigned nloc = b.st[0], nx = b.st[1];
        if (nloc == 0u) { xcd_barrier_complete(bar, b.x, nloc, nx); b.st[0] = nloc; b.st[1] = nx; }
        const unsigned old = xb_add(&bar[XB_XSUB(b.x)], 1u);
        const unsigned gen = old / nloc;
        if (old + 1u == (gen + 1u) * nloc) {
            __builtin_amdgcn_fence(__ATOMIC_RELEASE, "agent");
            asm volatile("s_waitcnt vmcnt(0)" ::: "memory");
            const unsigned og = xb_add(&bar[XB_TOP], 1u);
            const unsigned tg = og / nx;
            if (og + 1u == (tg + 1u) * nx) xb_add(&bar[XB_TOPGEN], 1u);
            else XB_SPIN(xb_ld(&bar[XB_TOPGEN]) == tg, bar);
            __builtin_amdgcn_fence(__ATOMIC_ACQUIRE, "agent");
            xb_add(&bar[XB_XGEN(b.x)], 1u);
            asm volatile("s_waitcnt vmcnt(0)" ::: "memory");
        } else {
            XB_SPIN(xb_ld(&bar[XB_XGEN(b.x)]) == gen, bar);
            __builtin_amdgcn_fence(__ATOMIC_ACQUIRE, "agent");
            asm volatile("s_waitcnt vmcnt(0)" ::: "memory");
        }
    }
}
__device__ __forceinline__ void xcd_barrier(const XcdBarrier& b) {
    asm volatile("s_waitcnt vmcnt(0)" ::: "memory");
    __syncthreads();
    if (threadIdx.x == 0) xcd_barrier_leader(b.bar, b.x, b.st);
    __syncthreads();
}

struct Args {
    const float *x, *c, *ctx, *c_ctx, *norm1_g, *norm2_g, *final_g, *w_mod, *b_mod, *w_in, *conv_w, *sink, *pool_w, *pool_scale, *w_branch, *w_out,
                *ffn_w_gu, *ffn_w_down, *router_w, *moe_w_gu, *moe_w_down;
    float* out; unsigned char* ws; int ph_lo, ph_hi;
};
template <int OFF> __device__ __forceinline__ const void* karg_p() { const void* r; asm volatile("s_load_dwordx2 %0, %1, %2\n\ts_waitcnt lgkmcnt(0)" : "=s"(r) : "s"(__builtin_amdgcn_kernarg_segment_ptr()), "i"(OFF)); return r; }
template <int OFF> __device__ __forceinline__ int karg_i() { int r; asm volatile("s_load_dword %0, %1, %2\n\ts_waitcnt lgkmcnt(0)" : "=s"(r) : "s"(__builtin_amdgcn_kernarg_segment_ptr()), "i"(OFF)); return r; }
#define KP(field) ((const float*)karg_p<(int)__builtin_offsetof(Args, field)>())
struct Frame {
    LAS unsigned char* lds;
    int tid, lane, wave, G, bx;
    unsigned char* ws;
};
__device__ __forceinline__ float wave_sum(float v) {
#pragma unroll
    for (int o = 1; o < 64; o <<= 1) v += __shfl_xor(v, o);
    return v;
}
__device__ __forceinline__ float wave_max(float v) {
#pragma unroll
    for (int o = 1; o < 64; o <<= 1) v = fmaxf(v, __shfl_xor(v, o));
    return v;
}
#define LDS_WAIT() asm volatile("s_waitcnt lgkmcnt(0)" ::: "memory")

template <bool F8>
__device__ __forceinline__ void p0_transpose_item(const float* W, int ldw, bf16* WT, int ldt, int koff, int k0, int n0, int drow0, LAS float* scr, int lane) {
    f32x4 v[16];
    const int rl = lane >> 4, c4 = 4 * (lane & 15);
#pragma unroll
    for (int i = 0; i < 16; ++i) v[i] = __builtin_nontemporal_load((const f32x4*)(W + (size_t)(k0 + 4 * i + rl) * ldw + n0 + c4));
#pragma unroll
    for (int i = 0; i < 16; ++i) { LAS float* p = scr + (4 * i + rl) * 65 + c4; p[0] = v[i].x; p[1] = v[i].y; p[2] = v[i].z; p[3] = v[i].w; }
    LDS_WAIT(); asm volatile("" ::: "memory");
    const int c = lane & 7;
#pragma unroll
    for (int j = 0; j < 8; ++j) { const int n = (lane >> 3) + 8 * j; const LAS float* sp = scr + (8 * c) * 65 + n;
        if constexpr (F8) { u32x2 o; o.x = pk4_fp8(sp[0 * 65] * W8SCALE, sp[1 * 65] * W8SCALE, sp[2 * 65] * W8SCALE, sp[3 * 65] * W8SCALE); o.y = pk4_fp8(sp[4 * 65] * W8SCALE, sp[5 * 65] * W8SCALE, sp[6 * 65] * W8SCALE, sp[7 * 65] * W8SCALE);
            *(u32x2*)((unsigned char*)WT + (size_t)(drow0 + n) * ldt + koff + k0 + 8 * c) = o; }
        else { u32x4 o; o.x = pk2(sp[0 * 65], sp[1 * 65]); o.y = pk2(sp[2 * 65], sp[3 * 65]); o.z = pk2(sp[4 * 65], sp[5 * 65]); o.w = pk2(sp[6 * 65], sp[7 * 65]);
            *(u32x4*)(WT + (size_t)(drow0 + n) * ldt + koff + k0 + 8 * c) = o; } }
    LDS_WAIT(); asm volatile("" ::: "memory");
}
template <bool F8>
__device__ __forceinline__ void p0_job_item(const float* W, int ldw, int K, int N, bf16* WT, int ldt, int koff, int IL, int item, LAS float* scr, int lane) {
    const int nblk = N / 64, kb = item / nblk, nb = item % nblk, n0 = 64 * nb;
    int drow0 = n0;
    if (IL > 0) { const int half = n0 >= IL ? 1 : 0, f = n0 - half * IL; drow0 = 256 * (f / 128) + 128 * half + (f % 128); }
    p0_transpose_item<F8>(W, ldw, WT, ldt, koff, 64 * kb, n0, drow0, scr, lane);
}
__device__ __forceinline__ void p0_prologue(Frame& F) {
    LAS float* scr = (LAS float*)(F.lds + F.wave * 16640);
    const int gw = F.bx * NWAVES + F.wave, NGW = F.G * NWAVES;
    constexpr int I_IN = (D / 64) * (ZG / 64), I_IN8 = (D / 64) * (3 * D / 64), I_BR = (512 / 64) * (D / 64), I_OUT = (D / 64) * (D / 64), I_GU0 = (D / 64) * (2 * DFF / 64), I_DN0 = (DFF / 64) * (D / 64),
                  I_MGU = (D / 64) * (2 * DFE / 64), I_MDN = (DFE / 64) * (D / 64);
    constexpr int NITEMS = 2 * I_IN + 2 * I_IN8 + 4 * I_BR + 2 * I_OUT + I_GU0 + I_DN0 + NE * I_MGU + NE * I_MDN;
    bf16* const wsb = (bf16*)F.ws;
    for (int it = gw; it < NITEMS; it += NGW) {
        int r = it;
        if (r < NE * I_MGU) { const int e = r / I_MGU; p0_job_item<true>(KP(moe_w_gu) + (size_t)e * D * 2 * DFE, 2 * DFE, D, 2 * DFE, (bf16*)(F.ws + WS_WMGU + (size_t)e * 2 * DFE * D), D, 0, DFE, r % I_MGU, scr, F.lane); continue; } r -= NE * I_MGU;
        if (r < NE * I_MDN) { const int e = r / I_MDN; p0_job_item<true>(KP(moe_w_down) + (size_t)e * DFE * D, D, DFE, D, (bf16*)(F.ws + WS_WMDN + (size_t)e * D * DFE), DFE, 0, 0, r % I_MDN, scr, F.lane); continue; } r -= NE * I_MDN;
        if (r < 2 * I_IN) { const int l = r / I_IN; p0_job_item<false>(KP(w_in) + (size_t)l * D * INW, INW, D, ZG, (bf16*)(F.ws + WS_WIN) + (size_t)l * ZG * D, D, 0, 0, r % I_IN, scr, F.lane); continue; } r -= 2 * I_IN;
        if (r < 2 * I_IN8) { const int l = r / I_IN8; p0_job_item<true>(KP(w_in) + (size_t)l * D * INW + ZG, INW, D, 3 * D, (bf16*)(F.ws + WS_WIN8 + (size_t)l * 3 * D * D), D, 0, 0, r % I_IN8, scr, F.lane); continue; } r -= 2 * I_IN8;
        if (r < 4 * I_BR) { const int j = r / I_BR, l = j >> 1, b = j & 1; p0_job_item<false>(KP(w_branch) + (size_t)(l * 3 + b) * 512 * D, D, 512, D, (bf16*)(F.ws + WS_WBR) + (size_t)l * D * MIXW, MIXW, 512 * b, 0, r % I_BR, scr, F.lane); continue; } r -= 4 * I_BR;
        if (r < 2 * I_OUT) { const int l = r / I_OUT; p0_job_item<false>(KP(w_out) + (size_t)l * D * D, D, D, D, (bf16*)(F.ws + WS_WOUT) + (size_t)l * D * D, D, 0, 0, r % I_OUT, scr, F.lane); continue; } r -= 2 * I_OUT;
        if (r < I_GU0) { p0_job_item<FFN0_FP8 != 0>(KP(ffn_w_gu), 2 * DFF, D, 2 * DFF, (bf16*)(F.ws + WS_WGU0), D, 0, DFF, r, scr, F.lane); continue; } r -= I_GU0;
        p0_job_item<(FFN0_FP8 || DN0_FP8)>(KP(ffn_w_down), D, DFF, D, (bf16*)(F.ws + WS_WDN0), DFF, 0, 0, r, scr, F.lane);
    }
    (void)wsb;
    __syncthreads();
    constexpr int I_MOD = 2 * (MODW / 64), I_FOLD = 2 * 4 * (D / 64);
    for (int it = F.bx; it < I_MOD + I_FOLD + 1; it += F.G) {
        if (it < I_MOD) {
            const int l = it / (MODW / 64), cb = it % (MODW / 64);
            LAS float* sv = (LAS float*)F.lds;
            LAS float* red = (LAS float*)(F.lds + 32768);
            for (int i = F.tid; i < 5 * D; i += NTHR) { const int r = i / D, k = i % D; const float v = r < 4 ? KP(c)[r * D + k] : KP(c_ctx)[k]; sv[i] = v / (1.f + __expf(-v)); }
            __syncthreads();
            const int col = cb * 64 + F.lane; const float* wp = KP(w_mod) + (size_t)l * D * MODW + col;
            float a0 = 0.f, a1 = 0.f, a2 = 0.f, a3 = 0.f, a4 = 0.f;
#pragma unroll 8
            for (int kk = 0; kk < 128; ++kk) { const int k = F.wave * 128 + kk; const float w = wp[(size_t)k * MODW];
                a0 += sv[k] * w; a1 += sv[D + k] * w; a2 += sv[2 * D + k] * w; a3 += sv[3 * D + k] * w; a4 += sv[4 * D + k] * w; }
            red[(F.wave * 5 + 0) * 64 + F.lane] = a0; red[(F.wave * 5 + 1) * 64 + F.lane] = a1; red[(F.wave * 5 + 2) * 64 + F.lane] = a2;
            red[(F.wave * 5 + 3) * 64 + F.lane] = a3; red[(F.wave * 5 + 4) * 64 + F.lane] = a4;
            __syncthreads();
            if (F.tid < 320) { const int r = F.tid / 64, ln = F.tid % 64; float s = 0.f;
#pragma unroll
                for (int w = 0; w < 8; ++w) s += red[(w * 5 + r) * 64 + ln];
                const int cc = cb * 64 + ln;
                ((float*)(F.ws + WS_MODV))[(size_t)(l * 5 + r) * MODW + cc] = s + KP(b_mod)[l * MODW + cc]; }
            __syncthreads();
        } else if (it < I_MOD + I_FOLD) {
            const int r = it - I_MOD, l = r / 64, g = (r % 64) / 16, nb = r % 16;
            LAS float* pw = (LAS float*)F.lds;
            const float* pws = KP(pool_w) + (size_t)(l * 4 + g) * 128 * 128;
            for (int i = F.tid; i < 128 * 128; i += NTHR) pw[i] = pws[i];
            __syncthreads();
            const int n = nb * 64 + F.lane; const float* w2 = KP(w_branch) + (size_t)(l * 3 + 2) * 512 * D + (size_t)(128 * g) * D + n;
            const float* ps = KP(pool_scale) + l * 512 + 128 * g;
            float acc[16];
#pragma unroll
            for (int q = 0; q < 16; ++q) acc[q] = 0.f;
            for (int j = 0; j < 128; ++j) { const float wv = w2[(size_t)j * D] * ps[j];
#pragma unroll
                for (int q = 0; q < 16; ++q) acc[q] += pw[(F.wave * 16 + q) * 128 + j] * wv; }
            bf16* dst = (bf16*)(F.ws + WS_WBR) + (size_t)l * D * MIXW + (size_t)n * MIXW + 1024 + 128 * g + F.wave * 16;
            u32x4 o0, o1; o0.x = pk2(acc[0], acc[1]); o0.y = pk2(acc[2], acc[3]); o0.z = pk2(acc[4], acc[5]); o0.w = pk2(acc[6], acc[7]);
            o1.x = pk2(acc[8], acc[9]); o1.y = pk2(acc[10], acc[11]); o1.z = pk2(acc[12], acc[13]); o1.w = pk2(acc[14], acc[15]);
            *(u32x4*)dst = o0; *(u32x4*)(dst + 8) = o1;
            __syncthreads();
        } else {
            for (int i = F.tid; i < 64 * 16; i += NTHR) { const int pos = i / 16, fi = i % 16;
                const float inv = powf(10000.0f, -(float)fi / 16.0f); const float ang = (float)pos * inv;
                ((float*)(F.ws + WS_ROPE))[2 * i] = cosf(ang); ((float*)(F.ws + WS_ROPE))[2 * i + 1] = sinf(ang); }
        }
    }
}

template <bool ROUTER, int OUTM = 0>
__device__ __forceinline__ void norm_mod_phase(Frame& F, const float* xl, const float* xc, const float* gvec, const float* modl, int shi, int sci, int nrows, const float* router_w) {
    bf16* H = (bf16*)(F.ws + WS_H);
    LAS int* lcnt = (LAS int*)F.lds;
    if (ROUTER) { if (F.tid < 8) lcnt[F.tid] = 0; __syncthreads(); }
    if constexpr (!ROUTER) {
        const int nwv = F.G * NWAVES, gw = F.bx * NWAVES + F.wave;
        for (int r0 = gw; r0 < nrows; r0 += 2 * nwv) {
            const bool has1 = r0 + nwv < nrows; const int r1 = has1 ? r0 + nwv : r0;
            const int b0 = r0 < ML ? r0 / SEQ : 4, b1 = r1 < ML ? r1 / SEQ : 4;
            const float* x0 = r0 < ML ? xl + (size_t)r0 * D : xc + (size_t)(r0 - ML) * D; const float* x1 = r1 < ML ? xl + (size_t)r1 * D : xc + (size_t)(r1 - ML) * D;
            const float* m0 = modl + (size_t)b0 * MODW; const float* m1 = modl + (size_t)b1 * MODW;
            f32x4 va[4], vb[4], g[4], sh0[4], sc0[4], sh1[4], sc1[4];
#pragma unroll
            for (int j = 0; j < 4; ++j) { const int c = 4 * F.lane + 256 * j; va[j] = *(const f32x4*)(x0 + c); vb[j] = *(const f32x4*)(x1 + c); }
#pragma unroll
            for (int j = 0; j < 4; ++j) { const int c = 4 * F.lane + 256 * j; g[j] = *(const f32x4*)(gvec + c); sh0[j] = *(const f32x4*)(m0 + shi * D + c); sc0[j] = *(const f32x4*)(m0 + sci * D + c);
                sh1[j] = *(const f32x4*)(m1 + shi * D + c); sc1[j] = *(const f32x4*)(m1 + sci * D + c); }
            float sa = 0.f, sb = 0.f;
#pragma unroll
            for (int j = 0; j < 4; ++j) { sa += (va[j].x * va[j].x + va[j].y * va[j].y) + (va[j].z * va[j].z + va[j].w * va[j].w); sb += (vb[j].x * vb[j].x + vb[j].y * vb[j].y) + (vb[j].z * vb[j].z + vb[j].w * vb[j].w); }
            const float ra = 1.0f / sqrtf(wave_sum(sa) * (1.f / D) + EPS), rb = 1.0f / sqrtf(wave_sum(sb) * (1.f / D) + EPS);
#pragma unroll
            for (int j = 0; j < 4; ++j) { const int c = 4 * F.lane + 256 * j;
                const f32x4 oa = (va[j] * ra * g[j]) * (sc0[j] + 1.0f) + sh0[j], ob = (vb[j] * rb * g[j]) * (sc1[j] + 1.0f) + sh1[j];
                if constexpr (OUTM == 1) { *(unsigned*)((unsigned char*)H + (size_t)r0 * D + c) = pk4_fp8(oa.x, oa.y, oa.z, oa.w); if (has1) *(unsigned*)((unsigned char*)H + (size_t)r1 * D + c) = pk4_fp8(ob.x, ob.y, ob.z, ob.w); }
                else { u32x2 o; o.x = pk2(oa.x, oa.y); o.y = pk2(oa.z, oa.w); *(u32x2*)(H + (size_t)r0 * D + c) = o; if (has1) { o.x = pk2(ob.x, ob.y); o.y = pk2(ob.z, ob.w); *(u32x2*)(H + (size_t)r1 * D + c) = o; } }
                if constexpr (OUTM == 2) { *(unsigned*)(F.ws + WS_H8 + (size_t)r0 * D + c) = pk4_fp8(oa.x, oa.y, oa.z, oa.w); if (has1) *(unsigned*)(F.ws + WS_H8 + (size_t)r1 * D + c) = pk4_fp8(ob.x, ob.y, ob.z, ob.w); } }
        }
        return;
    }
    const int nloop = ROUTER ? 8 : (nrows + F.G * NWAVES - 1) / (F.G * NWAVES);
    for (int i = 0; i < nloop; ++i) {
        const int r = ROUTER ? (F.bx * 64 + F.wave + 8 * i) : ((i * F.G + F.bx) * NWAVES + F.wave);
        if (r >= nrows) continue;
        const int bidx = r < ML ? r / SEQ : 4;
        const float* xr = r < ML ? xl + (size_t)r * D : xc + (size_t)(r - ML) * D;
        const float* mv = modl + (size_t)bidx * MODW;
        f32x4 v[4]; float ss = 0.f;
#pragma unroll
        for (int j = 0; j < 4; ++j) { v[j] = *(const f32x4*)(xr + 4 * F.lane + 256 * j); ss += (v[j].x * v[j].x + v[j].y * v[j].y) + (v[j].z * v[j].z + v[j].w * v[j].w); }
        const float rstd = 1.0f / sqrtf(wave_sum(ss) * (1.f / D) + EPS);
#pragma unroll
        for (int j = 0; j < 4; ++j) { const int c = 4 * F.lane + 256 * j;
            const f32x4 g = *(const f32x4*)(gvec + c), sh = *(const f32x4*)(mv + shi * D + c), sc = *(const f32x4*)(mv + sci * D + c);
            v[j] = (v[j] * rstd * g) * (sc + 1.0f) + sh;
            if constexpr (OUTM == 1) *(unsigned*)((unsigned char*)H + (size_t)r * D + c) = pk4_fp8(v[j].x, v[j].y, v[j].z, v[j].w);
            else { u32x2 o; o.x = pk2(v[j].x, v[j].y); o.y = pk2(v[j].z, v[j].w); *(u32x2*)(H + (size_t)r * D + c) = o; }
            if constexpr (OUTM == 2) *(unsigned*)(F.ws + WS_H8 + (size_t)r * D + c) = pk4_fp8(v[j].x, v[j].y, v[j].z, v[j].w); }
        if (ROUTER) {
            float lg[8];
#pragma unroll
            for (int e = 0; e < 8; ++e) lg[e] = 0.f;
#pragma unroll
            for (int j = 0; j < 4; ++j)
#pragma unroll
                for (int q = 0; q < 4; ++q) { const int c = 4 * F.lane + 256 * j + q; const f32x4 w0 = *(const f32x4*)(router_w + (size_t)c * 8), w1 = *(const f32x4*)(router_w + (size_t)c * 8 + 4); const float hv = v[j][q];
                    lg[0] += hv * w0.x; lg[1] += hv * w0.y; lg[2] += hv * w0.z; lg[3] += hv * w0.w; lg[4] += hv * w1.x; lg[5] += hv * w1.y; lg[6] += hv * w1.z; lg[7] += hv * w1.w; }
#pragma unroll
            for (int e = 0; e < 8; ++e) lg[e] = wave_sum(lg[e]);
            int e1 = 0; float v1 = lg[0];
#pragma unroll
            for (int e = 1; e < 8; ++e) if (lg[e] > v1) { v1 = lg[e]; e1 = e; }
            int e2 = -1; float v2 = -3.0e38f;
#pragma unroll
            for (int e = 0; e < 8; ++e) if (e != e1 && lg[e] > v2) { v2 = lg[e]; e2 = e; }
            const float ex = __expf(v2 - v1), w1 = 1.f / (1.f + ex), w2 = ex * w1;
            if (F.lane == 0) {
                const int p1 = atomicAdd((int*)&lcnt[e1], 1), p2 = atomicAdd((int*)&lcnt[e2], 1);
                int* te = (int*)(F.ws + WS_TOKE) + 2 * r; te[0] = e1; te[1] = e2;
                int* tp = (int*)(F.ws + WS_TOKP) + 2 * r; tp[0] = p1; tp[1] = p2;
                float* tw = (float*)(F.ws + WS_TOKW) + 2 * r; tw[0] = w1; tw[1] = w2;
            }
        }
    }
    if (ROUTER) { __syncthreads(); if (F.tid < 8) ((int*)(F.ws + WS_CNTWG))[F.bx * 8 + F.tid] = lcnt[F.tid]; __syncthreads(); }
}

__device__ __forceinline__ void moe_scatter_phase(Frame& F) {
    LAS int* tab = (LAS int*)F.lds;
    const int* cw = (const int*)(F.ws + WS_CNTWG);
    if (F.tid < 32) tab[F.tid] = 0;
    __syncthreads();
    for (int idx = F.tid; idx < F.G * 8; idx += NTHR) {
        const int c = __hip_atomic_load(cw + idx, __ATOMIC_RELAXED, __HIP_MEMORY_SCOPE_AGENT); const int w = idx >> 3, e = idx & 7;
        atomicAdd((int*)&tab[16 + e], c); if (w < F.bx) atomicAdd((int*)&tab[8 + e], c);
    }
    __syncthreads();
    if (F.tid == 0) { int off = 0; for (int e = 0; e < 8; ++e) { tab[e] = off; off += ((tab[16 + e] + 255) / 256) * 256; } tab[24] = off / 256;
        if (F.bx == 0) { int* tl = (int*)(F.ws + WS_TILE); int t = 0; for (int e = 0; e < 8; ++e) { const int n = (tab[16 + e] + 255) / 256; for (int q = 0; q < n; ++q) tl[t++] = e; } tl[200] = t; } }
    __syncthreads();
    const bf16* H = (const bf16*)(F.ws + WS_H); bf16* HS = (bf16*)(F.ws + WS_H2S);
    for (int i = 0; i < 8; ++i) {
        const int r = F.bx * 64 + F.wave + 8 * i; if (r >= ML) continue;
        const int* te = (const int*)(F.ws + WS_TOKE) + 2 * r; const int* tp = (const int*)(F.ws + WS_TOKP) + 2 * r;
        const int e1 = te[0], e2 = te[1];
        const int s1 = tab[e1] + tab[8 + e1] + tp[0], s2 = tab[e2] + tab[8 + e2] + tp[1];
        if (F.lane == 0) { int* ts = (int*)(F.ws + WS_TOKS) + 2 * r; ts[0] = s1; ts[1] = s2; }
        const u32x4 a = ((const u32x4*)((const unsigned char*)H + (size_t)r * D))[F.lane];
        ((u32x4*)((unsigned char*)HS + (size_t)s1 * D))[F.lane] = a; ((u32x4*)((unsigned char*)HS + (size_t)s2 * D))[F.lane] = a;
    }
}

__device__ __forceinline__ void final_phase(Frame& F, const float* final_g, float* out, const float* modl) {
    const float* X1 = (const float*)(F.ws + WS_X1); const bf16* YS = (const bf16*)(F.ws + WS_YS);
    const int nwv = F.G * NWAVES, gw = F.bx * NWAVES + F.wave;
    for (int r0 = gw; r0 < ML; r0 += 2 * nwv) {
        const bool has1 = r0 + nwv < ML; const int r1 = has1 ? r0 + nwv : r0;
        const float* ga = modl + (size_t)(r0 / SEQ) * MODW + 5 * D; const float* gb = modl + (size_t)(r1 / SEQ) * MODW + 5 * D;
        const int* tsa = (const int*)(F.ws + WS_TOKS) + 2 * r0; const int* tsb = (const int*)(F.ws + WS_TOKS) + 2 * r1;
        const float* twa = (const float*)(F.ws + WS_TOKW) + 2 * r0; const float* twb = (const float*)(F.ws + WS_TOKW) + 2 * r1;
        const int a1 = tsa[0], a2 = tsa[1], b1 = tsb[0], b2 = tsb[1]; const float wa1 = twa[0], wa2 = twa[1], wb1 = twb[0], wb2 = twb[1];
        f32x4 xa[4], xb[4], gva[4], gvb[4], fg[4]; u32x2 ya1[4], ya2[4], yb1[4], yb2[4];
#pragma unroll
        for (int j = 0; j < 4; ++j) { const int c = 4 * F.lane + 256 * j;
            xa[j] = *(const f32x4*)(X1 + (size_t)r0 * D + c); xb[j] = *(const f32x4*)(X1 + (size_t)r1 * D + c);
            ya1[j] = *(const u32x2*)(YS + (size_t)a1 * D + c); ya2[j] = *(const u32x2*)(YS + (size_t)a2 * D + c); yb1[j] = *(const u32x2*)(YS + (size_t)b1 * D + c); yb2[j] = *(const u32x2*)(YS + (size_t)b2 * D + c);
            gva[j] = *(const f32x4*)(ga + c); gvb[j] = *(const f32x4*)(gb + c); fg[j] = *(const f32x4*)(final_g + c); }
        float sa = 0.f, sb = 0.f;
#pragma unroll
        for (int j = 0; j < 4; ++j) {
            f32x4 f; f.x = wa1 * bflo(ya1[j].x) + wa2 * bflo(ya2[j].x); f.y = wa1 * bfhi(ya1[j].x) + wa2 * bfhi(ya2[j].x); f.z = wa1 * bflo(ya1[j].y) + wa2 * bflo(ya2[j].y); f.w = wa1 * bfhi(ya1[j].y) + wa2 * bfhi(ya2[j].y);
            xa[j] = xa[j] + gva[j] * f; sa += (xa[j].x * xa[j].x + xa[j].y * xa[j].y) + (xa[j].z * xa[j].z + xa[j].w * xa[j].w);
            f.x = wb1 * bflo(yb1[j].x) + wb2 * bflo(yb2[j].x); f.y = wb1 * bfhi(yb1[j].x) + wb2 * bfhi(yb2[j].x); f.z = wb1 * bflo(yb1[j].y) + wb2 * bflo(yb2[j].y); f.w = wb1 * bfhi(yb1[j].y) + wb2 * bfhi(yb2[j].y);
            xb[j] = xb[j] + gvb[j] * f; sb += (xb[j].x * xb[j].x + xb[j].y * xb[j].y) + (xb[j].z * xb[j].z + xb[j].w * xb[j].w); }
        const float ra = 1.0f / sqrtf(wave_sum(sa) * (1.f / D) + EPS), rb = 1.0f / sqrtf(wave_sum(sb) * (1.f / D) + EPS);
#pragma unroll
        for (int j = 0; j < 4; ++j) { const int c = 4 * F.lane + 256 * j;
            __builtin_nontemporal_store(xa[j] * ra * fg[j], (f32x4*)(out + (size_t)r0 * D + c)); if (has1) __builtin_nontemporal_store(xb[j] * rb * fg[j], (f32x4*)(out + (size_t)r1 * D + c)); }
    }
}

__device__ __forceinline__ void unpack8(const u32x4 w, float (&f)[8]) { f[0] = bflo(w.x); f[1] = bfhi(w.x); f[2] = bflo(w.y); f[3] = bfhi(w.y); f[4] = bflo(w.z); f[5] = bfhi(w.z); f[6] = bflo(w.w); f[7] = bfhi(w.w); }
__device__ __forceinline__ void local_mix_phase(Frame& F, const float* cw, int nrows, const bool skip16) {
    const bf16* Z = (const bf16*)(F.ws + WS_Z); bf16* MIX = (bf16*)(F.ws + WS_MIX);
    const int vcu = (F.G % 8 == 0) ? (F.bx % 8) * (F.G / 8) + F.bx / 8 : F.bx;
    const int nwk = (skip16 && F.G > 32) ? F.G - 16 : F.G, wk = (skip16 && F.G > 32) ? vcu - 16 : vcu;
    const int total = (nrows / 8) * 64, stride = nwk * NTHR;
    for (int idx = (wk < 0 ? total : wk * NTHR + F.tid); idx < total; idx += stride) {
        const int r0 = (idx >> 6) * 8, cg = idx & 63, c0 = cg * 8;
        int t0, L;
        if (r0 < ML) { t0 = r0 % SEQ; L = SEQ; } else { t0 = (r0 - ML) % CTXL; L = CTXL; }
        const bf16* zb = Z + (size_t)(r0 - t0) * INW;
        { float wa[8], wb[8], wc_[8];
          { const f32x4 a0 = *(const f32x4*)(cw + c0), a1 = *(const f32x4*)(cw + c0 + 4), b0 = *(const f32x4*)(cw + 512 + c0), b1 = *(const f32x4*)(cw + 512 + c0 + 4), d0 = *(const f32x4*)(cw + 1024 + c0), d1 = *(const f32x4*)(cw + 1024 + c0 + 4);
            wa[0] = a0.x; wa[1] = a0.y; wa[2] = a0.z; wa[3] = a0.w; wa[4] = a1.x; wa[5] = a1.y; wa[6] = a1.z; wa[7] = a1.w;
            wb[0] = b0.x; wb[1] = b0.y; wb[2] = b0.z; wb[3] = b0.w; wb[4] = b1.x; wb[5] = b1.y; wb[6] = b1.z; wb[7] = b1.w;
            wc_[0] = d0.x; wc_[1] = d0.y; wc_[2] = d0.z; wc_[3] = d0.w; wc_[4] = d1.x; wc_[5] = d1.y; wc_[6] = d1.z; wc_[7] = d1.w; }
          float pp[8], pc[8], pn[8];
#pragma unroll
          for (int q = 0; q < 8; ++q) pp[q] = 0.f;
          if (t0 > 0) { float cx[8], cc[8]; const bf16* zr = zb + (size_t)(t0 - 1) * INW; unpack8(*(const u32x4*)(zr + ZCX + c0), cx); unpack8(*(const u32x4*)(zr + ZCC + c0), cc);
#pragma unroll
              for (int q = 0; q < 8; ++q) pp[q] = cc[q] * cx[q]; }
          { float cx[8], cc[8]; const bf16* zr = zb + (size_t)t0 * INW; unpack8(*(const u32x4*)(zr + ZCX + c0), cx); unpack8(*(const u32x4*)(zr + ZCC + c0), cc);
#pragma unroll
              for (int q = 0; q < 8; ++q) pc[q] = cc[q] * cx[q]; }
#pragma unroll
          for (int i = 0; i < 8; ++i) { const int t = t0 + i;
#pragma unroll
              for (int q = 0; q < 8; ++q) pn[q] = 0.f;
              if (t + 1 < L) { float cx[8], cc[8]; const bf16* zr = zb + (size_t)(t + 1) * INW; unpack8(*(const u32x4*)(zr + ZCX + c0), cx); unpack8(*(const u32x4*)(zr + ZCC + c0), cc);
#pragma unroll
                  for (int q = 0; q < 8; ++q) pn[q] = cc[q] * cx[q]; }
              float cb[8], o[8]; unpack8(*(const u32x4*)(zb + (size_t)t * INW + ZCB + c0), cb);
#pragma unroll
              for (int q = 0; q < 8; ++q) { o[q] = cb[q] * (wa[q] * pp[q] + wb[q] * pc[q] + wc_[q] * pn[q]); pp[q] = pc[q]; pc[q] = pn[q]; }
              u32x4 w; w.x = pk2(o[0], o[1]); w.y = pk2(o[2], o[3]); w.z = pk2(o[4], o[5]); w.w = pk2(o[6], o[7]);
              *(u32x4*)(MIX + (size_t)(r0 + i) * MIXW + 512 + c0) = w; } }
        { const int hw = 1 << (c0 >> 7);
          float s[8];
#pragma unroll
          for (int q = 0; q < 8; ++q) s[q] = 0.f;
#pragma unroll
          for (int j = -8; j < 8; ++j) { const int tt = t0 + j; if (j >= -hw && j < hw && tt >= 0 && tt < L) { float u[8]; unpack8(*(const u32x4*)(zb + (size_t)tt * INW + ZPU + c0), u);
#pragma unroll
                  for (int q = 0; q < 8; ++q) s[q] += u[q]; } }
#pragma unroll
          for (int i = 0; i < 8; ++i) { const int t = t0 + i; const int lo = t - hw < 0 ? 0 : t - hw, hi = t + hw > L ? L : t + hw;
              float u0[8]; unpack8(*(const u32x4*)(zb + (size_t)t * INW + ZPU + c0), u0);
              const float inv = 1.0f / (float)(hi - lo);
              u32x4 w; w.x = pk2(s[0] * inv - u0[0], s[1] * inv - u0[1]); w.y = pk2(s[2] * inv - u0[2], s[3] * inv - u0[3]);
              w.z = pk2(s[4] * inv - u0[4], s[5] * inv - u0[5]); w.w = pk2(s[6] * inv - u0[6], s[7] * inv - u0[7]);
              *(u32x4*)(MIX + (size_t)(r0 + i) * MIXW + 1024 + c0) = w;
              if (i < 7) {
                  if (t + hw < L) { float u[8]; unpack8(*(const u32x4*)(zb + (size_t)(t + hw) * INW + ZPU + c0), u);
#pragma unroll
                      for (int q = 0; q < 8; ++q) s[q] += u[q]; }
                  if (t - hw >= 0) { float u[8]; unpack8(*(const u32x4*)(zb + (size_t)(t - hw) * INW + ZPU + c0), u);
#pragma unroll
                      for (int q = 0; q < 8; ++q) s[q] -= u[q]; } } } }
    }
}

__device__ __forceinline__ void attn_naive_phase(Frame& F, const float* sinkl, int nrows) {
    const bf16* Z = (const bf16*)(F.ws + WS_Z); bf16* MIX = (bf16*)(F.ws + WS_MIX);
    LAS float* qs = (LAS float*)(F.lds + F.wave * 10240);
    LAS float* sc = qs + 256;
    const int nunits = nrows * 2, NGW = F.G * NWAVES;
    for (int uidx = F.bx * NWAVES + F.wave; uidx < nunits; uidx += NGW) {
        const int r = uidx >> 1, kh = uidx & 1;
        int b, nloc, krow0;
        if (r < ML) { b = r / SEQ; const int t = r % SEQ; const int lo = t - 128 < 0 ? 0 : t - 128, hi = t + 128 > SEQ - 1 ? SEQ - 1 : t + 128; nloc = hi - lo + 1; krow0 = b * SEQ + lo; }
        else { b = (r - ML) / CTXL; nloc = 0; krow0 = 0; }
        const int crow0 = ML + b * CTXL, nk = nloc + CTXL;
        { const u32x2 qw = *(const u32x2*)(Z + (size_t)r * INW + ZQ + kh * 256 + 4 * F.lane); const int g = F.lane >> 4, d = (4 * F.lane) & 63;
          qs[(d + 0) * 4 + g] = bflo(qw.x); qs[(d + 1) * 4 + g] = bfhi(qw.x); qs[(d + 2) * 4 + g] = bflo(qw.y); qs[(d + 3) * 4 + g] = bfhi(qw.y); }
        LDS_WAIT(); asm volatile("" ::: "memory");
        for (int c0 = 0; c0 < nk; c0 += 64) {
            const int kk = c0 + F.lane;
            if (kk < nk) {
                const int krow = kk < nloc ? krow0 + kk : crow0 + (kk - nloc);
                const u32x4* kp = (const u32x4*)(Z + (size_t)krow * INW + ZK + kh * 64);
                f32x4 s = (f32x4){0.f, 0.f, 0.f, 0.f};
#pragma unroll
                for (int d8 = 0; d8 < 8; ++d8) { float kf[8]; unpack8(kp[d8], kf);
#pragma unroll
                    for (int q = 0; q < 8; ++q) { const f32x4 qv = *(const LAS f32x4*)(qs + (d8 * 8 + q) * 4); s += qv * kf[q]; } }
                *(LAS f32x4*)(sc + kk * 4) = s;
            }
        }
        LDS_WAIT(); asm volatile("" ::: "memory");
        f32x4 mx; { const float* sk = sinkl + kh * 4; mx = (f32x4){sk[0] * LOG2E, sk[1] * LOG2E, sk[2] * LOG2E, sk[3] * LOG2E}; }
        const f32x4 snk = mx;
        for (int kk = F.lane; kk < nk; kk += 64) { const f32x4 s = *(const LAS f32x4*)(sc + kk * 4); mx.x = fmaxf(mx.x, s.x); mx.y = fmaxf(mx.y, s.y); mx.z = fmaxf(mx.z, s.z); mx.w = fmaxf(mx.w, s.w); }
        mx.x = wave_max(mx.x); mx.y = wave_max(mx.y); mx.z = wave_max(mx.z); mx.w = wave_max(mx.w);
        f32x4 sm = (f32x4){0.f, 0.f, 0.f, 0.f};
        for (int kk = F.lane; kk < nk; kk += 64) { f32x4 s = *(const LAS f32x4*)(sc + kk * 4);
            s.x = exp2f(s.x - mx.x); s.y = exp2f(s.y - mx.y); s.z = exp2f(s.z - mx.z); s.w = exp2f(s.w - mx.w); sm += s; *(LAS f32x4*)(sc + kk * 4) = s; }
        sm.x = wave_sum(sm.x) + exp2f(snk.x - mx.x); sm.y = wave_sum(sm.y) + exp2f(snk.y - mx.y); sm.z = wave_sum(sm.z) + exp2f(snk.z - mx.z); sm.w = wave_sum(sm.w) + exp2f(snk.w - mx.w);
        LDS_WAIT(); asm volatile("" ::: "memory");
        f32x4 o = (f32x4){0.f, 0.f, 0.f, 0.f};
        const bf16* vb = Z + ZV + kh * 64 + F.lane;
#pragma unroll 4
        for (int kk = 0; kk < nk; ++kk) { const int krow = kk < nloc ? krow0 + kk : crow0 + (kk - nloc);
            const float v = bf2f((unsigned)vb[(size_t)krow * INW]); const f32x4 p = *(const LAS f32x4*)(sc + kk * 4); o += p * v; }
        bf16* op = MIX + (size_t)r * MIXW + kh * 256 + F.lane;
        op[0] = (bf16)f2bf(o.x / sm.x); op[64] = (bf16)f2bf(o.y / sm.y); op[128] = (bf16)f2bf(o.z / sm.z); op[192] = (bf16)f2bf(o.w / sm.w);
        LDS_WAIT(); asm volatile("" ::: "memory");
    }
}

typedef float f32x16 __attribute__((ext_vector_type(16)));
typedef short s16x4 __attribute__((ext_vector_type(4)));
__device__ __forceinline__ unsigned cvtpk(float lo, float hi) { f32x2 v = {lo, hi}; pg8::bf16x2_t b = __builtin_convertvector(v, pg8::bf16x2_t); return __builtin_bit_cast(unsigned, b); }
__device__ __forceinline__ s16x4 vtr(const LAS unsigned char* p) { return __builtin_bit_cast(s16x4, __builtin_amdgcn_ds_read_tr16_b64_v4i16((LAS s16x4*)p)); }
constexpr int AKP = 144, ATT_V_OFF = 128 * AKP;
__device__ __forceinline__ void attn_unit(Frame& F, const bf16* Z, bf16* MIX, const float* sinkl, const bool isctx, const int b, const int kh, const int qblk) {
    const int qrow0 = isctx ? ML + b * CTXL + qblk * 128 : b * SEQ + qblk * 128;
    const int cbase = ML + b * CTXL;
    const bool has_prev = !isctx && qblk > 0, has_next = !isctx && qblk < 31;
    const int nch = isctx ? 2 : 3 + (has_prev ? 1 : 0) + (has_next ? 1 : 0);
    const int lane = F.lane, r = lane & 31, h = lane >> 5, g = F.wave >> 1, qh = F.wave & 1, head = kh * 4 + g;
    LAS unsigned char* Ks = F.lds; LAS unsigned char* Vs = F.lds + ATT_V_OFF;
    bf16x8 qf[2][4];
#pragma unroll
    for (int sub = 0; sub < 2; ++sub)
#pragma unroll
        for (int ks = 0; ks < 4; ++ks) qf[sub][ks] = *(const bf16x8*)(Z + (size_t)(qrow0 + 64 * qh + 32 * sub + r) * INW + ZQ + head * 64 + 16 * ks + 8 * h);
    const float sk = sinkl[head] * LOG2E;
    float m[2], l[2]; f32x16 O[2][2];
#pragma unroll
    for (int sub = 0; sub < 2; ++sub) { m[sub] = sk; l[sub] = h == 0 ? 1.f : 0.f;
#pragma unroll
        for (int db = 0; db < 2; ++db)
#pragma unroll
            for (int i = 0; i < 16; ++i) O[sub][db][i] = 0.f; }
#define ATT_CHUNK(ci, row0, kind) do { if (isctx) { row0 = cbase + 128 * (ci); kind = 0; } else if ((ci) == 0) { row0 = qrow0; kind = 0; } else if ((ci) <= 2) { row0 = cbase + 128 * ((ci) - 1); kind = 0; } \
        else if ((ci) == 3 && has_prev) { row0 = qrow0 - 128; kind = 1; } else { row0 = qrow0 + 128; kind = 2; } } while (0)
    const int skey = F.tid >> 3, spart = F.tid & 7;
    u32x4 pk0, pk1, pv0, pv1;
#define ATT_LOAD(ci) do { int row0_, kind_; ATT_CHUNK(ci, row0_, kind_); (void)kind_; const bf16* kp_ = Z + (size_t)(row0_ + skey) * INW + ZK + kh * 64 + spart * 8; \
        pk0 = *(const u32x4*)kp_; pk1 = *(const u32x4*)(kp_ + (size_t)64 * INW); pv0 = *(const u32x4*)(kp_ + (ZV - ZK)); pv1 = *(const u32x4*)(kp_ + (size_t)64 * INW + (ZV - ZK)); } while (0)
    ATT_LOAD(0);
    const int grp = (lane >> 4) & 1, q4 = (lane & 15) >> 2, p4 = lane & 3;
    for (int ci = 0; ci < nch; ++ci) {
        __syncthreads();
        *(LAS u32x4*)(Ks + skey * AKP + spart * 16) = pk0; *(LAS u32x4*)(Ks + (skey + 64) * AKP + spart * 16) = pk1;
        *(LAS u32x4*)(Vs + skey * AKP + spart * 16) = pv0; *(LAS u32x4*)(Vs + (skey + 64) * AKP + spart * 16) = pv1;
        if (ci + 1 < nch) ATT_LOAD(ci + 1);
        __syncthreads();
        int row0, kind; ATT_CHUNK(ci, row0, kind); (void)row0;
        int dl = 4 * h - r - 64 * qh; asm volatile("" : "+v"(dl));
        for (int t = 0; t < 4; ++t) {
            if (kind == 1 && 32 * t + 31 < 64 * qh) continue;
            if (kind == 2 && 32 * t > 64 * qh + 63) continue;
            bf16x8 kf[4], vf[2][2];
#pragma unroll
            for (int ks = 0; ks < 4; ++ks) kf[ks] = *(const LAS bf16x8*)(Ks + (32 * t + r) * AKP + 32 * ks + 16 * h);
#pragma unroll
            for (int s = 0; s < 2; ++s)
#pragma unroll
                for (int db = 0; db < 2; ++db) { const LAS unsigned char* vp = Vs + (32 * t + 16 * s + 4 * h + q4) * AKP + (32 * db + 16 * grp + 4 * p4) * 2;
                    const s16x4 lo = vtr(vp), hi = vtr(vp + 8 * AKP); vf[s][db] = __builtin_shufflevector(lo, hi, 0, 1, 2, 3, 4, 5, 6, 7); }
#pragma unroll
            for (int sub = 0; sub < 2; ++sub) {
                if (kind == 1 && 32 * t + 31 < 64 * qh + 32 * sub) continue;
                if (kind == 2 && 32 * t > 64 * qh + 32 * sub + 31) continue;
                f32x16 S;
#pragma unroll
                for (int i = 0; i < 16; ++i) S[i] = 0.f;
#pragma unroll
                for (int ks = 0; ks < 4; ++ks) S = __builtin_amdgcn_mfma_f32_32x32x16_bf16(kf[ks], qf[sub][ks], S, 0, 0, 0);
                if (kind != 0) { const int d0 = dl + 32 * t - 32 * sub;
#pragma unroll
                    for (int i = 0; i < 16; ++i) { const int dd = d0 + (i & 3) + 8 * (i >> 2); const bool ok = kind == 1 ? (dd >= 0) : (dd <= 0); S[i] = ok ? S[i] : -1.0e30f; } }
                float tmax = S[0];
#pragma unroll
                for (int i = 1; i < 16; ++i) tmax = fmaxf(tmax, S[i]);
                tmax = fmaxf(tmax, __shfl_xor(tmax, 32));
                const float mnew = fmaxf(m[sub], tmax);
                if (__any(mnew > m[sub])) { const float alpha = __builtin_amdgcn_exp2f(m[sub] - mnew); l[sub] *= alpha; m[sub] = mnew;
#pragma unroll
                    for (int db = 0; db < 2; ++db)
#pragma unroll
                        for (int i = 0; i < 16; ++i) O[sub][db][i] *= alpha; }
                float ps = 0.f;
#pragma unroll
                for (int i = 0; i < 16; ++i) { S[i] = __builtin_amdgcn_exp2f(S[i] - m[sub]); ps += S[i]; }
                l[sub] += ps;
                u32x4 w0, w1; w0.x = cvtpk(S[0], S[1]); w0.y = cvtpk(S[2], S[3]); w0.z = cvtpk(S[4], S[5]); w0.w = cvtpk(S[6], S[7]);
                w1.x = cvtpk(S[8], S[9]); w1.y = cvtpk(S[10], S[11]); w1.z = cvtpk(S[12], S[13]); w1.w = cvtpk(S[14], S[15]);
                const bf16x8 P0 = __builtin_bit_cast(bf16x8, w0), P1 = __builtin_bit_cast(bf16x8, w1);
#pragma unroll
                for (int db = 0; db < 2; ++db) { O[sub][db] = __builtin_amdgcn_mfma_f32_32x32x16_bf16(vf[0][db], P0, O[sub][db], 0, 0, 0); O[sub][db] = __builtin_amdgcn_mfma_f32_32x32x16_bf16(vf[1][db], P1, O[sub][db], 0, 0, 0); }
            }
        }
    }
#undef ATT_CHUNK
#undef ATT_LOAD
#pragma unroll
    for (int sub = 0; sub < 2; ++sub) { const float lt = l[sub] + __shfl_xor(l[sub], 32), inv = 1.f / lt;
        bf16* op = MIX + (size_t)(qrow0 + 64 * qh + 32 * sub + r) * MIXW + head * 64 + 4 * h;
#pragma unroll
        for (int db = 0; db < 2; ++db)
#pragma unroll
            for (int gq = 0; gq < 4; ++gq) { u32x2 w; w.x = cvtpk(O[sub][db][4 * gq] * inv, O[sub][db][4 * gq + 1] * inv); w.y = cvtpk(O[sub][db][4 * gq + 2] * inv, O[sub][db][4 * gq + 3] * inv);
                *(u32x2*)(op + 32 * db + 8 * gq) = w; } }
}
__device__ __forceinline__ void attn_mfma_phase(Frame& F, const float* sinkl, const bool with_ctx) {
    const bf16* Z = (const bf16*)(F.ws + WS_Z); bf16* MIX = (bf16*)(F.ws + WS_MIX);
    const int vcu = (F.G % 8 == 0) ? (F.bx % 8) * (F.G / 8) + F.bx / 8 : F.bx;
    const int nun = with_ctx ? 272 : 256;
    for (int u = vcu; u < nun; u += F.G) { const bool isctx = u >= 256; const int uu = isctx ? (u - 256) : u;
        attn_unit(F, Z, MIX, sinkl, isctx, isctx ? (uu >> 2) : (uu >> 6), isctx ? ((uu >> 1) & 1) : ((uu >> 5) & 1), isctx ? (uu & 1) : (uu & 31)); }
    __syncthreads();
}

using pg8::Unit;
struct SchedStd {
    const char* A; const char* B; size_t astep, bstep; int nM, nN, G, c, nx, xpm0, xpn;
    __device__ __forceinline__ bool next(int i, Unit& u) const {
        const int L = i * G + c, nwg = nM * nN; if (L >= nwg + nx) return false;
        if (L < nwg) pg8::tile_of(L, nM, nN, u.pm, u.pn); else { u.pm = xpm0 + (L - nwg); u.pn = xpn; }
        u.tag = 0; u.a = A + (size_t)u.pm * astep; u.b = B + (size_t)u.pn * bstep; return true;
    }
};
struct SchedMoe {
    const char* A; const char* B; size_t astep, bstep_e, bstep_n; int NJ, G, c; const int* tile;
    __device__ __forceinline__ bool next(int i, Unit& u) const {
        const int nt = __builtin_amdgcn_readfirstlane(__hip_atomic_load(tile + 200, __ATOMIC_RELAXED, __HIP_MEMORY_SCOPE_AGENT));
        const int L = i * G + c; if (L >= nt * NJ) return false;
        u.pm = L % nt; u.pn = L / nt; u.tag = __builtin_amdgcn_readfirstlane(__hip_atomic_load(tile + u.pm, __ATOMIC_RELAXED, __HIP_MEMORY_SCOPE_AGENT));
        u.a = A + (size_t)u.pm * astep; u.b = B + (size_t)u.tag * bstep_e + (size_t)u.pn * bstep_n; return true;
    }
};

struct EpiGate {
    static constexpr bool PERM = true, MIDHOOK = false;
    bf16* Z;
    __device__ __forceinline__ void operator()(const f32x4 (&acc)[2][2][4][2], const Unit& u, int wr, int wc, int fr, int fq) const {
        const int row0 = u.pm * 256 + wr * 64 + fr, col0 = ZG + u.pn * 256 + wc * 32 + 8 * fq;
#pragma unroll
        for (int ai = 0; ai < 2; ++ai)
#pragma unroll
            for (int m = 0; m < 4; ++m)
#pragma unroll
                for (int bj = 0; bj < 2; ++bj) { f32x4 v0 = acc[ai][bj][m][0], v1 = acc[ai][bj][m][1];
#pragma unroll
                    for (int q = 0; q < 4; ++q) { v0[q] = __builtin_amdgcn_rcpf(1.f + __expf(-v0[q])); v1[q] = __builtin_amdgcn_rcpf(1.f + __expf(-v1[q])); }
                    u32x4 w; w.x = pg8::cvt_pk_bf16(v0[0], v0[1]); w.y = pg8::cvt_pk_bf16(v0[2], v0[3]); w.z = pg8::cvt_pk_bf16(v1[0], v1[1]); w.w = pg8::cvt_pk_bf16(v1[2], v1[3]);
                    *(u32x4*)(Z + (size_t)(row0 + ai * 128 + m * 16) * INW + col0 + bj * 128) = w; }
    }
};
struct EpiIn {
    static constexpr bool PERM = true, MIDHOOK = false;
    bf16* Z; const float* rope;
    __device__ __forceinline__ void operator()(const f32x4 (&acc)[2][2][4][2], const Unit& u, int wr, int wc, int fr, int fq) const {
        const int row0 = u.pm * 256 + wr * 64 + fr, col0 = u.pn * 256 + wc * 32 + 8 * fq;
        const bool latent = u.pm < 64, gate = u.pn >= 11;
        const float sgn = fq < 2 ? -1.f : 1.f;
#pragma unroll
        for (int ai = 0; ai < 2; ++ai)
#pragma unroll
            for (int m = 0; m < 4; ++m) { const int row = row0 + ai * 128 + m * 16; bf16* rowp = Z + (size_t)row * INW + col0;
                const int pos = (wc & 1) ? (16 * m + fr) : (4 * (u.pm & 15) + 2 * ai + wr);
#pragma unroll
                for (int bj = 0; bj < 2; ++bj) { f32x4 v0 = acc[ai][bj][m][0], v1 = acc[ai][bj][m][1];
                    const bool isq = u.pn < 2, isk = (u.pn == 2 && bj == 0);
                    if (isq || isk) {
                        if (latent) {
                            const f32x4* cs = (const f32x4*)(rope + (size_t)(pos * 16 + 8 * (fq & 1)) * 2);
                            const f32x4 t0 = cs[0], t1 = cs[1], t2 = cs[2], t3 = cs[3];
                            f32x4 p0, p1;
                            p0.x = __shfl_xor(v0.x, 32); p0.y = __shfl_xor(v0.y, 32); p0.z = __shfl_xor(v0.z, 32); p0.w = __shfl_xor(v0.w, 32);
                            p1.x = __shfl_xor(v1.x, 32); p1.y = __shfl_xor(v1.y, 32); p1.z = __shfl_xor(v1.z, 32); p1.w = __shfl_xor(v1.w, 32);
                            v0.x = v0.x * t0.x + p0.x * (sgn * t0.y); v0.y = v0.y * t0.z + p0.y * (sgn * t0.w); v0.z = v0.z * t1.x + p0.z * (sgn * t1.y); v0.w = v0.w * t1.z + p0.w * (sgn * t1.w);
                            v1.x = v1.x * t2.x + p1.x * (sgn * t2.y); v1.y = v1.y * t2.z + p1.y * (sgn * t2.w); v1.z = v1.z * t3.x + p1.z * (sgn * t3.y); v1.w = v1.w * t3.z + p1.w * (sgn * t3.w);
                        }
                        if (isq) { v0 = v0 * QSCALE; v1 = v1 * QSCALE; }
                    }
                    if (gate) {
#pragma unroll
                        for (int q = 0; q < 4; ++q) { v0[q] = 1.f / (1.f + __expf(-v0[q])); v1[q] = 1.f / (1.f + __expf(-v1[q])); } }
                    u32x4 w; w.x = pg8::cvt_pk_bf16(v0[0], v0[1]); w.y = pg8::cvt_pk_bf16(v0[2], v0[3]); w.z = pg8::cvt_pk_bf16(v1[0], v1[1]); w.w = pg8::cvt_pk_bf16(v1[2], v1[3]);
                    *(u32x4*)(rowp + bj * 128) = w; } }
    }
};
struct EpiBrG {
    static constexpr bool PERM = true, MIDHOOK = true;
    const bf16* Z; bf16* Y;
    __device__ __forceinline__ void mid(f32x4 (&acc)[2][2][4][2], const Unit& u, int seg, int wr, int wc, int fr, int fq) const {
        const int row0 = u.pm * 256 + wr * 64 + fr, col0 = u.pn * 256 + wc * 32 + 8 * fq;
#pragma unroll
        for (int ai = 0; ai < 2; ++ai)
#pragma unroll
            for (int m = 0; m < 4; ++m) { const bf16* gp = Z + (size_t)(row0 + ai * 128 + m * 16) * INW + ZG + (seg - 1) * D + col0;
#pragma unroll
                for (int bj = 0; bj < 2; ++bj) { const u32x4 ga = *(const u32x4*)(gp + bj * 128), gb = *(const u32x4*)(gp + D + bj * 128);
                    f32x4 r0, r1;
                    r0.x = bflo(ga.x) * __builtin_amdgcn_rcpf(bflo(gb.x)); r0.y = bfhi(ga.x) * __builtin_amdgcn_rcpf(bfhi(gb.x)); r0.z = bflo(ga.y) * __builtin_amdgcn_rcpf(bflo(gb.y)); r0.w = bfhi(ga.y) * __builtin_amdgcn_rcpf(bfhi(gb.y));
                    r1.x = bflo(ga.z) * __builtin_amdgcn_rcpf(bflo(gb.z)); r1.y = bfhi(ga.z) * __builtin_amdgcn_rcpf(bfhi(gb.z)); r1.z = bflo(ga.w) * __builtin_amdgcn_rcpf(bflo(gb.w)); r1.w = bfhi(ga.w) * __builtin_amdgcn_rcpf(bfhi(gb.w));
                    acc[ai][bj][m][0] *= r0; acc[ai][bj][m][1] *= r1; }
                if (m == 3) asm volatile("" ::: "memory"); }
    }
    __device__ __forceinline__ void operator()(const f32x4 (&acc)[2][2][4][2], const Unit& u, int wr, int wc, int fr, int fq) const {
        const int row0 = u.pm * 256 + wr * 64 + fr, col0 = u.pn * 256 + wc * 32 + 8 * fq;
#pragma unroll
        for (int ai = 0; ai < 2; ++ai)
#pragma unroll
            for (int m = 0; m < 4; ++m) { const size_t row = (size_t)(row0 + ai * 128 + m * 16); const bf16* gp = Z + row * INW + ZG + 2 * D + col0;
#pragma unroll
                for (int bj = 0; bj < 2; ++bj) { const u32x4 g = *(const u32x4*)(gp + bj * 128); const f32x4 v0 = acc[ai][bj][m][0], v1 = acc[ai][bj][m][1];
                    u32x4 w; w.x = pg8::cvt_pk_bf16(v0[0] * bflo(g.x), v0[1] * bfhi(g.x)); w.y = pg8::cvt_pk_bf16(v0[2] * bflo(g.y), v0[3] * bfhi(g.y));
                    w.z = pg8::cvt_pk_bf16(v1[0] * bflo(g.z), v1[1] * bfhi(g.z)); w.w = pg8::cvt_pk_bf16(v1[2] * bflo(g.w), v1[3] * bfhi(g.w));
                    *(u32x4*)(Y + row * D + col0 + bj * 128) = w; } }
    }
};
struct EpiRes {
    static constexpr bool PERM = true, MIDHOOK = false;
    const float* rl; const float* rc; float* out; const float* gv;
    __device__ __forceinline__ void operator()(const f32x4 (&acc)[2][2][4][2], const Unit& u, int wr, int wc, int fr, int fq) const {
        const int row0 = u.pm * 256 + wr * 64 + fr, col0 = u.pn * 256 + wc * 32 + 8 * fq;
        const int bidx = u.pm < 64 ? (u.pm >> 4) : 4; const float* g = gv + (size_t)bidx * MODW;
        const float* rbase = u.pm < 64 ? rl : rc - (size_t)ML * D;
        f32x4 gg[2][2];
#pragma unroll
        for (int bj = 0; bj < 2; ++bj)
#pragma unroll
            for (int n = 0; n < 2; ++n) gg[bj][n] = *(const f32x4*)(g + col0 + bj * 128 + n * 4);
#pragma unroll
        for (int ai = 0; ai < 2; ++ai)
#pragma unroll
            for (int m = 0; m < 4; ++m) { const size_t off = (size_t)(row0 + ai * 128 + m * 16) * D + col0;
#pragma unroll
                for (int bj = 0; bj < 2; ++bj)
#pragma unroll
                    for (int n = 0; n < 2; ++n) *(f32x4*)(out + off + bj * 128 + n * 4) = *(const f32x4*)(rbase + off + bj * 128 + n * 4) + gg[bj][n] * acc[ai][bj][m][n]; }
    }
};
template <bool F8> struct EpiSwiglu {
    static constexpr bool PERM = true, MIDHOOK = false;
    unsigned char* ACT; int ldc;
    __device__ __forceinline__ void operator()(const f32x4 (&acc)[2][2][4][2], const Unit& u, int wr, int wc, int fr, int fq) const {
        const int row0 = u.pm * 256 + wr * 64 + fr, col0 = u.pn * 128 + wc * 32 + 8 * fq;
#pragma unroll
        for (int ai = 0; ai < 2; ++ai)
#pragma unroll
            for (int m = 0; m < 4; ++m) { f32x4 r[2];
#pragma unroll
                for (int n = 0; n < 2; ++n) { const f32x4 g = acc[ai][0][m][n], up = acc[ai][1][m][n];
#pragma unroll
                    for (int q = 0; q < 4; ++q) r[n][q] = g[q] * __builtin_amdgcn_rcpf(1.f + __expf(-g[q])) * up[q]; }
                if constexpr (F8) { u32x2 w; w.x = pk4_fp8(r[0][0], r[0][1], r[0][2], r[0][3]); w.y = pk4_fp8(r[1][0], r[1][1], r[1][2], r[1][3]);
                    *(u32x2*)(ACT + (size_t)(row0 + ai * 128 + m * 16) * ldc + col0) = w; }
                else { u32x4 w; w.x = pg8::cvt_pk_bf16(r[0][0], r[0][1]); w.y = pg8::cvt_pk_bf16(r[0][2], r[0][3]); w.z = pg8::cvt_pk_bf16(r[1][0], r[1][1]); w.w = pg8::cvt_pk_bf16(r[1][2], r[1][3]);
                    *(u32x4*)((bf16*)ACT + (size_t)(row0 + ai * 128 + m * 16) * ldc + col0) = w; } }
    }
};
struct EpiPlain {
    static constexpr bool PERM = true, MIDHOOK = false;
    bf16* O; int ldc;
    __device__ __forceinline__ void operator()(const f32x4 (&acc)[2][2][4][2], const Unit& u, int wr, int wc, int fr, int fq) const {
        const int row0 = u.pm * 256 + wr * 64 + fr, col0 = u.pn * 256 + wc * 32 + 8 * fq;
#pragma unroll
        for (int ai = 0; ai < 2; ++ai)
#pragma unroll
            for (int m = 0; m < 4; ++m)
#pragma unroll
                for (int bj = 0; bj < 2; ++bj) { const f32x4 v0 = acc[ai][bj][m][0], v1 = acc[ai][bj][m][1];
                    u32x4 w; w.x = pg8::cvt_pk_bf16(v0[0], v0[1]); w.y = pg8::cvt_pk_bf16(v0[2], v0[3]); w.z = pg8::cvt_pk_bf16(v1[0], v1[1]); w.w = pg8::cvt_pk_bf16(v1[2], v1[3]);
                    *(u32x4*)(O + (size_t)(row0 + ai * 128 + m * 16) * ldc + col0 + bj * 128) = w; }
    }
};

#ifndef PHASE_MASK
#define PHASE_MASK 0xFFFFFFFFu
#endif
#define IN(k) (((PHASE_MASK >> (k)) & 1u) && lo <= (k) && (k) < hi)
#define SEAM(k) do { if (IN(k) && IN((k) + 1)) xcd_barrier(bar); } while (0)
#ifndef DUP_MASK
#define DUP_MASK 0u
#endif
#define REP(k) for (int rep_ = 0; rep_ < (((DUP_MASK >> (k)) & 1u) ? 2 : 1); ++rep_, (((DUP_MASK >> (k)) & 1u) && rep_ == 1 ? xcd_barrier(bar) : (void)0))
#define SITE() do { F.ws = (unsigned char*)karg_p<(int)__builtin_offsetof(Args, ws)>(); int t_ = threadIdx.x; asm volatile("" : "+v"(t_)); F.tid = t_; F.lane = t_ & 63; } while (0)
template <int l> __device__ __forceinline__ void layer_common(Frame& F, const int lo, const int hi, const XcdBarrier& bar, LAS unsigned char* ring) {
    constexpr int pb = 1 + 8 * l;
        if (IN(pb + 0)) REP(pb + 0) { SITE(); const float* modl = (const float*)(F.ws + WS_MODV) + (size_t)l * 5 * MODW; const float* X2 = (const float*)(F.ws + WS_X2);
            const float* xl = l == 0 ? KP(x) : X2; const float* xc = l == 0 ? KP(ctx) : X2 + (size_t)ML * D;
            norm_mod_phase<false, 2>(F, xl, xc, KP(norm1_g) + l * D, modl, 0, 1, MT, nullptr); } SEAM(pb + 0);
        if (IN(pb + 1)) REP(pb + 1) { SITE();
            { SchedStd S{(const char*)(F.ws + WS_H), (const char*)(F.ws + WS_WIN) + (size_t)l * ZG * D * 2, (size_t)256 * D * 2, (size_t)256 * D * 2, l == 0 ? 68 : 64, 11, F.G, F.bx, l == 0 ? 0 : 4, 64, 2};
              EpiIn E{(bf16*)(F.ws + WS_Z), (const float*)(F.ws + WS_ROPE)};
              pg8::gemm_phase<EpiIn, SchedStd, true, true>(ring, D * 2, D * 2, D * 2, S, E); }
            { SITE(); SchedStd S{(const char*)(F.ws + WS_H8), (const char*)(F.ws + WS_WIN8) + (size_t)l * 3 * D * D, (size_t)256 * D, (size_t)256 * D, l == 0 ? 68 : 64, 12, F.G, (F.bx + 20) % F.G, 0, 0, 0};
              EpiGate E{(bf16*)(F.ws + WS_Z)};
              pg8::gemm_phase<EpiGate, SchedStd, true, true, true>(ring, D, D, D, S, E); }
        } SEAM(pb + 1);
        if (IN(pb + 2)) REP(pb + 2) { SITE(); const int nrows = l == 0 ? MT : ML; if (ATTN_NAIVE) attn_naive_phase(F, KP(sink) + l * 8, nrows); else { for (int rp_ = 0; rp_ < 1 + PROBE_ATT; ++rp_) attn_mfma_phase(F, KP(sink) + l * 8, l == 0); } for (int rp_ = 0; rp_ < 1 + PROBE_MIXL; ++rp_) local_mix_phase(F, KP(conv_w) + (size_t)l * 3 * 512, nrows, l == 0 && !ATTN_NAIVE); } SEAM(pb + 2);
        if (IN(pb + 3)) REP(pb + 3) { SITE();
            SchedStd S{(const char*)(F.ws + WS_MIX), (const char*)(F.ws + WS_WBR) + (size_t)l * D * MIXW * 2, (size_t)256 * MIXW * 2, (size_t)256 * MIXW * 2, l == 0 ? 68 : 64, 4, F.G, F.bx, 0, 0, 0};
            EpiBrG E{(const bf16*)(F.ws + WS_Z), (bf16*)(F.ws + WS_Y)};
            pg8::gemm_phase<EpiBrG, SchedStd, true, true>(ring, MIXW * 2, MIXW * 2, MIXW * 2, S, E);
        } SEAM(pb + 3);
        if (IN(pb + 4)) REP(pb + 4) { SITE(); const float* modl = (const float*)(F.ws + WS_MODV) + (size_t)l * 5 * MODW; const float* X2 = (const float*)(F.ws + WS_X2);
            const float* xl = l == 0 ? KP(x) : X2; const float* xc = l == 0 ? KP(ctx) : X2 + (size_t)ML * D;
            SchedStd S{(const char*)(F.ws + WS_Y), (const char*)(F.ws + WS_WOUT) + (size_t)l * D * D * 2, (size_t)256 * D * 2, (size_t)256 * D * 2, l == 0 ? 68 : 64, 4, F.G, F.bx, 0, 0, 0};
            EpiRes E{xl, xc, (float*)(F.ws + WS_X1), modl + 2 * D};
            pg8::gemm_phase<EpiRes, SchedStd, true, true>(ring, D * 2, D * 2, D * 2, S, E);
        } SEAM(pb + 4);
}
constexpr int N_PHASES = 19;
__global__ void __launch_bounds__(NTHR, 2) mk_fwd(Args args_byval) {
    extern __shared__ __attribute__((aligned(16))) unsigned char lds_raw[];
    Frame F;
    F.lds = (LAS unsigned char*)lds_raw;
    F.tid = threadIdx.x; F.lane = F.tid & 63; F.wave = __builtin_amdgcn_readfirstlane(F.tid >> 6);
    F.G = gridDim.x; F.bx = blockIdx.x;
    SITE();
    volatile LAS unsigned* MISC = (volatile LAS unsigned*)(F.lds + MISC_OFF);
    for (int u = F.tid; u < (LDS_BYTES - LDSCTL_OFF) / 4; u += NTHR) ((LAS unsigned*)(F.lds + LDSCTL_OFF))[u] = 0u;
    __syncthreads();
    const int lo = karg_i<(int)__builtin_offsetof(Args, ph_lo)>(), hi = karg_i<(int)__builtin_offsetof(Args, ph_hi)>();
    const bool fused = (hi - lo) > 1;
    XcdBarrier bar; bar.bar = (unsigned*)(F.ws + WS_CTL) + CW_BAR; bar.x = 0; bar.st = nullptr;
    if (fused) bar = xcd_barrier_post((unsigned*)(F.ws + WS_CTL) + CW_BAR, MISC + 8);
    LAS unsigned char* ring = F.lds;

    if (IN(0)) REP(0) { SITE(); p0_prologue(F); } SEAM(0);

    layer_common<0>(F, lo, hi, bar, ring);
    {
            if (IN(6)) REP(6) { SITE(); const float* X1 = (const float*)(F.ws + WS_X1); norm_mod_phase<false, FFN0_FP8 ? 1 : 0>(F, X1, X1 + (size_t)ML * D, KP(norm2_g), (const float*)(F.ws + WS_MODV), 3, 4, MT, nullptr); } SEAM(6);
            if (IN(7)) REP(7) { SITE();
                constexpr int EB = FFN0_FP8 ? 1 : 2;
                SchedStd S{(const char*)(F.ws + WS_H), (const char*)(F.ws + WS_WGU0), (size_t)256 * D * EB, (size_t)256 * D * EB, 68, 22, F.G, F.bx, 0, 0, 0};
                EpiSwiglu<(FFN0_FP8 || DN0_FP8)> E{(unsigned char*)(F.ws + WS_ACT), DFF};
                pg8::gemm_phase<EpiSwiglu<(FFN0_FP8 || DN0_FP8)>, SchedStd, true, true, FFN0_FP8 != 0>(ring, D * EB, D * EB, D * EB, S, E);
            } SEAM(7);
            if (IN(8)) REP(8) { SITE(); const float* X1 = (const float*)(F.ws + WS_X1);
                constexpr int EB = (FFN0_FP8 || DN0_FP8) ? 1 : 2;
                SchedStd S{(const char*)(F.ws + WS_ACT), (const char*)(F.ws + WS_WDN0), (size_t)256 * DFF * EB, (size_t)256 * DFF * EB, 68, 4, F.G, F.bx, 0, 0, 0};
                EpiRes E{X1, X1 + (size_t)ML * D, (float*)(F.ws + WS_X2), (const float*)(F.ws + WS_MODV) + 5 * D};
                pg8::gemm_phase<EpiRes, SchedStd, true, true, (FFN0_FP8 || DN0_FP8)>(ring, DFF * EB, DFF * EB, DFF * EB, S, E);
            } SEAM(8);
    }
    layer_common<1>(F, lo, hi, bar, ring);
    {
            if (IN(14)) REP(14) { SITE(); const float* X1 = (const float*)(F.ws + WS_X1); norm_mod_phase<true, 1>(F, X1, X1, KP(norm2_g) + D, (const float*)(F.ws + WS_MODV) + (size_t)5 * MODW, 3, 4, ML, KP(router_w)); } SEAM(14);
            if (IN(15)) REP(15) { SITE(); moe_scatter_phase(F); } SEAM(15);
            if (IN(16)) REP(16) { SITE();
                SchedMoe S{(const char*)(F.ws + WS_H2S), (const char*)(F.ws + WS_WMGU), (size_t)256 * D, (size_t)2 * DFE * D, (size_t)256 * D, 28, F.G, F.bx, (const int*)(F.ws + WS_TILE)};
                EpiSwiglu<true> E{(unsigned char*)(F.ws + WS_ACT), DFE};
                pg8::gemm_phase<EpiSwiglu<true>, SchedMoe, true, true, true>(ring, D, D, D, S, E);
            } SEAM(16);
            if (IN(17)) REP(17) { SITE();
                SchedMoe S{(const char*)(F.ws + WS_ACT), (const char*)(F.ws + WS_WMDN), (size_t)256 * DFE, (size_t)D * DFE, (size_t)256 * DFE, 4, F.G, F.bx, (const int*)(F.ws + WS_TILE)};
                EpiPlain E{(bf16*)(F.ws + WS_YS), D};
                pg8::gemm_phase<EpiPlain, SchedMoe, true, true, true>(ring, DFE, DFE, DFE, S, E);
            } SEAM(17);
            if (IN(18)) REP(18) { SITE(); final_phase(F, KP(final_g), (float*)karg_p<(int)__builtin_offsetof(Args, out)>(), (const float*)(F.ws + WS_MODV) + (size_t)5 * MODW); }
        }

#undef IN
#undef SEAM
}

extern "C" void kernel_launch(void* const* d_in, const int* in_sizes, int n_in, void* d_out, int out_size, void* d_ws, size_t ws_size, hipStream_t stream) {
    static int grid = 0;
    if (grid == 0) {
        if (n_in != 21 || out_size != ML * D || ws_size < WS_END) { fprintf(stderr, "kernel_launch: unexpected sizes (n_in %d, out %d, ws %zu < %zu)\n", n_in, out_size, ws_size, (size_t)WS_END); grid = -1; return; }
        int dev = 0, cus = 0, per_cu = 0;
        if (hipGetDevice(&dev) != hipSuccess || hipDeviceGetAttribute(&cus, hipDeviceAttributeMultiprocessorCount, dev) != hipSuccess) { grid = -1; return; }
        if (hipFuncSetAttribute((const void*)mk_fwd, hipFuncAttributeMaxDynamicSharedMemorySize, LDS_BYTES) != hipSuccess) { fprintf(stderr, "kernel_launch: hipFuncSetAttribute failed\n"); grid = -1; return; }
        if (hipOccupancyMaxActiveBlocksPerMultiprocessor(&per_cu, (const void*)mk_fwd, NTHR, LDS_BYTES) != hipSuccess || per_cu < 1) { fprintf(stderr, "kernel_launch: occupancy query says %d\n", per_cu); per_cu = 1; }
        (void)hipGetLastError();
        grid = cus;
    }
    if (grid < 0) return;
    (void)hipMemsetAsync((char*)d_ws + WS_CTL, 0, CTL_ZERO_BYTES, stream);
    Args a{};
    const float** pp = (const float**)&a;
    for (int i = 0; i < 21; ++i) pp[i] = (const float*)d_in[i];
    a.out = (float*)d_out; a.ws = (unsigned char*)d_ws;
#if MK_FUSED
    a.ph_lo = 0; a.ph_hi = N_PHASES;
    hipLaunchKernelGGL(mk_fwd, dim3(grid), dim3(NTHR), LDS_BYTES, stream, a);
#else
    for (int p = 0; p < N_PHASES; ++p) { a.ph_lo = p; a.ph_hi = p + 1; hipLaunchKernelGGL(mk_fwd, dim3(grid), dim3(NTHR), LDS_BYTES, stream, a); }
#endif
}
```

```cpp
#include <hip/hip_runtime.h>
#include <cstdio>
#include <cstdint>

#ifndef ATTN_NAIVE
#define ATTN_NAIVE 0
#endif
#ifndef DN0_FP8
#define DN0_FP8 1
#endif
#ifndef FFN0_FP8
#define FFN0_FP8 0
#endif
#ifndef PROBE_ATT
#define PROBE_ATT 0
#endif
#ifndef PROBE_MIXL
#define PROBE_MIXL 0
#endif
#ifndef MK_FUSED
#define MK_FUSED 1
#endif

#define LAS __attribute__((address_space(3)))
#define GAS __attribute__((address_space(1)))
typedef unsigned short bf16;
typedef short bf16x8 __attribute__((ext_vector_type(8)));
typedef float f32x4 __attribute__((ext_vector_type(4)));
typedef float f32x2 __attribute__((ext_vector_type(2)));
typedef unsigned u32x4 __attribute__((ext_vector_type(4)));
typedef unsigned u32x2 __attribute__((ext_vector_type(2)));
typedef GAS unsigned gu32;

constexpr int D = 1024, NB = 4, SEQ = 4096, ML = NB * SEQ, CTXL = 256, MC = NB * CTXL, MT = ML + MC;
constexpr int INW = 5888, DFF = 2816, DFE = 3584, NE = 8;
constexpr int ZQ = 0, ZK = 512, ZV = 640, ZCX = 768, ZCB = 1280, ZCC = 1792, ZPU = 2304, ZG = 2816;
constexpr int MIXW = 1536;
constexpr int MS = 2 * ML + NE * 256;
constexpr int MODW = 6 * D;
constexpr float EPS = 1e-6f;
constexpr float LOG2E = 1.4426950408889634f, QSCALE = 0.125f * LOG2E;
constexpr int NWAVES = 8, NTHR = 512;

__device__ __forceinline__ unsigned f2bf(float f) { unsigned u = __builtin_bit_cast(unsigned, f); return (u + 0x7fffu + ((u >> 16) & 1u)) >> 16; }
typedef __bf16 bf16x2v __attribute__((ext_vector_type(2)));
__device__ __forceinline__ unsigned pk2(float lo, float hi) { f32x2 v = {lo, hi}; bf16x2v b = __builtin_convertvector(v, bf16x2v); return __builtin_bit_cast(unsigned, b); }
__device__ __forceinline__ float bf2f(unsigned b) { return __builtin_bit_cast(float, b << 16); }
__device__ __forceinline__ float clamp8(float x) { return __builtin_amdgcn_fmed3f(x, -448.f, 448.f); }
__device__ __forceinline__ unsigned pk4_fp8(float a, float b, float c, float d) { int w = 0; w = __builtin_amdgcn_cvt_pk_fp8_f32(clamp8(a), clamp8(b), w, false); w = __builtin_amdgcn_cvt_pk_fp8_f32(clamp8(c), clamp8(d), w, true); return (unsigned)w; }
constexpr float W8SCALE = 256.0f;
__device__ __forceinline__ float bflo(unsigned w) { return __builtin_bit_cast(float, w << 16); }
__device__ __forceinline__ float bfhi(unsigned w) { return __builtin_bit_cast(float, w & 0xffff0000u); }

namespace pg8 {
constexpr int BM = 256, BK = 64, HALF = 128, HTB = HALF * BK * 2, STAGE_BYTES = 8 * HTB, NXCD = 8, WGM = 8;
__host__ __device__ __forceinline__ int lds_byte(int r, int c) { const int st = (r >> 4) * 2 + (c >> 5), rr = r & 15, cc = c & 31, ob = rr * 64 + cc * 2; return st * 1024 + (ob ^ (((ob >> 9) & 1) << 5)); }
__host__ __device__ __forceinline__ void stage_rc(int b, int& R, int& C) { const int st = b / 1024, sb = b % 1024, swz = sb ^ (((sb >> 9) & 1) << 5); R = (st >> 1) * 16 + swz / 64; C = (st & 1) * 32 + (swz % 64) / 2; }
__host__ __device__ __forceinline__ int perm32(int rho) { const int n = rho >> 4, i = rho & 15; return 8 * (i >> 2) + 4 * n + (i & 3); }

struct Unit { int pm, pn, tag; const char* a; const char* b; };

__device__ __forceinline__ void tile_of(int L, int nM, int nN, int& pm, int& pn) {
    const int nwg = nM * nN; int wgid = L;
    { const int q = nwg / NXCD, r = nwg % NXCD, xcd = wgid % NXCD, off = wgid / NXCD; wgid = (xcd < r ? xcd * (q + 1) : r * (q + 1) + (xcd - r) * q) + off; }
    const int nig = WGM * nN, gid = wgid / nig, fm = gid * WGM, gsz = (nM - fm) < WGM ? (nM - fm) : WGM;
    pm = fm + ((wgid % nig) % gsz); pn = (wgid % nig) / gsz;
}

typedef __bf16 bf16x2_t __attribute__((ext_vector_type(2)));
__device__ __forceinline__ unsigned cvt_pk_bf16(float lo, float hi) { f32x2 v = {lo, hi}; bf16x2_t b = __builtin_convertvector(v, bf16x2_t); return __builtin_bit_cast(unsigned, b); }

typedef int i32x8 __attribute__((ext_vector_type(8)));
typedef int i32x4 __attribute__((ext_vector_type(4)));
template <class Epi, class Sched, bool ALIGN_EPI = false, bool SP2 = false, bool FP8 = false>
__device__ __forceinline__ void gemm_phase(LAS unsigned char* lds, const int lda, const int ldb, const int K, const Sched& S, const Epi& E) {
    int tid_ = threadIdx.x; asm volatile("" : "+v"(tid_));
    const int tid = tid_, wid = __builtin_amdgcn_readfirstlane(tid >> 6), lane = tid & 63, wr = wid >> 2, wc = wid & 3, fr = lane & 15, fq = lane >> 4;
    const int nt = K / 128;
    unsigned voffA[2], voffB[2];
#pragma unroll
    for (int i = 0; i < 2; ++i) { int R, C; stage_rc(tid * 16 + i * 8192, R, C); const int Rb = Epi::PERM ? ((R & ~31) + perm32(R & 31)) : R;
        voffA[i] = (unsigned)(R * lda + C * 2); voffB[i] = (unsigned)(Rb * ldb + C * 2); }
    const size_t kstep = (size_t)(BK * 2);
    const size_t hstepA = (size_t)HALF * lda, hstepB = (size_t)HALF * ldb;
    const unsigned ldsw = (unsigned)wid * 1024u;
    const int aoff = lds_byte(wr * 64 + fr, fq * 8), boff = lds_byte(wc * 32 + fr, fq * 8);
#define PG8_SA(b, h) (((b) * 2 + (h)) * HTB)
#define PG8_SB(b, h) ((4 + (b) * 2 + (h)) * HTB)
#define PG8_STAGE(bufoff, gbase, voff) do { _Pragma("unroll") for (int _i = 0; _i < 2; ++_i) \
        __builtin_amdgcn_global_load_lds((const unsigned*)((const char*)(gbase) + (voff)[_i]), (LAS unsigned*)(lds + (bufoff) + ldsw + _i * 8192), 16, 0, 0); } while (0)
#define PG8_RD(off) __builtin_bit_cast(i32x4, *(const LAS bf16x8*)(lds + (off)))
#define PG8_LDA(dst, b, h) do { _Pragma("unroll") for (int m = 0; m < 4; ++m) dst[m] = __builtin_shufflevector(PG8_RD(PG8_SA(b, h) + aoff + m * 2048), PG8_RD(PG8_SA(b, h) + aoff + m * 2048 + 1024), 0, 1, 2, 3, 4, 5, 6, 7); } while (0)
#define PG8_LDB(dst, b, h) do { _Pragma("unroll") for (int n = 0; n < 2; ++n) dst[n] = __builtin_shufflevector(PG8_RD(PG8_SB(b, h) + boff + n * 2048), PG8_RD(PG8_SB(b, h) + boff + n * 2048 + 1024), 0, 1, 2, 3, 4, 5, 6, 7); } while (0)
#define PG8_LO(x) __builtin_bit_cast(bf16x8, __builtin_shufflevector((x), (x), 0, 1, 2, 3))
#define PG8_HI(x) __builtin_bit_cast(bf16x8, __builtin_shufflevector((x), (x), 4, 5, 6, 7))
#define PG8_MMA(ai, bj, At, Bt) do { __builtin_amdgcn_s_setprio(1); _Pragma("unroll") for (int m = 0; m < 4; ++m) _Pragma("unroll") for (int n = 0; n < 2; ++n) { \
        if constexpr (FP8) asm volatile("s_nop 1\n\tv_mfma_scale_f32_16x16x128_f8f6f4 %0, %1, %2, %0, %3, %4 op_sel_hi:[0,0,0]" : "+v"(acc[ai][bj][m][n]) : "v"(Bt[n]), "v"(At[m]), "v"(sc_w), "v"(sc_a)); \
        else { acc[ai][bj][m][n] = __builtin_amdgcn_mfma_f32_16x16x32_bf16(PG8_LO(Bt[n]), PG8_LO(At[m]), acc[ai][bj][m][n], 0, 0, 0); \
               acc[ai][bj][m][n] = __builtin_amdgcn_mfma_f32_16x16x32_bf16(PG8_HI(Bt[n]), PG8_HI(At[m]), acc[ai][bj][m][n], 0, 0, 0); } } __builtin_amdgcn_s_setprio(0); } while (0)
#define PG8_WAIT_V(n) asm volatile("s_waitcnt vmcnt(" #n ")" ::: "memory")
#define PG8_WAIT_L(n) asm volatile("s_waitcnt lgkmcnt(" #n ")" ::: "memory")
#define PG8_BAR __builtin_amdgcn_s_barrier()
#define PG8_SCHED __builtin_amdgcn_sched_barrier(0)
    Unit cur, nxt; int ui = 0;
    if (!S.next(0, cur)) return;
    f32x4 acc[2][2][4][2];
#pragma unroll
    for (int a = 0; a < 2; ++a)
#pragma unroll
        for (int b = 0; b < 2; ++b)
#pragma unroll
            for (int m = 0; m < 4; ++m)
#pragma unroll
                for (int n = 0; n < 2; ++n) acc[a][b][m][n] = (f32x4){0.f, 0.f, 0.f, 0.f};
    i32x8 At[4], B0[2], B1[2];
    const int sc_w = 0x77777777, sc_a = 0x7f7f7f7f;
    const char* cA = cur.a; const char* cB = cur.b;
    if constexpr (SP2) {
        PG8_STAGE(PG8_SB(0, 0), cB, voffB); PG8_STAGE(PG8_SB(0, 1), cB + hstepB, voffB); PG8_STAGE(PG8_SA(0, 0), cA, voffA); PG8_STAGE(PG8_SA(0, 1), cA + hstepA, voffA);
        if (wr == 1) PG8_BAR;
        PG8_WAIT_V(2); PG8_BAR;
        PG8_STAGE(PG8_SB(1, 0), cB + kstep, voffB); PG8_STAGE(PG8_SA(1, 0), cA + kstep, voffA); PG8_STAGE(PG8_SB(1, 1), cB + hstepB + kstep, voffB);
        PG8_WAIT_V(6); PG8_BAR;
    } else {
        PG8_STAGE(PG8_SB(0, 0), cB, voffB); PG8_STAGE(PG8_SA(0, 0), cA, voffA); PG8_STAGE(PG8_SB(0, 1), cB + hstepB, voffB); PG8_STAGE(PG8_SA(0, 1), cA + hstepA, voffA);
        if (wr == 1) PG8_BAR;
        PG8_WAIT_V(4); PG8_BAR;
        PG8_STAGE(PG8_SB(1, 0), cB + kstep, voffB); PG8_STAGE(PG8_SA(1, 0), cA + kstep, voffA); PG8_STAGE(PG8_SB(1, 1), cB + hstepB + kstep, voffB);
        PG8_WAIT_V(6); PG8_BAR;
    }
    for (;;) {
        const bool has_next = S.next(ui + 1, nxt);
        const char* nA = has_next ? nxt.a : cA; const char* nB = has_next ? nxt.b : cB;
        for (int t = 0; t < nt; t += 2) {
            const bool last = (t == nt - 2);
            const char* a1 = cA + (size_t)(t + 1) * kstep;
            const char* a2 = last ? nA : cA + (size_t)(t + 2) * kstep; const char* b2 = last ? nB : cB + (size_t)(t + 2) * kstep;
            const char* a3 = a2 + kstep; const char* b3 = b2 + kstep;
            if constexpr (SP2) {
            PG8_LDB(B0, 0, 0); PG8_LDB(B1, 0, 1); PG8_SCHED; PG8_LDA(At, 0, 0); PG8_STAGE(PG8_SA(1, 1), a1 + hstepA, voffA);
            PG8_WAIT_V(8); PG8_WAIT_L(0); PG8_BAR; PG8_MMA(0, 0, At, B0); PG8_MMA(0, 1, At, B1); PG8_BAR; PG8_SCHED;
            PG8_LDA(At, 0, 1); PG8_STAGE(PG8_SB(0, 0), b2, voffB); PG8_STAGE(PG8_SB(0, 1), b2 + hstepB, voffB); PG8_STAGE(PG8_SA(0, 0), a2, voffA);
            PG8_WAIT_V(8); PG8_WAIT_L(0); PG8_BAR; PG8_MMA(1, 0, At, B0); PG8_MMA(1, 1, At, B1); PG8_BAR; PG8_SCHED;
            PG8_LDB(B0, 1, 0); PG8_LDB(B1, 1, 1); PG8_SCHED; PG8_LDA(At, 1, 0); PG8_STAGE(PG8_SA(0, 1), a2 + hstepA, voffA);
            PG8_WAIT_V(8); PG8_WAIT_L(0); PG8_BAR; PG8_MMA(0, 0, At, B0); PG8_MMA(0, 1, At, B1); PG8_BAR; PG8_SCHED;
            PG8_LDA(At, 1, 1); PG8_STAGE(PG8_SB(1, 0), b3, voffB); PG8_STAGE(PG8_SB(1, 1), b3 + hstepB, voffB); PG8_STAGE(PG8_SA(1, 0), a3, voffA);
            PG8_WAIT_V(8); PG8_WAIT_L(0); PG8_BAR; PG8_MMA(1, 0, At, B0); PG8_MMA(1, 1, At, B1); PG8_BAR; PG8_SCHED;
            } else {
            PG8_LDB(B0, 0, 0); PG8_SCHED; PG8_LDA(At, 0, 0); PG8_STAGE(PG8_SA(1, 1), a1 + hstepA, voffA);
            PG8_WAIT_L(8); PG8_BAR; PG8_WAIT_L(0); PG8_MMA(0, 0, At, B0); PG8_BAR; PG8_SCHED;
            PG8_LDB(B1, 0, 1); PG8_STAGE(PG8_SB(0, 0), b2, voffB);
            PG8_BAR; PG8_WAIT_L(0); PG8_MMA(0, 1, At, B1); PG8_BAR;
            PG8_LDA(At, 0, 1); PG8_STAGE(PG8_SA(0, 0), a2, voffA);
            PG8_BAR; PG8_WAIT_L(0); PG8_MMA(1, 0, At, B0); PG8_BAR; PG8_SCHED;
            PG8_STAGE(PG8_SB(0, 1), b2 + hstepB, voffB);
            PG8_WAIT_V(6); PG8_BAR; PG8_MMA(1, 1, At, B1); PG8_BAR;
            PG8_LDB(B0, 1, 0); PG8_SCHED; PG8_LDA(At, 1, 0); PG8_STAGE(PG8_SA(0, 1), a2 + hstepA, voffA);
            PG8_WAIT_L(8); PG8_BAR; PG8_WAIT_L(0); PG8_MMA(0, 0, At, B0); PG8_BAR; PG8_SCHED;
            PG8_LDB(B1, 1, 1); PG8_STAGE(PG8_SB(1, 0), b3, voffB);
            PG8_BAR; PG8_WAIT_L(0); PG8_MMA(0, 1, At, B1); PG8_BAR;
            PG8_LDA(At, 1, 1); PG8_STAGE(PG8_SA(1, 0), a3, voffA);
            PG8_BAR; PG8_WAIT_L(0); PG8_MMA(1, 0, At, B0); PG8_BAR; PG8_SCHED;
            PG8_STAGE(PG8_SB(1, 1), b3 + hstepB, voffB);
            PG8_WAIT_V(6); PG8_BAR; PG8_MMA(1, 1, At, B1); PG8_BAR;
            }
            if constexpr (Epi::MIDHOOK) { if (((t + 2) & 7) == 0 && !last) { int fr_ = fr, fq_ = fq; asm volatile("" : "+v"(fr_), "+v"(fq_)); E.mid(acc, cur, (t + 2) >> 3, wr, wc, fr_, fq_); } }
        }
        if constexpr (ALIGN_EPI) { if (wr == 0) PG8_BAR; }
        if constexpr (FP8) asm volatile("s_nop 15\n\ts_nop 15" ::: "memory");
        { int fr_ = fr, fq_ = fq; asm volatile("" : "+v"(fr_), "+v"(fq_));
          E(acc, cur, wr, wc, fr_, fq_); }
        if (!has_next) break;
#pragma unroll
        for (int a = 0; a < 2; ++a)
#pragma unroll
            for (int b = 0; b < 2; ++b)
#pragma unroll
                for (int m = 0; m < 4; ++m)
#pragma unroll
                    for (int n = 0; n < 2; ++n) acc[a][b][m][n] = (f32x4){0.f, 0.f, 0.f, 0.f};
        cur = nxt; cA = nA; cB = nB; ++ui;
        if constexpr (ALIGN_EPI) { if (wr == 1) PG8_BAR; }
    }
    PG8_WAIT_V(0);
    if constexpr (!ALIGN_EPI) { if (wr == 0) PG8_BAR; }
    PG8_BAR;
#undef PG8_SA
#undef PG8_SB
#undef PG8_STAGE
#undef PG8_LDA
#undef PG8_LDB
#undef PG8_MMA
#undef PG8_RD
#undef PG8_LO
#undef PG8_HI
#undef PG8_WAIT_V
#undef PG8_WAIT_L
#undef PG8_BAR
#undef PG8_SCHED
}
}

constexpr size_t MiB = 1u << 20;
constexpr size_t al256(size_t x) { return (x + 255) & ~(size_t)255; }
constexpr size_t WS_CTL = 0, CTL_ZERO_BYTES = 1 * MiB;
constexpr size_t WS_MODV = 1 * MiB;
constexpr size_t WS_ROPE = WS_MODV + al256((size_t)2 * 5 * MODW * 4);
constexpr size_t WS_CNTWG = WS_ROPE + al256(64 * 16 * 2 * 4);
constexpr size_t WS_TOKE = WS_CNTWG + al256(256 * 8 * 4);
constexpr size_t WS_TOKP = WS_TOKE + al256((size_t)ML * 2 * 4);
constexpr size_t WS_TOKW = WS_TOKP + al256((size_t)ML * 2 * 4);
constexpr size_t WS_TOKS = WS_TOKW + al256((size_t)ML * 2 * 4);
constexpr size_t WS_TILE = WS_TOKS + al256((size_t)ML * 2 * 4);
constexpr size_t WS_WIN = 4 * MiB;
constexpr size_t WS_WBR = WS_WIN + (size_t)2 * INW * D * 2;
constexpr size_t WS_WOUT = WS_WBR + (size_t)2 * 3 * D * 512 * 2;
constexpr size_t WS_WGU0 = WS_WOUT + (size_t)2 * D * D * 2;
constexpr size_t WS_WDN0 = WS_WGU0 + (size_t)2 * DFF * D * 2;
constexpr size_t WS_WMGU = WS_WDN0 + (size_t)D * DFF * 2;
constexpr size_t WS_WMDN = WS_WMGU + (size_t)NE * 2 * DFE * D * 2;
constexpr size_t WS_H = WS_WMDN + (size_t)NE * D * DFE * 2;
constexpr size_t WS_Z = WS_H + (size_t)MT * D * 2;
constexpr size_t WS_MIX = WS_Z + (size_t)MT * INW * 2;
constexpr size_t WS_ACT = WS_Z;
constexpr size_t WS_YACC = WS_MIX + (size_t)MT * MIXW * 2;
constexpr size_t WS_H2S = WS_YACC;
constexpr size_t WS_Y = WS_YACC + (size_t)MT * D * 4;
constexpr size_t WS_X1 = WS_Y + (size_t)MT * D * 2;
constexpr size_t WS_X2 = WS_X1 + (size_t)MT * D * 4;
constexpr size_t WS_YS = WS_X2;
constexpr size_t WS_H8 = WS_X2 + (size_t)MT * D * 4;
constexpr size_t WS_WIN8 = WS_H8 + (size_t)MT * D;
constexpr size_t WS_END = WS_WIN8 + (size_t)2 * 3 * D * D;
static_assert((size_t)MS * DFE * 2 <= (size_t)MT * INW * 2 + (size_t)MT * MIXW * 2, "ACT overlay");
static_assert((size_t)MS * D * 2 <= (size_t)MT * D * 4, "H2S / YS overlays");
static_assert(WS_TILE + 1024 <= WS_WIN, "small tables");
constexpr int CW_BAR = 4096;

constexpr int RING_BYTES = 131072;
constexpr int LDSCTL_OFF = 146944, MISC_OFF = LDSCTL_OFF + 320;
constexpr int LDS_BYTES = 147456;

#define XB_TMO      128
#define XB_XCNT(j)  (256  + 64 * (j))
#define XB_XSUB(j)  (1280 + 64 * (j))
#define XB_XGEN(j)  (2304 + 64 * (j))
#define XB_TOP      3328
#define XB_TOPGEN   3392
#define XCD_BAR_WORDS 3456
#define XB_SPIN_CAP (1u << 18)
__device__ __forceinline__ unsigned xb_ld(unsigned* p)              { return __hip_atomic_load(p, __ATOMIC_RELAXED, __HIP_MEMORY_SCOPE_AGENT); }
__device__ __forceinline__ unsigned xb_add(unsigned* p, unsigned v) { return __hip_atomic_fetch_add(p, v, __ATOMIC_RELAXED, __HIP_MEMORY_SCOPE_AGENT); }
__device__ __forceinline__ unsigned xb_xcc_id() { return (unsigned)__builtin_amdgcn_s_getreg((3 << 11) | 20) & 0xFu; }
#define XB_SPIN(cond, bar) do { unsigned _sp = 0; while (cond) { __builtin_amdgcn_s_sleep(1); \
    if ((++_sp & 255u) == 0u) { if (xb_ld(&(bar)[XB_TMO])) break; if (_sp > XB_SPIN_CAP) { atomicAdd(&(bar)[XB_TMO], 1u); break; } } } } while (0)
struct XcdBarrier { unsigned* bar; unsigned x; volatile LAS unsigned* st; };
__device__ __forceinline__ XcdBarrier xcd_barrier_post(unsigned* bar, volatile LAS unsigned* st) {
    XcdBarrier b; b.bar = bar; b.x = xb_xcc_id(); b.st = st;
    if (threadIdx.x == 0) (void)xb_add(&bar[XB_XCNT(b.x)], 1u);
    return b;
}
__device__ __forceinline__ void xcd_barrier_complete(unsigned* bar, unsigned x, unsigned& nloc, unsigned& nx) {
    const unsigned G = gridDim.x * gridDim.y * gridDim.z;
    unsigned sum, cnt, mine, sp = 0u;
    for (;;) {
        sum = 0u; cnt = 0u; mine = 0u;
#pragma unroll
        for (unsigned j = 0; j < 16; ++j) { const unsigned c = xb_ld(&bar[XB_XCNT(j)]); sum += c; cnt += (c > 0u) ? 1u : 0u; mine = (j == x) ? c : mine; }
        if (sum == G) break;
        __builtin_amdgcn_s_sleep(1);
        if ((++sp & 255u) == 0u) { if (xb_ld(&bar[XB_TMO])) break; if (sp > XB_SPIN_CAP) { atomicAdd(&bar[XB_TMO], 1u); break; } }
    }
    nloc = mine > 0u ? mine : 1u; nx = cnt > 0u ? cnt : 1u;
}
__device__ __attribute__((noinline)) void xcd_barrier_leader(unsigned* bar, unsigned bx_, volatile LAS unsigned* st) {
    {
        XcdBarrier b; b.bar = bar; b.x = bx_; b.st = st;
        __builtin_amdgcn_s_waitcnt(0);
        unsigned nloc = b.st[0], nx = b.st[1];
        if (nloc == 0u) { xcd_barrier_complete(bar, b.x, nloc, nx); b.st[0] = nloc; b.st[1] = nx; }
        const unsigned old = xb_add(&bar[XB_XSUB(b.x)], 1u);
        const unsigned gen = old / nloc;
        if (old + 1u == (gen + 1u) * nloc) {
            __builtin_amdgcn_fence(__ATOMIC_RELEASE, "agent");
            asm volatile("s_waitcnt vmcnt(0)" ::: "memory");
            const unsigned og = xb_add(&bar[XB_TOP], 1u);
            const unsigned tg = og / nx;
            if (og + 1u == (tg + 1u) * nx) xb_add(&bar[XB_TOPGEN], 1u);
            else XB_SPIN(xb_ld(&bar[XB_TOPGEN]) == tg, bar);
            __builtin_amdgcn_fence(__ATOMIC_ACQUIRE, "agent");
            xb_add(&bar[XB_XGEN(b.x)], 1u);
            asm volatile("s_waitcnt vmcnt(0)" ::: "memory");
        } else {
            XB_SPIN(xb_ld(&bar[XB_XGEN(b.x)]) == gen, bar);
            __builtin_amdgcn_fence(__ATOMIC_ACQUIRE, "agent");
            asm volatile("s_waitcnt vmcnt(0)" ::: "memory");
        }
    }
}
__device__ __forceinline__ void xcd_barrier(const XcdBarrier& b) {
    asm volatile("s_waitcnt vmcnt(0)" ::: "memory");
    __syncthreads();
    if (threadIdx.x == 0) xcd_barrier_leader(b.bar, b.x, b.st);
    __syncthreads();
}

struct Args {
    const float *x, *c, *ctx, *c_ctx, *norm1_g, *norm2_g, *final_g, *w_mod, *b_mod, *w_in, *conv_w, *sink, *pool_w, *pool_scale, *w_branch, *w_out,
                *ffn_w_gu, *ffn_w_down, *router_w, *moe_w_gu, *moe_w_down;
    float* out; unsigned char* ws; int ph_lo, ph_hi;
};
template <int OFF> __device__ __forceinline__ const void* karg_p() { const void* r; asm volatile("s_load_dwordx2 %0, %1, %2\n\ts_waitcnt lgkmcnt(0)" : "=s"(r) : "s"(__builtin_amdgcn_kernarg_segment_ptr()), "i"(OFF)); return r; }
template <int OFF> __device__ __forceinline__ int karg_i() { int r; asm volatile("s_load_dword %0, %1, %2\n\ts_waitcnt lgkmcnt(0)" : "=s"(r) : "s"(__builtin_amdgcn_kernarg_segment_ptr()), "i"(OFF)); return r; }
#define KP(field) ((const float*)karg_p<(int)__builtin_offsetof(Args, field)>())
struct Frame {
    LAS unsigned char* lds;
    int tid, lane, wave, G, bx;
    unsigned char* ws;
};
__device__ __forceinline__ float wave_sum(float v) {
#pragma unroll
    for (int o = 1; o < 64; o <<= 1) v += __shfl_xor(v, o);
    return v;
}
__device__ __forceinline__ float wave_max(float v) {
#pragma unroll
    for (int o = 1; o < 64; o <<= 1) v = fmaxf(v, __shfl_xor(v, o));
    return v;
}
#define LDS_WAIT() asm volatile("s_waitcnt lgkmcnt(0)" ::: "memory")

template <bool F8>
__device__ __forceinline__ void p0_transpose_item(const float* W, int ldw, bf16* WT, int ldt, int koff, int k0, int n0, int drow0, LAS float* scr, int lane) {
    f32x4 v[16];
    const int rl = lane >> 4, c4 = 4 * (lane & 15);
#pragma unroll
    for (int i = 0; i < 16; ++i) v[i] = __builtin_nontemporal_load((const f32x4*)(W + (size_t)(k0 + 4 * i + rl) * ldw + n0 + c4));
#pragma unroll
    for (int i = 0; i < 16; ++i) { LAS float* p = scr + (4 * i + rl) * 65 + c4; p[0] = v[i].x; p[1] = v[i].y; p[2] = v[i].z; p[3] = v[i].w; }
    LDS_WAIT(); asm volatile("" ::: "memory");
    const int c = lane & 7;
#pragma unroll
    for (int j = 0; j < 8; ++j) { const int n = (lane >> 3) + 8 * j; const LAS float* sp = scr + (8 * c) * 65 + n;
        if constexpr (F8) { u32x2 o; o.x = pk4_fp8(sp[0 * 65] * W8SCALE, sp[1 * 65] * W8SCALE, sp[2 * 65] * W8SCALE, sp[3 * 65] * W8SCALE); o.y = pk4_fp8(sp[4 * 65] * W8SCALE, sp[5 * 65] * W8SCALE, sp[6 * 65] * W8SCALE, sp[7 * 65] * W8SCALE);
            *(u32x2*)((unsigned char*)WT + (size_t)(drow0 + n) * ldt + koff + k0 + 8 * c) = o; }
        else { u32x4 o; o.x = pk2(sp[0 * 65], sp[1 * 65]); o.y = pk2(sp[2 * 65], sp[3 * 65]); o.z = pk2(sp[4 * 65], sp[5 * 65]); o.w = pk2(sp[6 * 65], sp[7 * 65]);
            *(u32x4*)(WT + (size_t)(drow0 + n) * ldt + koff + k0 + 8 * c) = o; } }
    LDS_WAIT(); asm volatile("" ::: "memory");
}
template <bool F8>
__device__ __forceinline__ void p0_job_item(const float* W, int ldw, int K, int N, bf16* WT, int ldt, int koff, int IL, int item, LAS float* scr, int lane) {
    const int nblk = N / 64, kb = item / nblk, nb = item % nblk, n0 = 64 * nb;
    int drow0 = n0;
    if (IL > 0) { const int half = n0 >= IL ? 1 : 0, f = n0 - half * IL; drow0 = 256 * (f / 128) + 128 * half + (f % 128); }
    p0_transpose_item<F8>(W, ldw, WT, ldt, koff, 64 * kb, n0, drow0, scr, lane);
}
__device__ __forceinline__ void p0_prologue(Frame& F) {
    LAS float* scr = (LAS float*)(F.lds + F.wave * 16640);
    const int gw = F.bx * NWAVES + F.wave, NGW = F.G * NWAVES;
    constexpr int I_IN = (D / 64) * (ZG / 64), I_IN8 = (D / 64) * (3 * D / 64), I_BR = (512 / 64) * (D / 64), I_OUT = (D / 64) * (D / 64), I_GU0 = (D / 64) * (2 * DFF / 64), I_DN0 = (DFF / 64) * (D / 64),
                  I_MGU = (D / 64) * (2 * DFE / 64), I_MDN = (DFE / 64) * (D / 64);
    constexpr int NITEMS = 2 * I_IN + 2 * I_IN8 + 4 * I_BR + 2 * I_OUT + I_GU0 + I_DN0 + NE * I_MGU + NE * I_MDN;
    bf16* const wsb = (bf16*)F.ws;
    for (int it = gw; it < NITEMS; it += NGW) {
        int r = it;
        if (r < NE * I_MGU) { const int e = r / I_MGU; p0_job_item<true>(KP(moe_w_gu) + (size_t)e * D * 2 * DFE, 2 * DFE, D, 2 * DFE, (bf16*)(F.ws + WS_WMGU + (size_t)e * 2 * DFE * D), D, 0, DFE, r % I_MGU, scr, F.lane); continue; } r -= NE * I_MGU;
        if (r < NE * I_MDN) { const int e = r / I_MDN; p0_job_item<true>(KP(moe_w_down) + (size_t)e * DFE * D, D, DFE, D, (bf16*)(F.ws + WS_WMDN + (size_t)e * D * DFE), DFE, 0, 0, r % I_MDN, scr, F.lane); continue; } r -= NE * I_MDN;
        if (r < 2 * I_IN) { const int l = r / I_IN; p0_job_item<false>(KP(w_in) + (size_t)l * D * INW, INW, D, ZG, (bf16*)(F.ws + WS_WIN) + (size_t)l * ZG * D, D, 0, 0, r % I_IN, scr, F.lane); continue; } r -= 2 * I_IN;
        if (r < 2 * I_IN8) { const int l = r / I_IN8; p0_job_item<true>(KP(w_in) + (size_t)l * D * INW + ZG, INW, D, 3 * D, (bf16*)(F.ws + WS_WIN8 + (size_t)l * 3 * D * D), D, 0, 0, r % I_IN8, scr, F.lane); continue; } r -= 2 * I_IN8;
        if (r < 4 * I_BR) { const int j = r / I_BR, l = j >> 1, b = j & 1; p0_job_item<false>(KP(w_branch) + (size_t)(l * 3 + b) * 512 * D, D, 512, D, (bf16*)(F.ws + WS_WBR) + (size_t)l * D * MIXW, MIXW, 512 * b, 0, r % I_BR, scr, F.lane); continue; } r -= 4 * I_BR;
        if (r < 2 * I_OUT) { const int l = r / I_OUT; p0_job_item<false>(KP(w_out) + (size_t)l * D * D, D, D, D, (bf16*)(F.ws + WS_WOUT) + (size_t)l * D * D, D, 0, 0, r % I_OUT, scr, F.lane); continue; } r -= 2 * I_OUT;
        if (r < I_GU0) { p0_job_item<FFN0_FP8 != 0>(KP(ffn_w_gu), 2 * DFF, D, 2 * DFF, (bf16*)(F.ws + WS_WGU0), D, 0, DFF, r, scr, F.lane); continue; } r -= I_GU0;
        p0_job_item<(FFN0_FP8 || DN0_FP8)>(KP(ffn_w_down), D, DFF, D, (bf16*)(F.ws + WS_WDN0), DFF, 0, 0, r, scr, F.lane);
    }
    (void)wsb;
    __syncthreads();
    constexpr int I_MOD = 2 * (MODW / 64), I_FOLD = 2 * 4 * (D / 64);
    for (int it = F.bx; it < I_MOD + I_FOLD + 1; it += F.G) {
        if (it < I_MOD) {
            const int l = it / (MODW / 64), cb = it % (MODW / 64);
            LAS float* sv = (LAS float*)F.lds;
            LAS float* red = (LAS float*)(F.lds + 32768);
            for (int i = F.tid; i < 5 * D; i += NTHR) { const int r = i / D, k = i % D; const float v = r < 4 ? KP(c)[r * D + k] : KP(c_ctx)[k]; sv[i] = v / (1.f + __expf(-v)); }
            __syncthreads();
            const int col = cb * 64 + F.lane; const float* wp = KP(w_mod) + (size_t)l * D * MODW + col;
            float a0 = 0.f, a1 = 0.f, a2 = 0.f, a3 = 0.f, a4 = 0.f;
#pragma unroll 8
            for (int kk = 0; kk < 128; ++kk) { const int k = F.wave * 128 + kk; const float w = wp[(size_t)k * MODW];
                a0 += sv[k] * w; a1 += sv[D + k] * w; a2 += sv[2 * D + k] * w; a3 += sv[3 * D + k] * w; a4 += sv[4 * D + k] * w; }
            red[(F.wave * 5 + 0) * 64 + F.lane] = a0; red[(F.wave * 5 + 1) * 64 + F.lane] = a1; red[(F.wave * 5 + 2) * 64 + F.lane] = a2;
            red[(F.wave * 5 + 3) * 64 + F.lane] = a3; red[(F.wave * 5 + 4) * 64 + F.lane] = a4;
            __syncthreads();
            if (F.tid < 320) { const int r = F.tid / 64, ln = F.tid % 64; float s = 0.f;
#pragma unroll
                for (int w = 0; w < 8; ++w) s += red[(w * 5 + r) * 64 + ln];
                const int cc = cb * 64 + ln;
                ((float*)(F.ws + WS_MODV))[(size_t)(l * 5 + r) * MODW + cc] = s + KP(b_mod)[l * MODW + cc]; }
            __syncthreads();
        } else if (it < I_MOD + I_FOLD) {
            const int r = it - I_MOD, l = r / 64, g = (r % 64) / 16, nb = r % 16;
            LAS float* pw = (LAS float*)F.lds;
            const float* pws = KP(pool_w) + (size_t)(l * 4 + g) * 128 * 128;
            for (int i = F.tid; i < 128 * 128; i += NTHR) pw[i] = pws[i];
            __syncthreads();
            const int n = nb * 64 + F.lane; const float* w2 = KP(w_branch) + (size_t)(l * 3 + 2) * 512 * D + (size_t)(128 * g) * D + n;
            const float* ps = KP(pool_scale) + l * 512 + 128 * g;
            float acc[16];
#pragma unroll
            for (int q = 0; q < 16; ++q) acc[q] = 0.f;
            for (int j = 0; j < 128; ++j) { const float wv = w2[(size_t)j * D] * ps[j];
#pragma unroll
                for (int q = 0; q < 16; ++q) acc[q] += pw[(F.wave * 16 + q) * 128 + j] * wv; }
            bf16* dst = (bf16*)(F.ws + WS_WBR) + (size_t)l * D * MIXW + (size_t)n * MIXW + 1024 + 128 * g + F.wave * 16;
            u32x4 o0, o1; o0.x = pk2(acc[0], acc[1]); o0.y = pk2(acc[2], acc[3]); o0.z = pk2(acc[4], acc[5]); o0.w = pk2(acc[6], acc[7]);
            o1.x = pk2(acc[8], acc[9]); o1.y = pk2(acc[10], acc[11]); o1.z = pk2(acc[12], acc[13]); o1.w = pk2(acc[14], acc[15]);
            *(u32x4*)dst = o0; *(u32x4*)(dst + 8) = o1;
            __syncthreads();
        } else {
            for (int i = F.tid; i < 64 * 16; i += NTHR) { const int pos = i / 16, fi = i % 16;
                const float inv = powf(10000.0f, -(float)fi / 16.0f); const float ang = (float)pos * inv;
                ((float*)(F.ws + WS_ROPE))[2 * i] = cosf(ang); ((float*)(F.ws + WS_ROPE))[2 * i + 1] = sinf(ang); }
        }
    }
}

template <bool ROUTER, int OUTM = 0, bool INB = false>
__device__ __forceinline__ void norm_mod_phase(Frame& F, const float* xl, const float* xc, const float* gvec, const float* modl, int shi, int sci, int nrows, const float* router_w) {
    bf16* H = (bf16*)(F.ws + WS_H);
    LAS int* lcnt = (LAS int*)F.lds;
    if (ROUTER) { if (F.tid < 8) lcnt[F.tid] = 0; __syncthreads(); }
    if constexpr (!ROUTER) {
        const int nwv = F.G * NWAVES, gw = F.bx * NWAVES + F.wave;
        for (int r0 = gw; r0 < nrows; r0 += 2 * nwv) {
            const bool has1 = r0 + nwv < nrows; const int r1 = has1 ? r0 + nwv : r0;
            const int b0 = r0 < ML ? r0 / SEQ : 4, b1 = r1 < ML ? r1 / SEQ : 4;
            const size_t o0 = r0 < ML ? (size_t)r0 * D : (size_t)(r0 - ML) * D, o1 = r1 < ML ? (size_t)r1 * D : (size_t)(r1 - ML) * D;
            const float* x0 = (r0 < ML ? xl : xc) + o0; const float* x1 = (r1 < ML ? xl : xc) + o1;
            const bf16* y0 = (const bf16*)(r0 < ML ? xl : xc) + o0; const bf16* y1 = (const bf16*)(r1 < ML ? xl : xc) + o1;
            const float* m0 = modl + (size_t)b0 * MODW; const float* m1 = modl + (size_t)b1 * MODW;
            f32x4 va[4], vb[4], g[4], sh0[4], sc0[4], sh1[4], sc1[4];
#pragma unroll
            for (int j = 0; j < 4; ++j) { const int c = 4 * F.lane + 256 * j;
                if constexpr (INB) { const u32x2 wa_ = *(const u32x2*)(y0 + c), wb_ = *(const u32x2*)(y1 + c); va[j] = (f32x4){bflo(wa_.x), bfhi(wa_.x), bflo(wa_.y), bfhi(wa_.y)}; vb[j] = (f32x4){bflo(wb_.x), bfhi(wb_.x), bflo(wb_.y), bfhi(wb_.y)}; }
                else { va[j] = *(const f32x4*)(x0 + c); vb[j] = *(const f32x4*)(x1 + c); } }
#pragma unroll
            for (int j = 0; j < 4; ++j) { const int c = 4 * F.lane + 256 * j; g[j] = *(const f32x4*)(gvec + c); sh0[j] = *(const f32x4*)(m0 + shi * D + c); sc0[j] = *(const f32x4*)(m0 + sci * D + c);
                sh1[j] = *(const f32x4*)(m1 + shi * D + c); sc1[j] = *(const f32x4*)(m1 + sci * D + c); }
            float sa = 0.f, sb = 0.f;
#pragma unroll
            for (int j = 0; j < 4; ++j) { sa += (va[j].x * va[j].x + va[j].y * va[j].y) + (va[j].z * va[j].z + va[j].w * va[j].w); sb += (vb[j].x * vb[j].x + vb[j].y * vb[j].y) + (vb[j].z * vb[j].z + vb[j].w * vb[j].w); }
            const float ra = 1.0f / sqrtf(wave_sum(sa) * (1.f / D) + EPS), rb = 1.0f / sqrtf(wave_sum(sb) * (1.f / D) + EPS);
#pragma unroll
            for (int j = 0; j < 4; ++j) { const int c = 4 * F.lane + 256 * j;
                const f32x4 oa = (va[j] * ra * g[j]) * (sc0[j] + 1.0f) + sh0[j], ob = (vb[j] * rb * g[j]) * (sc1[j] + 1.0f) + sh1[j];
                if constexpr (OUTM == 1) { *(unsigned*)((unsigned char*)H + (size_t)r0 * D + c) = pk4_fp8(oa.x, oa.y, oa.z, oa.w); if (has1) *(unsigned*)((unsigned char*)H + (size_t)r1 * D + c) = pk4_fp8(ob.x, ob.y, ob.z, ob.w); }
                else { u32x2 o; o.x = pk2(oa.x, oa.y); o.y = pk2(oa.z, oa.w); *(u32x2*)(H + (size_t)r0 * D + c) = o; if (has1) { o.x = pk2(ob.x, ob.y); o.y = pk2(ob.z, ob.w); *(u32x2*)(H + (size_t)r1 * D + c) = o; } }
                if constexpr (OUTM == 2) { *(unsigned*)(F.ws + WS_H8 + (size_t)r0 * D + c) = pk4_fp8(oa.x, oa.y, oa.z, oa.w); if (has1) *(unsigned*)(F.ws + WS_H8 + (size_t)r1 * D + c) = pk4_fp8(ob.x, ob.y, ob.z, ob.w); } }
        }
        return;
    }
    const int nloop = ROUTER ? 8 : (nrows + F.G * NWAVES - 1) / (F.G * NWAVES);
    for (int i = 0; i < nloop; ++i) {
        const int r = ROUTER ? (F.bx * 64 + F.wave + 8 * i) : ((i * F.G + F.bx) * NWAVES + F.wave);
        if (r >= nrows) continue;
        const int bidx = r < ML ? r / SEQ : 4;
        const size_t ro = r < ML ? (size_t)r * D : (size_t)(r - ML) * D;
        const float* xr = (r < ML ? xl : xc) + ro; const bf16* yr = (const bf16*)(r < ML ? xl : xc) + ro;
        const float* mv = modl + (size_t)bidx * MODW;
        f32x4 v[4]; float ss = 0.f;
#pragma unroll
        for (int j = 0; j < 4; ++j) { if constexpr (INB) { const u32x2 w_ = *(const u32x2*)(yr + 4 * F.lane + 256 * j); v[j] = (f32x4){bflo(w_.x), bfhi(w_.x), bflo(w_.y), bfhi(w_.y)}; } else v[j] = *(const f32x4*)(xr + 4 * F.lane + 256 * j); ss += (v[j].x * v[j].x + v[j].y * v[j].y) + (v[j].z * v[j].z + v[j].w * v[j].w); }
        const float rstd = 1.0f / sqrtf(wave_sum(ss) * (1.f / D) + EPS);
#pragma unroll
        for (int j = 0; j < 4; ++j) { const int c = 4 * F.lane + 256 * j;
            const f32x4 g = *(const f32x4*)(gvec + c), sh = *(const f32x4*)(mv + shi * D + c), sc = *(const f32x4*)(mv + sci * D + c);
            v[j] = (v[j] * rstd * g) * (sc + 1.0f) + sh;
            if constexpr (OUTM == 1) *(unsigned*)((unsigned char*)H + (size_t)r * D + c) = pk4_fp8(v[j].x, v[j].y, v[j].z, v[j].w);
            else { u32x2 o; o.x = pk2(v[j].x, v[j].y); o.y = pk2(v[j].z, v[j].w); *(u32x2*)(H + (size_t)r * D + c) = o; }
            if constexpr (OUTM == 2) *(unsigned*)(F.ws + WS_H8 + (size_t)r * D + c) = pk4_fp8(v[j].x, v[j].y, v[j].z, v[j].w); }
        if (ROUTER) {
            float lg[8];
#pragma unroll
            for (int e = 0; e < 8; ++e) lg[e] = 0.f;
#pragma unroll
            for (int j = 0; j < 4; ++j)
#pragma unroll
                for (int q = 0; q < 4; ++q) { const int c = 4 * F.lane + 256 * j + q; const f32x4 w0 = *(const f32x4*)(router_w + (size_t)c * 8), w1 = *(const f32x4*)(router_w + (size_t)c * 8 + 4); const float hv = v[j][q];
                    lg[0] += hv * w0.x; lg[1] += hv * w0.y; lg[2] += hv * w0.z; lg[3] += hv * w0.w; lg[4] += hv * w1.x; lg[5] += hv * w1.y; lg[6] += hv * w1.z; lg[7] += hv * w1.w; }
#pragma unroll
            for (int e = 0; e < 8; ++e) lg[e] = wave_sum(lg[e]);
            int e1 = 0; float v1 = lg[0];
#pragma unroll
            for (int e = 1; e < 8; ++e) if (lg[e] > v1) { v1 = lg[e]; e1 = e; }
            int e2 = -1; float v2 = -3.0e38f;
#pragma unroll
            for (int e = 0; e < 8; ++e) if (e != e1 && lg[e] > v2) { v2 = lg[e]; e2 = e; }
            const float ex = __expf(v2 - v1), w1 = 1.f / (1.f + ex), w2 = ex * w1;
            if (F.lane == 0) {
                const int p1 = atomicAdd((int*)&lcnt[e1], 1), p2 = atomicAdd((int*)&lcnt[e2], 1);
                int* te = (int*)(F.ws + WS_TOKE) + 2 * r; te[0] = e1; te[1] = e2;
                int* tp = (int*)(F.ws + WS_TOKP) + 2 * r; tp[0] = p1; tp[1] = p2;
                float* tw = (float*)(F.ws + WS_TOKW) + 2 * r; tw[0] = w1; tw[1] = w2;
            }
        }
    }
    if (ROUTER) { __syncthreads(); if (F.tid < 8) ((int*)(F.ws + WS_CNTWG))[F.bx * 8 + F.tid] = lcnt[F.tid]; __syncthreads(); }
}

__device__ __forceinline__ void moe_scatter_phase(Frame& F) {
    LAS int* tab = (LAS int*)F.lds;
    const int* cw = (const int*)(F.ws + WS_CNTWG);
    if (F.tid < 32) tab[F.tid] = 0;
    __syncthreads();
    for (int idx = F.tid; idx < F.G * 8; idx += NTHR) {
        const int c = __hip_atomic_load(cw + idx, __ATOMIC_RELAXED, __HIP_MEMORY_SCOPE_AGENT); const int w = idx >> 3, e = idx & 7;
        atomicAdd((int*)&tab[16 + e], c); if (w < F.bx) atomicAdd((int*)&tab[8 + e], c);
    }
    __syncthreads();
    if (F.tid == 0) { int off = 0; for (int e = 0; e < 8; ++e) { tab[e] = off; off += ((tab[16 + e] + 255) / 256) * 256; } tab[24] = off / 256;
        if (F.bx == 0) { int* tl = (int*)(F.ws + WS_TILE); int t = 0; for (int e = 0; e < 8; ++e) { const int n = (tab[16 + e] + 255) / 256; for (int q = 0; q < n; ++q) tl[t++] = e; } tl[200] = t; } }
    __syncthreads();
    const bf16* H = (const bf16*)(F.ws + WS_H); bf16* HS = (bf16*)(F.ws + WS_H2S);
    for (int i = 0; i < 8; ++i) {
        const int r = F.bx * 64 + F.wave + 8 * i; if (r >= ML) continue;
        const int* te = (const int*)(F.ws + WS_TOKE) + 2 * r; const int* tp = (const int*)(F.ws + WS_TOKP) + 2 * r;
        const int e1 = te[0], e2 = te[1];
        const int s1 = tab[e1] + tab[8 + e1] + tp[0], s2 = tab[e2] + tab[8 + e2] + tp[1];
        if (F.lane == 0) { int* ts = (int*)(F.ws + WS_TOKS) + 2 * r; ts[0] = s1; ts[1] = s2; }
        const u32x4 a = ((const u32x4*)((const unsigned char*)H + (size_t)r * D))[F.lane];
        ((u32x4*)((unsigned char*)HS + (size_t)s1 * D))[F.lane] = a; ((u32x4*)((unsigned char*)HS + (size_t)s2 * D))[F.lane] = a;
    }
}

__device__ __forceinline__ void final_phase(Frame& F, const float* final_g, float* out, const float* modl) {
    const bf16* X1 = (const bf16*)(F.ws + WS_X1); const bf16* YS = (const bf16*)(F.ws + WS_YS);
    const int nwv = F.G * NWAVES, gw = F.bx * NWAVES + F.wave;
    for (int r0 = gw; r0 < ML; r0 += 2 * nwv) {
        const bool has1 = r0 + nwv < ML; const int r1 = has1 ? r0 + nwv : r0;
        const float* ga = modl + (size_t)(r0 / SEQ) * MODW + 5 * D; const float* gb = modl + (size_t)(r1 / SEQ) * MODW + 5 * D;
        const int* tsa = (const int*)(F.ws + WS_TOKS) + 2 * r0; const int* tsb = (const int*)(F.ws + WS_TOKS) + 2 * r1;
        const float* twa = (const float*)(F.ws + WS_TOKW) + 2 * r0; const float* twb = (const float*)(F.ws + WS_TOKW) + 2 * r1;
        const int a1 = tsa[0], a2 = tsa[1], b1 = tsb[0], b2 = tsb[1]; const float wa1 = twa[0], wa2 = twa[1], wb1 = twb[0], wb2 = twb[1];
        f32x4 xa[4], xb[4], gva[4], gvb[4], fg[4]; u32x2 ya1[4], ya2[4], yb1[4], yb2[4];
#pragma unroll
        for (int j = 0; j < 4; ++j) { const int c = 4 * F.lane + 256 * j;
            { const u32x2 wa_ = *(const u32x2*)(X1 + (size_t)r0 * D + c), wb_ = *(const u32x2*)(X1 + (size_t)r1 * D + c);
              xa[j] = (f32x4){bflo(wa_.x), bfhi(wa_.x), bflo(wa_.y), bfhi(wa_.y)}; xb[j] = (f32x4){bflo(wb_.x), bfhi(wb_.x), bflo(wb_.y), bfhi(wb_.y)}; }
            ya1[j] = *(const u32x2*)(YS + (size_t)a1 * D + c); ya2[j] = *(const u32x2*)(YS + (size_t)a2 * D + c); yb1[j] = *(const u32x2*)(YS + (size_t)b1 * D + c); yb2[j] = *(const u32x2*)(YS + (size_t)b2 * D + c);
            gva[j] = *(const f32x4*)(ga + c); gvb[j] = *(const f32x4*)(gb + c); fg[j] = *(const f32x4*)(final_g + c); }
        float sa = 0.f, sb = 0.f;
#pragma unroll
        for (int j = 0; j < 4; ++j) {
            f32x4 f; f.x = wa1 * bflo(ya1[j].x) + wa2 * bflo(ya2[j].x); f.y = wa1 * bfhi(ya1[j].x) + wa2 * bfhi(ya2[j].x); f.z = wa1 * bflo(ya1[j].y) + wa2 * bflo(ya2[j].y); f.w = wa1 * bfhi(ya1[j].y) + wa2 * bfhi(ya2[j].y);
            xa[j] = xa[j] + gva[j] * f; sa += (xa[j].x * xa[j].x + xa[j].y * xa[j].y) + (xa[j].z * xa[j].z + xa[j].w * xa[j].w);
            f.x = wb1 * bflo(yb1[j].x) + wb2 * bflo(yb2[j].x); f.y = wb1 * bfhi(yb1[j].x) + wb2 * bfhi(yb2[j].x); f.z = wb1 * bflo(yb1[j].y) + wb2 * bflo(yb2[j].y); f.w = wb1 * bfhi(yb1[j].y) + wb2 * bfhi(yb2[j].y);
            xb[j] = xb[j] + gvb[j] * f; sb += (xb[j].x * xb[j].x + xb[j].y * xb[j].y) + (xb[j].z * xb[j].z + xb[j].w * xb[j].w); }
        const float ra = 1.0f / sqrtf(wave_sum(sa) * (1.f / D) + EPS), rb = 1.0f / sqrtf(wave_sum(sb) * (1.f / D) + EPS);
#pragma unroll
        for (int j = 0; j < 4; ++j) { const int c = 4 * F.lane + 256 * j;
            __builtin_nontemporal_store(xa[j] * ra * fg[j], (f32x4*)(out + (size_t)r0 * D + c)); if (has1) __builtin_nontemporal_store(xb[j] * rb * fg[j], (f32x4*)(out + (size_t)r1 * D + c)); }
    }
}

__device__ __forceinline__ void unpack8(const u32x4 w, float (&f)[8]) { f[0] = bflo(w.x); f[1] = bfhi(w.x); f[2] = bflo(w.y); f[3] = bfhi(w.y); f[4] = bflo(w.z); f[5] = bfhi(w.z); f[6] = bflo(w.w); f[7] = bfhi(w.w); }
__device__ __forceinline__ void local_mix_phase(Frame& F, const float* cw, int nrows, const bool skip16) {
    const bf16* Z = (const bf16*)(F.ws + WS_Z); bf16* MIX = (bf16*)(F.ws + WS_MIX);
    const int vcu = (F.G % 8 == 0) ? (F.bx % 8) * (F.G / 8) + F.bx / 8 : F.bx;
    const int nwk = (skip16 && F.G > 32) ? F.G - 16 : F.G, wk = (skip16 && F.G > 32) ? vcu - 16 : vcu;
    const int total = (nrows / 8) * 64, stride = nwk * NTHR;
    for (int idx = (wk < 0 ? total : wk * NTHR + F.tid); idx < total; idx += stride) {
        const int r0 = (idx >> 6) * 8, cg = idx & 63, c0 = cg * 8;
        int t0, L;
        if (r0 < ML) { t0 = r0 % SEQ; L = SEQ; } else { t0 = (r0 - ML) % CTXL; L = CTXL; }
        const bf16* zb = Z + (size_t)(r0 - t0) * INW;
        { float wa[8], wb[8], wc_[8];
          { const f32x4 a0 = *(const f32x4*)(cw + c0), a1 = *(const f32x4*)(cw + c0 + 4), b0 = *(const f32x4*)(cw + 512 + c0), b1 = *(const f32x4*)(cw + 512 + c0 + 4), d0 = *(const f32x4*)(cw + 1024 + c0), d1 = *(const f32x4*)(cw + 1024 + c0 + 4);
            wa[0] = a0.x; wa[1] = a0.y; wa[2] = a0.z; wa[3] = a0.w; wa[4] = a1.x; wa[5] = a1.y; wa[6] = a1.z; wa[7] = a1.w;
            wb[0] = b0.x; wb[1] = b0.y; wb[2] = b0.z; wb[3] = b0.w; wb[4] = b1.x; wb[5] = b1.y; wb[6] = b1.z; wb[7] = b1.w;
            wc_[0] = d0.x; wc_[1] = d0.y; wc_[2] = d0.z; wc_[3] = d0.w; wc_[4] = d1.x; wc_[5] = d1.y; wc_[6] = d1.z; wc_[7] = d1.w; }
          float pp[8], pc[8], pn[8];
#pragma unroll
          for (int q = 0; q < 8; ++q) pp[q] = 0.f;
          if (t0 > 0) { float cx[8], cc[8]; const bf16* zr = zb + (size_t)(t0 - 1) * INW; unpack8(*(const u32x4*)(zr + ZCX + c0), cx); unpack8(*(const u32x4*)(zr + ZCC + c0), cc);
#pragma unroll
              for (int q = 0; q < 8; ++q) pp[q] = cc[q] * cx[q]; }
          { float cx[8], cc[8]; const bf16* zr = zb + (size_t)t0 * INW; unpack8(*(const u32x4*)(zr + ZCX + c0), cx); unpack8(*(const u32x4*)(zr + ZCC + c0), cc);
#pragma unroll
              for (int q = 0; q < 8; ++q) pc[q] = cc[q] * cx[q]; }
#pragma unroll
          for (int i = 0; i < 8; ++i) { const int t = t0 + i;
#pragma unroll
              for (int q = 0; q < 8; ++q) pn[q] = 0.f;
              if (t + 1 < L) { float cx[8], cc[8]; const bf16* zr = zb + (size_t)(t + 1) * INW; unpack8(*(const u32x4*)(zr + ZCX + c0), cx); unpack8(*(const u32x4*)(zr + ZCC + c0), cc);
#pragma unroll
                  for (int q = 0; q < 8; ++q) pn[q] = cc[q] * cx[q]; }
              float cb[8], o[8]; unpack8(*(const u32x4*)(zb + (size_t)t * INW + ZCB + c0), cb);
#pragma unroll
              for (int q = 0; q < 8; ++q) { o[q] = cb[q] * (wa[q] * pp[q] + wb[q] * pc[q] + wc_[q] * pn[q]); pp[q] = pc[q]; pc[q] = pn[q]; }
              u32x4 w; w.x = pk2(o[0], o[1]); w.y = pk2(o[2], o[3]); w.z = pk2(o[4], o[5]); w.w = pk2(o[6], o[7]);
              *(u32x4*)(MIX + (size_t)(r0 + i) * MIXW + 512 + c0) = w; } }
        { const int hw = 1 << (c0 >> 7);
          float s[8];
#pragma unroll
          for (int q = 0; q < 8; ++q) s[q] = 0.f;
#pragma unroll
          for (int j = -8; j < 8; ++j) { const int tt = t0 + j; if (j >= -hw && j < hw && tt >= 0 && tt < L) { float u[8]; unpack8(*(const u32x4*)(zb + (size_t)tt * INW + ZPU + c0), u);
#pragma unroll
                  for (int q = 0; q < 8; ++q) s[q] += u[q]; } }
#pragma unroll
          for (int i = 0; i < 8; ++i) { const int t = t0 + i; const int lo = t - hw < 0 ? 0 : t - hw, hi = t + hw > L ? L : t + hw;
              float u0[8]; unpack8(*(const u32x4*)(zb + (size_t)t * INW + ZPU + c0), u0);
              const float inv = 1.0f / (float)(hi - lo);
              u32x4 w; w.x = pk2(s[0] * inv - u0[0], s[1] * inv - u0[1]); w.y = pk2(s[2] * inv - u0[2], s[3] * inv - u0[3]);
              w.z = pk2(s[4] * inv - u0[4], s[5] * inv - u0[5]); w.w = pk2(s[6] * inv - u0[6], s[7] * inv - u0[7]);
              *(u32x4*)(MIX + (size_t)(r0 + i) * MIXW + 1024 + c0) = w;
              if (i < 7) {
                  if (t + hw < L) { float u[8]; unpack8(*(const u32x4*)(zb + (size_t)(t + hw) * INW + ZPU + c0), u);
#pragma unroll
                      for (int q = 0; q < 8; ++q) s[q] += u[q]; }
                  if (t - hw >= 0) { float u[8]; unpack8(*(const u32x4*)(zb + (size_t)(t - hw) * INW + ZPU + c0), u);
#pragma unroll
                      for (int q = 0; q < 8; ++q) s[q] -= u[q]; } } } }
    }
}

__device__ __forceinline__ void attn_naive_phase(Frame& F, const float* sinkl, int nrows) {
    const bf16* Z = (const bf16*)(F.ws + WS_Z); bf16* MIX = (bf16*)(F.ws + WS_MIX);
    LAS float* qs = (LAS float*)(F.lds + F.wave * 10240);
    LAS float* sc = qs + 256;
    const int nunits = nrows * 2, NGW = F.G * NWAVES;
    for (int uidx = F.bx * NWAVES + F.wave; uidx < nunits; uidx += NGW) {
        const int r = uidx >> 1, kh = uidx & 1;
        int b, nloc, krow0;
        if (r < ML) { b = r / SEQ; const int t = r % SEQ; const int lo = t - 128 < 0 ? 0 : t - 128, hi = t + 128 > SEQ - 1 ? SEQ - 1 : t + 128; nloc = hi - lo + 1; krow0 = b * SEQ + lo; }
        else { b = (r - ML) / CTXL; nloc = 0; krow0 = 0; }
        const int crow0 = ML + b * CTXL, nk = nloc + CTXL;
        { const u32x2 qw = *(const u32x2*)(Z + (size_t)r * INW + ZQ + kh * 256 + 4 * F.lane); const int g = F.lane >> 4, d = (4 * F.lane) & 63;
          qs[(d + 0) * 4 + g] = bflo(qw.x); qs[(d + 1) * 4 + g] = bfhi(qw.x); qs[(d + 2) * 4 + g] = bflo(qw.y); qs[(d + 3) * 4 + g] = bfhi(qw.y); }
        LDS_WAIT(); asm volatile("" ::: "memory");
        for (int c0 = 0; c0 < nk; c0 += 64) {
            const int kk = c0 + F.lane;
            if (kk < nk) {
                const int krow = kk < nloc ? krow0 + kk : crow0 + (kk - nloc);
                const u32x4* kp = (const u32x4*)(Z + (size_t)krow * INW + ZK + kh * 64);
                f32x4 s = (f32x4){0.f, 0.f, 0.f, 0.f};
#pragma unroll
                for (int d8 = 0; d8 < 8; ++d8) { float kf[8]; unpack8(kp[d8], kf);
#pragma unroll
                    for (int q = 0; q < 8; ++q) { const f32x4 qv = *(const LAS f32x4*)(qs + (d8 * 8 + q) * 4); s += qv * kf[q]; } }
                *(LAS f32x4*)(sc + kk * 4) = s;
            }
        }
        LDS_WAIT(); asm volatile("" ::: "memory");
        f32x4 mx; { const float* sk = sinkl + kh * 4; mx = (f32x4){sk[0] * LOG2E, sk[1] * LOG2E, sk[2] * LOG2E, sk[3] * LOG2E}; }
        const f32x4 snk = mx;
        for (int kk = F.lane; kk < nk; kk += 64) { const f32x4 s = *(const LAS f32x4*)(sc + kk * 4); mx.x = fmaxf(mx.x, s.x); mx.y = fmaxf(mx.y, s.y); mx.z = fmaxf(mx.z, s.z); mx.w = fmaxf(mx.w, s.w); }
        mx.x = wave_max(mx.x); mx.y = wave_max(mx.y); mx.z = wave_max(mx.z); mx.w = wave_max(mx.w);
        f32x4 sm = (f32x4){0.f, 0.f, 0.f, 0.f};
        for (int kk = F.lane; kk < nk; kk += 64) { f32x4 s = *(const LAS f32x4*)(sc + kk * 4);
            s.x = exp2f(s.x - mx.x); s.y = exp2f(s.y - mx.y); s.z = exp2f(s.z - mx.z); s.w = exp2f(s.w - mx.w); sm += s; *(LAS f32x4*)(sc + kk * 4) = s; }
        sm.x = wave_sum(sm.x) + exp2f(snk.x - mx.x); sm.y = wave_sum(sm.y) + exp2f(snk.y - mx.y); sm.z = wave_sum(sm.z) + exp2f(snk.z - mx.z); sm.w = wave_sum(sm.w) + exp2f(snk.w - mx.w);
        LDS_WAIT(); asm volatile("" ::: "memory");
        f32x4 o = (f32x4){0.f, 0.f, 0.f, 0.f};
        const bf16* vb = Z + ZV + kh * 64 + F.lane;
#pragma unroll 4
        for (int kk = 0; kk < nk; ++kk) { const int krow = kk < nloc ? krow0 + kk : crow0 + (kk - nloc);
            const float v = bf2f((unsigned)vb[(size_t)krow * INW]); const f32x4 p = *(const LAS f32x4*)(sc + kk * 4); o += p * v; }
        bf16* op = MIX + (size_t)r * MIXW + kh * 256 + F.lane;
        op[0] = (bf16)f2bf(o.x / sm.x); op[64] = (bf16)f2bf(o.y / sm.y); op[128] = (bf16)f2bf(o.z / sm.z); op[192] = (bf16)f2bf(o.w / sm.w);
        LDS_WAIT(); asm volatile("" ::: "memory");
    }
}

typedef float f32x16 __attribute__((ext_vector_type(16)));
typedef short s16x4 __attribute__((ext_vector_type(4)));
__device__ __forceinline__ unsigned cvtpk(float lo, float hi) { f32x2 v = {lo, hi}; pg8::bf16x2_t b = __builtin_convertvector(v, pg8::bf16x2_t); return __builtin_bit_cast(unsigned, b); }
__device__ __forceinline__ s16x4 vtr(const LAS unsigned char* p) { return __builtin_bit_cast(s16x4, __builtin_amdgcn_ds_read_tr16_b64_v4i16((LAS s16x4*)p)); }
constexpr int AKP = 144, ATT_V_OFF = 128 * AKP;
__device__ __forceinline__ void attn_unit(Frame& F, const bf16* Z, bf16* MIX, const float* sinkl, const bool isctx, const int b, const int kh, const int qblk) {
    const int qrow0 = isctx ? ML + b * CTXL + qblk * 128 : b * SEQ + qblk * 128;
    const int cbase = ML + b * CTXL;
    const bool has_prev = !isctx && qblk > 0, has_next = !isctx && qblk < 31;
    const int nch = isctx ? 2 : 3 + (has_prev ? 1 : 0) + (has_next ? 1 : 0);
    const int lane = F.lane, r = lane & 31, h = lane >> 5, g = F.wave >> 1, qh = F.wave & 1, head = kh * 4 + g;
    LAS unsigned char* Ks = F.lds; LAS unsigned char* Vs = F.lds + ATT_V_OFF;
    bf16x8 qf[2][4];
#pragma unroll
    for (int sub = 0; sub < 2; ++sub)
#pragma unroll
        for (int ks = 0; ks < 4; ++ks) qf[sub][ks] = *(const bf16x8*)(Z + (size_t)(qrow0 + 64 * qh + 32 * sub + r) * INW + ZQ + head * 64 + 16 * ks + 8 * h);
    const float sk = sinkl[head] * LOG2E;
    float m[2], l[2]; f32x16 O[2][2];
#pragma unroll
    for (int sub = 0; sub < 2; ++sub) { m[sub] = sk; l[sub] = h == 0 ? 1.f : 0.f;
#pragma unroll
        for (int db = 0; db < 2; ++db)
#pragma unroll
            for (int i = 0; i < 16; ++i) O[sub][db][i] = 0.f; }
#define ATT_CHUNK(ci, row0, kind) do { if (isctx) { row0 = cbase + 128 * (ci); kind = 0; } else if ((ci) == 0) { row0 = qrow0; kind = 0; } else if ((ci) <= 2) { row0 = cbase + 128 * ((ci) - 1); kind = 0; } \
        else if ((ci) == 3 && has_prev) { row0 = qrow0 - 128; kind = 1; } else { row0 = qrow0 + 128; kind = 2; } } while (0)
    const int skey = F.tid >> 3, spart = F.tid & 7;
    u32x4 pk0, pk1, pv0, pv1;
#define ATT_LOAD(ci) do { int row0_, kind_; ATT_CHUNK(ci, row0_, kind_); (void)kind_; const bf16* kp_ = Z + (size_t)(row0_ + skey) * INW + ZK + kh * 64 + spart * 8; \
        pk0 = *(const u32x4*)kp_; pk1 = *(const u32x4*)(kp_ + (size_t)64 * INW); pv0 = *(const u32x4*)(kp_ + (ZV - ZK)); pv1 = *(const u32x4*)(kp_ + (size_t)64 * INW + (ZV - ZK)); } while (0)
    ATT_LOAD(0);
    const int grp = (lane >> 4) & 1, q4 = (lane & 15) >> 2, p4 = lane & 3;
    for (int ci = 0; ci < nch; ++ci) {
        __syncthreads();
        *(LAS u32x4*)(Ks + skey * AKP + spart * 16) = pk0; *(LAS u32x4*)(Ks + (skey + 64) * AKP + spart * 16) = pk1;
        *(LAS u32x4*)(Vs + skey * AKP + spart * 16) = pv0; *(LAS u32x4*)(Vs + (skey + 64) * AKP + spart * 16) = pv1;
        if (ci + 1 < nch) ATT_LOAD(ci + 1);
        __syncthreads();
        int row0, kind; ATT_CHUNK(ci, row0, kind); (void)row0;
        int dl = 4 * h - r - 64 * qh; asm volatile("" : "+v"(dl));
        for (int t = 0; t < 4; ++t) {
            if (kind == 1 && 32 * t + 31 < 64 * qh) continue;
            if (kind == 2 && 32 * t > 64 * qh + 63) continue;
            bf16x8 kf[4], vf[2][2];
#pragma unroll
            for (int ks = 0; ks < 4; ++ks) kf[ks] = *(const LAS bf16x8*)(Ks + (32 * t + r) * AKP + 32 * ks + 16 * h);
#pragma unroll
            for (int s = 0; s < 2; ++s)
#pragma unroll
                for (int db = 0; db < 2; ++db) { const LAS unsigned char* vp = Vs + (32 * t + 16 * s + 4 * h + q4) * AKP + (32 * db + 16 * grp + 4 * p4) * 2;
                    const s16x4 lo = vtr(vp), hi = vtr(vp + 8 * AKP); vf[s][db] = __builtin_shufflevector(lo, hi, 0, 1, 2, 3, 4, 5, 6, 7); }
#pragma unroll
            for (int sub = 0; sub < 2; ++sub) {
                if (kind == 1 && 32 * t + 31 < 64 * qh + 32 * sub) continue;
                if (kind == 2 && 32 * t > 64 * qh + 32 * sub + 31) continue;
                f32x16 S;
#pragma unroll
                for (int i = 0; i < 16; ++i) S[i] = 0.f;
#pragma unroll
                for (int ks = 0; ks < 4; ++ks) S = __builtin_amdgcn_mfma_f32_32x32x16_bf16(kf[ks], qf[sub][ks], S, 0, 0, 0);
                if (kind != 0) { const int d0 = dl + 32 * t - 32 * sub;
#pragma unroll
                    for (int i = 0; i < 16; ++i) { const int dd = d0 + (i & 3) + 8 * (i >> 2); const bool ok = kind == 1 ? (dd >= 0) : (dd <= 0); S[i] = ok ? S[i] : -1.0e30f; } }
                float tmax = S[0];
#pragma unroll
                for (int i = 1; i < 16; ++i) tmax = fmaxf(tmax, S[i]);
                tmax = fmaxf(tmax, __shfl_xor(tmax, 32));
                const float mnew = fmaxf(m[sub], tmax);
                if (__any(mnew > m[sub])) { const float alpha = __builtin_amdgcn_exp2f(m[sub] - mnew); l[sub] *= alpha; m[sub] = mnew;
#pragma unroll
                    for (int db = 0; db < 2; ++db)
#pragma unroll
                        for (int i = 0; i < 16; ++i) O[sub][db][i] *= alpha; }
                float ps = 0.f;
#pragma unroll
                for (int i = 0; i < 16; ++i) { S[i] = __builtin_amdgcn_exp2f(S[i] - m[sub]); ps += S[i]; }
                l[sub] += ps;
                u32x4 w0, w1; w0.x = cvtpk(S[0], S[1]); w0.y = cvtpk(S[2], S[3]); w0.z = cvtpk(S[4], S[5]); w0.w = cvtpk(S[6], S[7]);
                w1.x = cvtpk(S[8], S[9]); w1.y = cvtpk(S[10], S[11]); w1.z = cvtpk(S[12], S[13]); w1.w = cvtpk(S[14], S[15]);
                const bf16x8 P0 = __builtin_bit_cast(bf16x8, w0), P1 = __builtin_bit_cast(bf16x8, w1);
#pragma unroll
                for (int db = 0; db < 2; ++db) { O[sub][db] = __builtin_amdgcn_mfma_f32_32x32x16_bf16(vf[0][db], P0, O[sub][db], 0, 0, 0); O[sub][db] = __builtin_amdgcn_mfma_f32_32x32x16_bf16(vf[1][db], P1, O[sub][db], 0, 0, 0); }
            }
        }
    }
#undef ATT_CHUNK
#undef ATT_LOAD
#pragma unroll
    for (int sub = 0; sub < 2; ++sub) { const float lt = l[sub] + __shfl_xor(l[sub], 32), inv = 1.f / lt;
        bf16* op = MIX + (size_t)(qrow0 + 64 * qh + 32 * sub + r) * MIXW + head * 64 + 4 * h;
#pragma unroll
        for (int db = 0; db < 2; ++db)
#pragma unroll
            for (int gq = 0; gq < 4; ++gq) { u32x2 w; w.x = cvtpk(O[sub][db][4 * gq] * inv, O[sub][db][4 * gq + 1] * inv); w.y = cvtpk(O[sub][db][4 * gq + 2] * inv, O[sub][db][4 * gq + 3] * inv);
                *(u32x2*)(op + 32 * db + 8 * gq) = w; } }
}
__device__ __forceinline__ void attn_mfma_phase(Frame& F, const float* sinkl, const bool with_ctx) {
    const bf16* Z = (const bf16*)(F.ws + WS_Z); bf16* MIX = (bf16*)(F.ws + WS_MIX);
    const int vcu = (F.G % 8 == 0) ? (F.bx % 8) * (F.G / 8) + F.bx / 8 : F.bx;
    const int nun = with_ctx ? 272 : 256;
    for (int u = vcu; u < nun; u += F.G) { const bool isctx = u >= 256; const int uu = isctx ? (u - 256) : u;
        attn_unit(F, Z, MIX, sinkl, isctx, isctx ? (uu >> 2) : (uu >> 6), isctx ? ((uu >> 1) & 1) : ((uu >> 5) & 1), isctx ? (uu & 1) : (uu & 31)); }
    __syncthreads();
}

using pg8::Unit;
struct SchedStd {
    const char* A; const char* B; size_t astep, bstep; int nM, nN, G, c, nx, xpm0, xpn;
    __device__ __forceinline__ bool next(int i, Unit& u) const {
        const int L = i * G + c, nwg = nM * nN; if (L >= nwg + nx) return false;
        if (L < nwg) pg8::tile_of(L, nM, nN, u.pm, u.pn); else { u.pm = xpm0 + (L - nwg); u.pn = xpn; }
        u.tag = 0; u.a = A + (size_t)u.pm * astep; u.b = B + (size_t)u.pn * bstep; return true;
    }
};
struct SchedMoe {
    const char* A; const char* B; size_t astep, bstep_e, bstep_n; int NJ, G, c; const int* tile;
    __device__ __forceinline__ bool next(int i, Unit& u) const {
        const int nt = __builtin_amdgcn_readfirstlane(__hip_atomic_load(tile + 200, __ATOMIC_RELAXED, __HIP_MEMORY_SCOPE_AGENT));
        const int L = i * G + c; if (L >= nt * NJ) return false;
        u.pm = L % nt; u.pn = L / nt; u.tag = __builtin_amdgcn_readfirstlane(__hip_atomic_load(tile + u.pm, __ATOMIC_RELAXED, __HIP_MEMORY_SCOPE_AGENT));
        u.a = A + (size_t)u.pm * astep; u.b = B + (size_t)u.tag * bstep_e + (size_t)u.pn * bstep_n; return true;
    }
};

struct EpiGate {
    static constexpr bool PERM = true, MIDHOOK = false;
    bf16* Z;
    __device__ __forceinline__ void operator()(const f32x4 (&acc)[2][2][4][2], const Unit& u, int wr, int wc, int fr, int fq) const {
        const int row0 = u.pm * 256 + wr * 64 + fr, col0 = ZG + u.pn * 256 + wc * 32 + 8 * fq;
#pragma unroll
        for (int ai = 0; ai < 2; ++ai)
#pragma unroll
            for (int m = 0; m < 4; ++m)
#pragma unroll
                for (int bj = 0; bj < 2; ++bj) { f32x4 v0 = acc[ai][bj][m][0], v1 = acc[ai][bj][m][1];
#pragma unroll
                    for (int q = 0; q < 4; ++q) { v0[q] = __builtin_amdgcn_rcpf(1.f + __expf(-v0[q])); v1[q] = __builtin_amdgcn_rcpf(1.f + __expf(-v1[q])); }
                    u32x4 w; w.x = pg8::cvt_pk_bf16(v0[0], v0[1]); w.y = pg8::cvt_pk_bf16(v0[2], v0[3]); w.z = pg8::cvt_pk_bf16(v1[0], v1[1]); w.w = pg8::cvt_pk_bf16(v1[2], v1[3]);
                    *(u32x4*)(Z + (size_t)(row0 + ai * 128 + m * 16) * INW + col0 + bj * 128) = w; }
    }
};
struct EpiIn {
    static constexpr bool PERM = true, MIDHOOK = false;
    bf16* Z; const float* rope;
    __device__ __forceinline__ void operator()(const f32x4 (&acc)[2][2][4][2], const Unit& u, int wr, int wc, int fr, int fq) const {
        const int row0 = u.pm * 256 + wr * 64 + fr, col0 = u.pn * 256 + wc * 32 + 8 * fq;
        const bool latent = u.pm < 64, gate = u.pn >= 11;
        const float sgn = fq < 2 ? -1.f : 1.f;
#pragma unroll
        for (int ai = 0; ai < 2; ++ai)
#pragma unroll
            for (int m = 0; m < 4; ++m) { const int row = row0 + ai * 128 + m * 16; bf16* rowp = Z + (size_t)row * INW + col0;
                const int pos = (wc & 1) ? (16 * m + fr) : (4 * (u.pm & 15) + 2 * ai + wr);
#pragma unroll
                for (int bj = 0; bj < 2; ++bj) { f32x4 v0 = acc[ai][bj][m][0], v1 = acc[ai][bj][m][1];
                    const bool isq = u.pn < 2, isk = (u.pn == 2 && bj == 0);
                    if (isq || isk) {
                        if (latent) {
                            const f32x4* cs = (const f32x4*)(rope + (size_t)(pos * 16 + 8 * (fq & 1)) * 2);
                            const f32x4 t0 = cs[0], t1 = cs[1], t2 = cs[2], t3 = cs[3];
                            f32x4 p0, p1;
                            p0.x = __shfl_xor(v0.x, 32); p0.y = __shfl_xor(v0.y, 32); p0.z = __shfl_xor(v0.z, 32); p0.w = __shfl_xor(v0.w, 32);
                            p1.x = __shfl_xor(v1.x, 32); p1.y = __shfl_xor(v1.y, 32); p1.z = __shfl_xor(v1.z, 32); p1.w = __shfl_xor(v1.w, 32);
                            v0.x = v0.x * t0.x + p0.x * (sgn * t0.y); v0.y = v0.y * t0.z + p0.y * (sgn * t0.w); v0.z = v0.z * t1.x + p0.z * (sgn * t1.y); v0.w = v0.w * t1.z + p0.w * (sgn * t1.w);
                            v1.x = v1.x * t2.x + p1.x * (sgn * t2.y); v1.y = v1.y * t2.z + p1.y * (sgn * t2.w); v1.z = v1.z * t3.x + p1.z * (sgn * t3.y); v1.w = v1.w * t3.z + p1.w * (sgn * t3.w);
                        }
                        if (isq) { v0 = v0 * QSCALE; v1 = v1 * QSCALE; }
                    }
                    if (gate) {
#pragma unroll
                        for (int q = 0; q < 4; ++q) { v0[q] = 1.f / (1.f + __expf(-v0[q])); v1[q] = 1.f / (1.f + __expf(-v1[q])); } }
                    u32x4 w; w.x = pg8::cvt_pk_bf16(v0[0], v0[1]); w.y = pg8::cvt_pk_bf16(v0[2], v0[3]); w.z = pg8::cvt_pk_bf16(v1[0], v1[1]); w.w = pg8::cvt_pk_bf16(v1[2], v1[3]);
                    *(u32x4*)(rowp + bj * 128) = w; } }
    }
};
struct EpiBrG {
    static constexpr bool PERM = true, MIDHOOK = true;
    const bf16* Z; bf16* Y;
    __device__ __forceinline__ void mid(f32x4 (&acc)[2][2][4][2], const Unit& u, int seg, int wr, int wc, int fr, int fq) const {
        const int row0 = u.pm * 256 + wr * 64 + fr, col0 = u.pn * 256 + wc * 32 + 8 * fq;
#pragma unroll
        for (int ai = 0; ai < 2; ++ai)
#pragma unroll
            for (int m = 0; m < 4; ++m) { const bf16* gp = Z + (size_t)(row0 + ai * 128 + m * 16) * INW + ZG + (seg - 1) * D + col0;
#pragma unroll
                for (int bj = 0; bj < 2; ++bj) { const u32x4 ga = *(const u32x4*)(gp + bj * 128), gb = *(const u32x4*)(gp + D + bj * 128);
                    f32x4 r0, r1;
                    r0.x = bflo(ga.x) * __builtin_amdgcn_rcpf(bflo(gb.x)); r0.y = bfhi(ga.x) * __builtin_amdgcn_rcpf(bfhi(gb.x)); r0.z = bflo(ga.y) * __builtin_amdgcn_rcpf(bflo(gb.y)); r0.w = bfhi(ga.y) * __builtin_amdgcn_rcpf(bfhi(gb.y));
                    r1.x = bflo(ga.z) * __builtin_amdgcn_rcpf(bflo(gb.z)); r1.y = bfhi(ga.z) * __builtin_amdgcn_rcpf(bfhi(gb.z)); r1.z = bflo(ga.w) * __builtin_amdgcn_rcpf(bflo(gb.w)); r1.w = bfhi(ga.w) * __builtin_amdgcn_rcpf(bfhi(gb.w));
                    acc[ai][bj][m][0] *= r0; acc[ai][bj][m][1] *= r1; }
                if (m == 3) asm volatile("" ::: "memory"); }
    }
    __device__ __forceinline__ void operator()(const f32x4 (&acc)[2][2][4][2], const Unit& u, int wr, int wc, int fr, int fq) const {
        const int row0 = u.pm * 256 + wr * 64 + fr, col0 = u.pn * 256 + wc * 32 + 8 * fq;
#pragma unroll
        for (int ai = 0; ai < 2; ++ai)
#pragma unroll
            for (int m = 0; m < 4; ++m) { const size_t row = (size_t)(row0 + ai * 128 + m * 16); const bf16* gp = Z + row * INW + ZG + 2 * D + col0;
#pragma unroll
                for (int bj = 0; bj < 2; ++bj) { const u32x4 g = *(const u32x4*)(gp + bj * 128); const f32x4 v0 = acc[ai][bj][m][0], v1 = acc[ai][bj][m][1];
                    u32x4 w; w.x = pg8::cvt_pk_bf16(v0[0] * bflo(g.x), v0[1] * bfhi(g.x)); w.y = pg8::cvt_pk_bf16(v0[2] * bflo(g.y), v0[3] * bfhi(g.y));
                    w.z = pg8::cvt_pk_bf16(v1[0] * bflo(g.z), v1[1] * bfhi(g.z)); w.w = pg8::cvt_pk_bf16(v1[2] * bflo(g.w), v1[3] * bfhi(g.w));
                    *(u32x4*)(Y + row * D + col0 + bj * 128) = w; } }
    }
};
template <bool RB> struct EpiRes {
    static constexpr bool PERM = true, MIDHOOK = false;
    const void* rl; const void* rc; bf16* out; const float* gv;
    __device__ __forceinline__ void operator()(const f32x4 (&acc)[2][2][4][2], const Unit& u, int wr, int wc, int fr, int fq) const {
        const int row0 = u.pm * 256 + wr * 64 + fr, col0 = u.pn * 256 + wc * 32 + 8 * fq;
        const int bidx = u.pm < 64 ? (u.pm >> 4) : 4; const float* g = gv + (size_t)bidx * MODW;
        const size_t rshift = u.pm < 64 ? 0 : (size_t)ML * D;
        const float* rf = (const float*)(u.pm < 64 ? rl : rc) - rshift; const bf16* rb = (const bf16*)(u.pm < 64 ? rl : rc) - rshift;
        f32x4 gg[2][2];
#pragma unroll
        for (int bj = 0; bj < 2; ++bj)
#pragma unroll
            for (int n = 0; n < 2; ++n) gg[bj][n] = *(const f32x4*)(g + col0 + bj * 128 + n * 4);
#pragma unroll
        for (int ai = 0; ai < 2; ++ai)
#pragma unroll
            for (int m = 0; m < 4; ++m) { const size_t off = (size_t)(row0 + ai * 128 + m * 16) * D + col0;
#pragma unroll
                for (int bj = 0; bj < 2; ++bj) { f32x4 r0, r1;
                    if constexpr (RB) { const u32x4 w = *(const u32x4*)(rb + off + bj * 128); r0 = (f32x4){bflo(w.x), bfhi(w.x), bflo(w.y), bfhi(w.y)}; r1 = (f32x4){bflo(w.z), bfhi(w.z), bflo(w.w), bfhi(w.w)}; }
                    else { r0 = *(const f32x4*)(rf + off + bj * 128); r1 = *(const f32x4*)(rf + off + bj * 128 + 4); }
                    r0 += gg[bj][0] * acc[ai][bj][m][0]; r1 += gg[bj][1] * acc[ai][bj][m][1];
                    u32x4 o; o.x = pg8::cvt_pk_bf16(r0[0], r0[1]); o.y = pg8::cvt_pk_bf16(r0[2], r0[3]); o.z = pg8::cvt_pk_bf16(r1[0], r1[1]); o.w = pg8::cvt_pk_bf16(r1[2], r1[3]);
                    *(u32x4*)(out + off + bj * 128) = o; } }
    }
};
template <bool F8> struct EpiSwiglu {
    static constexpr bool PERM = true, MIDHOOK = false;
    unsigned char* ACT; int ldc;
    __device__ __forceinline__ void operator()(const f32x4 (&acc)[2][2][4][2], const Unit& u, int wr, int wc, int fr, int fq) const {
        const int row0 = u.pm * 256 + wr * 64 + fr, col0 = u.pn * 128 + wc * 32 + 8 * fq;
#pragma unroll
        for (int ai = 0; ai < 2; ++ai)
#pragma unroll
            for (int m = 0; m < 4; ++m) { f32x4 r[2];
#pragma unroll
                for (int n = 0; n < 2; ++n) { const f32x4 g = acc[ai][0][m][n], up = acc[ai][1][m][n];
#pragma unroll
                    for (int q = 0; q < 4; ++q) r[n][q] = g[q] * __builtin_amdgcn_rcpf(1.f + __expf(-g[q])) * up[q]; }
                if constexpr (F8) { u32x2 w; w.x = pk4_fp8(r[0][0], r[0][1], r[0][2], r[0][3]); w.y = pk4_fp8(r[1][0], r[1][1], r[1][2], r[1][3]);
                    *(u32x2*)(ACT + (size_t)(row0 + ai * 128 + m * 16) * ldc + col0) = w; }
                else { u32x4 w; w.x = pg8::cvt_pk_bf16(r[0][0], r[0][1]); w.y = pg8::cvt_pk_bf16(r[0][2], r[0][3]); w.z = pg8::cvt_pk_bf16(r[1][0], r[1][1]); w.w = pg8::cvt_pk_bf16(r[1][2], r[1][3]);
                    *(u32x4*)((bf16*)ACT + (size_t)(row0 + ai * 128 + m * 16) * ldc + col0) = w; } }
    }
};
struct EpiPlain {
    static constexpr bool PERM = true, MIDHOOK = false;
    bf16* O; int ldc;
    __device__ __forceinline__ void operator()(const f32x4 (&acc)[2][2][4][2], const Unit& u, int wr, int wc, int fr, int fq) const {
        const int row0 = u.pm * 256 + wr * 64 + fr, col0 = u.pn * 256 + wc * 32 + 8 * fq;
#pragma unroll
        for (int ai = 0; ai < 2; ++ai)
#pragma unroll
            for (int m = 0; m < 4; ++m)
#pragma unroll
                for (int bj = 0; bj < 2; ++bj) { const f32x4 v0 = acc[ai][bj][m][0], v1 = acc[ai][bj][m][1];
                    u32x4 w; w.x = pg8::cvt_pk_bf16(v0[0], v0[1]); w.y = pg8::cvt_pk_bf16(v0[2], v0[3]); w.z = pg8::cvt_pk_bf16(v1[0], v1[1]); w.w = pg8::cvt_pk_bf16(v1[2], v1[3]);
                    *(u32x4*)(O + (size_t)(row0 + ai * 128 + m * 16) * ldc + col0 + bj * 128) = w; }
    }
};

#ifndef PHASE_MASK
#define PHASE_MASK 0xFFFFFFFFu
#endif
#define IN(k) (((PHASE_MASK >> (k)) & 1u) && lo <= (k) && (k) < hi)
#define SEAM(k) do { if (IN(k) && IN((k) + 1)) xcd_barrier(bar); } while (0)
#ifndef DUP_MASK
#define DUP_MASK 0u
#endif
#define REP(k) for (int rep_ = 0; rep_ < (((DUP_MASK >> (k)) & 1u) ? 2 : 1); ++rep_, (((DUP_MASK >> (k)) & 1u) && rep_ == 1 ? xcd_barrier(bar) : (void)0))
#define SITE() do { F.ws = (unsigned char*)karg_p<(int)__builtin_offsetof(Args, ws)>(); int t_ = threadIdx.x; asm volatile("" : "+v"(t_)); F.tid = t_; F.lane = t_ & 63; } while (0)
template <int l> __device__ __forceinline__ void layer_common(Frame& F, const int lo, const int hi, const XcdBarrier& bar, LAS unsigned char* ring) {
    constexpr int pb = 1 + 8 * l;
        if (IN(pb + 0)) REP(pb + 0) { SITE(); const float* modl = (const float*)(F.ws + WS_MODV) + (size_t)l * 5 * MODW; const bf16* X2 = (const bf16*)(F.ws + WS_X2);
            const float* xl = l == 0 ? KP(x) : (const float*)X2; const float* xc = l == 0 ? KP(ctx) : (const float*)(X2 + (size_t)ML * D);
            norm_mod_phase<false, 2, l != 0>(F, xl, xc, KP(norm1_g) + l * D, modl, 0, 1, MT, nullptr); } SEAM(pb + 0);
        if (IN(pb + 1)) REP(pb + 1) { SITE();
            { SchedStd S{(const char*)(F.ws + WS_H), (const char*)(F.ws + WS_WIN) + (size_t)l * ZG * D * 2, (size_t)256 * D * 2, (size_t)256 * D * 2, l == 0 ? 68 : 64, 11, F.G, F.bx, l == 0 ? 0 : 4, 64, 2};
              EpiIn E{(bf16*)(F.ws + WS_Z), (const float*)(F.ws + WS_ROPE)};
              pg8::gemm_phase<EpiIn, SchedStd, true, true>(ring, D * 2, D * 2, D * 2, S, E); }
            { SITE(); SchedStd S{(const char*)(F.ws + WS_H8), (const char*)(F.ws + WS_WIN8) + (size_t)l * 3 * D * D, (size_t)256 * D, (size_t)256 * D, l == 0 ? 68 : 64, 12, F.G, (F.bx + 20) % F.G, 0, 0, 0};
              EpiGate E{(bf16*)(F.ws + WS_Z)};
              pg8::gemm_phase<EpiGate, SchedStd, true, true, true>(ring, D, D, D, S, E); }
        } SEAM(pb + 1);
        if (IN(pb + 2)) REP(pb + 2) { SITE(); const int nrows = l == 0 ? MT : ML; if (ATTN_NAIVE) attn_naive_phase(F, KP(sink) + l * 8, nrows); else { for (int rp_ = 0; rp_ < 1 + PROBE_ATT; ++rp_) attn_mfma_phase(F, KP(sink) + l * 8, l == 0); } for (int rp_ = 0; rp_ < 1 + PROBE_MIXL; ++rp_) local_mix_phase(F, KP(conv_w) + (size_t)l * 3 * 512, nrows, l == 0 && !ATTN_NAIVE); } SEAM(pb + 2);
        if (IN(pb + 3)) REP(pb + 3) { SITE();
            SchedStd S{(const char*)(F.ws + WS_MIX), (const char*)(F.ws + WS_WBR) + (size_t)l * D * MIXW * 2, (size_t)256 * MIXW * 2, (size_t)256 * MIXW * 2, l == 0 ? 68 : 64, 4, F.G, F.bx, 0, 0, 0};
            EpiBrG E{(const bf16*)(F.ws + WS_Z), (bf16*)(F.ws + WS_Y)};
            pg8::gemm_phase<EpiBrG, SchedStd, true, true>(ring, MIXW * 2, MIXW * 2, MIXW * 2, S, E);
        } SEAM(pb + 3);
        if (IN(pb + 4)) REP(pb + 4) { SITE(); const float* modl = (const float*)(F.ws + WS_MODV) + (size_t)l * 5 * MODW; const bf16* X2 = (const bf16*)(F.ws + WS_X2);
            const void* xl = l == 0 ? (const void*)KP(x) : (const void*)X2; const void* xc = l == 0 ? (const void*)KP(ctx) : (const void*)(X2 + (size_t)ML * D);
            SchedStd S{(const char*)(F.ws + WS_Y), (const char*)(F.ws + WS_WOUT) + (size_t)l * D * D * 2, (size_t)256 * D * 2, (size_t)256 * D * 2, l == 0 ? 68 : 64, 4, F.G, F.bx, 0, 0, 0};
            EpiRes<l != 0> E{xl, xc, (bf16*)(F.ws + WS_X1), modl + 2 * D};
            pg8::gemm_phase<EpiRes<l != 0>, SchedStd, true, true>(ring, D * 2, D * 2, D * 2, S, E);
        } SEAM(pb + 4);
}
constexpr int N_PHASES = 19;
__global__ void __launch_bounds__(NTHR, 2) mk_fwd(Args args_byval) {
    extern __shared__ __attribute__((aligned(16))) unsigned char lds_raw[];
    Frame F;
    F.lds = (LAS unsigned char*)lds_raw;
    F.tid = threadIdx.x; F.lane = F.tid & 63; F.wave = __builtin_amdgcn_readfirstlane(F.tid >> 6);
    F.G = gridDim.x; F.bx = blockIdx.x;
    SITE();
    volatile LAS unsigned* MISC = (volatile LAS unsigned*)(F.lds + MISC_OFF);
    for (int u = F.tid; u < (LDS_BYTES - LDSCTL_OFF) / 4; u += NTHR) ((LAS unsigned*)(F.lds + LDSCTL_OFF))[u] = 0u;
    __syncthreads();
    const int lo = karg_i<(int)__builtin_offsetof(Args, ph_lo)>(), hi = karg_i<(int)__builtin_offsetof(Args, ph_hi)>();
    const bool fused = (hi - lo) > 1;
    XcdBarrier bar; bar.bar = (unsigned*)(F.ws + WS_CTL) + CW_BAR; bar.x = 0; bar.st = nullptr;
    if (fused) bar = xcd_barrier_post((unsigned*)(F.ws + WS_CTL) + CW_BAR, MISC + 8);
    LAS unsigned char* ring = F.lds;

    if (IN(0)) REP(0) { SITE(); p0_prologue(F); } SEAM(0);

    layer_common<0>(F, lo, hi, bar, ring);
    {
            if (IN(6)) REP(6) { SITE(); const bf16* X1 = (const bf16*)(F.ws + WS_X1); norm_mod_phase<false, FFN0_FP8 ? 1 : 0, true>(F, (const float*)X1, (const float*)(X1 + (size_t)ML * D), KP(norm2_g), (const float*)(F.ws + WS_MODV), 3, 4, MT, nullptr); } SEAM(6);
            if (IN(7)) REP(7) { SITE();
                constexpr int EB = FFN0_FP8 ? 1 : 2;
                SchedStd S{(const char*)(F.ws + WS_H), (const char*)(F.ws + WS_WGU0), (size_t)256 * D * EB, (size_t)256 * D * EB, 68, 22, F.G, F.bx, 0, 0, 0};
                EpiSwiglu<(FFN0_FP8 || DN0_FP8)> E{(unsigned char*)(F.ws + WS_ACT), DFF};
                pg8::gemm_phase<EpiSwiglu<(FFN0_FP8 || DN0_FP8)>, SchedStd, true, true, FFN0_FP8 != 0>(ring, D * EB, D * EB, D * EB, S, E);
            } SEAM(7);
            if (IN(8)) REP(8) { SITE(); const bf16* X1 = (const bf16*)(F.ws + WS_X1);
                constexpr int EB = (FFN0_FP8 || DN0_FP8) ? 1 : 2;
                SchedStd S{(const char*)(F.ws + WS_ACT), (const char*)(F.ws + WS_WDN0), (size_t)256 * DFF * EB, (size_t)256 * DFF * EB, 68, 4, F.G, F.bx, 0, 0, 0};
                EpiRes<true> E{X1, X1 + (size_t)ML * D, (bf16*)(F.ws + WS_X2), (const float*)(F.ws + WS_MODV) + 5 * D};
                pg8::gemm_phase<EpiRes<true>, SchedStd, true, true, (FFN0_FP8 || DN0_FP8)>(ring, DFF * EB, DFF * EB, DFF * EB, S, E);
            } SEAM(8);
    }
    layer_common<1>(F, lo, hi, bar, ring);
    {
            if (IN(14)) REP(14) { SITE(); const float* X1 = (const float*)(F.ws + WS_X1); norm_mod_phase<true, 1, true>(F, X1, X1, KP(norm2_g) + D, (const float*)(F.ws + WS_MODV) + (size_t)5 * MODW, 3, 4, ML, KP(router_w)); } SEAM(14);
            if (IN(15)) REP(15) { SITE(); moe_scatter_phase(F); } SEAM(15);
            if (IN(16)) REP(16) { SITE();
                SchedMoe S{(const char*)(F.ws + WS_H2S), (const char*)(F.ws + WS_WMGU), (size_t)256 * D, (size_t)2 * DFE * D, (size_t)256 * D, 28, F.G, F.bx, (const int*)(F.ws + WS_TILE)};
                EpiSwiglu<true> E{(unsigned char*)(F.ws + WS_ACT), DFE};
                pg8::gemm_phase<EpiSwiglu<true>, SchedMoe, true, true, true>(ring, D, D, D, S, E);
            } SEAM(16);
            if (IN(17)) REP(17) { SITE();
                SchedMoe S{(const char*)(F.ws + WS_ACT), (const char*)(F.ws + WS_WMDN), (size_t)256 * DFE, (size_t)D * DFE, (size_t)256 * DFE, 4, F.G, F.bx, (const int*)(F.ws + WS_TILE)};
                EpiPlain E{(bf16*)(F.ws + WS_YS), D};
                pg8::gemm_phase<EpiPlain, SchedMoe, true, true, true>(ring, DFE, DFE, DFE, S, E);
            } SEAM(17);
            if (IN(18)) REP(18) { SITE(); final_phase(F, KP(final_g), (float*)karg_p<(int)__builtin_offsetof(Args, out)>(), (const float*)(F.ws + WS_MODV) + (size_t)5 * MODW); }
        }

#undef IN
#undef SEAM
}

extern "C" void kernel_launch(void* const* d_in, const int* in_sizes, int n_in, void* d_out, int out_size, void* d_ws, size_t ws_size, hipStream_t stream) {
    static int grid = 0;
    if (grid == 0) {
        if (n_in != 21 || out_size != ML * D || ws_size < WS_END) { fprintf(stderr, "kernel_launch: unexpected sizes (n_in %d, out %d, ws %zu < %zu)\n", n_in, out_size, ws_size, (size_t)WS_END); grid = -1; return; }
        int dev = 0, cus = 0, per_cu = 0;
        if (hipGetDevice(&dev) != hipSuccess || hipDeviceGetAttribute(&cus, hipDeviceAttributeMultiprocessorCount, dev) != hipSuccess) { grid = -1; return; }
        if (hipFuncSetAttribute((const void*)mk_fwd, hipFuncAttributeMaxDynamicSharedMemorySize, LDS_BYTES) != hipSuccess) { fprintf(stderr, "kernel_launch: hipFuncSetAttribute failed\n"); grid = -1; return; }
        if (hipOccupancyMaxActiveBlocksPerMultiprocessor(&per_cu, (const void*)mk_fwd, NTHR, LDS_BYTES) != hipSuccess || per_cu < 1) { fprintf(stderr, "kernel_launch: occupancy query says %d\n", per_cu); per_cu = 1; }
        (void)hipGetLastError();
        grid = cus;
    }
    if (grid < 0) return;
    (void)hipMemsetAsync((char*)d_ws + WS_CTL, 0, CTL_ZERO_BYTES, stream);
    Args a{};
    const float** pp = (const float**)&a;
    for (int i = 0; i < 21; ++i) pp[i] = (const float*)d_in[i];
    a.out = (float*)d_out; a.ws = (unsigned char*)d_ws;
#if MK_FUSED
    a.ph_lo = 0; a.ph_hi = N_PHASES;
    hipLaunchKernelGGL(mk_fwd, dim3(grid), dim3(NTHR), LDS_BYTES, stream, a);
#else
    for (int p = 0; p < N_PHASES; ++p) { a.ph_lo = p; a.ph_hi = p + 1; hipLaunchKernelGGL(mk_fwd, dim3(grid), dim3(NTHR), LDS_BYTES, stream, a); }
#endif
}
```
